# Optimizing an MI355X kernel written in HIP

```python
import math
import jax, jax.numpy as jnp
from jax import lax
import numpy as np

D_MODEL = 1024
BATCH = 32
SEQ = 2048
DEPTH = 4

GRID_W = 64
CTX_LEN = 256
HEAD_DIM = 64
Q_BLOCK = 128
ROPE_THETA = 10000.0
LN_EPS = 1e-6
RMS_EPS = 1e-6
NEG_INF = -1e30

NA_HEADS = 8
NA_WIN_H = 8
NA_WIN_W = 16
GQA_HEADS = 8
GQA_KV_HEADS = 2
GQA_GROUP = GQA_HEADS // GQA_KV_HEADS
DIFF_HEADS = 4
DIFF_V_DIM = 2 * HEAD_DIM
MLA_HEADS = 8
MLA_Q_RANK = 256
MLA_KV_RANK = 128
MLA_NOPE = 64
MLA_ROPE = 32
MLA_V = 64
MLA_QK = MLA_NOPE + MLA_ROPE
N_EXPERTS = 32
TOP_K = 4
D_EXPERT = 1024
SWIGLU_ALPHA = 1.702
SWIGLU_LIMIT = 7.0

DEEPNORM_ALPHA = (2 * DEPTH) ** 0.25
DEEPNORM_BETA = (8 * DEPTH) ** -0.25
N_EVEN = (DEPTH + 1) // 2
N_ODD = DEPTH // 2

NA_W = NA_HEADS * HEAD_DIM
GQA_Q_W = GQA_HEADS * HEAD_DIM
GQA_KV_W = GQA_KV_HEADS * HEAD_DIM
EVEN_SPLITS = (NA_W, NA_W, NA_W, GQA_Q_W, GQA_KV_W, GQA_KV_W)
EVEN_IN = sum(EVEN_SPLITS)
EVEN_MIX = NA_W + GQA_Q_W
DIFF_QK_W = DIFF_HEADS * 2 * HEAD_DIM
DIFF_V_W = DIFF_HEADS * DIFF_V_DIM
ODD_SPLITS = (DIFF_QK_W, DIFF_QK_W, DIFF_V_W, MLA_Q_RANK, MLA_KV_RANK, MLA_ROPE)
ODD_IN = sum(ODD_SPLITS)
ODD_MIX = DIFF_V_W + MLA_HEADS * MLA_V

kernel_name = "hybrid_na_gqa_diff_mla_moe_dit"


def layer_norm(x, g, b):
    xf = x.astype(jnp.float32)
    mu = jnp.mean(xf, axis=-1, keepdims=True)
    var = jnp.mean(jnp.square(xf - mu), axis=-1, keepdims=True)
    y = (xf - mu) * lax.rsqrt(var + LN_EPS) * g.astype(jnp.float32) + b.astype(jnp.float32)
    return y.astype(x.dtype)


def rms_norm(x, g):
    xf = x.astype(jnp.float32)
    y = xf * lax.rsqrt(jnp.mean(jnp.square(xf), axis=-1, keepdims=True) + RMS_EPS)
    return (y * g.astype(jnp.float32)).astype(x.dtype)


def _split(x, sizes):
    return jnp.split(x, [int(s) for s in np.cumsum(sizes)[:-1]], axis=-1)


def _heads(x, n):
    B, T, _ = x.shape
    return x.reshape(B, T, n, -1).transpose(0, 2, 1, 3)


def _merge_heads(x):
    B, H, T, d = x.shape
    return x.transpose(0, 2, 1, 3).reshape(B, T, H * d)


def axial_rope_tables(row_pos, col_pos, dim):
    quarter = dim // 4
    inv_freq = ROPE_THETA ** (-jnp.arange(quarter, dtype=jnp.float32) / quarter)
    ang_r = row_pos.astype(jnp.float32)[:, None] * inv_freq
    ang_c = col_pos.astype(jnp.float32)[:, None] * inv_freq
    return (jnp.cos(ang_r), jnp.sin(ang_r), jnp.cos(ang_c), jnp.sin(ang_c))


def _rotate(x, cos, sin):
    x1, x2 = jnp.split(x, 2, axis=-1)
    return jnp.concatenate([x1 * cos - x2 * sin, x1 * sin + x2 * cos], axis=-1)


def apply_axial_rope(x, tables):
    cr, sr, cc, sc = tables
    xr, xc = jnp.split(x.astype(jnp.float32), 2, axis=-1)
    return jnp.concatenate([_rotate(xr, cr, sr), _rotate(xc, cc, sc)], axis=-1).astype(x.dtype)


def _probs(q, k, scale):
    s = jnp.einsum("bkgqd,bkld->bkgql", q, k)
    return jax.nn.softmax(s.astype(jnp.float32) * scale, axis=-1)


def _joint_probs(q, k_lat, k_ctx, scale):
    s = jnp.concatenate([jnp.einsum("bkgqd,bksd->bkgqs", q, k_lat),
                         jnp.einsum("bkgqd,bkld->bkgql", q, k_ctx)], axis=-1)
    return jax.nn.softmax(s.astype(jnp.float32) * scale, axis=-1)


def _joint_values(p, v_lat, v_ctx):
    S = v_lat.shape[2]
    p = p.astype(v_lat.dtype)
    return (jnp.einsum("bkgqs,bksd->bkgqd", p[..., :S], v_lat)
            + jnp.einsum("bkgql,bkld->bkgqd", p[..., S:], v_ctx))


def _query_blocks(q):
    B, K, G, S, d = q.shape
    return q.reshape(B, K, G, S // Q_BLOCK, Q_BLOCK, d).transpose(3, 0, 1, 2, 4, 5)


def _merge_blocks(o):
    nb, B, K, G, Qb, d = o.shape
    return o.transpose(1, 2, 3, 0, 4, 5).reshape(B, K, G, nb * Qb, d)


def latent_attention(q, k_lat, v_lat, k_ctx, v_ctx, scale):
    out = lax.map(lambda qb: _joint_values(_joint_probs(qb, k_lat, k_ctx, scale), v_lat, v_ctx),
                  _query_blocks(q))
    return _merge_blocks(out)


def context_attention(q, k, v, scale):
    p = _probs(q, k, scale).astype(v.dtype)
    return jnp.einsum("bkgql,bkld->bkgqd", p, v)


def diff_latent_attention(q1, q2, k1, k2, v, k1c, k2c, vc, lam, scale):
    def one(args):
        a1, a2 = args
        p = _joint_probs(a1, k1, k1c, scale) - lam * _joint_probs(a2, k2, k2c, scale)
        return _joint_values(p, v, vc)
    return _merge_blocks(lax.map(one, (_query_blocks(q1), _query_blocks(q2))))


def diff_context_attention(q1, q2, k1, k2, v, lam, scale):
    p = _probs(q1, k1, scale) - lam * _probs(q2, k2, scale)
    return jnp.einsum("bkgql,bkld->bkgqd", p.astype(v.dtype), v)


def neighbourhood_attention(q, k, v, k_ctx, v_ctx, rpb, rows):
    B, H, S, d = q.shape
    scale = d ** -0.5
    wh = min(NA_WIN_H, rows)
    qg = q.reshape(B, H, rows, GRID_W, d).transpose(2, 0, 1, 3, 4)
    kg = k.reshape(B, H, rows, GRID_W, d)
    vg = v.reshape(B, H, rows, GRID_W, d)
    cols = jnp.arange(GRID_W)
    col_start = jnp.clip(cols - NA_WIN_W // 2, 0, GRID_W - NA_WIN_W)
    col_mask = (cols[None, :] >= col_start[:, None]) & (cols[None, :] < col_start[:, None] + NA_WIN_W)
    col_idx = jnp.clip(cols[None, :] - cols[:, None] + NA_WIN_W - 1, 0, 2 * NA_WIN_W - 2)
    rpb = rpb.astype(jnp.float32)

    def one(args):
        r, qr = args
        rs = jnp.clip(r - NA_WIN_H // 2, 0, rows - wh)
        kr = lax.dynamic_slice_in_dim(kg, rs, wh, axis=2)
        vr = lax.dynamic_slice_in_dim(vg, rs, wh, axis=2)
        row_idx = rs + jnp.arange(wh) - r + NA_WIN_H - 1
        bias = rpb[:, row_idx][:, :, col_idx].transpose(0, 2, 1, 3)
        s_loc = jnp.einsum("bhqd,bhrkd->bhqrk", qr, kr).astype(jnp.float32) * scale + bias[None]
        s_loc = jnp.where(col_mask[:, None, :], s_loc, NEG_INF).reshape(B, H, GRID_W, wh * GRID_W)
        s_ctx = jnp.einsum("bhqd,bhld->bhql", qr, k_ctx).astype(jnp.float32) * scale
        p = jax.nn.softmax(jnp.concatenate([s_loc, s_ctx], axis=-1), axis=-1).astype(v.dtype)
        p_loc = p[..., :wh * GRID_W].reshape(B, H, GRID_W, wh, GRID_W)
        return (jnp.einsum("bhqrk,bhrkd->bhqd", p_loc, vr)
                + jnp.einsum("bhql,bhld->bhqd", p[..., wh * GRID_W:], v_ctx))

    out = lax.map(one, (jnp.arange(rows), qg))
    return out.transpose(1, 2, 0, 3, 4).reshape(B, H, S, d)


def even_mixer(h_lat, h_ctx, w_in, w_out, rpb, q_gain, k_gain, rope64, rows, with_ctx):
    B, S, _ = h_lat.shape
    L = h_ctx.shape[1]
    scale = HEAD_DIM ** -0.5
    lat = _split(h_lat @ w_in, EVEN_SPLITS)
    ctp = _split(h_ctx @ w_in, EVEN_SPLITS)
    na_kc, na_vc = _heads(ctp[1], NA_HEADS), _heads(ctp[2], NA_HEADS)
    na_lat = neighbourhood_attention(_heads(lat[0], NA_HEADS), _heads(lat[1], NA_HEADS),
                                     _heads(lat[2], NA_HEADS), na_kc, na_vc, rpb, rows)
    gq = apply_axial_rope(rms_norm(_heads(lat[3], GQA_HEADS), q_gain), rope64)
    gk = apply_axial_rope(rms_norm(_heads(lat[4], GQA_KV_HEADS), k_gain), rope64)
    gv = _heads(lat[5], GQA_KV_HEADS)
    gkc = rms_norm(_heads(ctp[4], GQA_KV_HEADS), k_gain)
    gvc = _heads(ctp[5], GQA_KV_HEADS)
    g_lat = latent_attention(gq.reshape(B, GQA_KV_HEADS, GQA_GROUP, S, HEAD_DIM), gk, gv, gkc, gvc, scale)
    g_lat = g_lat.reshape(B, GQA_HEADS, S, HEAD_DIM)
    out_lat = jnp.concatenate([_merge_heads(na_lat), _merge_heads(g_lat)], axis=-1) @ w_out
    out_ctx = None
    if with_ctx:
        na_ctx = context_attention(_heads(ctp[0], NA_HEADS)[:, :, None], na_kc, na_vc, scale)[:, :, 0]
        gqc = rms_norm(_heads(ctp[3], GQA_HEADS), q_gain).reshape(B, GQA_KV_HEADS, GQA_GROUP, L, HEAD_DIM)
        g_ctx = context_attention(gqc, gkc, gvc, scale).reshape(B, GQA_HEADS, L, HEAD_DIM)
        out_ctx = jnp.concatenate([_merge_heads(na_ctx), _merge_heads(g_ctx)], axis=-1) @ w_out
    return out_lat, out_ctx


def _mla_q(cq, q_gain, w_uq, rope):
    q = _heads(rms_norm(cq, q_gain) @ w_uq, MLA_HEADS)
    q_nope, q_pe = q[..., :MLA_NOPE], q[..., MLA_NOPE:]
    if rope is not None:
        q_pe = apply_axial_rope(q_pe, rope)
    return jnp.concatenate([q_nope, q_pe], axis=-1)


def _mla_kv(ckv, k_pe, kv_gain, w_ukv, rope):
    B, T, _ = ckv.shape
    kv = _heads(rms_norm(ckv, kv_gain) @ w_ukv, MLA_HEADS)
    k_nope, v = kv[..., :MLA_NOPE], kv[..., MLA_NOPE:]
    k_pe = k_pe[:, None]
    if rope is not None:
        k_pe = apply_axial_rope(k_pe, rope)
    k = jnp.concatenate([k_nope, jnp.broadcast_to(k_pe, (B, MLA_HEADS, T, MLA_ROPE))], axis=-1)
    return k, v


def odd_mixer(h_lat, h_ctx, w_in, w_out, lq1, lk1, lq2, lk2, subln, mq_gain, w_uq, mkv_gain, w_ukv,
              lam_init, rope64, rope32, with_ctx):
    lat = _split(h_lat @ w_in, ODD_SPLITS)
    ctp = _split(h_ctx @ w_in, ODD_SPLITS)
    d_scale = HEAD_DIM ** -0.5
    m_scale = MLA_QK ** -0.5
    lam = (jnp.exp(jnp.sum(lq1.astype(jnp.float32) * lk1.astype(jnp.float32)))
           - jnp.exp(jnp.sum(lq2.astype(jnp.float32) * lk2.astype(jnp.float32))) + lam_init)
    rot = lambda t: apply_axial_rope(t, rope64)
    dq, dk, dv = _heads(lat[0], DIFF_HEADS), _heads(lat[1], DIFF_HEADS), _heads(lat[2], DIFF_HEADS)
    dkc, dvc = _heads(ctp[1], DIFF_HEADS), _heads(ctp[2], DIFF_HEADS)
    k1c, k2c = dkc[..., :HEAD_DIM], dkc[..., HEAD_DIM:]
    d_lat = diff_latent_attention(rot(dq[..., :HEAD_DIM])[:, :, None], rot(dq[..., HEAD_DIM:])[:, :, None],
                                  rot(dk[..., :HEAD_DIM]), rot(dk[..., HEAD_DIM:]), dv,
                                  k1c, k2c, dvc, lam, d_scale)[:, :, 0]
    d_lat = rms_norm(d_lat, subln) * (1.0 - lam_init)
    mk, mv = _mla_kv(lat[4], lat[5], mkv_gain, w_ukv, rope32)
    mkc, mvc = _mla_kv(ctp[4], ctp[5], mkv_gain, w_ukv, None)
    mq = _mla_q(lat[3], mq_gain, w_uq, rope32)
    m_lat = latent_attention(mq[:, :, None], mk, mv, mkc, mvc, m_scale)[:, :, 0]
    out_lat = jnp.concatenate([_merge_heads(d_lat), _merge_heads(m_lat)], axis=-1) @ w_out
    out_ctx = None
    if with_ctx:
        dqc = _heads(ctp[0], DIFF_HEADS)
        d_ctx = diff_context_attention(dqc[..., :HEAD_DIM][:, :, None], dqc[..., HEAD_DIM:][:, :, None],
                                       k1c, k2c, dvc, lam, d_scale)[:, :, 0]
        d_ctx = rms_norm(d_ctx, subln) * (1.0 - lam_init)
        mqc = _mla_q(ctp[3], mq_gain, w_uq, None)
        m_ctx = context_attention(mqc[:, :, None], mkc, mvc, m_scale)[:, :, 0]
        out_ctx = jnp.concatenate([_merge_heads(d_ctx), _merge_heads(m_ctx)], axis=-1) @ w_out
    return out_lat, out_ctx


def moe(h, router_w, router_b, w_gu, b_gu, w_down, b_down):
    B, T, D = h.shape
    t = h.reshape(B * T, D)
    logits = (t @ router_w + router_b).astype(jnp.float32)
    top_val, top_idx = lax.top_k(logits, TOP_K)
    top_w = jax.nn.softmax(top_val, axis=-1)
    gates = jnp.sum(jax.nn.one_hot(top_idx, N_EXPERTS, dtype=jnp.float32) * top_w[..., None], axis=1)

    def expert(acc, args):
        wgu, bgu, wd, bd, g = args
        gu = t @ wgu + bgu
        x_glu = jnp.minimum(gu[..., 0::2], SWIGLU_LIMIT)
        x_lin = jnp.clip(gu[..., 1::2], -SWIGLU_LIMIT, SWIGLU_LIMIT)
        y = ((x_lin + 1.0) * (x_glu * jax.nn.sigmoid(SWIGLU_ALPHA * x_glu))) @ wd + bd
        return acc + g[:, None] * y.astype(jnp.float32), None

    acc, _ = lax.scan(expert, jnp.zeros((B * T, D), jnp.float32), (w_gu, b_gu, w_down, b_down, gates.T))
    return acc.astype(h.dtype).reshape(B, T, D)


def _modulation(cvec, w, b):
    return jax.nn.silu(cvec) @ w + b


def setup_inputs(seed: int = 0) -> dict:
    key = jax.random.key(seed)
    keys = iter(jax.random.split(key, 48))

    def nrm(shape, scale):
        return jax.random.normal(next(keys), shape, jnp.float32) * scale

    def gain(shape):
        return 1.0 + nrm(shape, 0.05)

    D = D_MODEL
    beta = DEEPNORM_BETA
    return {
        "x": nrm((BATCH, SEQ, D), 1.0),
        "c": nrm((BATCH, D), 1.0),
        "ctx": nrm((BATCH, CTX_LEN, D), 1.0),
        "c_ctx": nrm((D,), 1.0),
        "mod_w": nrm((DEPTH, D, 6 * D), D ** -0.5),
        "mod_b": nrm((DEPTH, 6 * D), 0.02),
        "ln1_g": gain((DEPTH, D)),
        "ln1_b": nrm((DEPTH, D), 0.02),
        "ln2_g": gain((DEPTH, D)),
        "ln2_b": nrm((DEPTH, D), 0.02),
        "even_w_in": nrm((N_EVEN, D, EVEN_IN), D ** -0.5),
        "even_w_out": nrm((N_EVEN, EVEN_MIX, D), beta * EVEN_MIX ** -0.5),
        "na_rpb": nrm((N_EVEN, NA_HEADS, 2 * NA_WIN_H - 1, 2 * NA_WIN_W - 1), 0.2),
        "gqa_q_gain": gain((N_EVEN, HEAD_DIM)),
        "gqa_k_gain": gain((N_EVEN, HEAD_DIM)),
        "odd_w_in": nrm((N_ODD, D, ODD_IN), D ** -0.5),
        "odd_w_out": nrm((N_ODD, ODD_MIX, D), beta * ODD_MIX ** -0.5),
        "diff_lq1": nrm((N_ODD, HEAD_DIM), 0.1),
        "diff_lk1": nrm((N_ODD, HEAD_DIM), 0.1),
        "diff_lq2": nrm((N_ODD, HEAD_DIM), 0.1),
        "diff_lk2": nrm((N_ODD, HEAD_DIM), 0.1),
        "diff_subln": gain((N_ODD, DIFF_V_DIM)),
        "mla_q_gain": gain((N_ODD, MLA_Q_RANK)),
        "mla_w_uq": nrm((N_ODD, MLA_Q_RANK, MLA_HEADS * MLA_QK), MLA_Q_RANK ** -0.5),
        "mla_kv_gain": gain((N_ODD, MLA_KV_RANK)),
        "mla_w_ukv": nrm((N_ODD, MLA_KV_RANK, MLA_HEADS * (MLA_NOPE + MLA_V)), MLA_KV_RANK ** -0.5),
        "router_w": nrm((DEPTH, D, N_EXPERTS), D ** -0.5),
        "router_b": nrm((DEPTH, N_EXPERTS), 0.01),
        "exp_w_gu": nrm((DEPTH, N_EXPERTS, D, 2 * D_EXPERT), D ** -0.5),
        "exp_b_gu": nrm((DEPTH, N_EXPERTS, 2 * D_EXPERT), 0.01),
        "exp_w_down": nrm((DEPTH, N_EXPERTS, D_EXPERT, D), beta * D_EXPERT ** -0.5),
        "exp_b_down": nrm((DEPTH, N_EXPERTS, D), 0.01),
    }


def reference(x, c, ctx, c_ctx, mod_w, mod_b, ln1_g, ln1_b, ln2_g, ln2_b,
              even_w_in, even_w_out, na_rpb, gqa_q_gain, gqa_k_gain,
              odd_w_in, odd_w_out, diff_lq1, diff_lk1, diff_lq2, diff_lk2, diff_subln,
              mla_q_gain, mla_w_uq, mla_kv_gain, mla_w_ukv,
              router_w, router_b, exp_w_gu, exp_b_gu, exp_w_down, exp_b_down):
    B, S, D = x.shape
    L = ctx.shape[1]
    rows = S // GRID_W
    pos = jnp.arange(S)
    row_pos, col_pos = pos // GRID_W, pos % GRID_W
    rope64 = axial_rope_tables(row_pos, col_pos, HEAD_DIM)
    rope32 = axial_rope_tables(row_pos, col_pos, MLA_ROPE)
    for i in range(DEPTH):
        last = i == DEPTH - 1
        j = i // 2
        mod_lat = _modulation(c, mod_w[i], mod_b[i])[:, None, :]
        mod_ctx = _modulation(c_ctx, mod_w[i], mod_b[i])[None, None, :]
        sh1, sc1, g1, sh2, sc2, g2 = jnp.split(mod_lat, 6, axis=-1)
        csh1, csc1, cg1, csh2, csc2, cg2 = jnp.split(mod_ctx, 6, axis=-1)
        h_lat = x * (1.0 + sc1) + sh1
        h_ctx = ctx * (1.0 + csc1) + csh1
        if i % 2 == 0:
            o_lat, o_ctx = even_mixer(h_lat, h_ctx, even_w_in[j], even_w_out[j], na_rpb[j],
                                      gqa_q_gain[j], gqa_k_gain[j], rope64, rows, not last)
        else:
            lam_init = 0.8 - 0.6 * math.exp(-0.3 * i)
            o_lat, o_ctx = odd_mixer(h_lat, h_ctx, odd_w_in[j], odd_w_out[j], diff_lq1[j], diff_lk1[j],
                                     diff_lq2[j], diff_lk2[j], diff_subln[j], mla_q_gain[j], mla_w_uq[j],
                                     mla_kv_gain[j], mla_w_ukv[j], lam_init, rope64, rope32, not last)
        x = layer_norm(DEEPNORM_ALPHA * x + g1 * o_lat, ln1_g[i], ln1_b[i])
        if last:
            y = moe(x * (1.0 + sc2) + sh2, router_w[i], router_b[i],
                    exp_w_gu[i], exp_b_gu[i], exp_w_down[i], exp_b_down[i])
            x = layer_norm(DEEPNORM_ALPHA * x + g2 * y, ln2_g[i], ln2_b[i])
        else:
            ctx = layer_norm(DEEPNORM_ALPHA * ctx + cg1 * o_ctx, ln1_g[i], ln1_b[i])
            h2 = jnp.concatenate([ctx * (1.0 + csc2) + csh2, x * (1.0 + sc2) + sh2], axis=1)
            y = moe(h2, router_w[i], router_b[i], exp_w_gu[i], exp_b_gu[i], exp_w_down[i], exp_b_down[i])
            ctx = layer_norm(DEEPNORM_ALPHA * ctx + cg2 * y[:, :L], ln2_g[i], ln2_b[i])
            x = layer_norm(DEEPNORM_ALPHA * x + g2 * y[:, L:], ln2_g[i], ln2_b[i])
    return x
```

```cpp
#include <hip/hip_runtime.h>
#include <cstdio>
#include <cstdint>

#ifndef MK_ONE_LAUNCH
#define MK_ONE_LAUNCH 1
#endif
#ifndef PROBE_SHADOW
#define PROBE_SHADOW 0
#endif

#define GAS __attribute__((address_space(1)))
#define LAS __attribute__((address_space(3)))
#define DI __device__ __forceinline__
typedef unsigned short bf16;
typedef short bf16x8 __attribute__((ext_vector_type(8)));
typedef short s16x4 __attribute__((ext_vector_type(4)));
typedef float f32x2 __attribute__((ext_vector_type(2)));
typedef float f32x4 __attribute__((ext_vector_type(4)));
typedef float f32x16 __attribute__((ext_vector_type(16)));
typedef unsigned u32x2 __attribute__((ext_vector_type(2)));
typedef unsigned u32x4 __attribute__((ext_vector_type(4)));

constexpr int DM = 1024, NBATCH = 32, SEQ = 2048, CTXL = 256, TPB = SEQ + CTXL  ;
constexpr int T = NBATCH * TPB;
constexpr int NL = 4, NPP = 2304;
constexpr int NE = 32, DE = 1024;
constexpr int NTILE_M = T / 256;
constexpr float LOG2E = 1.4426950408889634f;
constexpr float C2 = 0.125f * LOG2E;
constexpr float C2M = 0.10206207261596575f * LOG2E;
constexpr float DN_ALPHA = 1.6817928305074290f;
constexpr float LN_EPS = 1e-6f, RMS_EPS = 1e-6f;
constexpr float LOG2_THETA = 13.287712379549449f;

constexpr size_t MiB = 1u << 20;
constexpr size_t WS_CTL = 0, CTL_ZERO_BYTES = 1 * MiB;
constexpr size_t WS_MOD = 1 * MiB;
constexpr size_t WS_WIN = 8 * MiB;
constexpr size_t WS_WOUT = 28 * MiB;
constexpr size_t WS_WUQ = 36 * MiB;
constexpr size_t WS_WUKV = 37 * MiB;
constexpr size_t WS_LIST = 40 * MiB;
constexpr size_t WS_GATE = 50 * MiB;
constexpr size_t WS_WGU = 64 * MiB;
constexpr size_t WS_WD = 576 * MiB;
constexpr size_t WS_X = 832 * MiB;
constexpr size_t WS_H = 1120 * MiB;
constexpr size_t WS_P = 1264 * MiB;
constexpr size_t WS_QM = 1588 * MiB;
constexpr size_t WS_KVM = 1696 * MiB;
constexpr size_t WS_MIX = 1840 * MiB;
constexpr size_t WS_ACT = 1984 * MiB;
constexpr size_t WS_Y = 2576 * MiB;
constexpr size_t WS_H8 = 3152 * MiB;
constexpr size_t WS_GSORT = 3224 * MiB;
constexpr size_t WS_PQ = 3234 * MiB;
constexpr size_t WS_END = 3558 * MiB;
constexpr float WGU_SCALE = 64.0f, WD_SCALE = 128.0f, Y_SCALE = 64.0f, WO_SCALE = 128.0f, MIX_SCALE = 16.0f;
#ifndef INPROJ_FP8
#define INPROJ_FP8 1
#endif
constexpr float WI_SCALE = 64.0f, H_SCALE = 8.0f;
constexpr int ACT_ROWS = T * 4 + 32 * 256;
static_assert(WS_MOD + (size_t)4 * 33 * 6144 * 4 <= WS_WIN && WS_WIN + (size_t)4 * 2304 * 1024 * 2 <= WS_WOUT && WS_LIST + (size_t)32 * T * 4 <= WS_GATE && WS_GATE + (size_t)T * 16 <= WS_WGU, "ws map 1");
static_assert(WS_X + (size_t)T * 4096 <= WS_H && WS_H + (size_t)T * 2048 <= WS_P && WS_P + (size_t)T * NPP * 2 <= WS_QM && WS_QM + (size_t)T * 768 * 2 <= WS_KVM && WS_KVM + (size_t)T * 2048 <= WS_MIX, "ws map 2");
static_assert(WS_MIX + (size_t)T * 2048 <= WS_ACT && WS_ACT + (size_t)ACT_ROWS * 2048 <= WS_Y && WS_Y + (size_t)T * 4 * 2048 <= WS_H8 && WS_H8 + (size_t)T * 1024 <= WS_GSORT && WS_GSORT + (size_t)32 * T * 4 <= WS_PQ && WS_PQ + (size_t)T * NPP * 2 <= WS_END, "ws map 3");
constexpr int CW_TMO = 0;
constexpr int CW_CNT = 1024;
constexpr int CW_BAR = 16384;
constexpr int MAX_LAUNCH = 40;
static_assert(CW_CNT + 4 * 32 * 64 <= CW_BAR && (CW_BAR + MAX_LAUNCH * 3456) * 4 <= (int)CTL_ZERO_BYTES, "ctl");

constexpr int LDS_BYTES = 147456;
constexpr int MISC_OFF = 143360;
constexpr int NWAVES = 8, NTHR = 512;

DI unsigned f2bf(float f) { unsigned u = __builtin_bit_cast(unsigned, f); return (u + 0x7fffu + ((u >> 16) & 1u)) >> 16; }
DI unsigned pk2(float lo, float hi) { return f2bf(lo) | (f2bf(hi) << 16); }
DI float bf2f(unsigned short b) { return __builtin_bit_cast(float, (unsigned)b << 16); }
DI float bflo(unsigned w) { return __builtin_bit_cast(float, w << 16); }
DI float bfhi(unsigned w) { return __builtin_bit_cast(float, w & 0xffff0000u); }
#define WS_DPP(v, ctrl, rmask) __builtin_bit_cast(float, __builtin_amdgcn_update_dpp(0, __builtin_bit_cast(int, v), ctrl, rmask, 0xf, false))
DI float wave_sum(float v) {
    v += WS_DPP(v, 0xB1, 0xf);
    v += WS_DPP(v, 0x4E, 0xf);
    v += WS_DPP(v, 0x141, 0xf);
    v += WS_DPP(v, 0x140, 0xf);
    v += WS_DPP(v, 0x142, 0xa);
    v += WS_DPP(v, 0x143, 0xc);
    return __builtin_bit_cast(float, __builtin_amdgcn_readlane(__builtin_bit_cast(int, v), 63));
}
DI float fast_exp2(float x) { return __builtin_amdgcn_exp2f(x); }
DI unsigned pk4_fp8(float a, float b, float c, float d) { unsigned w = __builtin_amdgcn_cvt_pk_fp8_f32(a, b, 0u, false); return __builtin_amdgcn_cvt_pk_fp8_f32(c, d, w, true); }
DI int opaque_tid() { int t = threadIdx.x; asm volatile("" : "+v"(t)); return t; }
DI const char* uni_ptr(const char* p) { const unsigned long long v = (unsigned long long)p; const unsigned lo = __builtin_amdgcn_readfirstlane((unsigned)v), hi = __builtin_amdgcn_readfirstlane((unsigned)(v >> 32)); return (const char*)(((unsigned long long)hi << 32) | lo); }

#define XB_TMO      128
#define XB_XCNT(j)  (256  + 64 * (j))
#define XB_XSUB(j)  (1280 + 64 * (j))
#define XB_XGEN(j)  (2304 + 64 * (j))
#define XB_TOP      3328
#define XB_TOPGEN   3392
#define XCD_BAR_WORDS 3456
#define XB_SPIN_CAP (1u << 22)
DI unsigned xb_ld(unsigned* p)              { return __hip_atomic_load(p, __ATOMIC_RELAXED, __HIP_MEMORY_SCOPE_AGENT); }
DI unsigned xb_add(unsigned* p, unsigned v) { return __hip_atomic_fetch_add(p, v, __ATOMIC_RELAXED, __HIP_MEMORY_SCOPE_AGENT); }
DI unsigned xb_xcc_id() { return (unsigned)__builtin_amdgcn_s_getreg((3 << 11) | 20) & 0xFu; }
#define XB_SPIN(cond, bar) do { unsigned _sp = 0; while (cond) { __builtin_amdgcn_s_sleep(1); \
    if ((++_sp & 255u) == 0u) { if (xb_ld(&(bar)[XB_TMO])) break; if (_sp > XB_SPIN_CAP) { atomicAdd(&(bar)[XB_TMO], 1u); break; } } } } while (0)
struct XcdBarrier { unsigned* bar; unsigned x; volatile LAS unsigned* st; };
DI XcdBarrier xcd_barrier_post(unsigned* bar, volatile LAS unsigned* st) {
    XcdBarrier b; b.bar = bar; b.x = xb_xcc_id(); b.st = st;
    if (threadIdx.x == 0) (void)xb_add(&bar[XB_XCNT(b.x)], 1u);
    return b;
}
DI void xcd_barrier_complete(unsigned* bar, unsigned x, unsigned& nloc, unsigned& nx) {
    const unsigned G = gridDim.x * gridDim.y * gridDim.z;
    unsigned sum, cnt, mine, sp = 0u;
    for (;;) {
        sum = 0u; cnt = 0u; mine = 0u;
#pragma unroll
        for (unsigned j = 0; j < 16; ++j) { const unsigned c = xb_ld(&bar[XB_XCNT(j)]); sum += c; cnt += (c > 0u) ? 1u : 0u; mine = (j == x) ? c : mine; }
        if (sum == G) break;
        __builtin_amdgcn_s_sleep(1);
        if ((++sp & 255u) == 0u) { if (xb_ld(&bar[XB_TMO])) break; if (sp > XB_SPIN_CAP) { atomicAdd(&bar[XB_TMO], 1u); break; } }
    }
    nloc = mine > 0u ? mine : 1u; nx = cnt > 0u ? cnt : 1u;
}
DI void xcd_barrier(const XcdBarrier& b) {
    asm volatile("s_waitcnt vmcnt(0)" ::: "memory");
    __syncthreads();
    if (threadIdx.x == 0) {
        unsigned* bar = b.bar;
        __builtin_amdgcn_s_waitcnt(0);
        unsigned nloc = b.st[0], nx = b.st[1];
        if (nloc == 0u) { xcd_barrier_complete(bar, b.x, nloc, nx); b.st[0] = nloc; b.st[1] = nx; }
        const unsigned old = xb_add(&bar[XB_XSUB(b.x)], 1u);
        const unsigned gen = old / nloc;
        if (old + 1u == (gen + 1u) * nloc) {
            __builtin_amdgcn_fence(__ATOMIC_RELEASE, "agent");
            asm volatile("s_waitcnt vmcnt(0)" ::: "memory");
            const unsigned og = xb_add(&bar[XB_TOP], 1u);
            const unsigned tg = og / nx;
            if (og + 1u == (tg + 1u) * nx) xb_add(&bar[XB_TOPGEN], 1u);
            else XB_SPIN(xb_ld(&bar[XB_TOPGEN]) == tg, bar);
            __builtin_amdgcn_fence(__ATOMIC_ACQUIRE, "agent");
            xb_add(&bar[XB_XGEN(b.x)], 1u);
            asm volatile("s_waitcnt vmcnt(0)" ::: "memory");
        } else {
            XB_SPIN(xb_ld(&bar[XB_XGEN(b.x)]) == gen, bar);
            __builtin_amdgcn_fence(__ATOMIC_ACQUIRE, "agent");
            asm volatile("s_waitcnt vmcnt(0)" ::: "memory");
        }
    }
    __syncthreads();
}

namespace pg8 {
constexpr int BM = 256, BK = 64, HALF = 128, HTB = HALF * BK * 2, STAGE_BYTES = 8 * HTB, NXCD = 8, WGM = 8;
DI int lds_byte(int r, int c) { const int st = (r >> 4) * 2 + (c >> 5), rr = r & 15, cc = c & 31, ob = rr * 64 + cc * 2; return st * 1024 + (ob ^ (((ob >> 9) & 1) << 5)); }
DI void stage_rc(int b, int& R, int& C) { const int st = b / 1024, sb = b % 1024, swz = sb ^ (((sb >> 9) & 1) << 5); R = (st >> 1) * 16 + swz / 64; C = (st & 1) * 32 + (swz % 64) / 2; }
DI int perm32(int rho) { const int n = rho >> 4, i = rho & 15; return 8 * (i >> 2) + 4 * n + (i & 3); }
DI void glds_s(const char* base, unsigned voff, unsigned dst) { unsigned keep;
    asm volatile("s_mov_b32 %0, m0\n\ts_mov_b32 m0, %3\n\ts_nop 4\n\tglobal_load_lds_dwordx4 %1, %2\n\ts_mov_b32 m0, %0" : "=&s"(keep) : "v"(voff), "s"(base), "s"(dst) : "memory"); }
DI void glds_dword(const char* base, unsigned voff, unsigned dst) { unsigned keep;
    asm volatile("s_mov_b32 %0, m0\n\ts_mov_b32 m0, %3\n\ts_nop 4\n\tglobal_load_lds_dword %1, %2\n\ts_mov_b32 m0, %0" : "=&s"(keep) : "v"(voff), "s"(base), "s"(dst) : "memory"); }
typedef float f32x2_cv __attribute__((ext_vector_type(2))); typedef __bf16 bf16x2_cv __attribute__((ext_vector_type(2)));
DI unsigned cvt_pk_bf16(float lo, float hi) { const f32x2_cv v = {lo, hi}; const bf16x2_cv b = __builtin_convertvector(v, bf16x2_cv); return __builtin_bit_cast(unsigned, b); }

typedef int i32x4v __attribute__((ext_vector_type(4)));
typedef int i32x8v __attribute__((ext_vector_type(8)));
DI i32x8v cat8(const bf16x8 a, const bf16x8 b) { return __builtin_shufflevector(__builtin_bit_cast(i32x4v, a), __builtin_bit_cast(i32x4v, b), 0, 1, 2, 3, 4, 5, 6, 7); }
DI void mfma_fp8_acc(f32x4& c, const i32x8v a, const i32x8v b) { asm volatile("v_mfma_f32_16x16x128_f8f6f4 %0, %1, %2, %0" : "+v"(c) : "v"(a), "v"(b)); }
DI void mfma_fp8_new(f32x4& c, const i32x8v a, const i32x8v b) { asm volatile("v_mfma_f32_16x16x128_f8f6f4 %0, %1, %2, 0" : "=&v"(c) : "v"(a), "v"(b)); }
#define MFMA_DRAIN() asm volatile("s_nop 15\n\ts_nop 15\n\ts_nop 15\n\ts_nop 15\n\ts_nop 15" ::: "memory")
struct Unit { int pm, pn, e, mt, idx; };

template <bool FP8, class Epi, class Sched>
DI void gemm_phase(LAS unsigned char* lds, const int KB_in, const Sched& S, const Epi& E) {
    int K = KB_in; asm volatile("" : "+s"(K));
    const int tid = opaque_tid(), wid = __builtin_amdgcn_readfirstlane(tid >> 6), lane = tid & 63, wr = wid >> 2, wc = wid & 3, fr = lane & 15, fq = lane >> 4;
    const int nt = K / 128;
    int Rr[2], Cc[2]; unsigned voffB[2];
#pragma unroll
    for (int i = 0; i < 2; ++i) { int R, C; stage_rc(tid * 16 + i * 8192, R, C); Rr[i] = R; Cc[i] = C; const int Rb = (R & ~31) + perm32(R & 31); voffB[i] = (unsigned)(Rb * K + C * 2); }
    const size_t kstep = (size_t)128;
    const size_t hstepB = (size_t)HALF * K;
    const unsigned ldsw = (unsigned)wid * 1024u;
    const unsigned ldsbase = (unsigned)(size_t)lds;
    const int aoff = lds_byte(wr * 64 + fr, fq * 8), boff = lds_byte(wc * 32 + fr, fq * 8);
#define PG8_SA(b, h) (((b) * 2 + (h)) * HTB)
#define PG8_SB(b, h) ((4 + (b) * 2 + (h)) * HTB)
#define PG8_STAGE(bufoff, gbase, voff) do { _Pragma("unroll") for (int _i = 0; _i < 2; ++_i) \
        glds_s((const char*)(gbase), (voff)[_i], ldsbase + (unsigned)(bufoff) + ldsw + (unsigned)(_i * 8192)); } while (0)
#define PG8_LDA(dst, b, h) do { _Pragma("unroll") for (int m = 0; m < 4; ++m) _Pragma("unroll") for (int k = 0; k < 2; ++k) dst[m][k] = *(const LAS bf16x8*)(lds + PG8_SA(b, h) + aoff + m * 2048 + k * 1024); } while (0)
#define PG8_LDB(dst, b, h) do { _Pragma("unroll") for (int n = 0; n < 2; ++n) _Pragma("unroll") for (int k = 0; k < 2; ++k) dst[n][k] = *(const LAS bf16x8*)(lds + PG8_SB(b, h) + boff + n * 2048 + k * 1024); } while (0)
#define PG8_MMA(ai, bj, At, Bt, ZC) do { __builtin_amdgcn_s_setprio(1); _Pragma("unroll") for (int m = 0; m < 4; ++m) _Pragma("unroll") for (int n = 0; n < 2; ++n) { \
        if constexpr (FP8) { if (ZC) mfma_fp8_new(acc[ai][bj][m][n], cat8(Bt[n][0], Bt[n][1]), cat8(At[m][0], At[m][1])); else mfma_fp8_acc(acc[ai][bj][m][n], cat8(Bt[n][0], Bt[n][1]), cat8(At[m][0], At[m][1])); } \
        else { acc[ai][bj][m][n] = __builtin_amdgcn_mfma_f32_16x16x32_bf16(Bt[n][0], At[m][0], acc[ai][bj][m][n], 0, 0, 0); \
               acc[ai][bj][m][n] = __builtin_amdgcn_mfma_f32_16x16x32_bf16(Bt[n][1], At[m][1], acc[ai][bj][m][n], 0, 0, 0); } } \
        __builtin_amdgcn_s_setprio(0); } while (0)
#define PG8_WAIT_V(n) asm volatile("s_waitcnt vmcnt(" #n ")" ::: "memory")
#define PG8_WAIT_L(n) asm volatile("s_waitcnt lgkmcnt(" #n ")" ::: "memory")
#define PG8_BAR __builtin_amdgcn_s_barrier()
#define PG8_SCHED __builtin_amdgcn_sched_barrier(0)
    Unit cur, nxt; int ui = 0;
    if (!S.next(0, cur)) return;
    f32x4 acc[2][2][4][2];
#define PG8_ZERO_ACC() do { if constexpr (!FP8) { _Pragma("unroll") for (int a = 0; a < 2; ++a) _Pragma("unroll") for (int b = 0; b < 2; ++b) _Pragma("unroll") for (int m = 0; m < 4; ++m) _Pragma("unroll") for (int n = 0; n < 2; ++n) acc[a][b][m][n] = (f32x4){0.f, 0.f, 0.f, 0.f}; } } while (0)
    PG8_ZERO_ACC();
    bf16x8 At[4][2], B0[2][2], B1[2][2];
    unsigned cvo0[2], cvo1[2], nvo0[2], nvo1[2];
    S.a_off(cur, Rr, Cc, cvo0, cvo1);
    asm volatile("" : "+v"(cvo0[0]), "+v"(cvo0[1]), "+v"(cvo1[0]), "+v"(cvo1[1]), "+v"(voffB[0]), "+v"(voffB[1]));
    const char* const aB = uni_ptr(S.a_base());
    const char* cB = uni_ptr(S.b_base(cur));
    PG8_STAGE(PG8_SB(0, 0), cB, voffB); PG8_STAGE(PG8_SB(0, 1), cB + hstepB, voffB); PG8_STAGE(PG8_SA(0, 0), aB, cvo0); PG8_STAGE(PG8_SA(0, 1), aB, cvo1);
    if (wr == 1) PG8_BAR;
    PG8_WAIT_V(2); PG8_BAR;
    PG8_STAGE(PG8_SB(1, 0), cB + kstep, voffB); PG8_STAGE(PG8_SA(1, 0), aB + kstep, cvo0); PG8_STAGE(PG8_SB(1, 1), cB + hstepB + kstep, voffB);
    PG8_WAIT_V(6); PG8_BAR;
    for (;;) {
        const bool has_next = S.next(ui + 1, nxt);
        const char* nB = uni_ptr(has_next ? S.b_base(nxt) : cB);
        if (has_next) { int R2[2], C2[2]; const int tid2 = opaque_tid();
#pragma unroll
            for (int i = 0; i < 2; ++i) stage_rc(tid2 * 16 + i * 8192, R2[i], C2[i]);
            S.a_off(nxt, R2, C2, nvo0, nvo1); }
        else { nvo0[0] = cvo0[0]; nvo0[1] = cvo0[1]; nvo1[0] = cvo1[0]; nvo1[1] = cvo1[1]; }
        asm volatile("" : "+v"(nvo0[0]), "+v"(nvo0[1]), "+v"(nvo1[0]), "+v"(nvo1[1]));
#define PG8_KITER(ZC_) do { \
            const bool last = (t == nt - 2); \
            const char* a1 = aB + (size_t)(t + 1) * kstep; \
            const char* a2 = last ? aB : aB + (size_t)(t + 2) * kstep; const char* b2 = last ? nB : cB + (size_t)(t + 2) * kstep; \
            const char* a3 = a2 + kstep; const char* b3 = b2 + kstep; \
            unsigned v20[2], v21[2]; \
            v20[0] = last ? nvo0[0] : cvo0[0]; v20[1] = last ? nvo0[1] : cvo0[1]; v21[0] = last ? nvo1[0] : cvo1[0]; v21[1] = last ? nvo1[1] : cvo1[1]; \
            if constexpr (Sched::HAS_FILL) { if (t == 2) S.fill_async(ui, wid, lane); } \
            PG8_LDB(B0, 0, 0); PG8_LDB(B1, 0, 1); PG8_SCHED; PG8_LDA(At, 0, 0); PG8_STAGE(PG8_SA(1, 1), a1, cvo1); \
            PG8_WAIT_V(8); PG8_WAIT_L(0); PG8_BAR; PG8_MMA(0, 0, At, B0, ZC_); PG8_MMA(0, 1, At, B1, ZC_); PG8_BAR; PG8_SCHED; \
            PG8_LDA(At, 0, 1); PG8_STAGE(PG8_SB(0, 0), b2, voffB); PG8_STAGE(PG8_SB(0, 1), b2 + hstepB, voffB); PG8_STAGE(PG8_SA(0, 0), a2, v20); \
            PG8_WAIT_V(8); PG8_WAIT_L(0); PG8_BAR; PG8_MMA(1, 0, At, B0, ZC_); PG8_MMA(1, 1, At, B1, ZC_); PG8_BAR; PG8_SCHED; \
            PG8_LDB(B0, 1, 0); PG8_LDB(B1, 1, 1); PG8_SCHED; PG8_LDA(At, 1, 0); PG8_STAGE(PG8_SA(0, 1), a2, v21); \
            PG8_WAIT_V(8); PG8_WAIT_L(0); PG8_BAR; PG8_MMA(0, 0, At, B0, false); PG8_MMA(0, 1, At, B1, false); PG8_BAR; PG8_SCHED; \
            PG8_LDA(At, 1, 1); PG8_STAGE(PG8_SB(1, 0), b3, voffB); PG8_STAGE(PG8_SB(1, 1), b3 + hstepB, voffB); PG8_STAGE(PG8_SA(1, 0), a3, v20); \
            PG8_WAIT_V(8); PG8_WAIT_L(0); PG8_BAR; PG8_MMA(1, 0, At, B0, false); PG8_MMA(1, 1, At, B1, false); PG8_BAR; PG8_SCHED; \
        } while (0)
        if constexpr (FP8) {
            { int t = 0; PG8_KITER(true); }
            for (int t = 2; t < nt; t += 2) PG8_KITER(false);
        } else {
            for (int t = 0; t < nt; t += 2) PG8_KITER(false);
        }
#undef PG8_KITER
        if (wr == 0) PG8_BAR;
        if constexpr (FP8) MFMA_DRAIN();
        { const int tid3 = opaque_tid(), wid3 = __builtin_amdgcn_readfirstlane(tid3 >> 6), lane3 = tid3 & 63; E(acc, cur, wid3 >> 2, wid3 & 3, lane3 & 15, lane3 >> 4); }
        if (!has_next) break;
        PG8_ZERO_ACC();
        cur = nxt; cB = nB; cvo0[0] = nvo0[0]; cvo0[1] = nvo0[1]; cvo1[0] = nvo1[0]; cvo1[1] = nvo1[1]; ++ui;
        if (wr == 1) PG8_BAR;
    }
    PG8_WAIT_V(0);
    PG8_BAR;
#undef PG8_SA
#undef PG8_SB
#undef PG8_STAGE
#undef PG8_LDA
#undef PG8_LDB
#undef PG8_MMA
#undef PG8_WAIT_V
#undef PG8_WAIT_L
#undef PG8_BAR
#undef PG8_SCHED
}

struct DenseSched {
    const bf16* A; int lda; const bf16* Bt; int K; int nM, nN, nwg, G, c; int skip_ctx;
    DI void init(const bf16* A_, int lda_, const bf16* Bt_, int K_, int nM_, int nN_, int G_, int c_, int skip) { A = A_; lda = lda_; Bt = Bt_; K = K_; nM = nM_; nN = nN_; nwg = nM * nN; G = G_; c = c_; skip_ctx = skip; }
    DI bool next(int i, Unit& u) const {
        const long L = (long)i * G + c; if (L >= nwg) return false;
        int wgid = (int)L; { const int q = nwg / NXCD, r = nwg % NXCD, xcd = wgid % NXCD, off = wgid / NXCD; wgid = (xcd < r ? xcd * (q + 1) : r * (q + 1) + (xcd - r) * q) + off; }
        const int nig = WGM * nN, gid = wgid / nig, fm = gid * WGM, gsz = (nM - fm) < WGM ? (nM - fm) : WGM;
        int pm = fm + ((wgid % nig) % gsz); u.pn = (wgid % nig) / gsz;
        if (skip_ctx) pm = pm + pm / 8 + 1;
        u.pm = pm; u.e = 0; u.mt = 0; u.idx = i; return true;
    }
    static constexpr bool HAS_FILL = false;
    DI void fill_async(int, int, int) const {}
    DI const char* a_base() const { return (const char*)A; }
    DI const char* b_base(const Unit& u) const { return (const char*)Bt + (size_t)u.pn * 256 * K * 2; }
    DI void a_off(const Unit& u, const int (&R)[2], const int (&C)[2], unsigned (&o0)[2], unsigned (&o1)[2]) const {
#pragma unroll
        for (int i = 0; i < 2; ++i) { o0[i] = (unsigned)((u.pm * 256 + R[i]) * lda + C[i]) * 2u; o1[i] = (unsigned)((u.pm * 256 + 128 + R[i]) * lda + C[i]) * 2u; }
    }
};

constexpr int UTAB_OFF = 131072, RTAB_OFF = 132096;
constexpr int RSLOT = 768;
struct GroupSched {
    const LAS int* tab; const LAS int* utab; LAS unsigned* rtab; int nunits;
    int nN, G, c, K;
    const char* Abase; const unsigned* list; const float* gsort; int gather;
    const char* Bbase; size_t b_estride;
    const float* bias_l; int bias_estride;
    static constexpr bool HAS_FILL = true;
    DI bool next(int i, Unit& u) const {
        if (i >= nunits) return false;
        const int w0 = __builtin_amdgcn_readfirstlane(utab[2 * i]), w1 = __builtin_amdgcn_readfirstlane(utab[2 * i + 1]);
        u.pm = w0; u.e = w1 >> 16; u.mt = (w1 >> 3) & 0x1fff; u.pn = w1 & 7; u.idx = i; return true;
    }
    DI const char* a_base() const { return Abase; }
    DI const char* b_base(const Unit& u) const { return Bbase + (size_t)u.e * b_estride + (size_t)u.pn * 256 * K; }
    DI void a_off(const Unit& u, const int (&R)[2], const int (&C)[2], unsigned (&o0)[2], unsigned (&o1)[2]) const {
        if (gather) {
            const LAS unsigned* rt = rtab + (u.idx & 1) * RSLOT;
#pragma unroll
            for (int i = 0; i < 2; ++i) { const unsigned p0 = rt[R[i]], p1 = rt[128 + R[i]];
                o0[i] = (p0 >> 2) * 1024u + (unsigned)C[i] * 2u; o1[i] = (p1 >> 2) * 1024u + (unsigned)C[i] * 2u; }
        } else {
#pragma unroll
            for (int i = 0; i < 2; ++i) { o0[i] = (unsigned)((u.pm * 256 + R[i]) * 1024 + C[i] * 2); o1[i] = (unsigned)((u.pm * 256 + 128 + R[i]) * 1024 + C[i] * 2); }
        }
    }
    DI void fill_sync(int k, int tid) const {
        Unit u; if (!next(k, u)) return;
        const int cnt = __builtin_amdgcn_readfirstlane(tab[33 + u.e]); int idx = u.mt * 256 + (tid & 255); idx = idx < cnt ? idx : cnt - 1;
        LAS unsigned* rt = rtab + (k & 1) * RSLOT;
        if (tid < 256) { rt[tid] = list[(size_t)u.e * T + idx]; rt[512 + tid] = __builtin_bit_cast(unsigned, bias_l[(size_t)u.e * bias_estride + 256 * u.pn + tid]); }
        else rt[tid] = __builtin_bit_cast(unsigned, gsort[(size_t)u.e * T + idx]);
    }
    DI void fill_async(int ui, int wid, int lane) const {
        const unsigned base = (unsigned)(size_t)rtab; const int w4 = wid & 3;
        if (gather) {
            if (wid < 4) { Unit u; if (!next(ui + 2, u)) return;
                const int cnt = __builtin_amdgcn_readfirstlane(tab[33 + u.e]); int idx = u.mt * 256 + w4 * 64 + lane; idx = idx < cnt ? idx : cnt - 1;
                glds_dword((const char*)(list + (size_t)u.e * T), (unsigned)idx * 4u, base + (unsigned)((ui & 1) * RSLOT * 4 + w4 * 256)); }
            else { Unit u; if (!next(ui + 1, u)) return;
                glds_dword((const char*)(bias_l + (size_t)u.e * bias_estride + 256 * u.pn), (unsigned)(w4 * 64 + lane) * 4u, base + (unsigned)(((ui + 1) & 1) * RSLOT * 4 + 2048 + w4 * 256)); }
        } else {
            Unit u; if (!next(ui + 1, u)) return;
            const int cnt = __builtin_amdgcn_readfirstlane(tab[33 + u.e]); int idx = u.mt * 256 + w4 * 64 + lane; idx = idx < cnt ? idx : cnt - 1;
            const unsigned dst = base + (unsigned)(((ui + 1) & 1) * RSLOT * 4 + w4 * 256);
            if (wid < 4) { glds_dword((const char*)(list + (size_t)u.e * T), (unsigned)idx * 4u, dst);
                           glds_dword((const char*)(bias_l + (size_t)u.e * bias_estride + 256 * u.pn), (unsigned)(w4 * 64 + lane) * 4u, dst + 2048u); }
            else glds_dword((const char*)(gsort + (size_t)u.e * T), (unsigned)idx * 4u, dst + 1024u);
        }
    }
};
DI int build_unit_table(const LAS int* tab, LAS int* utab, const int nN, const int G, const int c) {
    const int tid = opaque_tid();
    const int nmt = tab[32];
    int nunits;
    if ((G & 7) == 0) {
        const int x = c & 7, rk = c >> 3, W = G >> 3;
        const int mloc = (nmt > x) ? (nmt - x + 7) >> 3 : 0, total = mloc * nN;
        nunits = (total > rk) ? (total - rk + W - 1) / W : 0;
        if (tid < nunits) { const int k = tid * W + rk, ml = k / nN, pn = k - ml * nN, mtile = x + 8 * ml; int e = 0;
            for (int j = 1; j < 32; ++j) e += (tab[j] <= mtile) ? 1 : 0;
            utab[2 * tid] = mtile; utab[2 * tid + 1] = (e << 16) | ((mtile - tab[e]) << 3) | pn; }
    } else {
        const int total = nmt * nN;
        nunits = (total > c) ? (total - c + G - 1) / G : 0;
        if (tid < nunits) { const int L = tid * G + c, mtile = L / nN, pn = L - mtile * nN; int e = 0;
            for (int j = 1; j < 32; ++j) e += (tab[j] <= mtile) ? 1 : 0;
            utab[2 * tid] = mtile; utab[2 * tid + 1] = (e << 16) | ((mtile - tab[e]) << 3) | pn; }
    }
    __syncthreads();
    return __builtin_amdgcn_readfirstlane(nunits);
}

struct EpiBf16 {
    bf16* O; int ldc; float sc;
    DI void operator()(const f32x4 (&acc)[2][2][4][2], const Unit& u, int wr, int wc, int fr, int fq) const {
        const int row0 = u.pm * 256 + wr * 64 + fr, col0 = u.pn * 256 + wc * 32 + 8 * fq;
#pragma unroll
        for (int ai = 0; ai < 2; ++ai)
#pragma unroll
            for (int m = 0; m < 4; ++m) { bf16* rowp = O + (size_t)(row0 + ai * HALF + m * 16) * ldc + col0;
#pragma unroll
                for (int bj = 0; bj < 2; ++bj) { const f32x4 v0 = acc[ai][bj][m][0] * sc, v1 = acc[ai][bj][m][1] * sc;
                    u32x4 w; w.x = cvt_pk_bf16(v0[0], v0[1]); w.y = cvt_pk_bf16(v0[2], v0[3]); w.z = cvt_pk_bf16(v1[0], v1[1]); w.w = cvt_pk_bf16(v1[2], v1[3]);
                    *(u32x4*)(rowp + bj * HALF) = w; } }
    }
};
struct EpiResid {
    bf16* X; const float* mod_l;
    DI void operator()(const f32x4 (&acc)[2][2][4][2], const Unit& u, int wr, int wc, int fr, int fq) const {
        const int b = u.pm / 9, mrow = (u.pm - b * 9 == 0) ? 32 : b;
        const float* g = mod_l + (size_t)mrow * 6144 + 2048;
        const int row0 = u.pm * 256 + wr * 64 + fr, col0 = u.pn * 256 + wc * 32 + 8 * fq;
        f32x4 gv[2][2];
#pragma unroll
        for (int bj = 0; bj < 2; ++bj)
#pragma unroll
            for (int n = 0; n < 2; ++n) gv[bj][n] = *(const f32x4*)(g + col0 + bj * HALF + 4 * n) * (1.0f / (WO_SCALE * MIX_SCALE));
#pragma unroll
        for (int ai = 0; ai < 2; ++ai)
#pragma unroll
            for (int m = 0; m < 4; ++m) { bf16* rowp = X + (size_t)(row0 + ai * HALF + m * 16) * DM + col0;
#pragma unroll
                for (int bj = 0; bj < 2; ++bj) { u32x4* px = (u32x4*)(rowp + bj * HALF); const u32x4 xw = *px;
                    const f32x4 x0 = (f32x4){bflo(xw.x), bfhi(xw.x), bflo(xw.y), bfhi(xw.y)}, x1 = (f32x4){bflo(xw.z), bfhi(xw.z), bflo(xw.w), bfhi(xw.w)};
                    const f32x4 y0 = x0 * DN_ALPHA + gv[bj][0] * acc[ai][bj][m][0], y1 = x1 * DN_ALPHA + gv[bj][1] * acc[ai][bj][m][1];
                    u32x4 w; w.x = cvt_pk_bf16(y0[0], y0[1]); w.y = cvt_pk_bf16(y0[2], y0[3]); w.z = cvt_pk_bf16(y1[0], y1[1]); w.w = cvt_pk_bf16(y1[2], y1[3]);
                    *px = w; } }
    }
};
struct EpiSwiglu {
    unsigned char* ACT; const LAS unsigned* rtab;
    DI void operator()(const f32x4 (&acc)[2][2][4][2], const Unit& u, int wr, int wc, int fr, int fq) const {
        const LAS float* bias = (const LAS float*)(rtab + (u.idx & 1) * RSLOT + 512);
        const int jc0 = u.pn * 128 + wc * 32 + 8 * fq, jl0 = wc * 32 + 8 * fq;
        f32x4 bg[2], bl[2];
#pragma unroll
        for (int n = 0; n < 2; ++n) { const f32x4 a = *(const LAS f32x4*)(bias + 2 * (jl0 + 4 * n)), b = *(const LAS f32x4*)(bias + 2 * (jl0 + 4 * n) + 4);
            bg[n] = (f32x4){a[0], a[2], b[0], b[2]}; bl[n] = (f32x4){a[1], a[3], b[1], b[3]}; }
        const int row0 = u.pm * 256 + wr * 64 + fr;
#pragma unroll
        for (int ai = 0; ai < 2; ++ai)
#pragma unroll
            for (int m = 0; m < 4; ++m) {
                float y[8];
#pragma unroll
                for (int n = 0; n < 2; ++n) { const f32x4 gl = acc[ai][0][m][n] * (1.0f / WGU_SCALE) + bg[n], li = acc[ai][1][m][n] * (1.0f / WGU_SCALE) + bl[n];
#pragma unroll
                    for (int i = 0; i < 4; i += 2) {
                        const f32x2 seven = {7.0f, 7.0f}, one = {1.0f, 1.0f};
                        const f32x2 gg = __builtin_elementwise_min((f32x2){gl[i], gl[i + 1]}, seven);
                        const f32x2 ll = __builtin_elementwise_min(__builtin_elementwise_max((f32x2){li[i], li[i + 1]}, -seven), seven);
                        const f32x2 t = gg * (-1.702f * LOG2E);
                        const f32x2 d = (f32x2){fast_exp2(t[0]), fast_exp2(t[1])} + one;
                        const f32x2 r = {__builtin_amdgcn_rcpf(d[0]), __builtin_amdgcn_rcpf(d[1])};
                        const f32x2 yy = (ll + one) * (gg * r);
                        y[4 * n + i] = yy[0]; y[4 * n + i + 1] = yy[1]; } }
                u32x2 w; w.x = pk4_fp8(y[0], y[1], y[2], y[3]); w.y = pk4_fp8(y[4], y[5], y[6], y[7]);
                *(u32x2*)(ACT + (size_t)(row0 + ai * HALF + m * 16) * DE + jc0) = w; }
    }
};
struct EpiDown {
    unsigned char* Y; const LAS unsigned* rtab; const LAS int* tab;
    DI void operator()(const f32x4 (&acc)[2][2][4][2], const Unit& u, int wr, int wc, int fr, int fq) const {
        const int nrows = __builtin_amdgcn_readfirstlane(tab[33 + u.e]) - u.mt * 256;
        const LAS unsigned* rt = rtab + (u.idx & 1) * RSLOT;
        const LAS float* bias = (const LAS float*)(rt + 512);
        const int cl0 = wc * 64 + 16 * fq, col0 = u.pn * 256 + cl0;
        f32x4 bv[2][2];
#pragma unroll
        for (int bj = 0; bj < 2; ++bj)
#pragma unroll
            for (int n = 0; n < 2; ++n) bv[bj][n] = *(const LAS f32x4*)(bias + cl0 + 8 * bj + 4 * n);
#pragma unroll
        for (int ai = 0; ai < 2; ++ai)
#pragma unroll
            for (int m = 0; m < 4; ++m) { const int rloc = ai * HALF + wr * 64 + m * 16 + fr;
                if (rloc < nrows) { const unsigned pair = rt[rloc]; float g = __builtin_bit_cast(float, rt[256 + rloc]); asm volatile("" : "+v"(g)); g *= Y_SCALE; const float sg = g * (1.0f / WD_SCALE);
                    u32x4 w;
#pragma unroll
                    for (int bj = 0; bj < 2; ++bj) { const f32x4 v0 = acc[ai][bj][m][0] * sg + bv[bj][0] * g, v1 = acc[ai][bj][m][1] * sg + bv[bj][1] * g;
                        w[2 * bj] = pk4_fp8(v0[0], v0[1], v0[2], v0[3]); w[2 * bj + 1] = pk4_fp8(v1[0], v1[1], v1[2], v1[3]); }
                    *(u32x4*)(Y + (size_t)pair * DM + col0) = w; } }
    }
};
}

namespace att {
typedef short v4i16_t __attribute__((ext_vector_type(4)));
DI int crow(int r, int hi) { return (r & 3) + 8 * (r >> 2) + 4 * hi; }
DI s16x4 vtr(const LAS unsigned char* p) { return __builtin_bit_cast(s16x4, __builtin_amdgcn_ds_read_tr16_b64_v4i16((LAS v4i16_t*)p)); }
#ifndef ATT_K8
#define ATT_K8 1
#endif
constexpr float Q8_SCALE = 4.0f, K8_SCALE = 0.25f;
DI u32x2 bf8x8(const u32x4 w, const float sc) {
    u32x2 o;
    o.x = pk4_fp8(bflo(w.x) * sc, bfhi(w.x) * sc, bflo(w.y) * sc, bfhi(w.y) * sc);
    o.y = pk4_fp8(bflo(w.z) * sc, bfhi(w.z) * sc, bflo(w.w) * sc, bfhi(w.w) * sc);
    return o;
}
DI pg8::i32x8v q_to_fp8(const bf16x8 (&qf)[4]) {
    pg8::i32x8v q;
#pragma unroll
    for (int d0 = 0; d0 < 4; ++d0) { const u32x2 t = bf8x8(__builtin_bit_cast(u32x4, qf[d0]), Q8_SCALE); q[2 * d0] = (int)t.x; q[2 * d0 + 1] = (int)t.y; }
    return q;
}
DI pg8::i32x8v k8_read(const LAS unsigned char* p) { const u32x4 a = *(const LAS u32x4*)p, b = *(const LAS u32x4*)(p + 16); return (pg8::i32x8v){(int)a.x, (int)a.y, (int)a.z, (int)a.w, (int)b.x, (int)b.y, (int)b.z, (int)b.w}; }
#define MFMA_QK8(kf, qf8, c) __builtin_amdgcn_mfma_scale_f32_32x32x64_f8f6f4(kf, qf8, c, 0, 0, 0, 0, 0, 0)
#define ATT_BAR() asm volatile("s_waitcnt lgkmcnt(0)\n\ts_barrier" ::: "memory")

struct AttnP {
    const bf16* Q; int qp;
    const bf16* K; int kp;
    const bf16* K2; int k2p;
    const bf16* V; int vp;
    unsigned char* O; int op;
    int kt0, ntiles;
    int brow0, na_lo, na_nloc, qr0;
    const float* rpb;
    int rope_q, qpos0;
    int shadow;
};
constexpr int RPB_OFF = 60 * 1024;
constexpr int O1_OFF = 64 * 1024;

template <int DQK, int DV, int MODE>
DI void attn_core(LAS unsigned char* lds, const AttnP& p, const bf16x8 (&qf)[DQK / 16], f32x16 (&o)[DV / 32], float& m_run, float& l_run, const int tid, const int wid, const int lane) {
    constexpr bool K8 = ATT_K8 && (DQK == 64);
    constexpr int KROWB = K8 ? 80 : (DQK + 8) * 2, VROWB = (DV == 64) ? 192 : 320, TILEB = 64 * (KROWB + VROWB), CPR = DQK / 8, VPR = DV / 8;
    constexpr int NKC = (DQK == 64) ? 1 : 2, NVC = DV / 64;
    static_assert(2 * TILEB <= RPB_OFF, "attention LDS");
    const int r32 = lane & 31, hi = lane >> 5;
    int krow[NKC], kch[NKC], vrow[NVC], vch[NVC];
#pragma unroll
    for (int i = 0; i < NKC; ++i) { const int c = tid + 512 * i; krow[i] = c / CPR; kch[i] = c - krow[i] * CPR; }
#pragma unroll
    for (int i = 0; i < NVC; ++i) { const int c = tid + 512 * i; vrow[i] = c / VPR; vch[i] = c - vrow[i] * VPR; }
    u32x4 krA[NKC], vrA[NVC], krB[NKC], vrB[NVC];
    const int ntiles = p.ntiles;
#define ATT_TROW(j) ((MODE == 0) ? (p.kt0 + 64 * (j)) : (((j) < p.na_nloc) ? (p.brow0 + 256 + (p.na_lo + (j)) * 64) : (p.brow0 + ((j) - p.na_nloc) * 64)))
#define ATT_LOAD(j, kr, vr) do { const int trow_ = ATT_TROW(j); \
        _Pragma("unroll") for (int i = 0; i < NKC; ++i) { if (DQK == 64 || i == 0 || tid < 256) { \
            const bf16* src_ = (kch[i] < 8) ? (p.K + (size_t)(trow_ + krow[i]) * p.kp + kch[i] * 8) : (p.K2 + (size_t)(trow_ + krow[i]) * p.k2p + (kch[i] - 8) * 8); \
            kr[i] = *(const u32x4*)src_; } } \
        _Pragma("unroll") for (int i = 0; i < NVC; ++i) vr[i] = *(const u32x4*)(p.V + (size_t)(trow_ + vrow[i]) * p.vp + vch[i] * 8); } while (0)
#define ATT_WRITE(b, kr, vr) do { LAS unsigned char* kb_ = lds + (b) * TILEB; LAS unsigned char* vb_ = kb_ + 64 * KROWB; \
        if constexpr (K8) { *(LAS u32x2*)(kb_ + krow[0] * KROWB + 32 * (kch[0] & 1) + 8 * (kch[0] >> 1)) = bf8x8(kr[0], K8_SCALE); } else { \
        _Pragma("unroll") for (int i = 0; i < NKC; ++i) { if (DQK == 64 || i == 0 || tid < 256) *(LAS u32x4*)(kb_ + krow[i] * KROWB + kch[i] * 16) = kr[i]; } } \
        _Pragma("unroll") for (int i = 0; i < NVC; ++i) *(LAS u32x4*)(vb_ + vrow[i] * VROWB + vch[i] * 16) = vr[i]; } while (0)
    ATT_LOAD(0, krA, vrA); ATT_WRITE(0, krA, vrA);
    if (ntiles > 1) ATT_LOAD(1, krB, vrB);
    if (ntiles > 2) ATT_LOAD(2, krA, vrA);
    ATT_BAR();
    pg8::i32x8v q8 = {0, 0, 0, 0, 0, 0, 0, 0};
    if constexpr (K8) q8 = q_to_fp8(qf);
    const bool sh_noload = PROBE_SHADOW && (p.shadow == 2), sh_nocomp = PROBE_SHADOW && (p.shadow == 1);
    f32x16 negm;
#pragma unroll
    for (int r = 0; r < 16; ++r) negm[r] = -m_run;
    bool first = true;
    const int qr = p.qr0 + (wid >> 1), rs = min(max(qr - 4, 0), 24);
    const int qc = 32 * (wid & 1) + r32, cs = min(max(qc - 8, 0), 48);
    const int q4 = (lane & 15) >> 2, p4 = lane & 3, blk = (lane >> 4) & 1;
    unsigned boff0[(MODE == 1 && DV == 64) ? 16 : 1], boff1[(MODE == 1 && DV == 64) ? 16 : 1];
    if (MODE == 1 && DV == 64) {
#pragma unroll
        for (int r = 0; r < 16; ++r) { const int kc0 = crow(r, hi), kc1 = kc0 + 32;
            boff0[r] = ((kc0 >= cs) && (kc0 < cs + 16)) ? (unsigned)(kc0 - qc + 15) * 4u : 124u;
            boff1[r] = ((kc1 >= cs) && (kc1 < cs + 16)) ? (unsigned)(kc1 - qc + 15) * 4u : 124u; }
    }
    auto tile = [&](const int j, auto&& stage) __attribute__((always_inline)) {
        bool staged = false;
        bool active = true; int krg = 0;
        if (MODE == 1) { krg = p.na_lo + j; active = (j >= p.na_nloc) || (krg >= rs && krg < rs + 8); }
        if (sh_nocomp) active = false;
        if (active && DV == 64) {
            const LAS unsigned char* kb = lds + (j & 1) * TILEB; const LAS unsigned char* vb = kb + 64 * KROWB;
            f32x16 s0 = negm, s1 = negm;
            if constexpr (K8) {
                s0 = MFMA_QK8(k8_read(kb + r32 * KROWB + 32 * hi), q8, s0);
                s1 = MFMA_QK8(k8_read(kb + (32 + r32) * KROWB + 32 * hi), q8, s1);
            } else {
#pragma unroll
            for (int d0 = 0; d0 < DQK / 16; ++d0) {
                const bf16x8 k0 = *(const LAS bf16x8*)(kb + r32 * KROWB + (16 * d0 + 8 * hi) * 2);
                const bf16x8 k1 = *(const LAS bf16x8*)(kb + (32 + r32) * KROWB + (16 * d0 + 8 * hi) * 2);
                s0 = __builtin_amdgcn_mfma_f32_32x32x16_bf16(k0, qf[d0], s0, 0, 0, 0);
                s1 = __builtin_amdgcn_mfma_f32_32x32x16_bf16(k1, qf[d0], s1, 0, 0, 0);
            } }
            if (MODE == 1 && j < p.na_nloc) {
                const LAS unsigned char* brow = lds + RPB_OFF + (krg - qr + 7) * 128;
#pragma unroll
                for (int r = 0; r < 16; ++r) { s0[r] += *(const LAS float*)(brow + boff0[r]); s1[r] += *(const LAS float*)(brow + boff1[r]); }
            }
            if (first) {
                float mt = fmaxf(fmaxf(s0[0], s1[0]), fmaxf(s0[1], s1[1]));
#pragma unroll
                for (int r = 2; r < 16; r += 2) mt = fmaxf(fmaxf(mt, fmaxf(s0[r], s1[r])), fmaxf(s0[r + 1], s1[r + 1]));
                mt = fmaxf(mt, __shfl_xor(mt, 32));
                const float dl = (mt > -__builtin_inff()) ? mt : 0.f;
                m_run += dl;
#pragma unroll
                for (int r = 0; r < 16; ++r) { s0[r] -= dl; s1[r] -= dl; negm[r] = -m_run; }
                first = false;
            }
            float ps0 = 0.f, ps1 = 0.f, ps2 = 0.f, ps3 = 0.f;
#pragma unroll
            for (int r = 0; r < 16; r += 2) { s0[r] = fast_exp2(s0[r]); s0[r + 1] = fast_exp2(s0[r + 1]); s1[r] = fast_exp2(s1[r]); s1[r + 1] = fast_exp2(s1[r + 1]);
                ps0 += s0[r]; ps1 += s0[r + 1]; ps2 += s1[r]; ps3 += s1[r + 1]; }
            const float ps = (ps0 + ps1) + (ps2 + ps3);
            l_run += ps;
            const float pt = ps + __shfl_xor(ps, 32);
            const bool need = pt > 65536.0f;
            bf16x8 pa[2][2];
#pragma unroll
            for (int s = 0; s < 2; ++s) {
                u32x4 w0, w1;
                w0.x = pg8::cvt_pk_bf16(s0[8 * s + 0], s0[8 * s + 1]); w0.y = pg8::cvt_pk_bf16(s0[8 * s + 2], s0[8 * s + 3]); w0.z = pg8::cvt_pk_bf16(s0[8 * s + 4], s0[8 * s + 5]); w0.w = pg8::cvt_pk_bf16(s0[8 * s + 6], s0[8 * s + 7]);
                w1.x = pg8::cvt_pk_bf16(s1[8 * s + 0], s1[8 * s + 1]); w1.y = pg8::cvt_pk_bf16(s1[8 * s + 2], s1[8 * s + 3]); w1.z = pg8::cvt_pk_bf16(s1[8 * s + 4], s1[8 * s + 5]); w1.w = pg8::cvt_pk_bf16(s1[8 * s + 6], s1[8 * s + 7]);
                pa[0][s] = __builtin_bit_cast(bf16x8, w0); pa[1][s] = __builtin_bit_cast(bf16x8, w1);
            }
            const LAS unsigned char* vbase = vb + (4 * hi + q4) * VROWB + 32 * blk + 8 * p4;
#pragma unroll
            for (int u = 0; u < 2; ++u)
#pragma unroll
                for (int s = 0; s < 2; ++s)
#pragma unroll
                    for (int c = 0; c < 2; ++c) {
                        const LAS unsigned char* a0 = vbase + (32 * u + 16 * s) * VROWB + 64 * c;
                        const s16x4 lo = vtr(a0), hh = vtr(a0 + 8 * VROWB);
                        const bf16x8 vf = (bf16x8){lo[0], lo[1], lo[2], lo[3], hh[0], hh[1], hh[2], hh[3]};
                        o[c % (DV / 32)] = __builtin_amdgcn_mfma_f32_32x32x16_bf16(pa[u][s], vf, o[c % (DV / 32)], 0, 0, 0);
                    }
            if (__any(need)) {
                const int ex = (int)((__builtin_bit_cast(unsigned, pt) >> 23) & 255u) - 127;
                const float dl = need ? (float)ex : 0.f, f = fast_exp2(-dl);
                m_run += dl; l_run *= f;
#pragma unroll
                for (int r = 0; r < 16; ++r) negm[r] = -m_run;
                int hio = hi; asm volatile("" : "+v"(hio));
#pragma unroll
                for (int r = 0; r < 16; ++r) { const float fr_ = __shfl(f, crow(r, hio)); o[0][r] *= fr_; o[1 % (DV / 32)][r] *= fr_; }
            }
        }
        if (active && DV != 64) {
            const LAS unsigned char* kb = lds + (j & 1) * TILEB; const LAS unsigned char* vb = kb + 64 * KROWB;
#pragma unroll
            for (int u = 0; u < 2; ++u) {
                const LAS unsigned char* kbu = kb + u * 32 * KROWB;
                f32x16 s0 = negm;
                if constexpr (K8) { s0 = MFMA_QK8(k8_read(kbu + r32 * KROWB + 32 * hi), q8, s0); } else {
#pragma unroll
                for (int d0 = 0; d0 < DQK / 16; ++d0) {
                    const bf16x8 k0 = *(const LAS bf16x8*)(kbu + r32 * KROWB + (16 * d0 + 8 * hi) * 2);
                    s0 = __builtin_amdgcn_mfma_f32_32x32x16_bf16(k0, qf[d0], s0, 0, 0, 0);
                } }
                if (MODE == 1 && j < p.na_nloc) {
                    const LAS float* brow = (const LAS float*)(lds + RPB_OFF) + (krg - qr + 7) * 32;
                    int hio = hi; asm volatile("" : "+v"(hio));
#pragma unroll
                    for (int r = 0; r < 16; ++r) {
                        const int kc0 = crow(r, hio) + 32 * u;
                        const bool v0 = (kc0 >= cs) && (kc0 < cs + 16);
                        const int i0 = min(max(kc0 - qc + 15, 0), 30);
                        s0[r] = v0 ? s0[r] + brow[i0] : -__builtin_inff();
                    }
                }
                if (first) {
                    float mt = fmaxf(fmaxf(s0[0], s0[1]), s0[2]);
#pragma unroll
                    for (int r = 3; r < 15; r += 2) mt = fmaxf(fmaxf(mt, s0[r]), s0[r + 1]);
                    mt = fmaxf(mt, s0[15]);
                    mt = fmaxf(mt, __shfl_xor(mt, 32));
                    const float dl = (mt > -__builtin_inff()) ? mt : 0.f;
                    m_run += dl;
#pragma unroll
                    for (int r = 0; r < 16; ++r) { s0[r] -= dl; negm[r] = -m_run; }
                    first = false;
                }
                float ps0 = 0.f, ps1 = 0.f;
#pragma unroll
                for (int r = 0; r < 16; r += 2) { s0[r] = fast_exp2(s0[r]); s0[r + 1] = fast_exp2(s0[r + 1]); ps0 += s0[r]; ps1 += s0[r + 1]; }
                const float ps = ps0 + ps1;
                l_run += ps;
                const float pt = ps + __shfl_xor(ps, 32);
                const bool need = pt > 65536.0f;
                bf16x8 pa[2];
#pragma unroll
                for (int s = 0; s < 2; ++s) {
                    u32x4 w0;
                    w0.x = pg8::cvt_pk_bf16(s0[8 * s + 0], s0[8 * s + 1]); w0.y = pg8::cvt_pk_bf16(s0[8 * s + 2], s0[8 * s + 3]); w0.z = pg8::cvt_pk_bf16(s0[8 * s + 4], s0[8 * s + 5]); w0.w = pg8::cvt_pk_bf16(s0[8 * s + 6], s0[8 * s + 7]);
                    pa[s] = __builtin_bit_cast(bf16x8, w0);
                }
                const LAS unsigned char* vbase = vb + (32 * u + 4 * hi + q4) * VROWB + 32 * blk + 8 * p4;
#pragma unroll
                for (int c = 0; c < DV / 32; ++c)
#pragma unroll
                    for (int s = 0; s < 2; ++s) {
                        const LAS unsigned char* a0 = vbase + (16 * s) * VROWB + 64 * c;
                        const s16x4 lo = vtr(a0), hh = vtr(a0 + 8 * VROWB);
                        const bf16x8 vf = (bf16x8){lo[0], lo[1], lo[2], lo[3], hh[0], hh[1], hh[2], hh[3]};
                        o[c] = __builtin_amdgcn_mfma_f32_32x32x16_bf16(pa[s], vf, o[c], 0, 0, 0);
                    }
                if (__any(need)) {
                    const int ex = (int)((__builtin_bit_cast(unsigned, pt) >> 23) & 255u) - 127;
                    const float dl = need ? (float)ex : 0.f, f = fast_exp2(-dl);
                    m_run += dl; l_run *= f;
#pragma unroll
                    for (int r = 0; r < 16; ++r) negm[r] = -m_run;
                    int hio = hi; asm volatile("" : "+v"(hio));
#pragma unroll
                    for (int r = 0; r < 16; ++r) { const float fr_ = __shfl(f, crow(r, hio));
#pragma unroll
                        for (int c = 0; c < DV / 32; ++c) o[c][r] *= fr_; }
                }
                if (u == 0) { stage(); staged = true; }
            }
        }
        if (!staged) stage();
    };
    for (int j = 0; j < ntiles; j += 2) {
        tile(j, [&]() { if (j + 1 < ntiles) ATT_WRITE((j + 1) & 1, krB, vrB);
                        if (j + 3 < ntiles) ATT_LOAD(j + 3, krB, vrB); });
        ATT_BAR();
        if (j + 1 >= ntiles) break;
        tile(j + 1, [&]() { if (j + 2 < ntiles) ATT_WRITE((j + 2) & 1, krA, vrA);
                            if (j + 4 < ntiles) ATT_LOAD(j + 4, krA, vrA); });
        ATT_BAR();
    }
#undef ATT_TROW
#undef ATT_LOAD
#undef ATT_WRITE
}

template <int DQK>
DI void attn_core_pipe(LAS unsigned char* lds, const AttnP& p, const bf16x8 (&qf)[DQK / 16], f32x16 (&o)[2], float& m_run, float& l_run, const int tid, const int wid, const int lane) {
    constexpr int KROWB = (DQK + 8) * 2, VROWB = 192, TILEB = 64 * (KROWB + VROWB), CPR = DQK / 8;
    constexpr int NKC = (DQK == 64) ? 1 : 2;
    static_assert(2 * TILEB <= RPB_OFF, "attention LDS");
    const int r32 = lane & 31, hi = lane >> 5;
    int krow[NKC], kch[NKC];
#pragma unroll
    for (int i = 0; i < NKC; ++i) { const int c = tid + 512 * i; krow[i] = c / CPR; kch[i] = c - krow[i] * CPR; }
    const int vrow = tid >> 3, vch = tid & 7;
    u32x4 kr[NKC], vr;
    const int nt = p.ntiles;
#define AP_LOADK(j) do { const int trow_ = p.kt0 + 64 * min((j), nt - 1); \
        _Pragma("unroll") for (int i = 0; i < NKC; ++i) { if (DQK == 64 || i == 0 || tid < 256) { \
            const bf16* src_ = (kch[i] < 8) ? (p.K + (size_t)(trow_ + krow[i]) * p.kp + kch[i] * 8) : (p.K2 + (size_t)(trow_ + krow[i]) * p.k2p + (kch[i] - 8) * 8); \
            kr[i] = *(const u32x4*)src_; } } } while (0)
#define AP_LOADV(j) do { const int trow_ = p.kt0 + 64 * min((j), nt - 1); vr = *(const u32x4*)(p.V + (size_t)(trow_ + vrow) * p.vp + vch * 8); } while (0)
#define AP_WRITEK(b) do { LAS unsigned char* kb_ = lds + (b) * TILEB; \
        _Pragma("unroll") for (int i = 0; i < NKC; ++i) { if (DQK == 64 || i == 0 || tid < 256) *(LAS u32x4*)(kb_ + krow[i] * KROWB + kch[i] * 16) = kr[i]; } } while (0)
#define AP_WRITEV(b) do { *(LAS u32x4*)(lds + (b) * TILEB + 64 * KROWB + vrow * VROWB + vch * 16) = vr; } while (0)
#define AP_QK(b, S0, S1) do { const LAS unsigned char* kb_ = lds + (b) * TILEB; \
        _Pragma("unroll") for (int d0 = 0; d0 < DQK / 16; ++d0) { \
            const bf16x8 k0_ = *(const LAS bf16x8*)(kb_ + r32 * KROWB + (16 * d0 + 8 * hi) * 2); \
            const bf16x8 k1_ = *(const LAS bf16x8*)(kb_ + (32 + r32) * KROWB + (16 * d0 + 8 * hi) * 2); \
            S0 = __builtin_amdgcn_mfma_f32_32x32x16_bf16(k0_, qf[d0], S0, 0, 0, 0); \
            S1 = __builtin_amdgcn_mfma_f32_32x32x16_bf16(k1_, qf[d0], S1, 0, 0, 0); } } while (0)
    AP_LOADK(0); AP_LOADV(0); AP_WRITEK(0); AP_WRITEV(0); AP_LOADK(1);
    ATT_BAR();
    f32x16 negm, s0, s1;
#pragma unroll
    for (int r = 0; r < 16; ++r) { s0[r] = 0.f; s1[r] = 0.f; }
    AP_QK(0, s0, s1);
    {
        float mt = fmaxf(fmaxf(s0[0], s1[0]), fmaxf(s0[1], s1[1]));
#pragma unroll
        for (int r = 2; r < 16; r += 2) mt = fmaxf(fmaxf(mt, fmaxf(s0[r], s1[r])), fmaxf(s0[r + 1], s1[r + 1]));
        mt = fmaxf(mt, __shfl_xor(mt, 32));
        m_run = mt;
#pragma unroll
        for (int r = 0; r < 16; ++r) { s0[r] -= mt; s1[r] -= mt; negm[r] = -mt; }
    }
    AP_WRITEK(1); AP_LOADK(2); AP_LOADV(1);
    ATT_BAR();
    const int q4 = (lane & 15) >> 2, p4 = lane & 3, blk = (lane >> 4) & 1;
    const LAS unsigned char* vlane = lds + 64 * KROWB + (4 * hi + q4) * VROWB + 32 * blk + 8 * p4;
#define AP_SOFTMAX_PV(J) \
        float ps0 = 0.f, ps1 = 0.f, ps2 = 0.f, ps3 = 0.f; \
        _Pragma("unroll") for (int r = 0; r < 16; r += 2) { s0[r] = fast_exp2(s0[r]); s0[r + 1] = fast_exp2(s0[r + 1]); s1[r] = fast_exp2(s1[r]); s1[r + 1] = fast_exp2(s1[r + 1]); \
            ps0 += s0[r]; ps1 += s0[r + 1]; ps2 += s1[r]; ps3 += s1[r + 1]; } \
        const float ps = (ps0 + ps1) + (ps2 + ps3); \
        l_run += ps; \
        bf16x8 pa[2][2]; \
        _Pragma("unroll") for (int s = 0; s < 2; ++s) { \
            u32x4 w0, w1; \
            w0.x = pg8::cvt_pk_bf16(s0[8 * s + 0], s0[8 * s + 1]); w0.y = pg8::cvt_pk_bf16(s0[8 * s + 2], s0[8 * s + 3]); w0.z = pg8::cvt_pk_bf16(s0[8 * s + 4], s0[8 * s + 5]); w0.w = pg8::cvt_pk_bf16(s0[8 * s + 6], s0[8 * s + 7]); \
            w1.x = pg8::cvt_pk_bf16(s1[8 * s + 0], s1[8 * s + 1]); w1.y = pg8::cvt_pk_bf16(s1[8 * s + 2], s1[8 * s + 3]); w1.z = pg8::cvt_pk_bf16(s1[8 * s + 4], s1[8 * s + 5]); w1.w = pg8::cvt_pk_bf16(s1[8 * s + 6], s1[8 * s + 7]); \
            pa[0][s] = __builtin_bit_cast(bf16x8, w0); pa[1][s] = __builtin_bit_cast(bf16x8, w1); } \
        const LAS unsigned char* vbase = vlane + ((J) & 1) * TILEB; \
        _Pragma("unroll") for (int u = 0; u < 2; ++u) _Pragma("unroll") for (int s = 0; s < 2; ++s) _Pragma("unroll") for (int c = 0; c < 2; ++c) { \
                    const LAS unsigned char* a0 = vbase + (32 * u + 16 * s) * VROWB + 64 * c; \
                    const s16x4 lo = vtr(a0), hh = vtr(a0 + 8 * VROWB); \
                    const bf16x8 vf = (bf16x8){lo[0], lo[1], lo[2], lo[3], hh[0], hh[1], hh[2], hh[3]}; \
                    o[c] = __builtin_amdgcn_mfma_f32_32x32x16_bf16(pa[u][s], vf, o[c], 0, 0, 0); }
    for (int j = 0; j < nt - 1; ++j) {
        AP_WRITEK(j & 1); AP_WRITEV((j + 1) & 1);
        AP_LOADK(j + 3); AP_LOADV(j + 2);
        f32x16 sn0 = negm, sn1 = negm;
        AP_QK((j + 1) & 1, sn0, sn1);
        AP_SOFTMAX_PV(j)
        const float pt = ps + __shfl_xor(ps, 32);
        const bool need = pt > 65536.0f;
        s0 = sn0; s1 = sn1;
        if (__any(need)) {
            const int ex = (int)((__builtin_bit_cast(unsigned, pt) >> 23) & 255u) - 127;
            const float dl = need ? (float)ex : 0.f, f = fast_exp2(-dl);
            m_run += dl; l_run *= f;
#pragma unroll
            for (int r = 0; r < 16; ++r) { negm[r] = -m_run; s0[r] -= dl; s1[r] -= dl; }
            int hio = hi; asm volatile("" : "+v"(hio));
#pragma unroll
            for (int r = 0; r < 16; ++r) { const float fr_ = __shfl(f, crow(r, hio)); o[0][r] *= fr_; o[1][r] *= fr_; }
        }
        ATT_BAR();
    }
    {
        AP_SOFTMAX_PV(nt - 1)
        ATT_BAR();
    }
#undef AP_SOFTMAX_PV
#undef AP_LOADK
#undef AP_LOADV
#undef AP_WRITEK
#undef AP_WRITEV
#undef AP_QK
}

DI void rope_frag(bf16x8& frag, const int position, const int hi, const float freq_step  ) {
    u32x4 mine = __builtin_bit_cast(u32x4, frag), oth;
#pragma unroll
    for (int w = 0; w < 4; ++w) oth[w] = (unsigned)__shfl_xor((int)mine[w], 32);
    float res[8];
#pragma unroll
    for (int i = 0; i < 8; ++i) {
        const float x = (i & 1) ? bfhi(mine[i >> 1]) : bflo(mine[i >> 1]);
        const float y = (i & 1) ? bfhi(oth[i >> 1]) : bflo(oth[i >> 1]);
        float rev = (float)position * fast_exp2(-(float)i * freq_step) * 0.15915494309189535f; rev = rev - floorf(rev);
        const float sn = __builtin_amdgcn_sinf(rev), cs = __builtin_amdgcn_cosf(rev);
        res[i] = hi ? (y * sn + x * cs) : (x * cs - y * sn);
    }
    u32x4 w; w.x = pk2(res[0], res[1]); w.y = pk2(res[2], res[3]); w.z = pk2(res[4], res[5]); w.w = pk2(res[6], res[7]);
    frag = __builtin_bit_cast(bf16x8, w);
}

template <int DQK, int MODE>
DI void attn_unit(LAS unsigned char* lds, const AttnP& p) {
    const int tid = opaque_tid(), lane = tid & 63, wid = __builtin_amdgcn_readfirstlane(tid >> 6), r32 = lane & 31, hi = lane >> 5;
    bf16x8 qf[DQK / 16];
    const bf16* qrow = p.Q + (size_t)(32 * wid + r32) * p.qp;
#pragma unroll
    for (int d0 = 0; d0 < DQK / 16; ++d0) qf[d0] = *(const bf16x8*)(qrow + 16 * d0 + 8 * hi);
    if (DQK == 96) { if (p.rope_q) { const int pos = p.qpos0 + 32 * wid + r32; rope_frag(qf[4], pos >> 6, hi, LOG2_THETA / 8.f); rope_frag(qf[5], pos & 63, hi, LOG2_THETA / 8.f); } }
    if (MODE == 1) { if (tid < 465) { const int dr = tid / 31, dc = tid - dr * 31; ((LAS float*)(lds + RPB_OFF))[dr * 32 + dc] = p.rpb[tid] * LOG2E; }
                     if (tid < 15) ((LAS float*)(lds + RPB_OFF))[tid * 32 + 31] = -__builtin_inff(); }
    f32x16 o[2];
#pragma unroll
    for (int r = 0; r < 16; ++r) { o[0][r] = 0.f; o[1][r] = 0.f; }
    float m_run = 0.f, l_run = 0.f;
    if constexpr (MODE == 0) attn_core_pipe<DQK>(lds, p, qf, o, m_run, l_run, tid, wid, lane); else attn_core<DQK, 64, MODE>(lds, p, qf, o, m_run, l_run, tid, wid, lane);
    const float l = l_run + __shfl_xor(l_run, 32), inv = 1.0f / l;
    unsigned char* orow = p.O + (size_t)(32 * wid) * p.op + r32;
#pragma unroll
    for (int r = 0; r < 16; ++r) { int hio = hi; asm volatile("" : "+v"(hio)); const int q = crow(r, hio); const float iv = __shfl(inv, q) * MIX_SCALE;
#pragma unroll
        for (int c = 0; c < 2; ++c) orow[(size_t)q * p.op + 32 * c] = (unsigned char)__builtin_amdgcn_cvt_pk_fp8_f32(o[c][r] * iv, 0.f, 0u, false);
        __builtin_amdgcn_sched_barrier(0); }
}

template <int DQK>
DI void attn_core_w64(LAS unsigned char* lds, const AttnP& p, const bf16x8 (&qa)[DQK / 16], const bf16x8 (&qb)[DQK / 16], f32x16 (&oa)[2], f32x16 (&ob)[2], float (&m_run)[2], float (&l_run)[2],
                      const int tid, const int wid, const int lane) {
    constexpr bool K8 = ATT_K8 && (DQK == 64), K8M = ATT_K8 && (DQK == 96);
    constexpr int KROWB = K8 ? 80 : K8M ? 112 : (DQK + 8) * 2, VROWB = 192, TILEB = 64 * (KROWB + VROWB), CPR = DQK / 8;
    constexpr int NKC = (DQK == 64) ? 1 : 2;
    constexpr bool USE_NEGM = (DQK == 64);
    static_assert(2 * TILEB <= RPB_OFF, "attention LDS");
    const int r32 = lane & 31, hi = lane >> 5;
    int krow[NKC], kch[NKC];
#pragma unroll
    for (int i = 0; i < NKC; ++i) { const int c = tid + 512 * i; krow[i] = c / CPR; kch[i] = c - krow[i] * CPR; }
    const int vrow = tid >> 3, vch = tid & 7;
    u32x4 krA[NKC], vrA, krB[NKC], vrB;
    const int nt = p.ntiles;
#define AW_LOAD(j, kr, vr) do { const int trow_ = p.kt0 + 64 * (j); \
        _Pragma("unroll") for (int i = 0; i < NKC; ++i) { if (DQK == 64 || i == 0 || tid < 256) { \
            const bf16* src_ = (kch[i] < 8) ? (p.K + (size_t)(trow_ + krow[i]) * p.kp + kch[i] * 8) : (p.K2 + (size_t)(trow_ + krow[i]) * p.k2p + (kch[i] - 8) * 8); \
            kr[i] = *(const u32x4*)src_; } } \
        vr = *(const u32x4*)(p.V + (size_t)(trow_ + vrow) * p.vp + vch * 8); } while (0)
#define AW_WRITE(b, kr, vr) do { LAS unsigned char* kb_ = lds + (b) * TILEB; \
        if constexpr (K8) { *(LAS u32x2*)(kb_ + krow[0] * KROWB + 32 * (kch[0] & 1) + 8 * (kch[0] >> 1)) = bf8x8(kr[0], K8_SCALE); } \
        else if constexpr (K8M) { _Pragma("unroll") for (int i = 0; i < NKC; ++i) { if (i == 0 || tid < 256) { const int kc_ = kch[i] - 8; \
            const int off_ = (kch[i] < 8) ? (32 * (kch[i] & 1) + 8 * (kch[i] >> 1)) : (64 + 16 * (kc_ & 1) + 8 * (kc_ >> 1)); \
            *(LAS u32x2*)(kb_ + krow[i] * KROWB + off_) = bf8x8(kr[i], K8_SCALE); } } } else { \
        _Pragma("unroll") for (int i = 0; i < NKC; ++i) { if (DQK == 64 || i == 0 || tid < 256) *(LAS u32x4*)(kb_ + krow[i] * KROWB + kch[i] * 16) = kr[i]; } } \
        *(LAS u32x4*)(kb_ + 64 * KROWB + vrow * VROWB + vch * 16) = vr; } while (0)
    AW_LOAD(0, krA, vrA); AW_WRITE(0, krA, vrA);
    if (nt > 1) AW_LOAD(1, krB, vrB);
    if (nt > 2) AW_LOAD(2, krA, vrA);
    ATT_BAR();
    pg8::i32x8v q8a = {0, 0, 0, 0, 0, 0, 0, 0}, q8b = {0, 0, 0, 0, 0, 0, 0, 0};
    pg8::i32x8v q8a1 = {0, 0, 0, 0, 0, 0, 0, 0}, q8b1 = {0, 0, 0, 0, 0, 0, 0, 0};
    if constexpr (K8) { q8a = q_to_fp8(qa); q8b = q_to_fp8(qb); }
    if constexpr (K8M) {
#pragma unroll
        for (int d0 = 0; d0 < 4; ++d0) { const u32x2 ta = bf8x8(__builtin_bit_cast(u32x4, qa[d0]), Q8_SCALE), tb = bf8x8(__builtin_bit_cast(u32x4, qb[d0]), Q8_SCALE); q8a[2 * d0] = (int)ta.x; q8a[2 * d0 + 1] = (int)ta.y; q8b[2 * d0] = (int)tb.x; q8b[2 * d0 + 1] = (int)tb.y; }
#pragma unroll
        for (int d0 = 4; d0 < 6; ++d0) { const u32x2 ta = bf8x8(__builtin_bit_cast(u32x4, qa[d0]), Q8_SCALE), tb = bf8x8(__builtin_bit_cast(u32x4, qb[d0]), Q8_SCALE); q8a1[2 * (d0 - 4)] = (int)ta.x; q8a1[2 * (d0 - 4) + 1] = (int)ta.y; q8b1[2 * (d0 - 4)] = (int)tb.x; q8b1[2 * (d0 - 4) + 1] = (int)tb.y; }
    }
    f32x16 nma, nmb;
#pragma unroll
    for (int r = 0; r < 16; ++r) { nma[r] = 0.f; nmb[r] = 0.f; }
    bool first = true;
    const int q4 = (lane & 15) >> 2, p4 = lane & 3, blk = (lane >> 4) & 1;
    auto half = [&](const int j, const int u) __attribute__((always_inline)) {
        const LAS unsigned char* kb = lds + (j & 1) * TILEB; const LAS unsigned char* vb = kb + 64 * KROWB;
        {
            const LAS unsigned char* kbu = kb + u * 32 * KROWB + r32 * KROWB + ((K8 || K8M) ? 32 : 16) * hi;
            f32x16 sa, sb;
            if (USE_NEGM) { sa = nma; sb = nmb; } else {
#pragma unroll
                for (int r = 0; r < 16; ++r) { sa[r] = 0.f; sb[r] = 0.f; } }
            if constexpr (K8) { const pg8::i32x8v k8 = k8_read(kbu); sa = MFMA_QK8(k8, q8a, sa); sb = MFMA_QK8(k8, q8b, sb); }
            else if constexpr (K8M) { const pg8::i32x8v k8 = k8_read(kbu); const u32x4 kt = *(const LAS u32x4*)(kbu + 64 - 16 * hi);
                const pg8::i32x8v k81 = {(int)kt.x, (int)kt.y, (int)kt.z, (int)kt.w, 0, 0, 0, 0};
                sa = MFMA_QK8(k8, q8a, sa); sb = MFMA_QK8(k8, q8b, sb); sa = MFMA_QK8(k81, q8a1, sa); sb = MFMA_QK8(k81, q8b1, sb); } else {
#pragma unroll
            for (int d0 = 0; d0 < DQK / 16; ++d0) {
                const bf16x8 k0 = *(const LAS bf16x8*)(kbu + 32 * d0);
                sa = __builtin_amdgcn_mfma_f32_32x32x16_bf16(k0, qa[d0], sa, 0, 0, 0);
                sb = __builtin_amdgcn_mfma_f32_32x32x16_bf16(k0, qb[d0], sb, 0, 0, 0);
            } }
            if (first) {
                float ma = fmaxf(fmaxf(sa[0], sa[1]), sa[2]), mb = fmaxf(fmaxf(sb[0], sb[1]), sb[2]);
#pragma unroll
                for (int r = 3; r < 15; r += 2) { ma = fmaxf(fmaxf(ma, sa[r]), sa[r + 1]); mb = fmaxf(fmaxf(mb, sb[r]), sb[r + 1]); }
                ma = fmaxf(ma, sa[15]); mb = fmaxf(mb, sb[15]);
                ma = fmaxf(ma, __shfl_xor(ma, 32)); mb = fmaxf(mb, __shfl_xor(mb, 32));
                m_run[0] = ma; m_run[1] = mb;
                if (USE_NEGM) {
#pragma unroll
                    for (int r = 0; r < 16; ++r) { sa[r] -= ma; sb[r] -= mb; nma[r] = -ma; nmb[r] = -mb; } }
                first = false;
            }
            float pa0 = 0.f, pa1 = 0.f, pb0 = 0.f, pb1 = 0.f;
            if (USE_NEGM) {
#pragma unroll
                for (int r = 0; r < 16; r += 2) { sa[r] = fast_exp2(sa[r]); sa[r + 1] = fast_exp2(sa[r + 1]); sb[r] = fast_exp2(sb[r]); sb[r + 1] = fast_exp2(sb[r + 1]);
                    pa0 += sa[r]; pa1 += sa[r + 1]; pb0 += sb[r]; pb1 += sb[r + 1]; }
            } else { const float ma = m_run[0], mb = m_run[1];
#pragma unroll
                for (int r = 0; r < 16; r += 2) { sa[r] = fast_exp2(sa[r] - ma); sa[r + 1] = fast_exp2(sa[r + 1] - ma); sb[r] = fast_exp2(sb[r] - mb); sb[r + 1] = fast_exp2(sb[r + 1] - mb);
                    pa0 += sa[r]; pa1 += sa[r + 1]; pb0 += sb[r]; pb1 += sb[r + 1]; }
            }
            const float psa = pa0 + pa1, psb = pb0 + pb1;
            l_run[0] += psa; l_run[1] += psb;
            const float pta = psa + __shfl_xor(psa, 32), ptb = psb + __shfl_xor(psb, 32);
            const bool needa = pta > 65536.0f, needb = ptb > 65536.0f;
            bf16x8 fa[2], fb[2];
#pragma unroll
            for (int s = 0; s < 2; ++s) {
                u32x4 w0, w1;
                w0.x = pg8::cvt_pk_bf16(sa[8 * s + 0], sa[8 * s + 1]); w0.y = pg8::cvt_pk_bf16(sa[8 * s + 2], sa[8 * s + 3]); w0.z = pg8::cvt_pk_bf16(sa[8 * s + 4], sa[8 * s + 5]); w0.w = pg8::cvt_pk_bf16(sa[8 * s + 6], sa[8 * s + 7]);
                w1.x = pg8::cvt_pk_bf16(sb[8 * s + 0], sb[8 * s + 1]); w1.y = pg8::cvt_pk_bf16(sb[8 * s + 2], sb[8 * s + 3]); w1.z = pg8::cvt_pk_bf16(sb[8 * s + 4], sb[8 * s + 5]); w1.w = pg8::cvt_pk_bf16(sb[8 * s + 6], sb[8 * s + 7]);
                fa[s] = __builtin_bit_cast(bf16x8, w0); fb[s] = __builtin_bit_cast(bf16x8, w1);
            }
            const LAS unsigned char* vbase = vb + (32 * u + 4 * hi + q4) * VROWB + 32 * blk + 8 * p4;
#pragma unroll
            for (int s = 0; s < 2; ++s)
#pragma unroll
                for (int c = 0; c < 2; ++c) {
                    const LAS unsigned char* a0 = vbase + (16 * s) * VROWB + 64 * c;
                    const s16x4 lo = vtr(a0), hh = vtr(a0 + 8 * VROWB);
                    const bf16x8 vf = (bf16x8){lo[0], lo[1], lo[2], lo[3], hh[0], hh[1], hh[2], hh[3]};
                    oa[c] = __builtin_amdgcn_mfma_f32_32x32x16_bf16(fa[s], vf, oa[c], 0, 0, 0);
                    ob[c] = __builtin_amdgcn_mfma_f32_32x32x16_bf16(fb[s], vf, ob[c], 0, 0, 0);
                }
            if (__any(needa || needb)) {
                const int exa = (int)((__builtin_bit_cast(unsigned, pta) >> 23) & 255u) - 127, exb = (int)((__builtin_bit_cast(unsigned, ptb) >> 23) & 255u) - 127;
                const float dla = needa ? (float)exa : 0.f, dlb = needb ? (float)exb : 0.f, fsa = fast_exp2(-dla), fsb = fast_exp2(-dlb);
                m_run[0] += dla; m_run[1] += dlb; l_run[0] *= fsa; l_run[1] *= fsb;
                if (USE_NEGM) {
#pragma unroll
                    for (int r = 0; r < 16; ++r) { nma[r] = -m_run[0]; nmb[r] = -m_run[1]; } }
                int hio = hi; asm volatile("" : "+v"(hio));
#pragma unroll
                for (int r = 0; r < 16; ++r) { const float fra = __shfl(fsa, crow(r, hio)), frb = __shfl(fsb, crow(r, hio)); oa[0][r] *= fra; oa[1][r] *= fra; ob[0][r] *= frb; ob[1][r] *= frb; }
            }
        }
    };
    for (int j = 0; j < nt; j += 2) {
        half(j, 0);
        if (j + 1 < nt) AW_WRITE((j + 1) & 1, krB, vrB);
        if (j + 3 < nt) AW_LOAD(j + 3, krB, vrB);
        half(j, 1);
        ATT_BAR();
        if (j + 1 >= nt) break;
        half(j + 1, 0);
        if (j + 2 < nt) AW_WRITE((j + 2) & 1, krA, vrA);
        if (j + 4 < nt) AW_LOAD(j + 4, krA, vrA);
        half(j + 1, 1);
        ATT_BAR();
    }
#undef AW_LOAD
#undef AW_WRITE
}

template <int DQK>
DI void attn_unit_w64(LAS unsigned char* lds, const AttnP& p) {
    const int tid = opaque_tid(), lane = tid & 63, wid = __builtin_amdgcn_readfirstlane(tid >> 6), r32 = lane & 31, hi = lane >> 5;
    bf16x8 qa[DQK / 16], qb[DQK / 16];
    const bf16* qrow = p.Q + (size_t)(64 * wid + r32) * p.qp;
#pragma unroll
    for (int d0 = 0; d0 < DQK / 16; ++d0) { qa[d0] = *(const bf16x8*)(qrow + 16 * d0 + 8 * hi); qb[d0] = *(const bf16x8*)(qrow + (size_t)32 * p.qp + 16 * d0 + 8 * hi); }
    if (DQK == 96) { if (p.rope_q) { const int pos = p.qpos0 + 64 * wid + r32;
        rope_frag(qa[4], pos >> 6, hi, LOG2_THETA / 8.f); rope_frag(qa[5], pos & 63, hi, LOG2_THETA / 8.f);
        rope_frag(qb[4], (pos + 32) >> 6, hi, LOG2_THETA / 8.f); rope_frag(qb[5], (pos + 32) & 63, hi, LOG2_THETA / 8.f); } }
    f32x16 oa[2], ob[2];
#pragma unroll
    for (int r = 0; r < 16; ++r) { oa[0][r] = 0.f; oa[1][r] = 0.f; ob[0][r] = 0.f; ob[1][r] = 0.f; }
    float m_run[2] = {0.f, 0.f}, l_run[2] = {0.f, 0.f};
    attn_core_w64<DQK>(lds, p, qa, qb, oa, ob, m_run, l_run, tid, wid, lane);
    const float inva = 1.0f / (l_run[0] + __shfl_xor(l_run[0], 32)), invb = 1.0f / (l_run[1] + __shfl_xor(l_run[1], 32));
    unsigned char* orow = p.O + (size_t)(64 * wid) * p.op + r32;
#pragma unroll
    for (int r = 0; r < 16; ++r) { int hio = hi; asm volatile("" : "+v"(hio)); const int q = crow(r, hio); const float iva = __shfl(inva, q) * MIX_SCALE, ivb = __shfl(invb, q) * MIX_SCALE;
#pragma unroll
        for (int c = 0; c < 2; ++c) { orow[(size_t)q * p.op + 32 * c] = (unsigned char)__builtin_amdgcn_cvt_pk_fp8_f32(oa[c][r] * iva, 0.f, 0u, false);
                                      orow[(size_t)(q + 32) * p.op + 32 * c] = (unsigned char)__builtin_amdgcn_cvt_pk_fp8_f32(ob[c][r] * ivb, 0.f, 0u, false); }
        __builtin_amdgcn_sched_barrier(0); }
}

DI void attn_unit_diff(LAS unsigned char* lds, const AttnP& p, const float lam, const float oml, const float* subln) {
    const int tid = opaque_tid(), lane = tid & 63, wid = __builtin_amdgcn_readfirstlane(tid >> 6), r32 = lane & 31, hi = lane >> 5;
    LAS unsigned* stash = (LAS unsigned*)(lds + O1_OFF) + tid;
    for (int jh = 0; jh < 2; ++jh) {
        AttnP pj = p; pj.K = p.K + 64 * jh;
        bf16x8 qf[4];
        const bf16* qrow = p.Q + (size_t)(32 * wid + r32) * p.qp + 64 * jh;
#pragma unroll
        for (int d0 = 0; d0 < 4; ++d0) qf[d0] = *(const bf16x8*)(qrow + 16 * d0 + 8 * hi);
        f32x16 o[4];
#pragma unroll
        for (int c = 0; c < 4; ++c)
#pragma unroll
            for (int r = 0; r < 16; ++r) o[c][r] = 0.f;
        float m_run = 0.f, l_run = 0.f;
        attn_core<64, 128, 0>(lds, pj, qf, o, m_run, l_run, tid, wid, lane);
        const float l = l_run + __shfl_xor(l_run, 32), inv = 1.0f / l;
        if (jh == 0) {
#pragma unroll
            for (int r = 0; r < 8; ++r) { int hio = hi; asm volatile("" : "+v"(hio)); const float iv0 = __shfl(inv, crow(2 * r, hio)), iv1 = __shfl(inv, crow(2 * r + 1, hio));
#pragma unroll
                for (int c = 0; c < 4; ++c) stash[512 * (c * 8 + r)] = pk2(o[c][2 * r] * iv0, o[c][2 * r + 1] * iv1);
                __builtin_amdgcn_sched_barrier(0); }
        } else {
            float sg[4];
#pragma unroll
            for (int c = 0; c < 4; ++c) sg[c] = subln[32 * c + r32] * (oml * MIX_SCALE);
            unsigned char* orow = p.O + (size_t)(32 * wid) * p.op + r32;
#pragma unroll
            for (int r = 0; r < 16; ++r) { int hio = hi; asm volatile("" : "+v"(hio)); const int q = crow(r, hio); const float iv = __shfl(inv, q);
                float v[4]; float ss = 0.f;
#pragma unroll
                for (int c = 0; c < 4; ++c) { const unsigned w1 = stash[512 * (c * 8 + (r >> 1))]; const float o1 = (r & 1) ? bfhi(w1) : bflo(w1); v[c] = o1 - lam * (o[c][r] * iv); ss += v[c] * v[c]; }
                ss += __shfl_xor(ss, 1); ss += __shfl_xor(ss, 2); ss += __shfl_xor(ss, 4); ss += __shfl_xor(ss, 8); ss += __shfl_xor(ss, 16);
                const float rinv = 1.0f / sqrtf(ss * (1.0f / 128.0f) + RMS_EPS);
#pragma unroll
                for (int c = 0; c < 4; ++c) orow[(size_t)q * p.op + 32 * c] = (unsigned char)__builtin_amdgcn_cvt_pk_fp8_f32(v[c] * rinv * sg[c], 0.f, 0u, false);
                __builtin_amdgcn_sched_barrier(0); }
        }
    }
}
}


DI void p0_mod_item(LAS unsigned char* lds, const float* c, const float* c_ctx, const float* mod_w, const float* mod_b, float* mod, const int item) {
    const int tid = opaque_tid(), lane = tid & 63, wid = __builtin_amdgcn_readfirstlane(tid >> 6), l = item / 48, col0 = (item - l * 48) * 128;
    constexpr int SP = 1026;
    LAS float* s = (LAS float*)lds;
    __syncthreads();
    for (int idx = tid; idx < 33 * 1024; idx += NTHR) { const int r = idx >> 10, kk = idx & 1023; const float cv = (r < 32) ? c[r * 1024 + kk] : c_ctx[kk]; s[r * SP + kk] = cv / (1.0f + __expf(-cv)); }
    __syncthreads();
    const int i32 = lane & 31, hi = lane >> 5;
    f32x16 acc[4];
#pragma unroll
    for (int cb = 0; cb < 4; ++cb)
#pragma unroll
        for (int r = 0; r < 16; ++r) acc[cb][r] = 0.f;
    float a32[4] = {0.f, 0.f, 0.f, 0.f};
    const float* w = mod_w + ((size_t)l * 1024 + wid * 128) * 6144 + col0 + i32;
    const LAS float* sa = s + i32 * SP + wid * 128 + 2 * hi;
    const LAS float* sc = s + 32 * SP + wid * 128 + 2 * hi;
#pragma unroll 4
    for (int q = 0; q < 32; ++q) {
        const float* wp = w + (size_t)(4 * q + 2 * hi) * 6144;
        float b0[4], b1[4];
#pragma unroll
        for (int cb = 0; cb < 4; ++cb) { b0[cb] = wp[32 * cb]; b1[cb] = wp[6144 + 32 * cb]; }
        const f32x2 av = *(const LAS f32x2*)(sa + 4 * q), cv = *(const LAS f32x2*)(sc + 4 * q);
#pragma unroll
        for (int cb = 0; cb < 4; ++cb) {
            acc[cb] = __builtin_amdgcn_mfma_f32_32x32x2f32(av[0], b0[cb], acc[cb], 0, 0, 0);
            acc[cb] = __builtin_amdgcn_mfma_f32_32x32x2f32(av[1], b1[cb], acc[cb], 0, 0, 0);
            a32[cb] += cv[0] * b0[cb] + cv[1] * b1[cb];
        }
    }
#pragma unroll
    for (int cb = 0; cb < 4; ++cb) a32[cb] += __shfl_xor(a32[cb], 32);
    __syncthreads();
    LAS float* red = s + (size_t)wid * 33 * 128;
#pragma unroll
    for (int cb = 0; cb < 4; ++cb) {
#pragma unroll
        for (int r = 0; r < 16; ++r) red[((r & 3) + 8 * (r >> 2) + 4 * hi) * 128 + 32 * cb + i32] = acc[cb][r];
        if (hi == 0) red[32 * 128 + 32 * cb + i32] = a32[cb];
    }
    __syncthreads();
    for (int idx = tid; idx < 33 * 128; idx += NTHR) { const int r = idx >> 7, cc = idx & 127; float v = 0.f;
#pragma unroll
        for (int wv = 0; wv < 8; ++wv) v += s[(wv * 33 + r) * 128 + cc];
        mod[((size_t)l * 33 + r) * 6144 + col0 + cc] = v + mod_b[l * 6144 + col0 + cc]; }
    __syncthreads();
}
struct TrDesc { const float* W; unsigned char* WT; int K, N, dK, mode, scale_n, fp8, item; float scale, scale2; };
constexpr int TI_GU = 128 * 1024, TI_D = 128 * 512, TI_WE = 2 * 1152, TI_WO_ = 2 * 976, TI_OUT = 4 * 512, TI_UQ = 2 * 96, TI_UKV = 2 * 64;
constexpr int TI_TOTAL = TI_GU + TI_D + TI_WE + TI_WO_ + TI_OUT + TI_UQ + TI_UKV;
DI TrDesc tr_decode(const float* const* in, unsigned char* ws, int r) {
    TrDesc d; d.scale_n = 0; d.scale = 1.f; d.scale2 = 1.f; d.mode = 0; d.fp8 = 0;
    if (r < TI_GU) { const int le = r >> 10; d.W = in[28] + (size_t)le * 1024 * 2048; d.K = 1024; d.N = 2048; d.WT = ws + WS_WGU + (size_t)le * 2048 * 1024; d.dK = 1024; d.mode = 1; d.scale_n = 1 << 30; d.scale = WGU_SCALE; d.fp8 = 1; d.item = r & 1023; return d; } r -= TI_GU;
    if (r < TI_D) { const int le = r >> 9; d.W = in[30] + (size_t)le * 1024 * 1024; d.K = 1024; d.N = 1024; d.WT = ws + WS_WD + (size_t)le * 1024 * 1024; d.dK = 1024; d.mode = 2; d.scale_n = 1 << 30; d.scale = WD_SCALE; d.fp8 = 1; d.item = r & 511; return d; } r -= TI_D;
    if (r < TI_WE) { const int j = r / 1152; d.W = in[10] + (size_t)j * 1024 * 2304; d.K = 1024; d.N = 2304; d.WT = ws + WS_WIN + (size_t)(2 * j) * 2304 * 1024 * 2; d.dK = 1024; d.scale_n = 512; d.scale = C2; d.item = r - j * 1152; if (INPROJ_FP8) { d.fp8 = 1; d.scale = C2 * WI_SCALE; d.scale2 = WI_SCALE; } return d; } r -= TI_WE;
    if (r < TI_WO_) { const int j = r / 976; d.W = in[15] + (size_t)j * 1024 * 1952; d.K = 1024; d.N = 1952; d.WT = ws + WS_WIN + (size_t)(2 * j + 1) * 2304 * 1024 * 2; d.dK = 1024; d.scale_n = 512; d.scale = C2; d.item = r - j * 976; if (INPROJ_FP8) { d.fp8 = 1; d.scale = C2 * WI_SCALE; d.scale2 = WI_SCALE; } return d; } r -= TI_WO_;
    if (r < TI_OUT) { const int q = r >> 9, j = q >> 1, odd = q & 1; d.W = in[odd ? 16 : 11] + (size_t)j * 1024 * 1024; d.K = 1024; d.N = 1024; d.WT = ws + WS_WOUT + (size_t)(2 * j + odd) * 1024 * 1024; d.dK = 1024; d.scale_n = 1 << 30; d.scale = WO_SCALE; d.fp8 = 1; d.item = r & 511; return d; } r -= TI_OUT;
    if (r < TI_UQ) { const int j = r / 96; d.W = in[23] + (size_t)j * 256 * 768; d.K = 256; d.N = 768; d.WT = ws + WS_WUQ + (size_t)j * 768 * 256 * 2; d.dK = 256; d.scale_n = 768; d.scale = C2M; d.item = r - j * 96; return d; } r -= TI_UQ;
    { const int j = r / 64; d.W = in[25] + (size_t)j * 128 * 1024; d.K = 128; d.N = 1024; d.WT = ws + WS_WUKV + (size_t)j * 1024 * 256 * 2; d.dK = 256; d.item = r - j * 64; return d; }
}
DI void tr_load(const TrDesc& d, f32x4 (&tv)[8], const int lane) {
    const int nblk = d.N / 32, kb = d.item / nblk, nb = d.item - kb * nblk, k0 = 64 * kb, n0 = 32 * nb;
    const float* p = d.W + (size_t)(k0 + (lane >> 3)) * d.N + n0 + 4 * (lane & 7);
#pragma unroll
    for (int i = 0; i < 8; ++i) tv[i] = *(const f32x4*)(p + (size_t)(8 * i) * d.N);
}
DI void tr_store(const TrDesc& d, LAS float* scr, const int lane) {
    const int nblk = d.N / 32, kb = d.item / nblk, nb = d.item - kb * nblk, k0 = 64 * kb, n0 = 32 * nb;
    if (d.fp8) {
        const int cch = lane & 3;
#pragma unroll
        for (int j = 0; j < 2; ++j) { const int nl = (lane >> 2) + 16 * j, n = n0 + nl; const LAS float* s = scr + (16 * cch) * 33 + nl; const float sc = (n < d.scale_n) ? d.scale : d.scale2;
            int row = n; if (d.mode == 1) { const int jj = n >> 1, sh = n & 1; row = 256 * (jj >> 7) + 128 * sh + (jj & 127); }
            if (d.mode == 2) { const int na = n & 255; row = (n & ~255) + 128 * ((na >> 3) & 1) + 32 * (na >> 6) + 8 * ((na >> 4) & 3) + (na & 7); }
            u32x4 o;
            o.x = pk4_fp8(s[0 * 33] * sc, s[1 * 33] * sc, s[2 * 33] * sc, s[3 * 33] * sc); o.y = pk4_fp8(s[4 * 33] * sc, s[5 * 33] * sc, s[6 * 33] * sc, s[7 * 33] * sc);
            o.z = pk4_fp8(s[8 * 33] * sc, s[9 * 33] * sc, s[10 * 33] * sc, s[11 * 33] * sc); o.w = pk4_fp8(s[12 * 33] * sc, s[13 * 33] * sc, s[14 * 33] * sc, s[15 * 33] * sc);
            *(u32x4*)(d.WT + (size_t)row * d.dK + k0 + 16 * cch) = o; }
    } else {
        const int cch = lane & 7;
#pragma unroll
        for (int j = 0; j < 4; ++j) { const int nl = (lane >> 3) + 8 * j, n = n0 + nl; const LAS float* s = scr + (8 * cch) * 33 + nl;
            const float sc = (n < d.scale_n) ? d.scale : 1.0f;
            u32x4 o; o.x = pk2(s[0 * 33] * sc, s[1 * 33] * sc); o.y = pk2(s[2 * 33] * sc, s[3 * 33] * sc); o.z = pk2(s[4 * 33] * sc, s[5 * 33] * sc); o.w = pk2(s[6 * 33] * sc, s[7 * 33] * sc);
            *(u32x4*)((bf16*)d.WT + (size_t)n * d.dK + k0 + 8 * cch) = o; }
    }
}
DI void p0_transposes(LAS unsigned char* lds, const float* const* in, unsigned char* ws, const int gw, const int ngw, const int wid, const int lane) {
    LAS float* scr = (LAS float*)(lds + wid * 16384);
    if (gw >= TI_TOTAL) return;
    f32x4 ta[8], tb[8];
    TrDesc da = tr_decode(in, ws, gw), db = da;
    tr_load(da, ta, lane);
    if (gw + ngw < TI_TOTAL) { db = tr_decode(in, ws, gw + ngw); tr_load(db, tb, lane); }
#define TR_STEP(D, TV, NEXT) do { \
        _Pragma("unroll") for (int i = 0; i < 8; ++i) { LAS float* sp = scr + ((lane >> 3) + 8 * i) * 33 + 4 * (lane & 7); sp[0] = TV[i][0]; sp[1] = TV[i][1]; sp[2] = TV[i][2]; sp[3] = TV[i][3]; } \
        TrDesc nx_ = D; \
        if ((NEXT) < TI_TOTAL) { nx_ = tr_decode(in, ws, (NEXT)); tr_load(nx_, TV, lane); } \
        asm volatile("s_waitcnt lgkmcnt(0)" ::: "memory"); \
        tr_store(D, scr, lane); \
        asm volatile("s_waitcnt lgkmcnt(0)" ::: "memory"); \
        D = nx_; } while (0)
    for (int it = gw; it < TI_TOTAL; it += 2 * ngw) {
        TR_STEP(da, ta, it + 2 * ngw);
        if (it + ngw >= TI_TOTAL) break;
        TR_STEP(db, tb, it + 3 * ngw);
    }
#undef TR_STEP
}
DI void p0_zero(unsigned char* ws, const int gtid, const int ngt) {
    if (INPROJ_FP8) { for (int i = gtid; i < 2 * 96 * 64; i += ngt) { const int j = i / (96 * 64), r = i - j * 96 * 64; *(u32x4*)(ws + WS_WIN + (size_t)(2 * j + 1) * 2304 * 1024 * 2 + (size_t)1952 * 1024 + (size_t)r * 16) = (u32x4){0u, 0u, 0u, 0u}; } }
    else for (int i = gtid; i < 2 * 96 * 128; i += ngt) { const int j = i / (96 * 128), r = i - j * 96 * 128; *(u32x4*)((bf16*)(ws + WS_WIN) + ((size_t)(2 * j + 1) * 2304 + 1952) * 1024 + (size_t)r * 8) = (u32x4){0u, 0u, 0u, 0u}; }
    for (int i = gtid; i < 2 * 1024 * 16; i += ngt) { const int row = i >> 4, ch = i & 15; *(u32x4*)((bf16*)(ws + WS_WUKV) + (size_t)row * 256 + 128 + ch * 8) = (u32x4){0u, 0u, 0u, 0u}; }
}
DI void p0b_rows(const float* x, const float* ctx, const float* mod0, bf16* X, bf16* H, const int gw, const int ngw, const int lane) {
    const int c0 = 16 * lane;
    f32x4 vn[4];
#define P0B_SRC(mm) (((mm) % TPB < CTXL) ? ctx + ((size_t)((mm) / TPB) * CTXL + (mm) % TPB) * DM : x + ((size_t)((mm) / TPB) * SEQ + ((mm) % TPB - CTXL)) * DM)
    if (gw < T) { const float* src = P0B_SRC(gw) + c0;
#pragma unroll
        for (int j = 0; j < 4; ++j) vn[j] = *(const f32x4*)(src + 4 * j); }
    for (int m = gw; m < T; m += ngw) {
        const int b = m / TPB, t = m - b * TPB;
        const float* md = mod0 + (size_t)((t < CTXL) ? 32 : b) * 6144 + c0;
        f32x4 vc[4];
#pragma unroll
        for (int j = 0; j < 4; ++j) vc[j] = vn[j];
        if (m + ngw < T) { const float* src = P0B_SRC(m + ngw) + c0;
#pragma unroll
            for (int j = 0; j < 4; ++j) vn[j] = *(const f32x4*)(src + 4 * j); }
        u32x4 xo[2], ho[2];
#pragma unroll
        for (int j = 0; j < 4; ++j) { const f32x4 v = vc[j];
            xo[j >> 1][2 * (j & 1)] = pk2(v[0], v[1]); xo[j >> 1][2 * (j & 1) + 1] = pk2(v[2], v[3]);
            const f32x4 sh = *(const f32x4*)(md + 4 * j), sc = *(const f32x4*)(md + 1024 + 4 * j); const f32x4 h = v * (sc + 1.0f) + sh;
            ho[j >> 1][2 * (j & 1)] = pk2(h[0], h[1]); ho[j >> 1][2 * (j & 1) + 1] = pk2(h[2], h[3]); }
        bf16* xr = X + (size_t)m * DM + c0; *(u32x4*)xr = xo[0]; *(u32x4*)(xr + 8) = xo[1];
        if (INPROJ_FP8) { u32x4 h8;
#pragma unroll
            for (int j = 0; j < 4; ++j) { const f32x4 sh = *(const f32x4*)(md + 4 * j), sc = *(const f32x4*)(md + 1024 + 4 * j); const f32x4 h = (vc[j] * (sc + 1.0f) + sh) * H_SCALE; h8[j] = pk4_fp8(h[0], h[1], h[2], h[3]); }
            *(u32x4*)((unsigned char*)H + (size_t)m * DM + c0) = h8; }
        else { bf16* hr = H + (size_t)m * DM + c0; *(u32x4*)hr = ho[0]; *(u32x4*)(hr + 8) = ho[1]; }
    }
#undef P0B_SRC
}
DI void unpack8(const u32x4 w, float (&v)[8]) { v[0] = bflo(w.x); v[1] = bfhi(w.x); v[2] = bflo(w.y); v[3] = bfhi(w.y); v[4] = bflo(w.z); v[5] = bfhi(w.z); v[6] = bflo(w.w); v[7] = bfhi(w.w); }
DI u32x4 pack8(const float (&v)[8]) { u32x4 w; w.x = pk2(v[0], v[1]); w.y = pk2(v[2], v[3]); w.z = pk2(v[4], v[5]); w.w = pk2(v[6], v[7]); return w; }
DI void rope_chunk(float (&y)[8], const float (&rf)[8], const float position, const bool second, const int pmask) {
#pragma unroll
    for (int e = 0; e < 8; ++e) { float rev = position * rf[e]; rev = rev - floorf(rev);
        const float sn = __builtin_amdgcn_sinf(rev), cs = __builtin_amdgcn_cosf(rev); const float partner = __shfl_xor(y[e], pmask);
        y[e] = second ? (partner * sn + y[e] * cs) : (y[e] * cs - partner * sn); }
}
DI void post_even_rows(const bf16* P, bf16* PQ, const float* qg, const float* kg, const int gw, const int ngw, const int lane) {
    const int ch = lane & 7;
    float gq[8], gk[8], rf[8];
#pragma unroll
    for (int e = 0; e < 8; ++e) { gq[e] = qg[8 * ch + e] * C2; gk[e] = kg[8 * ch + e]; rf[e] = fast_exp2(-(float)(8 * (ch & 1) + e) * (LOG2_THETA / 16.f)) * 0.15915494309189535f; }
    const bool second = (ch & 2) != 0, colpart = (ch & 4) != 0;
    u32x4 nq, nk;
    if (gw < T) { const bf16* r0 = P + (size_t)gw * NPP; nq = *(const u32x4*)(r0 + 1536 + 8 * lane); nk = *(const u32x4*)(r0 + 2048 + 8 * (lane & 15)); }
    for (int m = gw; m < T; m += ngw) {
        const int b = m / TPB, t = m - b * TPB; const bool lat = t >= CTXL; const int pos = t - CTXL;
        bf16* row = PQ + (size_t)m * NPP;
        u32x4* pq = (u32x4*)(row + 1536 + 8 * lane); u32x4* pk = (u32x4*)(row + 2048 + 8 * (lane & 15));
        const u32x4 wq = nq, wk = nk;
        if (m + ngw < T) { const bf16* r1 = P + (size_t)(m + ngw) * NPP; nq = *(const u32x4*)(r1 + 1536 + 8 * lane); nk = *(const u32x4*)(r1 + 2048 + 8 * (lane & 15)); }
        const float position = (float)(colpart ? (pos & 63) : (pos >> 6));
        float v[8];
        unpack8(wq, v);
        { float ss = 0.f;
#pragma unroll
          for (int e = 0; e < 8; ++e) ss += v[e] * v[e];
          ss += __shfl_xor(ss, 1); ss += __shfl_xor(ss, 2); ss += __shfl_xor(ss, 4);
          const float ri = 1.0f / sqrtf(ss * (1.0f / 64.0f) + RMS_EPS);
#pragma unroll
          for (int e = 0; e < 8; ++e) v[e] = v[e] * ri * gq[e];
          if (lat) rope_chunk(v, rf, position, second, 2);
          *pq = pack8(v); }
        unpack8(wk, v);
        { float ss = 0.f;
#pragma unroll
          for (int e = 0; e < 8; ++e) ss += v[e] * v[e];
          ss += __shfl_xor(ss, 1); ss += __shfl_xor(ss, 2); ss += __shfl_xor(ss, 4);
          const float ri = 1.0f / sqrtf(ss * (1.0f / 64.0f) + RMS_EPS);
#pragma unroll
          for (int e = 0; e < 8; ++e) v[e] = v[e] * ri * gk[e];
          if (lat) rope_chunk(v, rf, position, second, 2);
          if (lane < 16) *pk = pack8(v); }
    }
}
DI void post_odd_rows(const bf16* P, bf16* PQ, const float* mqg, const float* mkvg, const int gw, const int ngw, const int lane) {
    const int ch = lane & 7;
    float rf[8], rf32[8], g3[8];
#pragma unroll
    for (int e = 0; e < 8; ++e) { rf[e] = fast_exp2(-(float)(8 * (ch & 1) + e) * (LOG2_THETA / 16.f)) * 0.15915494309189535f; rf32[e] = fast_exp2(-(float)e * (LOG2_THETA / 8.f)) * 0.15915494309189535f;
        g3[e] = (lane < 32) ? mqg[8 * lane + e] : (lane < 48) ? mkvg[8 * (lane - 32) + e] : 1.0f; }
    const bool second = (ch & 2) != 0, colpart = (ch & 4) != 0;
    const int c3 = lane;
    const bool second32 = (lane & 1) != 0, colpart32 = (lane & 2) != 0;
    u32x4 n0, n1, n3;
#define PODD_LOAD(mm) do { const bf16* r_ = P + (size_t)(mm) * NPP; n3 = *(const u32x4*)(r_ + 1536 + 8 * c3); n0 = *(const u32x4*)(r_ + 8 * lane); n1 = *(const u32x4*)(r_ + 512 + 8 * lane); } while (0)
    if (gw < T) PODD_LOAD(gw);
    for (int m = gw; m < T; m += ngw) {
        const int b = m / TPB, t = m - b * TPB; const bool lat = t >= CTXL; const int pos = t - CTXL;
        bf16* row = PQ + (size_t)m * NPP;
        u32x4* p0 = (u32x4*)(row + 8 * lane); u32x4* p1 = (u32x4*)(row + 512 + 8 * lane); u32x4* p3 = (u32x4*)(row + 1536 + 8 * c3);
        const u32x4 w0 = n0, w1 = n1, w3 = n3;
        if (m + ngw < T) PODD_LOAD(m + ngw);
        float v[8];
        if (lat) {
            const float position = (float)(colpart ? (pos & 63) : (pos >> 6));
            unpack8(w0, v); rope_chunk(v, rf, position, second, 2); *p0 = pack8(v);
            unpack8(w1, v); rope_chunk(v, rf, position, second, 2); *p1 = pack8(v);
        } else { *p0 = w0; *p1 = w1; }
        unpack8(w3, v);
        float ss = 0.f;
#pragma unroll
        for (int e = 0; e < 8; ++e) ss += v[e] * v[e];
        ss += __shfl_xor(ss, 1); ss += __shfl_xor(ss, 2); ss += __shfl_xor(ss, 4); ss += __shfl_xor(ss, 8);
        const float ss16 = ss + __shfl_xor(ss, 16);
        const float ri = (lane < 32) ? 1.0f / sqrtf(ss16 * (1.0f / 256.0f) + RMS_EPS) : 1.0f / sqrtf(ss * (1.0f / 128.0f) + RMS_EPS);
        float vn[8];
#pragma unroll
        for (int e = 0; e < 8; ++e) vn[e] = v[e] * ri * g3[e];
        if (lat) { const float position32 = (float)(colpart32 ? (pos & 63) : (pos >> 6)); rope_chunk(v, rf32, position32, second32, 1); }
        if (lane < 48) *p3 = pack8(vn); else if (lane < 52) { if (lat) *p3 = pack8(v); else *p3 = w3; } else *p3 = (u32x4){0u, 0u, 0u, 0u};
    }
}
DI int ln_row(const int wg, const int i, const int last) { if (!last) return wg * 288 + i; const int idx = wg * 256 + i; return (idx >> 11) * TPB + CTXL + (idx & 2047); }

DI void ln1_router_table(LAS unsigned char* lds, const float* rw) {
    const int tid = opaque_tid();
    for (int i = 0; i < 32; ++i) { const int idx = tid + NTHR * i, e = idx & 31, k = (idx >> 5) * 2;
        *(LAS unsigned*)(lds + e * 2064 + k * 2) = pk2(rw[k * 32 + e], rw[(k + 1) * 32 + e]); }
}
DI void ln1_router_phase(LAS unsigned char* lds, bf16* X, unsigned char* H8, const float* mod_l, const float* lng, const float* lnb, const float* rw, const float* rb,
                         unsigned* cnt_l, unsigned* list, float* gsort, const int wg, const int last, const int have_table) {
    const int tid = opaque_tid(), lane = tid & 63, wid = __builtin_amdgcn_readfirstlane(tid >> 6);
    constexpr int TROW = 2064;
    LAS unsigned char* wrt = lds; LAS unsigned char* ht = lds + 66048; LAS float* logt = (LAS float*)(lds + 99072);
    LAS unsigned* ent = (LAS unsigned*)(lds + 101376); LAS float* entw = (LAS float*)(ent + 1152); LAS unsigned* lcnt = ent + 2304; LAS unsigned* lbase = lcnt + 32;
    if (!have_table) ln1_router_table(lds, rw);
    if (tid < 32) lcnt[tid] = 0u;
    const int nrows = last ? 256 : 288, nblk = nrows >> 4;
    const int c0 = 16 * lane;
    f32x4 gv[4], bv[4];
#pragma unroll
    for (int j = 0; j < 4; ++j) { gv[j] = *(const f32x4*)(lng + c0 + 4 * j); bv[j] = *(const f32x4*)(lnb + c0 + 4 * j); }
    u32x4 xnext[2][2];
#define LN1_LOAD(blk_) do { _Pragma("unroll") for (int r = 0; r < 2; ++r) { const bf16* xp_ = X + (size_t)ln_row(wg, (blk_) * 16 + 2 * wid + r, last) * DM + c0; \
        xnext[r][0] = *(const u32x4*)xp_; xnext[r][1] = *(const u32x4*)(xp_ + 8); } } while (0)
    LN1_LOAD(0);
    __syncthreads();
    for (int blk = 0; blk < nblk; ++blk) {
        u32x4 xcur[2][2];
#pragma unroll
        for (int r = 0; r < 2; ++r) { xcur[r][0] = xnext[r][0]; xcur[r][1] = xnext[r][1]; }
        if (blk + 1 < nblk) LN1_LOAD(blk + 1);
#pragma unroll
        for (int r = 0; r < 2; ++r) {
            const int m = ln_row(wg, blk * 16 + 2 * wid + r, last); const int b = m / TPB, t = m - b * TPB;
            const float* md = mod_l + (size_t)((t < CTXL) ? 32 : b) * 6144;
            f32x4 v[4]; float s = 0.f;
#pragma unroll
            for (int j = 0; j < 4; ++j) { const unsigned xa = xcur[r][j >> 1][2 * (j & 1)], xb = xcur[r][j >> 1][2 * (j & 1) + 1]; v[j] = (f32x4){bflo(xa), bfhi(xa), bflo(xb), bfhi(xb)}; s += (v[j][0] + v[j][1]) + (v[j][2] + v[j][3]); }
            const float mean = wave_sum(s) * (1.0f / DM); float s2 = 0.f;
#pragma unroll
            for (int j = 0; j < 4; ++j) { v[j] = v[j] - mean; s2 += (v[j][0] * v[j][0] + v[j][1] * v[j][1]) + (v[j][2] * v[j][2] + v[j][3] * v[j][3]); }
            const float rstd = 1.0f / sqrtf(wave_sum(s2) * (1.0f / DM) + LN_EPS);
            LAS unsigned char* hrow = ht + (2 * wid + r) * TROW + c0 * 2;
            u32x4 ho[2], h8;
#pragma unroll
            for (int j = 0; j < 4; ++j) { const f32x4 y = v[j] * rstd * gv[j] + bv[j];
                const f32x4 sh = *(const f32x4*)(md + 3072 + c0 + 4 * j), sc = *(const f32x4*)(md + 4096 + c0 + 4 * j); const f32x4 h = y * (sc + 1.0f) + sh;
                h8[j] = pk4_fp8(h[0], h[1], h[2], h[3]);
                ho[j >> 1][2 * (j & 1)] = pk2(h[0], h[1]); ho[j >> 1][2 * (j & 1) + 1] = pk2(h[2], h[3]); }
            *(u32x4*)(H8 + (size_t)m * DM + c0) = h8;
            *(LAS u32x4*)hrow = ho[0]; *(LAS u32x4*)(hrow + 16) = ho[1];
        }
        __syncthreads();
        if (wid < 2) {
            f32x4 d = {0.f, 0.f, 0.f, 0.f};
            const LAS unsigned char* ap = ht + (lane & 15) * TROW + (lane >> 4) * 16;
            const LAS unsigned char* bp = wrt + (16 * wid + (lane & 15)) * TROW + (lane >> 4) * 16;
#pragma unroll 8
            for (int s = 0; s < 32; ++s) d = __builtin_amdgcn_mfma_f32_16x16x32_bf16(*(const LAS bf16x8*)(ap + 64 * s), *(const LAS bf16x8*)(bp + 64 * s), d, 0, 0, 0);
            const float rbias = rb[16 * wid + (lane & 15)];
#pragma unroll
            for (int i = 0; i < 4; ++i) logt[(4 * (lane >> 4) + i) * 33 + 16 * wid + (lane & 15)] = d[i] + rbias;
        }
        __syncthreads();
        {
            const int half = lane >> 5, e = lane & 31, rr = 2 * wid + half;
            float v = logt[rr * 33 + e];
            float tv[4]; int te[4];
#define MX_DPP(x, ctrl, rmask) __builtin_bit_cast(float, __builtin_amdgcn_update_dpp(__builtin_bit_cast(int, x), __builtin_bit_cast(int, x), ctrl, rmask, 0xf, false))
#pragma unroll
            for (int k = 0; k < 4; ++k) {
                float m = v;
                m = fmaxf(m, MX_DPP(m, 0xB1, 0xf)); m = fmaxf(m, MX_DPP(m, 0x4E, 0xf)); m = fmaxf(m, MX_DPP(m, 0x141, 0xf)); m = fmaxf(m, MX_DPP(m, 0x140, 0xf));
                m = fmaxf(m, MX_DPP(m, 0x142, 0xa));
                const float m0 = __builtin_bit_cast(float, __builtin_amdgcn_readlane(__builtin_bit_cast(int, m), 31)), m1 = __builtin_bit_cast(float, __builtin_amdgcn_readlane(__builtin_bit_cast(int, m), 63));
                const float mh = half ? m1 : m0;
                const unsigned long long bal = __ballot(v == mh);
                const unsigned hm = half ? (unsigned)(bal >> 32) : (unsigned)bal;
                const int bi = __builtin_ctz(hm);
                tv[k] = mh; te[k] = bi;
                v = (e == bi) ? -3.0e38f : v;
            }
#undef MX_DPP
            const float e1 = __expf(tv[1] - tv[0]), e2 = __expf(tv[2] - tv[0]), e3 = __expf(tv[3] - tv[0]); const float rs = 1.0f / (1.0f + e1 + e2 + e3);
            if (e == 0) { const int irow = blk * 16 + rr;
                const float ww[4] = {rs, e1 * rs, e2 * rs, e3 * rs};
#pragma unroll
                for (int k = 0; k < 4; ++k) { const unsigned lr = __hip_atomic_fetch_add(lcnt + te[k], 1u, __ATOMIC_RELAXED, __HIP_MEMORY_SCOPE_WORKGROUP);
                    ent[irow * 4 + k] = (unsigned)te[k] | (lr << 8); entw[irow * 4 + k] = ww[k]; } }
        }
    }
#undef LN1_LOAD
    __syncthreads();
    if (tid < 32) lbase[tid] = __hip_atomic_fetch_add(cnt_l + tid * 64, lcnt[tid], __ATOMIC_RELAXED, __HIP_MEMORY_SCOPE_AGENT);
    __syncthreads();
    for (int sidx = tid; sidx < nrows * 4; sidx += NTHR) { const unsigned en = ent[sidx]; const int e = en & 255u; const unsigned lr = en >> 8;
        const int m = ln_row(wg, sidx >> 2, last); const size_t pos = (size_t)e * T + lbase[e] + lr; list[pos] = (unsigned)m * 4u + (unsigned)(sidx & 3); gsort[pos] = entw[sidx]; }
    __syncthreads();
}
DI void ln2_phase(bf16* X, const unsigned char* Y, bf16* H, float* out, const float* mod_l, const float* mod_n, const float* lng1, const float* lnb1, const float* lng, const float* lnb, const int wg, const int last, const int wid, const int lane) {
    const int nrows = last ? 256 : 288, c0 = 16 * lane;
    f32x4 gv[4], bv[4], gv1[4], bv1[4];
#pragma unroll
    for (int q = 0; q < 4; ++q) { gv[q] = *(const f32x4*)(lng + c0 + 4 * q); bv[q] = *(const f32x4*)(lnb + c0 + 4 * q); gv1[q] = *(const f32x4*)(lng1 + c0 + 4 * q); bv1[q] = *(const f32x4*)(lnb1 + c0 + 4 * q); }
    u32x4 xnext[2], ynext[4];
#define LN2_LOAD(mm) do { const bf16* xp_ = X + (size_t)(mm) * DM + c0; const unsigned char* yp_ = Y + (size_t)(mm) * 4 * DM + c0; \
        xnext[0] = *(const u32x4*)xp_; xnext[1] = *(const u32x4*)(xp_ + 8); \
        _Pragma("unroll") for (int k = 0; k < 4; ++k) ynext[k] = *(const u32x4*)(yp_ + (size_t)k * DM); } while (0)
    if (wid < nrows) LN2_LOAD(ln_row(wg, wid, last));
    for (int i = wid; i < nrows; i += NWAVES) {
        const int m = ln_row(wg, i, last); const int b = m / TPB, t = m - b * TPB; const int mrow = (t < CTXL) ? 32 : b;
        const float* md = mod_l + (size_t)mrow * 6144;
        bf16* xr = X + (size_t)m * DM + c0;
        u32x4 xcur[2], ycur[4];
        xcur[0] = xnext[0]; xcur[1] = xnext[1];
#pragma unroll
        for (int k = 0; k < 4; ++k) ycur[k] = ynext[k];
        if (i + NWAVES < nrows) LN2_LOAD(ln_row(wg, i + NWAVES, last));
        f32x4 v[4]; float s = 0.f;
        { float s1 = 0.f;
#pragma unroll
          for (int q = 0; q < 4; ++q) { const unsigned xa = xcur[q >> 1][2 * (q & 1)], xb = xcur[q >> 1][2 * (q & 1) + 1]; v[q] = (f32x4){bflo(xa), bfhi(xa), bflo(xb), bfhi(xb)}; s1 += (v[q][0] + v[q][1]) + (v[q][2] + v[q][3]); }
          const float mean1 = wave_sum(s1) * (1.0f / DM); float q1 = 0.f;
#pragma unroll
          for (int q = 0; q < 4; ++q) { v[q] = v[q] - mean1; q1 += (v[q][0] * v[q][0] + v[q][1] * v[q][1]) + (v[q][2] * v[q][2] + v[q][3] * v[q][3]); }
          const float rstd1 = 1.0f / sqrtf(wave_sum(q1) * (1.0f / DM) + LN_EPS);
#pragma unroll
          for (int q = 0; q < 4; ++q) v[q] = v[q] * rstd1 * gv1[q] + bv1[q]; }
#pragma unroll
        for (int q = 0; q < 4; ++q) { f32x4 y = (f32x4){0.f, 0.f, 0.f, 0.f};
#pragma unroll
            for (int k = 0; k < 4; ++k) { const unsigned w = ycur[k][q]; const f32x2 lo = __builtin_amdgcn_cvt_pk_f32_fp8(w, false), hi2 = __builtin_amdgcn_cvt_pk_f32_fp8(w, true); y += (f32x4){lo[0], lo[1], hi2[0], hi2[1]}; }
            const f32x4 g2 = *(const f32x4*)(md + 5120 + c0 + 4 * q) * (1.0f / Y_SCALE);
            v[q] = v[q] * DN_ALPHA + g2 * y; s += (v[q][0] + v[q][1]) + (v[q][2] + v[q][3]); }
        const float mean = wave_sum(s) * (1.0f / DM); float s2 = 0.f;
#pragma unroll
        for (int q = 0; q < 4; ++q) { v[q] = v[q] - mean; s2 += (v[q][0] * v[q][0] + v[q][1] * v[q][1]) + (v[q][2] * v[q][2] + v[q][3] * v[q][3]); }
        const float rstd = 1.0f / sqrtf(wave_sum(s2) * (1.0f / DM) + LN_EPS);
        if (last) { float* orow = out + ((size_t)b * SEQ + (t - CTXL)) * DM + c0;
#pragma unroll
            for (int q = 0; q < 4; ++q) *(f32x4*)(orow + 4 * q) = v[q] * rstd * gv[q] + bv[q];
        } else { const float* mn = mod_n + (size_t)mrow * 6144 + c0;
            u32x4 xo[2], ho[2];
#pragma unroll
            for (int q = 0; q < 4; ++q) { const f32x4 y = v[q] * rstd * gv[q] + bv[q];
                xo[q >> 1][2 * (q & 1)] = pk2(y[0], y[1]); xo[q >> 1][2 * (q & 1) + 1] = pk2(y[2], y[3]);
                const f32x4 sh = *(const f32x4*)(mn + 4 * q), sc = *(const f32x4*)(mn + 1024 + 4 * q); const f32x4 h = y * (sc + 1.0f) + sh;
                ho[q >> 1][2 * (q & 1)] = pk2(h[0], h[1]); ho[q >> 1][2 * (q & 1) + 1] = pk2(h[2], h[3]); }
            *(u32x4*)xr = xo[0]; *(u32x4*)(xr + 8) = xo[1];
            if (INPROJ_FP8) { u32x4 h8;
#pragma unroll
                for (int q = 0; q < 4; ++q) { const f32x4 y = v[q] * rstd * gv[q] + bv[q]; const f32x4 sh = *(const f32x4*)(mn + 4 * q), sc = *(const f32x4*)(mn + 1024 + 4 * q); const f32x4 h = (y * (sc + 1.0f) + sh) * H_SCALE; h8[q] = pk4_fp8(h[0], h[1], h[2], h[3]); }
                *(u32x4*)((unsigned char*)H + (size_t)m * DM + c0) = h8; }
            else { bf16* hr = H + (size_t)m * DM + c0; *(u32x4*)hr = ho[0]; *(u32x4*)(hr + 8) = ho[1]; }
        }
    }
#undef LN2_LOAD
}

DI void build_expert_table(LAS int* tab, const unsigned* cnt_l) {
    const int tid = opaque_tid();
    __syncthreads();
    if (tid < 32) tab[33 + tid] = (int)__hip_atomic_load(cnt_l + tid * 64, __ATOMIC_RELAXED, __HIP_MEMORY_SCOPE_AGENT);
    __syncthreads();
    if (tid == 0) { int acc = 0; for (int e = 0; e < 32; ++e) { tab[e] = acc; acc += (tab[33 + e] + 255) >> 8; } tab[32] = acc; }
    __syncthreads();
}


DI void attn_phase_even(LAS unsigned char* lds, const bf16* P, const bf16* PQ, unsigned char* MIX, const float* rpb_j, const int G, const int bx, const int shadow) {
    for (int i = 0;; ++i) {
        const int L = i * G + bx;
        att::AttnP p{}; bool na = false, big = false; p.shadow = shadow;
        p.qp = NPP; p.kp = NPP; p.vp = NPP; p.op = DM; p.K2 = P; p.k2p = NPP;
        if (L < 1024) { int b = L >> 5, h = (L >> 2) & 7, qb = L & 3;
            if (G == 256) { const int x = bx & 7, j = bx >> 3, g = x + 8 * (j >> 4), jq = j & 15; b = 8 * i + (g >> 1); h = 4 * (g & 1) + (jq >> 2); qb = jq & 3; }
            const int row0 = b * TPB + CTXL + qb * 512;
            p.Q = PQ + (size_t)row0 * NPP + 1536 + 64 * h; p.K = PQ + 2048 + 64 * (h >> 2); p.V = P + 2176 + 64 * (h >> 2); p.O = MIX + (size_t)row0 * DM + 512 + 64 * h; p.kt0 = b * TPB; p.ntiles = 36; big = true; }
        else if (L < 3072) { const int L2 = L - 1024; int b = L2 >> 6, h = (L2 >> 3) & 7, rg = (L2 + (L2 >> 8)) & 7  ;
            if (G == 256) { const int x = bx & 7, j = bx >> 3, g = x + 8 * (j >> 3); b = 4 * (i - 4) + (g >> 3); h = g & 7; rg = ((j & 7) + i) & 7; }
 const int qr0 = 4 * rg, row0 = b * TPB + CTXL + qr0 * 64;
            p.Q = P + (size_t)row0 * NPP + 64 * h; p.K = P + 512 + 64 * h; p.V = P + 1024 + 64 * h; p.O = MIX + (size_t)row0 * DM + 64 * h;
            p.brow0 = b * TPB; p.na_lo = min(max(qr0 - 4, 0), 24); p.na_nloc = min(max(qr0 - 1, 0), 24) + 7 - p.na_lo + 1; p.ntiles = p.na_nloc + 4; p.qr0 = qr0; p.rpb = rpb_j + h * 465; na = true; }
        else if (L < 3584) { const int L3 = L - 3072, b = L3 >> 4, hh = L3 & 15; const int row0 = b * TPB;
            if (hh < 8) { p.Q = P + (size_t)row0 * NPP + 64 * hh; p.K = P + 512 + 64 * hh; p.V = P + 1024 + 64 * hh; p.O = MIX + (size_t)row0 * DM + 64 * hh; }
            else { const int h = hh - 8; p.Q = PQ + (size_t)row0 * NPP + 1536 + 64 * h; p.K = PQ + 2048 + 64 * (h >> 2); p.V = P + 2176 + 64 * (h >> 2); p.O = MIX + (size_t)row0 * DM + 512 + 64 * h; }
            p.kt0 = row0; p.ntiles = 4; }
        else break;
#ifndef ATT_MASK
#define ATT_MASK 15
#endif
        if (na) { if (ATT_MASK & 1) att::attn_unit<64, 1>(lds, p); } else if (big) { if (ATT_MASK & 2) att::attn_unit_w64<64>(lds, p); } else { if (ATT_MASK & 2) att::attn_unit<64, 0>(lds, p); }
    }
}
DI void attn_phase_odd(LAS unsigned char* lds, const bf16* P, const bf16* PQ, const bf16* QM, const bf16* KVM, unsigned char* MIX, const float lam, const float oml, const float* subln, const int G, const int bx, const int last, const int shadow) {
    const int total = last ? 2048 : 2432;
    for (int i = 0;; ++i) {
        const int L = i * G + bx; if (L >= total) break;
        att::AttnP p{}; bool diff = false, big = false; p.shadow = shadow;
        p.op = DM; p.K2 = PQ + 1920; p.k2p = NPP;
        if (L < 1024 || (L >= 2048 && L < 2176)) { int b, h, row0;
            if (L < 1024) { b = L >> 5; h = (L >> 3) & 3; int qb = L & 7;
                if (G == 256) { const int x = bx & 7, j = bx >> 3, g = x + 8 * (j >> 3); b = 8 * i + (g >> 2); h = g & 3; qb = j & 7; }
                row0 = b * TPB + CTXL + qb * 256; p.ntiles = 36; } else { const int L3 = L - 2048; b = L3 >> 2; h = L3 & 3; row0 = b * TPB; p.ntiles = 4; }
            p.Q = PQ + (size_t)row0 * NPP + 128 * h; p.qp = NPP; p.K = PQ + 512 + 128 * h; p.kp = NPP; p.V = P + 1024 + 128 * h; p.vp = NPP; p.O = MIX + (size_t)row0 * DM + 128 * h; p.kt0 = b * TPB; diff = true; }
        else { int b, h, row0;
            if (L < 2048) { const int L2 = L - 1024; b = L2 >> 5; h = (L2 >> 2) & 7; int qb = L2 & 3;
                if (G == 256) { const int x = bx & 7, j = bx >> 3, g = x + 8 * (j >> 2); b = 8 * (i - 4) + (g >> 3); h = g & 7; qb = j & 3; }
                row0 = b * TPB + CTXL + qb * 512; p.ntiles = 36; p.rope_q = 1; p.qpos0 = qb * 512; big = true; }
            else { const int L4 = L - 2176; b = L4 >> 3; h = L4 & 7; row0 = b * TPB; p.ntiles = 4; p.rope_q = 0; p.qpos0 = 0; }
            p.Q = QM + (size_t)row0 * 768 + 96 * h; p.qp = 768; p.K = KVM + 128 * h; p.kp = DM; p.V = KVM + 128 * h + 64; p.vp = DM; p.O = MIX + (size_t)row0 * DM + 512 + 64 * h; p.kt0 = b * TPB; }
        if (diff) { if (ATT_MASK & 4) att::attn_unit_diff(lds, p, lam, oml, subln); } else if (big) { if (ATT_MASK & 8) att::attn_unit_w64<96>(lds, p); } else { if (ATT_MASK & 8) att::attn_unit<96, 0>(lds, p); }
    }
}

constexpr int NPHASE = 2 + 9 * NL;
struct Args { const float* in[32]; float* out; unsigned char* ws; int ph_lo, ph_hi, li, pad; };
__global__ void __launch_bounds__(NTHR, 2) fwd(Args a) {
    extern __shared__ __attribute__((aligned(16))) unsigned char lds_raw[];
    LAS unsigned char* lds = (LAS unsigned char*)lds_raw;
    volatile LAS unsigned* MISC = (volatile LAS unsigned*)(lds + MISC_OFF);
    LAS int* tab = (LAS int*)(lds + MISC_OFF + 256);
    LAS int* utab = (LAS int*)(lds + pg8::UTAB_OFF); LAS unsigned* rtab = (LAS unsigned*)(lds + pg8::RTAB_OFF);
    const int tid = opaque_tid(), lane = tid & 63, wid = __builtin_amdgcn_readfirstlane(tid >> 6);
    const int G = gridDim.x, bx = blockIdx.x, gw = bx * NWAVES + wid, ngw = G * NWAVES;
    for (int u = tid; u < (LDS_BYTES - MISC_OFF) / 4; u += NTHR) MISC[u] = 0u;
    __syncthreads();
    unsigned char* ws = a.ws;
    unsigned* ctl = (unsigned*)(ws + WS_CTL);
    const int lo = a.ph_lo, hi = a.ph_hi;
    XcdBarrier bar; bar.bar = ctl + CW_BAR + a.li * XCD_BAR_WORDS; bar.x = 0; bar.st = MISC;
    if (hi - lo > 1) bar = xcd_barrier_post(ctl + CW_BAR + a.li * XCD_BAR_WORDS, MISC);
#ifndef PH_MASK
#define PH_MASK 0x7ff
#endif
#define PHM(k) (((PH_MASK) >> ((k) < 2 ? (k) : 2 + ((k) - 2) % 9)) & 1)
#define IN(k) (PHM(k) && lo <= (k) && (k) < hi)
#ifndef PROBE_DUP
#define PROBE_DUP 0
#endif
#define NREP(kind) (1 + (((PROBE_DUP) >> (kind)) & 1))
#define SEAM(k) do { if (lo <= (k) && (k) + 1 < hi) xcd_barrier(bar); } while (0)
    float* mod = (float*)(ws + WS_MOD);
    bf16* X = (bf16*)(ws + WS_X); bf16* H = (bf16*)(ws + WS_H); bf16* P = (bf16*)(ws + WS_P); bf16* QM = (bf16*)(ws + WS_QM); bf16* KVM = (bf16*)(ws + WS_KVM);
    bf16* PQ = (bf16*)(ws + WS_PQ);
    unsigned char* MIX = ws + WS_MIX; unsigned char* ACT = ws + WS_ACT; unsigned char* H8 = ws + WS_H8; unsigned char* Y = ws + WS_Y;
    unsigned* list = (unsigned*)(ws + WS_LIST); float* gsort = (float*)(ws + WS_GSORT);

    if (IN(0)) for (int rep = 0; rep < NREP(0); ++rep) {
        for (int it = bx; it < 192; it += G) p0_mod_item(lds, a.in[1], a.in[3], a.in[4], a.in[5], mod, it);
        p0_transposes(lds, a.in, ws, gw, ngw, wid, lane);
        p0_zero(ws, bx * NTHR + tid, G * NTHR);
    }
    SEAM(0);
    if (IN(1)) p0b_rows(a.in[0], a.in[2], mod, X, H, gw, ngw, lane);
    SEAM(1);
    for (int l = 0; l < NL; ++l) {
        const int tid = opaque_tid(), lane = tid & 63, wid = __builtin_amdgcn_readfirstlane(tid >> 6), gw = bx * NWAVES + wid;
        const int pb = 2 + 9 * l, odd = l & 1, j = l >> 1, last = (l == NL - 1) ? 1 : 0;
        const float* mod_l = mod + (size_t)l * 33 * 6144;
        unsigned* cnt_l = ctl + CW_CNT + l * 32 * 64;
        if (IN(pb + 0)) for (int rep = 0; rep < NREP(2); ++rep) {
#if INPROJ_FP8
            pg8::DenseSched S; S.init(H, 512, (const bf16*)(ws + WS_WIN) + (size_t)l * 2304 * 1024, 512, NTILE_M, odd ? 8 : 9, G, bx, 0);
            pg8::EpiBf16 E{P, NPP, 1.0f / (WI_SCALE * H_SCALE)};
            pg8::gemm_phase<true>(lds, 1024, S, E);
#else
            pg8::DenseSched S; S.init(H, DM, (const bf16*)(ws + WS_WIN) + (size_t)l * 2304 * 1024, 1024, NTILE_M, odd ? 8 : 9, G, bx, 0);
            pg8::EpiBf16 E{P, NPP, 1.0f};
            pg8::gemm_phase<false>(lds, 2048, S, E);
#endif
        }
        SEAM(pb + 0);
        if (IN(pb + 1)) {
            if (odd) post_odd_rows(P, PQ, a.in[22] + j * 256, a.in[24] + j * 128, gw, ngw, lane);
            else post_even_rows(P, PQ, a.in[13] + j * 64, a.in[14] + j * 64, gw, ngw, lane);
        }
        SEAM(pb + 1);
        if (odd) {
            if (IN(pb + 2)) for (int rep = 0; rep < NREP(4); ++rep) {
                { pg8::DenseSched S; S.init(PQ + 1536, NPP, (const bf16*)(ws + WS_WUQ) + (size_t)j * 768 * 256, 256, NTILE_M, 3, G, bx, 0); pg8::EpiBf16 E{QM, 768, 1.0f}; pg8::gemm_phase<false>(lds, 512, S, E); }
                { pg8::DenseSched S; S.init(PQ + 1792, NPP, (const bf16*)(ws + WS_WUKV) + (size_t)j * 1024 * 256, 256, NTILE_M, 4, G, (bx + G - (NTILE_M * 3) % G) % G, 0); pg8::EpiBf16 E{KVM, DM, 1.0f}; pg8::gemm_phase<false>(lds, 512, S, E); }
            }
            SEAM(pb + 2);
        }
        if (IN(pb + 3)) for (int rep = 0; rep < NREP(5); ++rep) {
            if (odd) {
                const float s1 = wave_sum(a.in[17][j * 64 + lane] * a.in[18][j * 64 + lane]), s2 = wave_sum(a.in[19][j * 64 + lane] * a.in[20][j * 64 + lane]);
                const float lam_init = (l == 1) ? 0.35550906759310934f : 0.55605820415610350f;
                const float lam = __expf(s1) - __expf(s2) + lam_init;
#ifndef PROBE_SHADOW
#define PROBE_SHADOW 0
#endif
                attn_phase_odd(lds, P, PQ, QM, KVM, rep ? ACT : MIX, lam, 1.0f - lam_init, a.in[21] + j * 128, G, bx, last, rep ? PROBE_SHADOW : 0);
            } else attn_phase_even(lds, P, PQ, rep ? ACT : MIX, a.in[12] + (size_t)j * 8 * 465, G, bx, rep ? PROBE_SHADOW : 0);
        }
        SEAM(pb + 3 - ((odd || true) ? 0 : 0));
        if (IN(pb + 4)) {
            pg8::DenseSched S; S.init((const bf16*)MIX, 512, (const bf16*)(ws + WS_WOUT + (size_t)l * 1024 * 1024), 512, last ? 256 : NTILE_M, 4, G, bx, last);
            pg8::EpiResid E{X, mod_l};
            pg8::gemm_phase<true>(lds, 1024, S, E);
        }
        const int pre_rt = (IN(pb + 4) && IN(pb + 5) && G == 256) ? 1 : 0;
        if (pre_rt) { __syncthreads(); ln1_router_table(lds, a.in[26] + (size_t)l * 1024 * 32); }
        SEAM(pb + 4);
        if (IN(pb + 5)) {
            for (int wg = bx; wg < 256; wg += G)
                ln1_router_phase(lds, X, H8, mod_l, a.in[6] + l * 1024, a.in[7] + l * 1024, a.in[26] + (size_t)l * 1024 * 32, a.in[27] + l * 32, cnt_l, list, gsort, wg, last, pre_rt);
        }
        SEAM(pb + 5);
        if (IN(pb + 6)) for (int rep = 0; rep < NREP(8); ++rep) {
            build_expert_table(tab, cnt_l);
            const int nun = pg8::build_unit_table(tab, utab, 8, G, bx);
            pg8::GroupSched S{tab, utab, rtab, nun, 8, G, bx, 1024, (const char*)H8, list, gsort, 1, (const char*)(ws + WS_WGU + (size_t)l * 32 * 2048 * 1024), (size_t)2048 * 1024, a.in[29] + (size_t)l * 32 * 2048, 2048};
            S.fill_sync(0, tid); S.fill_sync(1, tid); __syncthreads();
            pg8::EpiSwiglu E{ACT, rtab};
            pg8::gemm_phase<true>(lds, 1024, S, E);
        }
        int nun_d = -1;
        if (IN(pb + 6) && IN(pb + 7) && NREP(9) == 1) {
            __syncthreads();
            build_expert_table(tab, cnt_l);
            nun_d = pg8::build_unit_table(tab, utab, 4, G, bx);
            pg8::GroupSched S{tab, utab, rtab, nun_d, 4, G, bx, 1024, (const char*)ACT, list, gsort, 0, (const char*)(ws + WS_WD + (size_t)l * 32 * 1024 * 1024), (size_t)1024 * 1024, a.in[31] + (size_t)l * 32 * 1024, 1024};
            S.fill_sync(0, tid);
        }
        SEAM(pb + 6);
        if (IN(pb + 7)) for (int rep = 0; rep < NREP(9); ++rep) {
            int nun = nun_d;
            if (nun_d < 0) { build_expert_table(tab, cnt_l); nun = pg8::build_unit_table(tab, utab, 4, G, bx); }
            pg8::GroupSched S{tab, utab, rtab, nun, 4, G, bx, 1024, (const char*)ACT, list, gsort, 0, (const char*)(ws + WS_WD + (size_t)l * 32 * 1024 * 1024), (size_t)1024 * 1024, a.in[31] + (size_t)l * 32 * 1024, 1024};
            if (nun_d < 0) S.fill_sync(0, tid);
            __syncthreads();
            pg8::EpiDown E{Y, rtab, tab};
            pg8::gemm_phase<true>(lds, 1024, S, E);
        }
        SEAM(pb + 7);
        if (IN(pb + 8)) {
            for (int wg = bx; wg < 256; wg += G)
                ln2_phase(X, Y, H, a.out, mod_l, mod + (size_t)(last ? l : l + 1) * 33 * 6144, a.in[6] + l * 1024, a.in[7] + l * 1024, a.in[8] + l * 1024, a.in[9] + l * 1024, wg, last, wid, lane);
        }
        SEAM(pb + 8);
    }
#undef IN
#undef SEAM
}

extern "C" void kernel_launch(void* const* d_in, const int* in_sizes, int n_in, void* d_out, int out_size, void* d_ws, size_t ws_size, hipStream_t stream) {
    static int grid = 0;
    if (grid == 0) {
        if (n_in != 32 || ws_size < WS_END || out_size != NBATCH * SEQ * DM) { fprintf(stderr, "kernel_launch: unexpected shapes (n_in %d, out %d, ws %zu)\n", n_in, out_size, ws_size); grid = -1; return; }
        int dev = 0, cus = 0, per_cu = 0;
        if (hipGetDevice(&dev) != hipSuccess || hipDeviceGetAttribute(&cus, hipDeviceAttributeMultiprocessorCount, dev) != hipSuccess) { grid = -1; return; }
        if (hipFuncSetAttribute((const void*)fwd, hipFuncAttributeMaxDynamicSharedMemorySize, LDS_BYTES) != hipSuccess) { fprintf(stderr, "kernel_launch: hipFuncSetAttribute failed\n"); grid = -1; return; }
        if (hipOccupancyMaxActiveBlocksPerMultiprocessor(&per_cu, (const void*)fwd, NTHR, LDS_BYTES) != hipSuccess || per_cu < 1) fprintf(stderr, "kernel_launch: occupancy query reports %d\n", per_cu);
        (void)hipGetLastError();
        grid = cus < 256 ? cus : 256;
    }
    if (grid < 0) return;
    (void)hipMemsetAsync((char*)d_ws + WS_CTL, 0, CTL_ZERO_BYTES, stream);
    Args a{};
    for (int i = 0; i < 32; ++i) a.in[i] = (const float*)d_in[i];
    a.out = (float*)d_out; a.ws = (unsigned char*)d_ws;
#if MK_ONE_LAUNCH
    a.ph_lo = 0; a.ph_hi = NPHASE; a.li = 0;
    hipLaunchKernelGGL(fwd, dim3(grid), dim3(NTHR), LDS_BYTES, stream, a);
#else
    int li = 0;
    for (int ph = 0; ph < NPHASE; ++ph) {
        if (ph >= 2 && ((ph - 2) % 9) == 2 && (((ph - 2) / 9) & 1) == 0) continue;
        a.ph_lo = ph; a.ph_hi = ph + 1; a.li = 0; ++li;
        hipLaunchKernelGGL(fwd, dim3(grid), dim3(NTHR), LDS_BYTES, stream, a);
    }
#endif
}
```

```cpp
#include <hip/hip_runtime.h>
#include <cstdio>
#include <cstdint>

#ifndef MK_ONE_LAUNCH
#define MK_ONE_LAUNCH 1
#endif
#ifndef PROBE_SHADOW
#define PROBE_SHADOW 0
#endif

#define GAS __attribute__((address_space(1)))
#define LAS __attribute__((address_space(3)))
#define DI __device__ __forceinline__
typedef unsigned short bf16;
typedef short bf16x8 __attribute__((ext_vector_type(8)));
typedef short s16x4 __attribute__((ext_vector_type(4)));
typedef float f32x2 __attribute__((ext_vector_type(2)));
typedef float f32x4 __attribute__((ext_vector_type(4)));
typedef float f32x16 __attribute__((ext_vector_type(16)));
typedef unsigned u32x2 __attribute__((ext_vector_type(2)));
typedef unsigned u32x4 __attribute__((ext_vector_type(4)));

constexpr int DM = 1024, NBATCH = 32, SEQ = 2048, CTXL = 256, TPB = SEQ + CTXL  ;
constexpr int T = NBATCH * TPB;
constexpr int NL = 4, NPP = 2304;
constexpr int NE = 32, DE = 1024;
constexpr int NTILE_M = T / 256;
constexpr float LOG2E = 1.4426950408889634f;
constexpr float C2 = 0.125f * LOG2E;
constexpr float C2M = 0.10206207261596575f * LOG2E;
constexpr float DN_ALPHA = 1.6817928305074290f;
constexpr float LN_EPS = 1e-6f, RMS_EPS = 1e-6f;
constexpr float LOG2_THETA = 13.287712379549449f;

constexpr size_t MiB = 1u << 20;
constexpr size_t WS_CTL = 0, CTL_ZERO_BYTES = 1 * MiB;
constexpr size_t WS_MOD = 1 * MiB;
constexpr size_t WS_WIN = 8 * MiB;
constexpr size_t WS_WOUT = 28 * MiB;
constexpr size_t WS_WUQ = 36 * MiB;
constexpr size_t WS_WUKV = 37 * MiB;
constexpr size_t WS_LIST = 40 * MiB;
constexpr size_t WS_GATE = 50 * MiB;
constexpr size_t WS_WGU = 64 * MiB;
constexpr size_t WS_WD = 576 * MiB;
constexpr size_t WS_X = 832 * MiB;
constexpr size_t WS_H = 1120 * MiB;
constexpr size_t WS_P = 1264 * MiB;
constexpr size_t WS_QM = 1588 * MiB;
constexpr size_t WS_KVM = 1696 * MiB;
constexpr size_t WS_MIX = 1840 * MiB;
constexpr size_t WS_ACT = 1984 * MiB;
constexpr size_t WS_Y = 2576 * MiB;
constexpr size_t WS_H8 = 3152 * MiB;
constexpr size_t WS_GSORT = 3224 * MiB;
constexpr size_t WS_PQ = 3234 * MiB;
constexpr size_t WS_END = 3558 * MiB;
constexpr float WGU_SCALE = 64.0f, WD_SCALE = 128.0f, Y_SCALE = 64.0f, WO_SCALE = 128.0f, MIX_SCALE = 16.0f;
#ifndef INPROJ_FP8
#define INPROJ_FP8 1
#endif
constexpr float WI_SCALE = 64.0f, H_SCALE = 8.0f;
constexpr int ACT_ROWS = T * 4 + 32 * 256;
static_assert(WS_MOD + (size_t)4 * 33 * 6144 * 4 <= WS_WIN && WS_WIN + (size_t)4 * 2304 * 1024 * 2 <= WS_WOUT && WS_LIST + (size_t)32 * T * 4 <= WS_GATE && WS_GATE + (size_t)T * 16 <= WS_WGU, "ws map 1");
static_assert(WS_X + (size_t)T * 4096 <= WS_H && WS_H + (size_t)T * 2048 <= WS_P && WS_P + (size_t)T * NPP * 2 <= WS_QM && WS_QM + (size_t)T * 768 * 2 <= WS_KVM && WS_KVM + (size_t)T * 2048 <= WS_MIX, "ws map 2");
static_assert(WS_MIX + (size_t)T * 2048 <= WS_ACT && WS_ACT + (size_t)ACT_ROWS * 2048 <= WS_Y && WS_Y + (size_t)T * 4 * 2048 <= WS_H8 && WS_H8 + (size_t)T * 1024 <= WS_GSORT && WS_GSORT + (size_t)32 * T * 4 <= WS_PQ && WS_PQ + (size_t)T * NPP * 2 <= WS_END, "ws map 3");
constexpr int CW_TMO = 0;
constexpr int CW_CNT = 1024;
constexpr int CW_BAR = 16384;
constexpr int MAX_LAUNCH = 40;
static_assert(CW_CNT + 4 * 32 * 64 <= CW_BAR && (CW_BAR + MAX_LAUNCH * 3456) * 4 <= (int)CTL_ZERO_BYTES, "ctl");

constexpr int LDS_BYTES = 147456;
constexpr int MISC_OFF = 143360;
constexpr int NWAVES = 8, NTHR = 512;

DI unsigned f2bf(float f) { unsigned u = __builtin_bit_cast(unsigned, f); return (u + 0x7fffu + ((u >> 16) & 1u)) >> 16; }
DI unsigned pk2(float lo, float hi) { return f2bf(lo) | (f2bf(hi) << 16); }
DI float bf2f(unsigned short b) { return __builtin_bit_cast(float, (unsigned)b << 16); }
DI float bflo(unsigned w) { return __builtin_bit_cast(float, w << 16); }
DI float bfhi(unsigned w) { return __builtin_bit_cast(float, w & 0xffff0000u); }
#define WS_DPP(v, ctrl, rmask) __builtin_bit_cast(float, __builtin_amdgcn_update_dpp(0, __builtin_bit_cast(int, v), ctrl, rmask, 0xf, false))
DI float wave_sum(float v) {
    v += WS_DPP(v, 0xB1, 0xf);
    v += WS_DPP(v, 0x4E, 0xf);
    v += WS_DPP(v, 0x141, 0xf);
    v += WS_DPP(v, 0x140, 0xf);
    v += WS_DPP(v, 0x142, 0xa);
    v += WS_DPP(v, 0x143, 0xc);
    return __builtin_bit_cast(float, __builtin_amdgcn_readlane(__builtin_bit_cast(int, v), 63));
}
DI float fast_exp2(float x) { return __builtin_amdgcn_exp2f(x); }
DI unsigned pk4_fp8(float a, float b, float c, float d) { unsigned w = __builtin_amdgcn_cvt_pk_fp8_f32(a, b, 0u, false); return __builtin_amdgcn_cvt_pk_fp8_f32(c, d, w, true); }
DI int opaque_tid() { int t = threadIdx.x; asm volatile("" : "+v"(t)); return t; }
DI const char* uni_ptr(const char* p) { const unsigned long long v = (unsigned long long)p; const unsigned lo = __builtin_amdgcn_readfirstlane((unsigned)v), hi = __builtin_amdgcn_readfirstlane((unsigned)(v >> 32)); return (const char*)(((unsigned long long)hi << 32) | lo); }

#define XB_TMO      128
#define XB_XCNT(j)  (256  + 64 * (j))
#define XB_XSUB(j)  (1280 + 64 * (j))
#define XB_XGEN(j)  (2304 + 64 * (j))
#define XB_TOP      3328
#define XB_TOPGEN   3392
#define XCD_BAR_WORDS 3456
#define XB_SPIN_CAP (1u << 22)
DI unsigned xb_ld(unsigned* p)              { return __hip_atomic_load(p, __ATOMIC_RELAXED, __HIP_MEMORY_SCOPE_AGENT); }
DI unsigned xb_add(unsigned* p, unsigned v) { return __hip_atomic_fetch_add(p, v, __ATOMIC_RELAXED, __HIP_MEMORY_SCOPE_AGENT); }
DI unsigned xb_xcc_id() { return (unsigned)__builtin_amdgcn_s_getreg((3 << 11) | 20) & 0xFu; }
#define XB_SPIN(cond, bar) do { unsigned _sp = 0; while (cond) { __builtin_amdgcn_s_sleep(1); \
    if ((++_sp & 255u) == 0u) { if (xb_ld(&(bar)[XB_TMO])) break; if (_sp > XB_SPIN_CAP) { atomicAdd(&(bar)[XB_TMO], 1u); break; } } } } while (0)
struct XcdBarrier { unsigned* bar; unsigned x; volatile LAS unsigned* st; };
DI XcdBarrier xcd_barrier_post(unsigned* bar, volatile LAS unsigned* st) {
    XcdBarrier b; b.bar = bar; b.x = xb_xcc_id(); b.st = st;
    if (threadIdx.x == 0) (void)xb_add(&bar[XB_XCNT(b.x)], 1u);
    return b;
}
DI void xcd_barrier_complete(unsigned* bar, unsigned x, unsigned& nloc, unsigned& nx) {
    const unsigned G = gridDim.x * gridDim.y * gridDim.z;
    unsigned sum, cnt, mine, sp = 0u;
    for (;;) {
        sum = 0u; cnt = 0u; mine = 0u;
#pragma unroll
        for (unsigned j = 0; j < 16; ++j) { const unsigned c = xb_ld(&bar[XB_XCNT(j)]); sum += c; cnt += (c > 0u) ? 1u : 0u; mine = (j == x) ? c : mine; }
        if (sum == G) break;
        __builtin_amdgcn_s_sleep(1);
        if ((++sp & 255u) == 0u) { if (xb_ld(&bar[XB_TMO])) break; if (sp > XB_SPIN_CAP) { atomicAdd(&bar[XB_TMO], 1u); break; } }
    }
    nloc = mine > 0u ? mine : 1u; nx = cnt > 0u ? cnt : 1u;
}
DI void xcd_barrier(const XcdBarrier& b) {
    asm volatile("s_waitcnt vmcnt(0)" ::: "memory");
    __syncthreads();
    if (threadIdx.x == 0) {
        unsigned* bar = b.bar;
        __builtin_amdgcn_s_waitcnt(0);
        unsigned nloc = b.st[0], nx = b.st[1];
        if (nloc == 0u) { xcd_barrier_complete(bar, b.x, nloc, nx); b.st[0] = nloc; b.st[1] = nx; }
        const unsigned old = xb_add(&bar[XB_XSUB(b.x)], 1u);
        const unsigned gen = old / nloc;
        if (old + 1u == (gen + 1u) * nloc) {
            __builtin_amdgcn_fence(__ATOMIC_RELEASE, "agent");
            asm volatile("s_waitcnt vmcnt(0)" ::: "memory");
            const unsigned og = xb_add(&bar[XB_TOP], 1u);
            const unsigned tg = og / nx;
            if (og + 1u == (tg + 1u) * nx) xb_add(&bar[XB_TOPGEN], 1u);
            else XB_SPIN(xb_ld(&bar[XB_TOPGEN]) == tg, bar);
            __builtin_amdgcn_fence(__ATOMIC_ACQUIRE, "agent");
            xb_add(&bar[XB_XGEN(b.x)], 1u);
            asm volatile("s_waitcnt vmcnt(0)" ::: "memory");
        } else {
            XB_SPIN(xb_ld(&bar[XB_XGEN(b.x)]) == gen, bar);
            __builtin_amdgcn_fence(__ATOMIC_ACQUIRE, "agent");
            asm volatile("s_waitcnt vmcnt(0)" ::: "memory");
        }
    }
    __syncthreads();
}

namespace pg8 {
constexpr int BM = 256, BK = 64, HALF = 128, HTB = HALF * BK * 2, STAGE_BYTES = 8 * HTB, NXCD = 8, WGM = 8;
DI int lds_byte(int r, int c) { const int st = (r >> 4) * 2 + (c >> 5), rr = r & 15, cc = c & 31, ob = rr * 64 + cc * 2; return st * 1024 + (ob ^ (((ob >> 9) & 1) << 5)); }
DI void stage_rc(int b, int& R, int& C) { const int st = b / 1024, sb = b % 1024, swz = sb ^ (((sb >> 9) & 1) << 5); R = (st >> 1) * 16 + swz / 64; C = (st & 1) * 32 + (swz % 64) / 2; }
DI int perm32(int rho) { const int n = rho >> 4, i = rho & 15; return 8 * (i >> 2) + 4 * n + (i & 3); }
DI void glds_s(const char* base, unsigned voff, unsigned dst) { unsigned keep;
    asm volatile("s_mov_b32 %0, m0\n\ts_mov_b32 m0, %3\n\ts_nop 4\n\tglobal_load_lds_dwordx4 %1, %2\n\ts_mov_b32 m0, %0" : "=&s"(keep) : "v"(voff), "s"(base), "s"(dst) : "memory"); }
DI void glds_dword(const char* base, unsigned voff, unsigned dst) { unsigned keep;
    asm volatile("s_mov_b32 %0, m0\n\ts_mov_b32 m0, %3\n\ts_nop 4\n\tglobal_load_lds_dword %1, %2\n\ts_mov_b32 m0, %0" : "=&s"(keep) : "v"(voff), "s"(base), "s"(dst) : "memory"); }
typedef float f32x2_cv __attribute__((ext_vector_type(2))); typedef __bf16 bf16x2_cv __attribute__((ext_vector_type(2)));
DI unsigned cvt_pk_bf16(float lo, float hi) { const f32x2_cv v = {lo, hi}; const bf16x2_cv b = __builtin_convertvector(v, bf16x2_cv); return __builtin_bit_cast(unsigned, b); }

typedef int i32x4v __attribute__((ext_vector_type(4)));
typedef int i32x8v __attribute__((ext_vector_type(8)));
DI i32x8v cat8(const bf16x8 a, const bf16x8 b) { return __builtin_shufflevector(__builtin_bit_cast(i32x4v, a), __builtin_bit_cast(i32x4v, b), 0, 1, 2, 3, 4, 5, 6, 7); }
DI void mfma_fp8_acc(f32x4& c, const i32x8v a, const i32x8v b) { asm volatile("v_mfma_f32_16x16x128_f8f6f4 %0, %1, %2, %0" : "+v"(c) : "v"(a), "v"(b)); }
DI void mfma_fp8_new(f32x4& c, const i32x8v a, const i32x8v b) { asm volatile("v_mfma_f32_16x16x128_f8f6f4 %0, %1, %2, 0" : "=&v"(c) : "v"(a), "v"(b)); }
#define MFMA_DRAIN() asm volatile("s_nop 15\n\ts_nop 15\n\ts_nop 15\n\ts_nop 15\n\ts_nop 15" ::: "memory")
struct Unit { int pm, pn, e, mt, idx; };

template <bool FP8, class Epi, class Sched>
DI void gemm_phase(LAS unsigned char* lds, const int KB_in, const Sched& S, const Epi& E) {
    int K = KB_in; asm volatile("" : "+s"(K));
    const int tid = opaque_tid(), wid = __builtin_amdgcn_readfirstlane(tid >> 6), lane = tid & 63, wr = wid >> 2, wc = wid & 3, fr = lane & 15, fq = lane >> 4;
    const int nt = K / 128;
    int Rr[2], Cc[2]; unsigned voffB[2];
#pragma unroll
    for (int i = 0; i < 2; ++i) { int R, C; stage_rc(tid * 16 + i * 8192, R, C); Rr[i] = R; Cc[i] = C; const int Rb = (R & ~31) + perm32(R & 31); voffB[i] = (unsigned)(Rb * K + C * 2); }
    const size_t kstep = (size_t)128;
    const size_t hstepB = (size_t)HALF * K;
    const unsigned ldsw = (unsigned)wid * 1024u;
    const unsigned ldsbase = (unsigned)(size_t)lds;
    const int aoff = lds_byte(wr * 64 + fr, fq * 8), boff = lds_byte(wc * 32 + fr, fq * 8);
#define PG8_SA(b, h) (((b) * 2 + (h)) * HTB)
#define PG8_SB(b, h) ((4 + (b) * 2 + (h)) * HTB)
#define PG8_STAGE(bufoff, gbase, voff) do { _Pragma("unroll") for (int _i = 0; _i < 2; ++_i) \
        glds_s((const char*)(gbase), (voff)[_i], ldsbase + (unsigned)(bufoff) + ldsw + (unsigned)(_i * 8192)); } while (0)
#define PG8_LDA(dst, b, h) do { _Pragma("unroll") for (int m = 0; m < 4; ++m) _Pragma("unroll") for (int k = 0; k < 2; ++k) dst[m][k] = *(const LAS bf16x8*)(lds + PG8_SA(b, h) + aoff + m * 2048 + k * 1024); } while (0)
#define PG8_LDB(dst, b, h) do { _Pragma("unroll") for (int n = 0; n < 2; ++n) _Pragma("unroll") for (int k = 0; k < 2; ++k) dst[n][k] = *(const LAS bf16x8*)(lds + PG8_SB(b, h) + boff + n * 2048 + k * 1024); } while (0)
#define PG8_MMA(ai, bj, At, Bt, ZC) do { __builtin_amdgcn_s_setprio(1); _Pragma("unroll") for (int m = 0; m < 4; ++m) _Pragma("unroll") for (int n = 0; n < 2; ++n) { \
        if constexpr (FP8) { if (ZC) mfma_fp8_new(acc[ai][bj][m][n], cat8(Bt[n][0], Bt[n][1]), cat8(At[m][0], At[m][1])); else mfma_fp8_acc(acc[ai][bj][m][n], cat8(Bt[n][0], Bt[n][1]), cat8(At[m][0], At[m][1])); } \
        else { acc[ai][bj][m][n] = __builtin_amdgcn_mfma_f32_16x16x32_bf16(Bt[n][0], At[m][0], acc[ai][bj][m][n], 0, 0, 0); \
               acc[ai][bj][m][n] = __builtin_amdgcn_mfma_f32_16x16x32_bf16(Bt[n][1], At[m][1], acc[ai][bj][m][n], 0, 0, 0); } } \
        __builtin_amdgcn_s_setprio(0); } while (0)
#define PG8_WAIT_V(n) asm volatile("s_waitcnt vmcnt(" #n ")" ::: "memory")
#define PG8_WAIT_L(n) asm volatile("s_waitcnt lgkmcnt(" #n ")" ::: "memory")
#define PG8_BAR __builtin_amdgcn_s_barrier()
#define PG8_SCHED __builtin_amdgcn_sched_barrier(0)
    Unit cur, nxt; int ui = 0;
    if (!S.next(0, cur)) return;
    f32x4 acc[2][2][4][2];
#define PG8_ZERO_ACC() do { if constexpr (!FP8) { _Pragma("unroll") for (int a = 0; a < 2; ++a) _Pragma("unroll") for (int b = 0; b < 2; ++b) _Pragma("unroll") for (int m = 0; m < 4; ++m) _Pragma("unroll") for (int n = 0; n < 2; ++n) acc[a][b][m][n] = (f32x4){0.f, 0.f, 0.f, 0.f}; } } while (0)
    PG8_ZERO_ACC();
    bf16x8 At[4][2], B0[2][2], B1[2][2];
    unsigned cvo0[2], cvo1[2], nvo0[2], nvo1[2];
    S.a_off(cur, Rr, Cc, cvo0, cvo1);
    asm volatile("" : "+v"(cvo0[0]), "+v"(cvo0[1]), "+v"(cvo1[0]), "+v"(cvo1[1]), "+v"(voffB[0]), "+v"(voffB[1]));
    const char* const aB = uni_ptr(S.a_base());
    const char* cB = uni_ptr(S.b_base(cur));
    PG8_STAGE(PG8_SB(0, 0), cB, voffB); PG8_STAGE(PG8_SB(0, 1), cB + hstepB, voffB); PG8_STAGE(PG8_SA(0, 0), aB, cvo0); PG8_STAGE(PG8_SA(0, 1), aB, cvo1);
    if (wr == 1) PG8_BAR;
    PG8_WAIT_V(2); PG8_BAR;
    PG8_STAGE(PG8_SB(1, 0), cB + kstep, voffB); PG8_STAGE(PG8_SA(1, 0), aB + kstep, cvo0); PG8_STAGE(PG8_SB(1, 1), cB + hstepB + kstep, voffB);
    PG8_WAIT_V(6); PG8_BAR;
    for (;;) {
        const bool has_next = S.next(ui + 1, nxt);
        const char* nB = uni_ptr(has_next ? S.b_base(nxt) : cB);
        if (has_next) { int R2[2], C2[2]; const int tid2 = opaque_tid();
#pragma unroll
            for (int i = 0; i < 2; ++i) stage_rc(tid2 * 16 + i * 8192, R2[i], C2[i]);
            S.a_off(nxt, R2, C2, nvo0, nvo1); }
        else { nvo0[0] = cvo0[0]; nvo0[1] = cvo0[1]; nvo1[0] = cvo1[0]; nvo1[1] = cvo1[1]; }
        asm volatile("" : "+v"(nvo0[0]), "+v"(nvo0[1]), "+v"(nvo1[0]), "+v"(nvo1[1]));
#define PG8_KITER(ZC_) do { \
            const bool last = (t == nt - 2); \
            const char* a1 = aB + (size_t)(t + 1) * kstep; \
            const char* a2 = last ? aB : aB + (size_t)(t + 2) * kstep; const char* b2 = last ? nB : cB + (size_t)(t + 2) * kstep; \
            const char* a3 = a2 + kstep; const char* b3 = b2 + kstep; \
            unsigned v20[2], v21[2]; \
            v20[0] = last ? nvo0[0] : cvo0[0]; v20[1] = last ? nvo0[1] : cvo0[1]; v21[0] = last ? nvo1[0] : cvo1[0]; v21[1] = last ? nvo1[1] : cvo1[1]; \
            if constexpr (Sched::HAS_FILL) { if (t == 2) S.fill_async(ui, wid, lane); } \
            PG8_LDB(B0, 0, 0); PG8_LDB(B1, 0, 1); PG8_SCHED; PG8_LDA(At, 0, 0); PG8_STAGE(PG8_SA(1, 1), a1, cvo1); \
            PG8_WAIT_V(8); PG8_WAIT_L(0); PG8_BAR; PG8_MMA(0, 0, At, B0, ZC_); PG8_MMA(0, 1, At, B1, ZC_); PG8_BAR; PG8_SCHED; \
            PG8_LDA(At, 0, 1); PG8_STAGE(PG8_SB(0, 0), b2, voffB); PG8_STAGE(PG8_SB(0, 1), b2 + hstepB, voffB); PG8_STAGE(PG8_SA(0, 0), a2, v20); \
            PG8_WAIT_V(8); PG8_WAIT_L(0); PG8_BAR; PG8_MMA(1, 0, At, B0, ZC_); PG8_MMA(1, 1, At, B1, ZC_); PG8_BAR; PG8_SCHED; \
            PG8_LDB(B0, 1, 0); PG8_LDB(B1, 1, 1); PG8_SCHED; PG8_LDA(At, 1, 0); PG8_STAGE(PG8_SA(0, 1), a2, v21); \
            PG8_WAIT_V(8); PG8_WAIT_L(0); PG8_BAR; PG8_MMA(0, 0, At, B0, false); PG8_MMA(0, 1, At, B1, false); PG8_BAR; PG8_SCHED; \
            PG8_LDA(At, 1, 1); PG8_STAGE(PG8_SB(1, 0), b3, voffB); PG8_STAGE(PG8_SB(1, 1), b3 + hstepB, voffB); PG8_STAGE(PG8_SA(1, 0), a3, v20); \
            PG8_WAIT_V(8); PG8_WAIT_L(0); PG8_BAR; PG8_MMA(1, 0, At, B0, false); PG8_MMA(1, 1, At, B1, false); PG8_BAR; PG8_SCHED; \
        } while (0)
        if constexpr (FP8) {
            { int t = 0; PG8_KITER(true); }
            for (int t = 2; t < nt; t += 2) PG8_KITER(false);
        } else {
            for (int t = 0; t < nt; t += 2) PG8_KITER(false);
        }
#undef PG8_KITER
        if (wr == 0) PG8_BAR;
        if constexpr (FP8) MFMA_DRAIN();
        { const int tid3 = opaque_tid(), wid3 = __builtin_amdgcn_readfirstlane(tid3 >> 6), lane3 = tid3 & 63; E(acc, cur, wid3 >> 2, wid3 & 3, lane3 & 15, lane3 >> 4); }
        if (!has_next) break;
        PG8_ZERO_ACC();
        cur = nxt; cB = nB; cvo0[0] = nvo0[0]; cvo0[1] = nvo0[1]; cvo1[0] = nvo1[0]; cvo1[1] = nvo1[1]; ++ui;
        if (wr == 1) PG8_BAR;
    }
    PG8_WAIT_V(0);
    PG8_BAR;
#undef PG8_SA
#undef PG8_SB
#undef PG8_STAGE
#undef PG8_LDA
#undef PG8_LDB
#undef PG8_MMA
#undef PG8_WAIT_V
#undef PG8_WAIT_L
#undef PG8_BAR
#undef PG8_SCHED
}

struct DenseSched {
    const bf16* A; int lda; const bf16* Bt; int K; int nM, nN, nwg, G, c; int skip_ctx;
    DI void init(const bf16* A_, int lda_, const bf16* Bt_, int K_, int nM_, int nN_, int G_, int c_, int skip) { A = A_; lda = lda_; Bt = Bt_; K = K_; nM = nM_; nN = nN_; nwg = nM * nN; G = G_; c = c_; skip_ctx = skip; }
    DI bool next(int i, Unit& u) const {
        const long L = (long)i * G + c; if (L >= nwg) return false;
        int wgid = (int)L; { const int q = nwg / NXCD, r = nwg % NXCD, xcd = wgid % NXCD, off = wgid / NXCD; wgid = (xcd < r ? xcd * (q + 1) : r * (q + 1) + (xcd - r) * q) + off; }
        const int nig = WGM * nN, gid = wgid / nig, fm = gid * WGM, gsz = (nM - fm) < WGM ? (nM - fm) : WGM;
        int pm = fm + ((wgid % nig) % gsz); u.pn = (wgid % nig) / gsz;
        if (skip_ctx) pm = pm + pm / 8 + 1;
        u.pm = pm; u.e = 0; u.mt = 0; u.idx = i; return true;
    }
    static constexpr bool HAS_FILL = false;
    DI void fill_async(int, int, int) const {}
    DI const char* a_base() const { return (const char*)A; }
    DI const char* b_base(const Unit& u) const { return (const char*)Bt + (size_t)u.pn * 256 * K * 2; }
    DI void a_off(const Unit& u, const int (&R)[2], const int (&C)[2], unsigned (&o0)[2], unsigned (&o1)[2]) const {
#pragma unroll
        for (int i = 0; i < 2; ++i) { o0[i] = (unsigned)((u.pm * 256 + R[i]) * lda + C[i]) * 2u; o1[i] = (unsigned)((u.pm * 256 + 128 + R[i]) * lda + C[i]) * 2u; }
    }
};

constexpr int UTAB_OFF = 131072, RTAB_OFF = 132096;
constexpr int RSLOT = 768;
struct GroupSched {
    const LAS int* tab; const LAS int* utab; LAS unsigned* rtab; int nunits;
    int nN, G, c, K;
    const char* Abase; const unsigned* list; const float* gsort; int gather;
    const char* Bbase; size_t b_estride;
    const float* bias_l; int bias_estride;
    static constexpr bool HAS_FILL = true;
    DI bool next(int i, Unit& u) const {
        if (i >= nunits) return false;
        const int w0 = __builtin_amdgcn_readfirstlane(utab[2 * i]), w1 = __builtin_amdgcn_readfirstlane(utab[2 * i + 1]);
        u.pm = w0; u.e = w1 >> 16; u.mt = (w1 >> 3) & 0x1fff; u.pn = w1 & 7; u.idx = i; return true;
    }
    DI const char* a_base() const { return Abase; }
    DI const char* b_base(const Unit& u) const { return Bbase + (size_t)u.e * b_estride + (size_t)u.pn * 256 * K; }
    DI void a_off(const Unit& u, const int (&R)[2], const int (&C)[2], unsigned (&o0)[2], unsigned (&o1)[2]) const {
        if (gather) {
            const LAS unsigned* rt = rtab + (u.idx & 1) * RSLOT;
#pragma unroll
            for (int i = 0; i < 2; ++i) { const unsigned p0 = rt[R[i]], p1 = rt[128 + R[i]];
                o0[i] = (p0 >> 2) * 1024u + (unsigned)C[i] * 2u; o1[i] = (p1 >> 2) * 1024u + (unsigned)C[i] * 2u; }
        } else {
#pragma unroll
            for (int i = 0; i < 2; ++i) { o0[i] = (unsigned)((u.pm * 256 + R[i]) * 1024 + C[i] * 2); o1[i] = (unsigned)((u.pm * 256 + 128 + R[i]) * 1024 + C[i] * 2); }
        }
    }
    DI void fill_sync(int k, int tid) const {
        Unit u; if (!next(k, u)) return;
        const int cnt = __builtin_amdgcn_readfirstlane(tab[33 + u.e]); int idx = u.mt * 256 + (tid & 255); idx = idx < cnt ? idx : cnt - 1;
        LAS unsigned* rt = rtab + (k & 1) * RSLOT;
        if (tid < 256) { rt[tid] = list[(size_t)u.e * T + idx]; rt[512 + tid] = __builtin_bit_cast(unsigned, bias_l[(size_t)u.e * bias_estride + 256 * u.pn + tid]); }
        else rt[tid] = __builtin_bit_cast(unsigned, gsort[(size_t)u.e * T + idx]);
    }
    DI void fill_async(int ui, int wid, int lane) const {
        const unsigned base = (unsigned)(size_t)rtab; const int w4 = wid & 3;
        if (gather) {
            if (wid < 4) { Unit u; if (!next(ui + 2, u)) return;
                const int cnt = __builtin_amdgcn_readfirstlane(tab[33 + u.e]); int idx = u.mt * 256 + w4 * 64 + lane; idx = idx < cnt ? idx : cnt - 1;
                glds_dword((const char*)(list + (size_t)u.e * T), (unsigned)idx * 4u, base + (unsigned)((ui & 1) * RSLOT * 4 + w4 * 256)); }
            else { Unit u; if (!next(ui + 1, u)) return;
                glds_dword((const char*)(bias_l + (size_t)u.e * bias_estride + 256 * u.pn), (unsigned)(w4 * 64 + lane) * 4u, base + (unsigned)(((ui + 1) & 1) * RSLOT * 4 + 2048 + w4 * 256)); }
        } else {
            Unit u; if (!next(ui + 1, u)) return;
            const int cnt = __builtin_amdgcn_readfirstlane(tab[33 + u.e]); int idx = u.mt * 256 + w4 * 64 + lane; idx = idx < cnt ? idx : cnt - 1;
            const unsigned dst = base + (unsigned)(((ui + 1) & 1) * RSLOT * 4 + w4 * 256);
            if (wid < 4) { glds_dword((const char*)(list + (size_t)u.e * T), (unsigned)idx * 4u, dst);
                           glds_dword((const char*)(bias_l + (size_t)u.e * bias_estride + 256 * u.pn), (unsigned)(w4 * 64 + lane) * 4u, dst + 2048u); }
            else glds_dword((const char*)(gsort + (size_t)u.e * T), (unsigned)idx * 4u, dst + 1024u);
        }
    }
};
DI int build_unit_table(const LAS int* tab, LAS int* utab, const int nN, const int G, const int c) {
    const int tid = opaque_tid();
    const int nmt = tab[32];
    int nunits;
    if ((G & 7) == 0) {
        const int x = c & 7, rk = c >> 3, W = G >> 3;
        const int mloc = (nmt > x) ? (nmt - x + 7) >> 3 : 0, total = mloc * nN;
        nunits = (total > rk) ? (total - rk + W - 1) / W : 0;
        if (tid < nunits) { const int k = tid * W + rk, ml = k / nN, pn = k - ml * nN, mtile = x + 8 * ml; int e = 0;
            for (int j = 1; j < 32; ++j) e += (tab[j] <= mtile) ? 1 : 0;
            utab[2 * tid] = mtile; utab[2 * tid + 1] = (e << 16) | ((mtile - tab[e]) << 3) | pn; }
    } else {
        const int total = nmt * nN;
        nunits = (total > c) ? (total - c + G - 1) / G : 0;
        if (tid < nunits) { const int L = tid * G + c, mtile = L / nN, pn = L - mtile * nN; int e = 0;
            for (int j = 1; j < 32; ++j) e += (tab[j] <= mtile) ? 1 : 0;
            utab[2 * tid] = mtile; utab[2 * tid + 1] = (e << 16) | ((mtile - tab[e]) << 3) | pn; }
    }
    __syncthreads();
    return __builtin_amdgcn_readfirstlane(nunits);
}

struct EpiBf16 {
    bf16* O; int ldc; float sc;
    DI void operator()(const f32x4 (&acc)[2][2][4][2], const Unit& u, int wr, int wc, int fr, int fq) const {
        const int row0 = u.pm * 256 + wr * 64 + fr, col0 = u.pn * 256 + wc * 32 + 8 * fq;
#pragma unroll
        for (int ai = 0; ai < 2; ++ai)
#pragma unroll
            for (int m = 0; m < 4; ++m) { bf16* rowp = O + (size_t)(row0 + ai * HALF + m * 16) * ldc + col0;
#pragma unroll
                for (int bj = 0; bj < 2; ++bj) { const f32x4 v0 = acc[ai][bj][m][0] * sc, v1 = acc[ai][bj][m][1] * sc;
                    u32x4 w; w.x = cvt_pk_bf16(v0[0], v0[1]); w.y = cvt_pk_bf16(v0[2], v0[3]); w.z = cvt_pk_bf16(v1[0], v1[1]); w.w = cvt_pk_bf16(v1[2], v1[3]);
                    *(u32x4*)(rowp + bj * HALF) = w; } }
    }
};
struct EpiResid {
    bf16* X; const float* mod_l;
    DI void operator()(const f32x4 (&acc)[2][2][4][2], const Unit& u, int wr, int wc, int fr, int fq) const {
        const int b = u.pm / 9, mrow = (u.pm - b * 9 == 0) ? 32 : b;
        const float* g = mod_l + (size_t)mrow * 6144 + 2048;
        const int row0 = u.pm * 256 + wr * 64 + fr, col0 = u.pn * 256 + wc * 32 + 8 * fq;
        f32x4 gv[2][2];
#pragma unroll
        for (int bj = 0; bj < 2; ++bj)
#pragma unroll
            for (int n = 0; n < 2; ++n) gv[bj][n] = *(const f32x4*)(g + col0 + bj * HALF + 4 * n) * (1.0f / (WO_SCALE * MIX_SCALE));
#pragma unroll
        for (int ai = 0; ai < 2; ++ai)
#pragma unroll
            for (int m = 0; m < 4; ++m) { bf16* rowp = X + (size_t)(row0 + ai * HALF + m * 16) * DM + col0;
#pragma unroll
                for (int bj = 0; bj < 2; ++bj) { u32x4* px = (u32x4*)(rowp + bj * HALF); const u32x4 xw = *px;
                    const f32x4 x0 = (f32x4){bflo(xw.x), bfhi(xw.x), bflo(xw.y), bfhi(xw.y)}, x1 = (f32x4){bflo(xw.z), bfhi(xw.z), bflo(xw.w), bfhi(xw.w)};
                    const f32x4 y0 = x0 * DN_ALPHA + gv[bj][0] * acc[ai][bj][m][0], y1 = x1 * DN_ALPHA + gv[bj][1] * acc[ai][bj][m][1];
                    u32x4 w; w.x = cvt_pk_bf16(y0[0], y0[1]); w.y = cvt_pk_bf16(y0[2], y0[3]); w.z = cvt_pk_bf16(y1[0], y1[1]); w.w = cvt_pk_bf16(y1[2], y1[3]);
                    *px = w; } }
    }
};
struct EpiSwiglu {
    unsigned char* ACT; const LAS unsigned* rtab;
    DI void operator()(const f32x4 (&acc)[2][2][4][2], const Unit& u, int wr, int wc, int fr, int fq) const {
        const LAS float* bias = (const LAS float*)(rtab + (u.idx & 1) * RSLOT + 512);
        const int jc0 = u.pn * 128 + wc * 32 + 8 * fq, jl0 = wc * 32 + 8 * fq;
        f32x4 bg[2], bl[2];
#pragma unroll
        for (int n = 0; n < 2; ++n) { const f32x4 a = *(const LAS f32x4*)(bias + 2 * (jl0 + 4 * n)), b = *(const LAS f32x4*)(bias + 2 * (jl0 + 4 * n) + 4);
            bg[n] = (f32x4){a[0], a[2], b[0], b[2]}; bl[n] = (f32x4){a[1], a[3], b[1], b[3]}; }
        const int row0 = u.pm * 256 + wr * 64 + fr;
#pragma unroll
        for (int ai = 0; ai < 2; ++ai)
#pragma unroll
            for (int m = 0; m < 4; ++m) {
                float y[8];
#pragma unroll
                for (int n = 0; n < 2; ++n) { const f32x4 gl = acc[ai][0][m][n] * (1.0f / WGU_SCALE) + bg[n], li = acc[ai][1][m][n] * (1.0f / WGU_SCALE) + bl[n];
#pragma unroll
                    for (int i = 0; i < 4; i += 2) {
                        const f32x2 seven = {7.0f, 7.0f}, one = {1.0f, 1.0f};
                        const f32x2 gg = __builtin_elementwise_min((f32x2){gl[i], gl[i + 1]}, seven);
                        const f32x2 ll = __builtin_elementwise_min(__builtin_elementwise_max((f32x2){li[i], li[i + 1]}, -seven), seven);
                        const f32x2 t = gg * (-1.702f * LOG2E);
                        const f32x2 d = (f32x2){fast_exp2(t[0]), fast_exp2(t[1])} + one;
                        const f32x2 r = {__builtin_amdgcn_rcpf(d[0]), __builtin_amdgcn_rcpf(d[1])};
                        const f32x2 yy = (ll + one) * (gg * r);
                        y[4 * n + i] = yy[0]; y[4 * n + i + 1] = yy[1]; } }
                u32x2 w; w.x = pk4_fp8(y[0], y[1], y[2], y[3]); w.y = pk4_fp8(y[4], y[5], y[6], y[7]);
                *(u32x2*)(ACT + (size_t)(row0 + ai * HALF + m * 16) * DE + jc0) = w; }
    }
};
struct EpiDown {
    unsigned char* Y; const LAS unsigned* rtab; const LAS int* tab;
    DI void operator()(const f32x4 (&acc)[2][2][4][2], const Unit& u, int wr, int wc, int fr, int fq) const {
        const int nrows = __builtin_amdgcn_readfirstlane(tab[33 + u.e]) - u.mt * 256;
        const LAS unsigned* rt = rtab + (u.idx & 1) * RSLOT;
        const LAS float* bias = (const LAS float*)(rt + 512);
        const int cl0 = wc * 64 + 16 * fq, col0 = u.pn * 256 + cl0;
        f32x4 bv[2][2];
#pragma unroll
        for (int bj = 0; bj < 2; ++bj)
#pragma unroll
            for (int n = 0; n < 2; ++n) bv[bj][n] = *(const LAS f32x4*)(bias + cl0 + 8 * bj + 4 * n);
#pragma unroll
        for (int ai = 0; ai < 2; ++ai)
#pragma unroll
            for (int m = 0; m < 4; ++m) { const int rloc = ai * HALF + wr * 64 + m * 16 + fr;
                if (rloc < nrows) { const unsigned pair = rt[rloc]; float g = __builtin_bit_cast(float, rt[256 + rloc]); asm volatile("" : "+v"(g)); g *= Y_SCALE; const float sg = g * (1.0f / WD_SCALE);
                    u32x4 w;
#pragma unroll
                    for (int bj = 0; bj < 2; ++bj) { const f32x4 v0 = acc[ai][bj][m][0] * sg + bv[bj][0] * g, v1 = acc[ai][bj][m][1] * sg + bv[bj][1] * g;
                        w[2 * bj] = pk4_fp8(v0[0], v0[1], v0[2], v0[3]); w[2 * bj + 1] = pk4_fp8(v1[0], v1[1], v1[2], v1[3]); }
                    *(u32x4*)(Y + (size_t)pair * DM + col0) = w; } }
    }
};
}

namespace att {
typedef short v4i16_t __attribute__((ext_vector_type(4)));
DI int crow(int r, int hi) { return (r & 3) + 8 * (r >> 2) + 4 * hi; }
DI s16x4 vtr(const LAS unsigned char* p) { return __builtin_bit_cast(s16x4, __builtin_amdgcn_ds_read_tr16_b64_v4i16((LAS v4i16_t*)p)); }
#ifndef ATT_K8
#define ATT_K8 1
#endif
constexpr float Q8_SCALE = 4.0f, K8_SCALE = 0.25f;
DI u32x2 bf8x8(const u32x4 w, const float sc) {
    u32x2 o;
    o.x = pk4_fp8(bflo(w.x) * sc, bfhi(w.x) * sc, bflo(w.y) * sc, bfhi(w.y) * sc);
    o.y = pk4_fp8(bflo(w.z) * sc, bfhi(w.z) * sc, bflo(w.w) * sc, bfhi(w.w) * sc);
    return o;
}
DI pg8::i32x8v q_to_fp8(const bf16x8 (&qf)[4]) {
    pg8::i32x8v q;
#pragma unroll
    for (int d0 = 0; d0 < 4; ++d0) { const u32x2 t = bf8x8(__builtin_bit_cast(u32x4, qf[d0]), Q8_SCALE); q[2 * d0] = (int)t.x; q[2 * d0 + 1] = (int)t.y; }
    return q;
}
DI pg8::i32x8v k8_read(const LAS unsigned char* p) { const u32x4 a = *(const LAS u32x4*)p, b = *(const LAS u32x4*)(p + 16); return (pg8::i32x8v){(int)a.x, (int)a.y, (int)a.z, (int)a.w, (int)b.x, (int)b.y, (int)b.z, (int)b.w}; }
#define MFMA_QK8(kf, qf8, c) __builtin_amdgcn_mfma_scale_f32_32x32x64_f8f6f4(kf, qf8, c, 0, 0, 0, 0, 0, 0)
#define ATT_BAR() asm volatile("s_waitcnt lgkmcnt(0)\n\ts_barrier" ::: "memory")

struct AttnP {
    const bf16* Q; int qp;
    const bf16* K; int kp;
    const bf16* K2; int k2p;
    const bf16* V; int vp;
    unsigned char* O; int op;
    int kt0, ntiles;
    int brow0, na_lo, na_nloc, qr0;
    const float* rpb;
    int rope_q, qpos0;
    int shadow;
};
constexpr int RPB_OFF = 60 * 1024;
constexpr int O1_OFF = 64 * 1024;

template <int DQK, int DV, int MODE>
DI void attn_core(LAS unsigned char* lds, const AttnP& p, const bf16x8 (&qf)[DQK / 16], f32x16 (&o)[DV / 32], float& m_run, float& l_run, const int tid, const int wid, const int lane) {
    constexpr bool K8 = ATT_K8 && (DQK == 64);
    constexpr int KROWB = K8 ? 80 : (DQK + 8) * 2, VROWB = (DV == 64) ? 192 : 320, TILEB = 64 * (KROWB + VROWB), CPR = DQK / 8, VPR = DV / 8;
    constexpr int NKC = (DQK == 64) ? 1 : 2, NVC = DV / 64;
    static_assert(2 * TILEB <= RPB_OFF, "attention LDS");
    const int r32 = lane & 31, hi = lane >> 5;
    int krow[NKC], kch[NKC], vrow[NVC], vch[NVC];
#pragma unroll
    for (int i = 0; i < NKC; ++i) { const int c = tid + 512 * i; krow[i] = c / CPR; kch[i] = c - krow[i] * CPR; }
#pragma unroll
    for (int i = 0; i < NVC; ++i) { const int c = tid + 512 * i; vrow[i] = c / VPR; vch[i] = c - vrow[i] * VPR; }
    u32x4 krA[NKC], vrA[NVC], krB[NKC], vrB[NVC];
    const int ntiles = p.ntiles;
#define ATT_TROW(j) ((MODE == 0) ? (p.kt0 + 64 * (j)) : (((j) < p.na_nloc) ? (p.brow0 + 256 + (p.na_lo + (j)) * 64) : (p.brow0 + ((j) - p.na_nloc) * 64)))
#define ATT_LOAD(j, kr, vr) do { const int trow_ = ATT_TROW(j); \
        _Pragma("unroll") for (int i = 0; i < NKC; ++i) { if (DQK == 64 || i == 0 || tid < 256) { \
            const bf16* src_ = (kch[i] < 8) ? (p.K + (size_t)(trow_ + krow[i]) * p.kp + kch[i] * 8) : (p.K2 + (size_t)(trow_ + krow[i]) * p.k2p + (kch[i] - 8) * 8); \
            kr[i] = *(const u32x4*)src_; } } \
        _Pragma("unroll") for (int i = 0; i < NVC; ++i) vr[i] = *(const u32x4*)(p.V + (size_t)(trow_ + vrow[i]) * p.vp + vch[i] * 8); } while (0)
#define ATT_WRITE(b, kr, vr) do { LAS unsigned char* kb_ = lds + (b) * TILEB; LAS unsigned char* vb_ = kb_ + 64 * KROWB; \
        if constexpr (K8) { *(LAS u32x2*)(kb_ + krow[0] * KROWB + 32 * (kch[0] & 1) + 8 * (kch[0] >> 1)) = bf8x8(kr[0], K8_SCALE); } else { \
        _Pragma("unroll") for (int i = 0; i < NKC; ++i) { if (DQK == 64 || i == 0 || tid < 256) *(LAS u32x4*)(kb_ + krow[i] * KROWB + kch[i] * 16) = kr[i]; } } \
        _Pragma("unroll") for (int i = 0; i < NVC; ++i) *(LAS u32x4*)(vb_ + vrow[i] * VROWB + vch[i] * 16) = vr[i]; } while (0)
    ATT_LOAD(0, krA, vrA); ATT_WRITE(0, krA, vrA);
    if (ntiles > 1) ATT_LOAD(1, krB, vrB);
    if (ntiles > 2) ATT_LOAD(2, krA, vrA);
    ATT_BAR();
    pg8::i32x8v q8 = {0, 0, 0, 0, 0, 0, 0, 0};
    if constexpr (K8) q8 = q_to_fp8(qf);
    const bool sh_noload = PROBE_SHADOW && (p.shadow == 2), sh_nocomp = PROBE_SHADOW && (p.shadow == 1);
    f32x16 negm;
#pragma unroll
    for (int r = 0; r < 16; ++r) negm[r] = -m_run;
    bool first = true;
    const int qr = p.qr0 + (wid >> 1), rs = min(max(qr - 4, 0), 24);
    const int qc = 32 * (wid & 1) + r32, cs = min(max(qc - 8, 0), 48);
    const int q4 = (lane & 15) >> 2, p4 = lane & 3, blk = (lane >> 4) & 1;
    unsigned boff0[(MODE == 1 && DV == 64) ? 16 : 1], boff1[(MODE == 1 && DV == 64) ? 16 : 1];
    if (MODE == 1 && DV == 64) {
#pragma unroll
        for (int r = 0; r < 16; ++r) { const int kc0 = crow(r, hi), kc1 = kc0 + 32;
            boff0[r] = ((kc0 >= cs) && (kc0 < cs + 16)) ? (unsigned)(kc0 - qc + 15) * 4u : 124u;
            boff1[r] = ((kc1 >= cs) && (kc1 < cs + 16)) ? (unsigned)(kc1 - qc + 15) * 4u : 124u; }
    }
    auto tile = [&](const int j, auto&& stage) __attribute__((always_inline)) {
        bool staged = false;
        bool active = true; int krg = 0;
        if (MODE == 1) { krg = p.na_lo + j; active = (j >= p.na_nloc) || (krg >= rs && krg < rs + 8); }
        if (sh_nocomp) active = false;
        if (active && DV == 64) {
            const LAS unsigned char* kb = lds + (j & 1) * TILEB; const LAS unsigned char* vb = kb + 64 * KROWB;
            f32x16 s0 = negm, s1 = negm;
            if constexpr (K8) {
                s0 = MFMA_QK8(k8_read(kb + r32 * KROWB + 32 * hi), q8, s0);
                s1 = MFMA_QK8(k8_read(kb + (32 + r32) * KROWB + 32 * hi), q8, s1);
                stage(); staged = true;
            } else {
#pragma unroll
            for (int d0 = 0; d0 < DQK / 16; ++d0) {
                const bf16x8 k0 = *(const LAS bf16x8*)(kb + r32 * KROWB + (16 * d0 + 8 * hi) * 2);
                const bf16x8 k1 = *(const LAS bf16x8*)(kb + (32 + r32) * KROWB + (16 * d0 + 8 * hi) * 2);
                s0 = __builtin_amdgcn_mfma_f32_32x32x16_bf16(k0, qf[d0], s0, 0, 0, 0);
                s1 = __builtin_amdgcn_mfma_f32_32x32x16_bf16(k1, qf[d0], s1, 0, 0, 0);
            } }
            if (MODE == 1 && j < p.na_nloc) {
                const LAS unsigned char* brow = lds + RPB_OFF + (krg - qr + 7) * 128;
#pragma unroll
                for (int r = 0; r < 16; ++r) { s0[r] += *(const LAS float*)(brow + boff0[r]); s1[r] += *(const LAS float*)(brow + boff1[r]); }
            }
            if (first) {
                float mt = fmaxf(fmaxf(s0[0], s1[0]), fmaxf(s0[1], s1[1]));
#pragma unroll
                for (int r = 2; r < 16; r += 2) mt = fmaxf(fmaxf(mt, fmaxf(s0[r], s1[r])), fmaxf(s0[r + 1], s1[r + 1]));
                mt = fmaxf(mt, __shfl_xor(mt, 32));
                const float dl = (mt > -__builtin_inff()) ? mt : 0.f;
                m_run += dl;
#pragma unroll
                for (int r = 0; r < 16; ++r) { s0[r] -= dl; s1[r] -= dl; negm[r] = -m_run; }
                first = false;
            }
            float ps0 = 0.f, ps1 = 0.f, ps2 = 0.f, ps3 = 0.f;
#pragma unroll
            for (int r = 0; r < 16; r += 2) { s0[r] = fast_exp2(s0[r]); s0[r + 1] = fast_exp2(s0[r + 1]); s1[r] = fast_exp2(s1[r]); s1[r + 1] = fast_exp2(s1[r + 1]);
                ps0 += s0[r]; ps1 += s0[r + 1]; ps2 += s1[r]; ps3 += s1[r + 1]; }
            const float ps = (ps0 + ps1) + (ps2 + ps3);
            l_run += ps;
            const float pt = ps + __shfl_xor(ps, 32);
            const bool need = pt > 65536.0f;
            bf16x8 pa[2][2];
#pragma unroll
            for (int s = 0; s < 2; ++s) {
                u32x4 w0, w1;
                w0.x = pg8::cvt_pk_bf16(s0[8 * s + 0], s0[8 * s + 1]); w0.y = pg8::cvt_pk_bf16(s0[8 * s + 2], s0[8 * s + 3]); w0.z = pg8::cvt_pk_bf16(s0[8 * s + 4], s0[8 * s + 5]); w0.w = pg8::cvt_pk_bf16(s0[8 * s + 6], s0[8 * s + 7]);
                w1.x = pg8::cvt_pk_bf16(s1[8 * s + 0], s1[8 * s + 1]); w1.y = pg8::cvt_pk_bf16(s1[8 * s + 2], s1[8 * s + 3]); w1.z = pg8::cvt_pk_bf16(s1[8 * s + 4], s1[8 * s + 5]); w1.w = pg8::cvt_pk_bf16(s1[8 * s + 6], s1[8 * s + 7]);
                pa[0][s] = __builtin_bit_cast(bf16x8, w0); pa[1][s] = __builtin_bit_cast(bf16x8, w1);
            }
            const LAS unsigned char* vbase = vb + (4 * hi + q4) * VROWB + 32 * blk + 8 * p4;
#pragma unroll
            for (int u = 0; u < 2; ++u)
#pragma unroll
                for (int s = 0; s < 2; ++s)
#pragma unroll
                    for (int c = 0; c < 2; ++c) {
                        const LAS unsigned char* a0 = vbase + (32 * u + 16 * s) * VROWB + 64 * c;
                        const s16x4 lo = vtr(a0), hh = vtr(a0 + 8 * VROWB);
                        const bf16x8 vf = (bf16x8){lo[0], lo[1], lo[2], lo[3], hh[0], hh[1], hh[2], hh[3]};
                        o[c % (DV / 32)] = __builtin_amdgcn_mfma_f32_32x32x16_bf16(pa[u][s], vf, o[c % (DV / 32)], 0, 0, 0);
                    }
            if (__any(need)) {
                const int ex = (int)((__builtin_bit_cast(unsigned, pt) >> 23) & 255u) - 127;
                const float dl = need ? (float)ex : 0.f, f = fast_exp2(-dl);
                m_run += dl; l_run *= f;
#pragma unroll
                for (int r = 0; r < 16; ++r) negm[r] = -m_run;
                int hio = hi; asm volatile("" : "+v"(hio));
#pragma unroll
                for (int r = 0; r < 16; ++r) { const float fr_ = __shfl(f, crow(r, hio)); o[0][r] *= fr_; o[1 % (DV / 32)][r] *= fr_; }
            }
        }
        if (active && DV != 64) {
            const LAS unsigned char* kb = lds + (j & 1) * TILEB; const LAS unsigned char* vb = kb + 64 * KROWB;
#pragma unroll
            for (int u = 0; u < 2; ++u) {
                const LAS unsigned char* kbu = kb + u * 32 * KROWB;
                f32x16 s0 = negm;
                if constexpr (K8) { s0 = MFMA_QK8(k8_read(kbu + r32 * KROWB + 32 * hi), q8, s0); if (u == 0) { stage(); staged = true; } } else {
#pragma unroll
                for (int d0 = 0; d0 < DQK / 16; ++d0) {
                    const bf16x8 k0 = *(const LAS bf16x8*)(kbu + r32 * KROWB + (16 * d0 + 8 * hi) * 2);
                    s0 = __builtin_amdgcn_mfma_f32_32x32x16_bf16(k0, qf[d0], s0, 0, 0, 0);
                } }
                if (MODE == 1 && j < p.na_nloc) {
                    const LAS float* brow = (const LAS float*)(lds + RPB_OFF) + (krg - qr + 7) * 32;
                    int hio = hi; asm volatile("" : "+v"(hio));
#pragma unroll
                    for (int r = 0; r < 16; ++r) {
                        const int kc0 = crow(r, hio) + 32 * u;
                        const bool v0 = (kc0 >= cs) && (kc0 < cs + 16);
                        const int i0 = min(max(kc0 - qc + 15, 0), 30);
                        s0[r] = v0 ? s0[r] + brow[i0] : -__builtin_inff();
                    }
                }
                if (first) {
                    float mt = fmaxf(fmaxf(s0[0], s0[1]), s0[2]);
#pragma unroll
                    for (int r = 3; r < 15; r += 2) mt = fmaxf(fmaxf(mt, s0[r]), s0[r + 1]);
                    mt = fmaxf(mt, s0[15]);
                    mt = fmaxf(mt, __shfl_xor(mt, 32));
                    const float dl = (mt > -__builtin_inff()) ? mt : 0.f;
                    m_run += dl;
#pragma unroll
                    for (int r = 0; r < 16; ++r) { s0[r] -= dl; negm[r] = -m_run; }
                    first = false;
                }
                float ps0 = 0.f, ps1 = 0.f;
#pragma unroll
                for (int r = 0; r < 16; r += 2) { s0[r] = fast_exp2(s0[r]); s0[r + 1] = fast_exp2(s0[r + 1]); ps0 += s0[r]; ps1 += s0[r + 1]; }
                const float ps = ps0 + ps1;
                l_run += ps;
                const float pt = ps + __shfl_xor(ps, 32);
                const bool need = pt > 65536.0f;
                bf16x8 pa[2];
#pragma unroll
                for (int s = 0; s < 2; ++s) {
                    u32x4 w0;
                    w0.x = pg8::cvt_pk_bf16(s0[8 * s + 0], s0[8 * s + 1]); w0.y = pg8::cvt_pk_bf16(s0[8 * s + 2], s0[8 * s + 3]); w0.z = pg8::cvt_pk_bf16(s0[8 * s + 4], s0[8 * s + 5]); w0.w = pg8::cvt_pk_bf16(s0[8 * s + 6], s0[8 * s + 7]);
                    pa[s] = __builtin_bit_cast(bf16x8, w0);
                }
                const LAS unsigned char* vbase = vb + (32 * u + 4 * hi + q4) * VROWB + 32 * blk + 8 * p4;
#pragma unroll
                for (int c = 0; c < DV / 32; ++c)
#pragma unroll
                    for (int s = 0; s < 2; ++s) {
                        const LAS unsigned char* a0 = vbase + (16 * s) * VROWB + 64 * c;
                        const s16x4 lo = vtr(a0), hh = vtr(a0 + 8 * VROWB);
                        const bf16x8 vf = (bf16x8){lo[0], lo[1], lo[2], lo[3], hh[0], hh[1], hh[2], hh[3]};
                        o[c] = __builtin_amdgcn_mfma_f32_32x32x16_bf16(pa[s], vf, o[c], 0, 0, 0);
                    }
                if (__any(need)) {
                    const int ex = (int)((__builtin_bit_cast(unsigned, pt) >> 23) & 255u) - 127;
                    const float dl = need ? (float)ex : 0.f, f = fast_exp2(-dl);
                    m_run += dl; l_run *= f;
#pragma unroll
                    for (int r = 0; r < 16; ++r) negm[r] = -m_run;
                    int hio = hi; asm volatile("" : "+v"(hio));
#pragma unroll
                    for (int r = 0; r < 16; ++r) { const float fr_ = __shfl(f, crow(r, hio));
#pragma unroll
                        for (int c = 0; c < DV / 32; ++c) o[c][r] *= fr_; }
                }
            }
        }
        if (!staged) stage();
    };
    for (int j = 0; j < ntiles; j += 2) {
        tile(j, [&]() { if (j + 1 < ntiles) ATT_WRITE((j + 1) & 1, krB, vrB);
                        if (j + 3 < ntiles) ATT_LOAD(j + 3, krB, vrB); });
        ATT_BAR();
        if (j + 1 >= ntiles) break;
        tile(j + 1, [&]() { if (j + 2 < ntiles) ATT_WRITE((j + 2) & 1, krA, vrA);
                            if (j + 4 < ntiles) ATT_LOAD(j + 4, krA, vrA); });
        ATT_BAR();
    }
#undef ATT_TROW
#undef ATT_LOAD
#undef ATT_WRITE
}

template <int DQK>
DI void attn_core_pipe(LAS unsigned char* lds, const AttnP& p, const bf16x8 (&qf)[DQK / 16], f32x16 (&o)[2], float& m_run, float& l_run, const int tid, const int wid, const int lane) {
    constexpr int KROWB = (DQK + 8) * 2, VROWB = 192, TILEB = 64 * (KROWB + VROWB), CPR = DQK / 8;
    constexpr int NKC = (DQK == 64) ? 1 : 2;
    static_assert(2 * TILEB <= RPB_OFF, "attention LDS");
    const int r32 = lane & 31, hi = lane >> 5;
    int krow[NKC], kch[NKC];
#pragma unroll
    for (int i = 0; i < NKC; ++i) { const int c = tid + 512 * i; krow[i] = c / CPR; kch[i] = c - krow[i] * CPR; }
    const int vrow = tid >> 3, vch = tid & 7;
    u32x4 kr[NKC], vr;
    const int nt = p.ntiles;
#define AP_LOADK(j) do { const int trow_ = p.kt0 + 64 * min((j), nt - 1); \
        _Pragma("unroll") for (int i = 0; i < NKC; ++i) { if (DQK == 64 || i == 0 || tid < 256) { \
            const bf16* src_ = (kch[i] < 8) ? (p.K + (size_t)(trow_ + krow[i]) * p.kp + kch[i] * 8) : (p.K2 + (size_t)(trow_ + krow[i]) * p.k2p + (kch[i] - 8) * 8); \
            kr[i] = *(const u32x4*)src_; } } } while (0)
#define AP_LOADV(j) do { const int trow_ = p.kt0 + 64 * min((j), nt - 1); vr = *(const u32x4*)(p.V + (size_t)(trow_ + vrow) * p.vp + vch * 8); } while (0)
#define AP_WRITEK(b) do { LAS unsigned char* kb_ = lds + (b) * TILEB; \
        _Pragma("unroll") for (int i = 0; i < NKC; ++i) { if (DQK == 64 || i == 0 || tid < 256) *(LAS u32x4*)(kb_ + krow[i] * KROWB + kch[i] * 16) = kr[i]; } } while (0)
#define AP_WRITEV(b) do { *(LAS u32x4*)(lds + (b) * TILEB + 64 * KROWB + vrow * VROWB + vch * 16) = vr; } while (0)
#define AP_QK(b, S0, S1) do { const LAS unsigned char* kb_ = lds + (b) * TILEB; \
        _Pragma("unroll") for (int d0 = 0; d0 < DQK / 16; ++d0) { \
            const bf16x8 k0_ = *(const LAS bf16x8*)(kb_ + r32 * KROWB + (16 * d0 + 8 * hi) * 2); \
            const bf16x8 k1_ = *(const LAS bf16x8*)(kb_ + (32 + r32) * KROWB + (16 * d0 + 8 * hi) * 2); \
            S0 = __builtin_amdgcn_mfma_f32_32x32x16_bf16(k0_, qf[d0], S0, 0, 0, 0); \
            S1 = __builtin_amdgcn_mfma_f32_32x32x16_bf16(k1_, qf[d0], S1, 0, 0, 0); } } while (0)
    AP_LOADK(0); AP_LOADV(0); AP_WRITEK(0); AP_WRITEV(0); AP_LOADK(1);
    ATT_BAR();
    f32x16 negm, s0, s1;
#pragma unroll
    for (int r = 0; r < 16; ++r) { s0[r] = 0.f; s1[r] = 0.f; }
    AP_QK(0, s0, s1);
    {
        float mt = fmaxf(fmaxf(s0[0], s1[0]), fmaxf(s0[1], s1[1]));
#pragma unroll
        for (int r = 2; r < 16; r += 2) mt = fmaxf(fmaxf(mt, fmaxf(s0[r], s1[r])), fmaxf(s0[r + 1], s1[r + 1]));
        mt = fmaxf(mt, __shfl_xor(mt, 32));
        m_run = mt;
#pragma unroll
        for (int r = 0; r < 16; ++r) { s0[r] -= mt; s1[r] -= mt; negm[r] = -mt; }
    }
    AP_WRITEK(1); AP_LOADK(2); AP_LOADV(1);
    ATT_BAR();
    const int q4 = (lane & 15) >> 2, p4 = lane & 3, blk = (lane >> 4) & 1;
    const LAS unsigned char* vlane = lds + 64 * KROWB + (4 * hi + q4) * VROWB + 32 * blk + 8 * p4;
#define AP_SOFTMAX_PV(J) \
        float ps0 = 0.f, ps1 = 0.f, ps2 = 0.f, ps3 = 0.f; \
        _Pragma("unroll") for (int r = 0; r < 16; r += 2) { s0[r] = fast_exp2(s0[r]); s0[r + 1] = fast_exp2(s0[r + 1]); s1[r] = fast_exp2(s1[r]); s1[r + 1] = fast_exp2(s1[r + 1]); \
            ps0 += s0[r]; ps1 += s0[r + 1]; ps2 += s1[r]; ps3 += s1[r + 1]; } \
        const float ps = (ps0 + ps1) + (ps2 + ps3); \
        l_run += ps; \
        bf16x8 pa[2][2]; \
        _Pragma("unroll") for (int s = 0; s < 2; ++s) { \
            u32x4 w0, w1; \
            w0.x = pg8::cvt_pk_bf16(s0[8 * s + 0], s0[8 * s + 1]); w0.y = pg8::cvt_pk_bf16(s0[8 * s + 2], s0[8 * s + 3]); w0.z = pg8::cvt_pk_bf16(s0[8 * s + 4], s0[8 * s + 5]); w0.w = pg8::cvt_pk_bf16(s0[8 * s + 6], s0[8 * s + 7]); \
            w1.x = pg8::cvt_pk_bf16(s1[8 * s + 0], s1[8 * s + 1]); w1.y = pg8::cvt_pk_bf16(s1[8 * s + 2], s1[8 * s + 3]); w1.z = pg8::cvt_pk_bf16(s1[8 * s + 4], s1[8 * s + 5]); w1.w = pg8::cvt_pk_bf16(s1[8 * s + 6], s1[8 * s + 7]); \
            pa[0][s] = __builtin_bit_cast(bf16x8, w0); pa[1][s] = __builtin_bit_cast(bf16x8, w1); } \
        const LAS unsigned char* vbase = vlane + ((J) & 1) * TILEB; \
        _Pragma("unroll") for (int u = 0; u < 2; ++u) _Pragma("unroll") for (int s = 0; s < 2; ++s) _Pragma("unroll") for (int c = 0; c < 2; ++c) { \
                    const LAS unsigned char* a0 = vbase + (32 * u + 16 * s) * VROWB + 64 * c; \
                    const s16x4 lo = vtr(a0), hh = vtr(a0 + 8 * VROWB); \
                    const bf16x8 vf = (bf16x8){lo[0], lo[1], lo[2], lo[3], hh[0], hh[1], hh[2], hh[3]}; \
                    o[c] = __builtin_amdgcn_mfma_f32_32x32x16_bf16(pa[u][s], vf, o[c], 0, 0, 0); }
    for (int j = 0; j < nt - 1; ++j) {
        AP_WRITEK(j & 1); AP_WRITEV((j + 1) & 1);
        AP_LOADK(j + 3); AP_LOADV(j + 2);
        f32x16 sn0 = negm, sn1 = negm;
        AP_QK((j + 1) & 1, sn0, sn1);
        AP_SOFTMAX_PV(j)
        const float pt = ps + __shfl_xor(ps, 32);
        const bool need = pt > 65536.0f;
        s0 = sn0; s1 = sn1;
        if (__any(need)) {
            const int ex = (int)((__builtin_bit_cast(unsigned, pt) >> 23) & 255u) - 127;
            const float dl = need ? (float)ex : 0.f, f = fast_exp2(-dl);
            m_run += dl; l_run *= f;
#pragma unroll
            for (int r = 0; r < 16; ++r) { negm[r] = -m_run; s0[r] -= dl; s1[r] -= dl; }
            int hio = hi; asm volatile("" : "+v"(hio));
#pragma unroll
            for (int r = 0; r < 16; ++r) { const float fr_ = __shfl(f, crow(r, hio)); o[0][r] *= fr_; o[1][r] *= fr_; }
        }
        ATT_BAR();
    }
    {
        AP_SOFTMAX_PV(nt - 1)
        ATT_BAR();
    }
#undef AP_SOFTMAX_PV
#undef AP_LOADK
#undef AP_LOADV
#undef AP_WRITEK
#undef AP_WRITEV
#undef AP_QK
}

DI void rope_frag(bf16x8& frag, const int position, const int hi, const float freq_step  ) {
    u32x4 mine = __builtin_bit_cast(u32x4, frag), oth;
#pragma unroll
    for (int w = 0; w < 4; ++w) oth[w] = (unsigned)__shfl_xor((int)mine[w], 32);
    float res[8];
#pragma unroll
    for (int i = 0; i < 8; ++i) {
        const float x = (i & 1) ? bfhi(mine[i >> 1]) : bflo(mine[i >> 1]);
        const float y = (i & 1) ? bfhi(oth[i >> 1]) : bflo(oth[i >> 1]);
        float rev = (float)position * fast_exp2(-(float)i * freq_step) * 0.15915494309189535f; rev = rev - floorf(rev);
        const float sn = __builtin_amdgcn_sinf(rev), cs = __builtin_amdgcn_cosf(rev);
        res[i] = hi ? (y * sn + x * cs) : (x * cs - y * sn);
    }
    u32x4 w; w.x = pk2(res[0], res[1]); w.y = pk2(res[2], res[3]); w.z = pk2(res[4], res[5]); w.w = pk2(res[6], res[7]);
    frag = __builtin_bit_cast(bf16x8, w);
}

template <int DQK, int MODE>
DI void attn_unit(LAS unsigned char* lds, const AttnP& p) {
    const int tid = opaque_tid(), lane = tid & 63, wid = __builtin_amdgcn_readfirstlane(tid >> 6), r32 = lane & 31, hi = lane >> 5;
    bf16x8 qf[DQK / 16];
    const bf16* qrow = p.Q + (size_t)(32 * wid + r32) * p.qp;
#pragma unroll
    for (int d0 = 0; d0 < DQK / 16; ++d0) qf[d0] = *(const bf16x8*)(qrow + 16 * d0 + 8 * hi);
    if (DQK == 96) { if (p.rope_q) { const int pos = p.qpos0 + 32 * wid + r32; rope_frag(qf[4], pos >> 6, hi, LOG2_THETA / 8.f); rope_frag(qf[5], pos & 63, hi, LOG2_THETA / 8.f); } }
    if (MODE == 1) { if (tid < 465) { const int dr = tid / 31, dc = tid - dr * 31; ((LAS float*)(lds + RPB_OFF))[dr * 32 + dc] = p.rpb[tid] * LOG2E; }
                     if (tid < 15) ((LAS float*)(lds + RPB_OFF))[tid * 32 + 31] = -__builtin_inff(); }
    f32x16 o[2];
#pragma unroll
    for (int r = 0; r < 16; ++r) { o[0][r] = 0.f; o[1][r] = 0.f; }
    float m_run = 0.f, l_run = 0.f;
    if constexpr (MODE == 0) attn_core_pipe<DQK>(lds, p, qf, o, m_run, l_run, tid, wid, lane); else attn_core<DQK, 64, MODE>(lds, p, qf, o, m_run, l_run, tid, wid, lane);
    const float l = l_run + __shfl_xor(l_run, 32), inv = 1.0f / l;
    unsigned char* orow = p.O + (size_t)(32 * wid) * p.op + r32;
#pragma unroll
    for (int r = 0; r < 16; ++r) { int hio = hi; asm volatile("" : "+v"(hio)); const int q = crow(r, hio); const float iv = __shfl(inv, q) * MIX_SCALE;
#pragma unroll
        for (int c = 0; c < 2; ++c) orow[(size_t)q * p.op + 32 * c] = (unsigned char)__builtin_amdgcn_cvt_pk_fp8_f32(o[c][r] * iv, 0.f, 0u, false);
        __builtin_amdgcn_sched_barrier(0); }
}

template <int DQK>
DI void attn_core_w64(LAS unsigned char* lds, const AttnP& p, const bf16x8 (&qa)[DQK / 16], const bf16x8 (&qb)[DQK / 16], f32x16 (&oa)[2], f32x16 (&ob)[2], float (&m_run)[2], float (&l_run)[2],
                      const int tid, const int wid, const int lane) {
    constexpr bool K8 = ATT_K8 && (DQK == 64), K8M = ATT_K8 && (DQK == 96);
    constexpr int KROWB = K8 ? 80 : K8M ? 112 : (DQK + 8) * 2, VROWB = 192, TILEB = 64 * (KROWB + VROWB), CPR = DQK / 8;
    constexpr int NKC = (DQK == 64) ? 1 : 2;
    constexpr bool USE_NEGM = (DQK == 64);
    static_assert(2 * TILEB <= RPB_OFF, "attention LDS");
    const int r32 = lane & 31, hi = lane >> 5;
    int krow[NKC], kch[NKC];
#pragma unroll
    for (int i = 0; i < NKC; ++i) { const int c = tid + 512 * i; krow[i] = c / CPR; kch[i] = c - krow[i] * CPR; }
    const int vrow = tid >> 3, vch = tid & 7;
    u32x4 krA[NKC], vrA, krB[NKC], vrB;
    const int nt = p.ntiles;
#define AW_LOAD(j, kr, vr) do { const int trow_ = p.kt0 + 64 * (j); \
        _Pragma("unroll") for (int i = 0; i < NKC; ++i) { if (DQK == 64 || i == 0 || tid < 256) { \
            const bf16* src_ = (kch[i] < 8) ? (p.K + (size_t)(trow_ + krow[i]) * p.kp + kch[i] * 8) : (p.K2 + (size_t)(trow_ + krow[i]) * p.k2p + (kch[i] - 8) * 8); \
            kr[i] = *(const u32x4*)src_; } } \
        vr = *(const u32x4*)(p.V + (size_t)(trow_ + vrow) * p.vp + vch * 8); } while (0)
#define AW_WRITE(b, kr, vr) do { LAS unsigned char* kb_ = lds + (b) * TILEB; \
        if constexpr (K8) { *(LAS u32x2*)(kb_ + krow[0] * KROWB + 32 * (kch[0] & 1) + 8 * (kch[0] >> 1)) = bf8x8(kr[0], K8_SCALE); } \
        else if constexpr (K8M) { _Pragma("unroll") for (int i = 0; i < NKC; ++i) { if (i == 0 || tid < 256) { const int kc_ = kch[i] - 8; \
            const int off_ = (kch[i] < 8) ? (32 * (kch[i] & 1) + 8 * (kch[i] >> 1)) : (64 + 16 * (kc_ & 1) + 8 * (kc_ >> 1)); \
            *(LAS u32x2*)(kb_ + krow[i] * KROWB + off_) = bf8x8(kr[i], K8_SCALE); } } } else { \
        _Pragma("unroll") for (int i = 0; i < NKC; ++i) { if (DQK == 64 || i == 0 || tid < 256) *(LAS u32x4*)(kb_ + krow[i] * KROWB + kch[i] * 16) = kr[i]; } } \
        *(LAS u32x4*)(kb_ + 64 * KROWB + vrow * VROWB + vch * 16) = vr; } while (0)
    AW_LOAD(0, krA, vrA); AW_WRITE(0, krA, vrA);
    if (nt > 1) AW_LOAD(1, krB, vrB);
    if (nt > 2) AW_LOAD(2, krA, vrA);
    ATT_BAR();
    pg8::i32x8v q8a = {0, 0, 0, 0, 0, 0, 0, 0}, q8b = {0, 0, 0, 0, 0, 0, 0, 0};
    pg8::i32x8v q8a1 = {0, 0, 0, 0, 0, 0, 0, 0}, q8b1 = {0, 0, 0, 0, 0, 0, 0, 0};
    if constexpr (K8) { q8a = q_to_fp8(qa); q8b = q_to_fp8(qb); }
    if constexpr (K8M) {
#pragma unroll
        for (int d0 = 0; d0 < 4; ++d0) { const u32x2 ta = bf8x8(__builtin_bit_cast(u32x4, qa[d0]), Q8_SCALE), tb = bf8x8(__builtin_bit_cast(u32x4, qb[d0]), Q8_SCALE); q8a[2 * d0] = (int)ta.x; q8a[2 * d0 + 1] = (int)ta.y; q8b[2 * d0] = (int)tb.x; q8b[2 * d0 + 1] = (int)tb.y; }
#pragma unroll
        for (int d0 = 4; d0 < 6; ++d0) { const u32x2 ta = bf8x8(__builtin_bit_cast(u32x4, qa[d0]), Q8_SCALE), tb = bf8x8(__builtin_bit_cast(u32x4, qb[d0]), Q8_SCALE); q8a1[2 * (d0 - 4)] = (int)ta.x; q8a1[2 * (d0 - 4) + 1] = (int)ta.y; q8b1[2 * (d0 - 4)] = (int)tb.x; q8b1[2 * (d0 - 4) + 1] = (int)tb.y; }
    }
    f32x16 nma, nmb;
#pragma unroll
    for (int r = 0; r < 16; ++r) { nma[r] = 0.f; nmb[r] = 0.f; }
    bool first = true;
    const int q4 = (lane & 15) >> 2, p4 = lane & 3, blk = (lane >> 4) & 1;
    auto half = [&](const int j, const int u) __attribute__((always_inline)) {
        const LAS unsigned char* kb = lds + (j & 1) * TILEB; const LAS unsigned char* vb = kb + 64 * KROWB;
        {
            const LAS unsigned char* kbu = kb + u * 32 * KROWB + r32 * KROWB + ((K8 || K8M) ? 32 : 16) * hi;
            f32x16 sa, sb;
            if (USE_NEGM) { sa = nma; sb = nmb; } else {
#pragma unroll
                for (int r = 0; r < 16; ++r) { sa[r] = 0.f; sb[r] = 0.f; } }
            if constexpr (K8) { const pg8::i32x8v k8 = k8_read(kbu); sa = MFMA_QK8(k8, q8a, sa); sb = MFMA_QK8(k8, q8b, sb); }
            else if constexpr (K8M) { const pg8::i32x8v k8 = k8_read(kbu); const u32x4 kt = *(const LAS u32x4*)(kbu + 64 - 16 * hi);
                const pg8::i32x8v k81 = {(int)kt.x, (int)kt.y, (int)kt.z, (int)kt.w, 0, 0, 0, 0};
                sa = MFMA_QK8(k8, q8a, sa); sb = MFMA_QK8(k8, q8b, sb); sa = MFMA_QK8(k81, q8a1, sa); sb = MFMA_QK8(k81, q8b1, sb); } else {
#pragma unroll
            for (int d0 = 0; d0 < DQK / 16; ++d0) {
                const bf16x8 k0 = *(const LAS bf16x8*)(kbu + 32 * d0);
                sa = __builtin_amdgcn_mfma_f32_32x32x16_bf16(k0, qa[d0], sa, 0, 0, 0);
                sb = __builtin_amdgcn_mfma_f32_32x32x16_bf16(k0, qb[d0], sb, 0, 0, 0);
            } }
            if (first) {
                float ma = fmaxf(fmaxf(sa[0], sa[1]), sa[2]), mb = fmaxf(fmaxf(sb[0], sb[1]), sb[2]);
#pragma unroll
                for (int r = 3; r < 15; r += 2) { ma = fmaxf(fmaxf(ma, sa[r]), sa[r + 1]); mb = fmaxf(fmaxf(mb, sb[r]), sb[r + 1]); }
                ma = fmaxf(ma, sa[15]); mb = fmaxf(mb, sb[15]);
                ma = fmaxf(ma, __shfl_xor(ma, 32)); mb = fmaxf(mb, __shfl_xor(mb, 32));
                m_run[0] = ma; m_run[1] = mb;
                if (USE_NEGM) {
#pragma unroll
                    for (int r = 0; r < 16; ++r) { sa[r] -= ma; sb[r] -= mb; nma[r] = -ma; nmb[r] = -mb; } }
                first = false;
            }
            float pa0 = 0.f, pa1 = 0.f, pb0 = 0.f, pb1 = 0.f;
            if (USE_NEGM) {
#pragma unroll
                for (int r = 0; r < 16; r += 2) { sa[r] = fast_exp2(sa[r]); sa[r + 1] = fast_exp2(sa[r + 1]); sb[r] = fast_exp2(sb[r]); sb[r + 1] = fast_exp2(sb[r + 1]);
                    pa0 += sa[r]; pa1 += sa[r + 1]; pb0 += sb[r]; pb1 += sb[r + 1]; }
            } else { const float ma = m_run[0], mb = m_run[1];
#pragma unroll
                for (int r = 0; r < 16; r += 2) { sa[r] = fast_exp2(sa[r] - ma); sa[r + 1] = fast_exp2(sa[r + 1] - ma); sb[r] = fast_exp2(sb[r] - mb); sb[r + 1] = fast_exp2(sb[r + 1] - mb);
                    pa0 += sa[r]; pa1 += sa[r + 1]; pb0 += sb[r]; pb1 += sb[r + 1]; }
            }
            const float psa = pa0 + pa1, psb = pb0 + pb1;
            l_run[0] += psa; l_run[1] += psb;
            const float pta = psa + __shfl_xor(psa, 32), ptb = psb + __shfl_xor(psb, 32);
            const bool needa = pta > 65536.0f, needb = ptb > 65536.0f;
            bf16x8 fa[2], fb[2];
#pragma unroll
            for (int s = 0; s < 2; ++s) {
                u32x4 w0, w1;
                w0.x = pg8::cvt_pk_bf16(sa[8 * s + 0], sa[8 * s + 1]); w0.y = pg8::cvt_pk_bf16(sa[8 * s + 2], sa[8 * s + 3]); w0.z = pg8::cvt_pk_bf16(sa[8 * s + 4], sa[8 * s + 5]); w0.w = pg8::cvt_pk_bf16(sa[8 * s + 6], sa[8 * s + 7]);
                w1.x = pg8::cvt_pk_bf16(sb[8 * s + 0], sb[8 * s + 1]); w1.y = pg8::cvt_pk_bf16(sb[8 * s + 2], sb[8 * s + 3]); w1.z = pg8::cvt_pk_bf16(sb[8 * s + 4], sb[8 * s + 5]); w1.w = pg8::cvt_pk_bf16(sb[8 * s + 6], sb[8 * s + 7]);
                fa[s] = __builtin_bit_cast(bf16x8, w0); fb[s] = __builtin_bit_cast(bf16x8, w1);
            }
            const LAS unsigned char* vbase = vb + (32 * u + 4 * hi + q4) * VROWB + 32 * blk + 8 * p4;
#pragma unroll
            for (int s = 0; s < 2; ++s)
#pragma unroll
                for (int c = 0; c < 2; ++c) {
                    const LAS unsigned char* a0 = vbase + (16 * s) * VROWB + 64 * c;
                    const s16x4 lo = vtr(a0), hh = vtr(a0 + 8 * VROWB);
                    const bf16x8 vf = (bf16x8){lo[0], lo[1], lo[2], lo[3], hh[0], hh[1], hh[2], hh[3]};
                    oa[c] = __builtin_amdgcn_mfma_f32_32x32x16_bf16(fa[s], vf, oa[c], 0, 0, 0);
                    ob[c] = __builtin_amdgcn_mfma_f32_32x32x16_bf16(fb[s], vf, ob[c], 0, 0, 0);
                }
            if (__any(needa || needb)) {
                const int exa = (int)((__builtin_bit_cast(unsigned, pta) >> 23) & 255u) - 127, exb = (int)((__builtin_bit_cast(unsigned, ptb) >> 23) & 255u) - 127;
                const float dla = needa ? (float)exa : 0.f, dlb = needb ? (float)exb : 0.f, fsa = fast_exp2(-dla), fsb = fast_exp2(-dlb);
                m_run[0] += dla; m_run[1] += dlb; l_run[0] *= fsa; l_run[1] *= fsb;
                if (USE_NEGM) {
#pragma unroll
                    for (int r = 0; r < 16; ++r) { nma[r] = -m_run[0]; nmb[r] = -m_run[1]; } }
                int hio = hi; asm volatile("" : "+v"(hio));
#pragma unroll
                for (int r = 0; r < 16; ++r) { const float fra = __shfl(fsa, crow(r, hio)), frb = __shfl(fsb, crow(r, hio)); oa[0][r] *= fra; oa[1][r] *= fra; ob[0][r] *= frb; ob[1][r] *= frb; }
            }
        }
    };
    for (int j = 0; j < nt; j += 2) {
        half(j, 0);
        if (j + 1 < nt) AW_WRITE((j + 1) & 1, krB, vrB);
        if (j + 3 < nt) AW_LOAD(j + 3, krB, vrB);
        half(j, 1);
        ATT_BAR();
        if (j + 1 >= nt) break;
        half(j + 1, 0);
        if (j + 2 < nt) AW_WRITE((j + 2) & 1, krA, vrA);
        if (j + 4 < nt) AW_LOAD(j + 4, krA, vrA);
        half(j + 1, 1);
        ATT_BAR();
    }
#undef AW_LOAD
#undef AW_WRITE
}

template <int DQK>
DI void attn_unit_w64(LAS unsigned char* lds, const AttnP& p) {
    const int tid = opaque_tid(), lane = tid & 63, wid = __builtin_amdgcn_readfirstlane(tid >> 6), r32 = lane & 31, hi = lane >> 5;
    bf16x8 qa[DQK / 16], qb[DQK / 16];
    const bf16* qrow = p.Q + (size_t)(64 * wid + r32) * p.qp;
#pragma unroll
    for (int d0 = 0; d0 < DQK / 16; ++d0) { qa[d0] = *(const bf16x8*)(qrow + 16 * d0 + 8 * hi); qb[d0] = *(const bf16x8*)(qrow + (size_t)32 * p.qp + 16 * d0 + 8 * hi); }
    if (DQK == 96) { if (p.rope_q) { const int pos = p.qpos0 + 64 * wid + r32;
        rope_frag(qa[4], pos >> 6, hi, LOG2_THETA / 8.f); rope_frag(qa[5], pos & 63, hi, LOG2_THETA / 8.f);
        rope_frag(qb[4], (pos + 32) >> 6, hi, LOG2_THETA / 8.f); rope_frag(qb[5], (pos + 32) & 63, hi, LOG2_THETA / 8.f); } }
    f32x16 oa[2], ob[2];
#pragma unroll
    for (int r = 0; r < 16; ++r) { oa[0][r] = 0.f; oa[1][r] = 0.f; ob[0][r] = 0.f; ob[1][r] = 0.f; }
    float m_run[2] = {0.f, 0.f}, l_run[2] = {0.f, 0.f};
    attn_core_w64<DQK>(lds, p, qa, qb, oa, ob, m_run, l_run, tid, wid, lane);
    const float inva = 1.0f / (l_run[0] + __shfl_xor(l_run[0], 32)), invb = 1.0f / (l_run[1] + __shfl_xor(l_run[1], 32));
    unsigned char* orow = p.O + (size_t)(64 * wid) * p.op + r32;
#pragma unroll
    for (int r = 0; r < 16; ++r) { int hio = hi; asm volatile("" : "+v"(hio)); const int q = crow(r, hio); const float iva = __shfl(inva, q) * MIX_SCALE, ivb = __shfl(invb, q) * MIX_SCALE;
#pragma unroll
        for (int c = 0; c < 2; ++c) { orow[(size_t)q * p.op + 32 * c] = (unsigned char)__builtin_amdgcn_cvt_pk_fp8_f32(oa[c][r] * iva, 0.f, 0u, false);
                                      orow[(size_t)(q + 32) * p.op + 32 * c] = (unsigned char)__builtin_amdgcn_cvt_pk_fp8_f32(ob[c][r] * ivb, 0.f, 0u, false); }
        __builtin_amdgcn_sched_barrier(0); }
}

DI void attn_unit_diff(LAS unsigned char* lds, const AttnP& p, const float lam, const float oml, const float* subln) {
    const int tid = opaque_tid(), lane = tid & 63, wid = __builtin_amdgcn_readfirstlane(tid >> 6), r32 = lane & 31, hi = lane >> 5;
    LAS unsigned* stash = (LAS unsigned*)(lds + O1_OFF) + tid;
    for (int jh = 0; jh < 2; ++jh) {
        AttnP pj = p; pj.K = p.K + 64 * jh;
        bf16x8 qf[4];
        const bf16* qrow = p.Q + (size_t)(32 * wid + r32) * p.qp + 64 * jh;
#pragma unroll
        for (int d0 = 0; d0 < 4; ++d0) qf[d0] = *(const bf16x8*)(qrow + 16 * d0 + 8 * hi);
        f32x16 o[4];
#pragma unroll
        for (int c = 0; c < 4; ++c)
#pragma unroll
            for (int r = 0; r < 16; ++r) o[c][r] = 0.f;
        float m_run = 0.f, l_run = 0.f;
        attn_core<64, 128, 0>(lds, pj, qf, o, m_run, l_run, tid, wid, lane);
        const float l = l_run + __shfl_xor(l_run, 32), inv = 1.0f / l;
        if (jh == 0) {
#pragma unroll
            for (int r = 0; r < 8; ++r) { int hio = hi; asm volatile("" : "+v"(hio)); const float iv0 = __shfl(inv, crow(2 * r, hio)), iv1 = __shfl(inv, crow(2 * r + 1, hio));
#pragma unroll
                for (int c = 0; c < 4; ++c) stash[512 * (c * 8 + r)] = pk2(o[c][2 * r] * iv0, o[c][2 * r + 1] * iv1);
                __builtin_amdgcn_sched_barrier(0); }
        } else {
            float sg[4];
#pragma unroll
            for (int c = 0; c < 4; ++c) sg[c] = subln[32 * c + r32] * (oml * MIX_SCALE);
            unsigned char* orow = p.O + (size_t)(32 * wid) * p.op + r32;
#pragma unroll
            for (int r = 0; r < 16; ++r) { int hio = hi; asm volatile("" : "+v"(hio)); const int q = crow(r, hio); const float iv = __shfl(inv, q);
                float v[4]; float ss = 0.f;
#pragma unroll
                for (int c = 0; c < 4; ++c) { const unsigned w1 = stash[512 * (c * 8 + (r >> 1))]; const float o1 = (r & 1) ? bfhi(w1) : bflo(w1); v[c] = o1 - lam * (o[c][r] * iv); ss += v[c] * v[c]; }
                ss += __shfl_xor(ss, 1); ss += __shfl_xor(ss, 2); ss += __shfl_xor(ss, 4); ss += __shfl_xor(ss, 8); ss += __shfl_xor(ss, 16);
                const float rinv = 1.0f / sqrtf(ss * (1.0f / 128.0f) + RMS_EPS);
#pragma unroll
                for (int c = 0; c < 4; ++c) orow[(size_t)q * p.op + 32 * c] = (unsigned char)__builtin_amdgcn_cvt_pk_fp8_f32(v[c] * rinv * sg[c], 0.f, 0u, false);
                __builtin_amdgcn_sched_barrier(0); }
        }
    }
}
}


DI void p0_mod_item(LAS unsigned char* lds, const float* c, const float* c_ctx, const float* mod_w, const float* mod_b, float* mod, const int item) {
    const int tid = opaque_tid(), lane = tid & 63, wid = __builtin_amdgcn_readfirstlane(tid >> 6), l = item / 48, col0 = (item - l * 48) * 128;
    constexpr int SP = 1026;
    LAS float* s = (LAS float*)lds;
    __syncthreads();
    for (int idx = tid; idx < 33 * 1024; idx += NTHR) { const int r = idx >> 10, kk = idx & 1023; const float cv = (r < 32) ? c[r * 1024 + kk] : c_ctx[kk]; s[r * SP + kk] = cv / (1.0f + __expf(-cv)); }
    __syncthreads();
    const int i32 = lane & 31, hi = lane >> 5;
    f32x16 acc[4];
#pragma unroll
    for (int cb = 0; cb < 4; ++cb)
#pragma unroll
        for (int r = 0; r < 16; ++r) acc[cb][r] = 0.f;
    float a32[4] = {0.f, 0.f, 0.f, 0.f};
    const float* w = mod_w + ((size_t)l * 1024 + wid * 128) * 6144 + col0 + i32;
    const LAS float* sa = s + i32 * SP + wid * 128 + 2 * hi;
    const LAS float* sc = s + 32 * SP + wid * 128 + 2 * hi;
#pragma unroll 4
    for (int q = 0; q < 32; ++q) {
        const float* wp = w + (size_t)(4 * q + 2 * hi) * 6144;
        float b0[4], b1[4];
#pragma unroll
        for (int cb = 0; cb < 4; ++cb) { b0[cb] = wp[32 * cb]; b1[cb] = wp[6144 + 32 * cb]; }
        const f32x2 av = *(const LAS f32x2*)(sa + 4 * q), cv = *(const LAS f32x2*)(sc + 4 * q);
#pragma unroll
        for (int cb = 0; cb < 4; ++cb) {
            acc[cb] = __builtin_amdgcn_mfma_f32_32x32x2f32(av[0], b0[cb], acc[cb], 0, 0, 0);
            acc[cb] = __builtin_amdgcn_mfma_f32_32x32x2f32(av[1], b1[cb], acc[cb], 0, 0, 0);
            a32[cb] += cv[0] * b0[cb] + cv[1] * b1[cb];
        }
    }
#pragma unroll
    for (int cb = 0; cb < 4; ++cb) a32[cb] += __shfl_xor(a32[cb], 32);
    __syncthreads();
    LAS float* red = s + (size_t)wid * 33 * 128;
#pragma unroll
    for (int cb = 0; cb < 4; ++cb) {
#pragma unroll
        for (int r = 0; r < 16; ++r) red[((r & 3) + 8 * (r >> 2) + 4 * hi) * 128 + 32 * cb + i32] = acc[cb][r];
        if (hi == 0) red[32 * 128 + 32 * cb + i32] = a32[cb];
    }
    __syncthreads();
    for (int idx = tid; idx < 33 * 128; idx += NTHR) { const int r = idx >> 7, cc = idx & 127; float v = 0.f;
#pragma unroll
        for (int wv = 0; wv < 8; ++wv) v += s[(wv * 33 + r) * 128 + cc];
        mod[((size_t)l * 33 + r) * 6144 + col0 + cc] = v + mod_b[l * 6144 + col0 + cc]; }
    __syncthreads();
}
struct TrDesc { const float* W; unsigned char* WT; int K, N, dK, mode, scale_n, fp8, item; float scale, scale2; };
constexpr int TI_GU = 128 * 1024, TI_D = 128 * 512, TI_WE = 2 * 1152, TI_WO_ = 2 * 976, TI_OUT = 4 * 512, TI_UQ = 2 * 96, TI_UKV = 2 * 64;
constexpr int TI_TOTAL = TI_GU + TI_D + TI_WE + TI_WO_ + TI_OUT + TI_UQ + TI_UKV;
DI TrDesc tr_decode(const float* const* in, unsigned char* ws, int r) {
    TrDesc d; d.scale_n = 0; d.scale = 1.f; d.scale2 = 1.f; d.mode = 0; d.fp8 = 0;
    if (r < TI_GU) { const int le = r >> 10; d.W = in[28] + (size_t)le * 1024 * 2048; d.K = 1024; d.N = 2048; d.WT = ws + WS_WGU + (size_t)le * 2048 * 1024; d.dK = 1024; d.mode = 1; d.scale_n = 1 << 30; d.scale = WGU_SCALE; d.fp8 = 1; d.item = r & 1023; return d; } r -= TI_GU;
    if (r < TI_D) { const int le = r >> 9; d.W = in[30] + (size_t)le * 1024 * 1024; d.K = 1024; d.N = 1024; d.WT = ws + WS_WD + (size_t)le * 1024 * 1024; d.dK = 1024; d.mode = 2; d.scale_n = 1 << 30; d.scale = WD_SCALE; d.fp8 = 1; d.item = r & 511; return d; } r -= TI_D;
    if (r < TI_WE) { const int j = r / 1152; d.W = in[10] + (size_t)j * 1024 * 2304; d.K = 1024; d.N = 2304; d.WT = ws + WS_WIN + (size_t)(2 * j) * 2304 * 1024 * 2; d.dK = 1024; d.scale_n = 512; d.scale = C2; d.item = r - j * 1152; if (INPROJ_FP8) { d.fp8 = 1; d.scale = C2 * WI_SCALE; d.scale2 = WI_SCALE; } return d; } r -= TI_WE;
    if (r < TI_WO_) { const int j = r / 976; d.W = in[15] + (size_t)j * 1024 * 1952; d.K = 1024; d.N = 1952; d.WT = ws + WS_WIN + (size_t)(2 * j + 1) * 2304 * 1024 * 2; d.dK = 1024; d.scale_n = 512; d.scale = C2; d.item = r - j * 976; if (INPROJ_FP8) { d.fp8 = 1; d.scale = C2 * WI_SCALE; d.scale2 = WI_SCALE; } return d; } r -= TI_WO_;
    if (r < TI_OUT) { const int q = r >> 9, j = q >> 1, odd = q & 1; d.W = in[odd ? 16 : 11] + (size_t)j * 1024 * 1024; d.K = 1024; d.N = 1024; d.WT = ws + WS_WOUT + (size_t)(2 * j + odd) * 1024 * 1024; d.dK = 1024; d.scale_n = 1 << 30; d.scale = WO_SCALE; d.fp8 = 1; d.item = r & 511; return d; } r -= TI_OUT;
    if (r < TI_UQ) { const int j = r / 96; d.W = in[23] + (size_t)j * 256 * 768; d.K = 256; d.N = 768; d.WT = ws + WS_WUQ + (size_t)j * 768 * 256 * 2; d.dK = 256; d.scale_n = 768; d.scale = C2M; d.item = r - j * 96; return d; } r -= TI_UQ;
    { const int j = r / 64; d.W = in[25] + (size_t)j * 128 * 1024; d.K = 128; d.N = 1024; d.WT = ws + WS_WUKV + (size_t)j * 1024 * 256 * 2; d.dK = 256; d.item = r - j * 64; return d; }
}
DI void tr_load(const TrDesc& d, f32x4 (&tv)[8], const int lane) {
    const int nblk = d.N / 32, kb = d.item / nblk, nb = d.item - kb * nblk, k0 = 64 * kb, n0 = 32 * nb;
    const float* p = d.W + (size_t)(k0 + (lane >> 3)) * d.N + n0 + 4 * (lane & 7);
#pragma unroll
    for (int i = 0; i < 8; ++i) tv[i] = *(const f32x4*)(p + (size_t)(8 * i) * d.N);
}
DI void tr_store(const TrDesc& d, LAS float* scr, const int lane) {
    const int nblk = d.N / 32, kb = d.item / nblk, nb = d.item - kb * nblk, k0 = 64 * kb, n0 = 32 * nb;
    if (d.fp8) {
        const int cch = lane & 3;
#pragma unroll
        for (int j = 0; j < 2; ++j) { const int nl = (lane >> 2) + 16 * j, n = n0 + nl; const LAS float* s = scr + (16 * cch) * 33 + nl; const float sc = (n < d.scale_n) ? d.scale : d.scale2;
            int row = n; if (d.mode == 1) { const int jj = n >> 1, sh = n & 1; row = 256 * (jj >> 7) + 128 * sh + (jj & 127); }
            if (d.mode == 2) { const int na = n & 255; row = (n & ~255) + 128 * ((na >> 3) & 1) + 32 * (na >> 6) + 8 * ((na >> 4) & 3) + (na & 7); }
            u32x4 o;
            o.x = pk4_fp8(s[0 * 33] * sc, s[1 * 33] * sc, s[2 * 33] * sc, s[3 * 33] * sc); o.y = pk4_fp8(s[4 * 33] * sc, s[5 * 33] * sc, s[6 * 33] * sc, s[7 * 33] * sc);
            o.z = pk4_fp8(s[8 * 33] * sc, s[9 * 33] * sc, s[10 * 33] * sc, s[11 * 33] * sc); o.w = pk4_fp8(s[12 * 33] * sc, s[13 * 33] * sc, s[14 * 33] * sc, s[15 * 33] * sc);
            *(u32x4*)(d.WT + (size_t)row * d.dK + k0 + 16 * cch) = o; }
    } else {
        const int cch = lane & 7;
#pragma unroll
        for (int j = 0; j < 4; ++j) { const int nl = (lane >> 3) + 8 * j, n = n0 + nl; const LAS float* s = scr + (8 * cch) * 33 + nl;
            const float sc = (n < d.scale_n) ? d.scale : 1.0f;
            u32x4 o; o.x = pk2(s[0 * 33] * sc, s[1 * 33] * sc); o.y = pk2(s[2 * 33] * sc, s[3 * 33] * sc); o.z = pk2(s[4 * 33] * sc, s[5 * 33] * sc); o.w = pk2(s[6 * 33] * sc, s[7 * 33] * sc);
            *(u32x4*)((bf16*)d.WT + (size_t)n * d.dK + k0 + 8 * cch) = o; }
    }
}
DI void p0_transposes(LAS unsigned char* lds, const float* const* in, unsigned char* ws, const int gw, const int ngw, const int wid, const int lane) {
    LAS float* scr = (LAS float*)(lds + wid * 16384);
    if (gw >= TI_TOTAL) return;
    f32x4 ta[8], tb[8];
    TrDesc da = tr_decode(in, ws, gw), db = da;
    tr_load(da, ta, lane);
    if (gw + ngw < TI_TOTAL) { db = tr_decode(in, ws, gw + ngw); tr_load(db, tb, lane); }
#define TR_STEP(D, TV, NEXT) do { \
        _Pragma("unroll") for (int i = 0; i < 8; ++i) { LAS float* sp = scr + ((lane >> 3) + 8 * i) * 33 + 4 * (lane & 7); sp[0] = TV[i][0]; sp[1] = TV[i][1]; sp[2] = TV[i][2]; sp[3] = TV[i][3]; } \
        TrDesc nx_ = D; \
        if ((NEXT) < TI_TOTAL) { nx_ = tr_decode(in, ws, (NEXT)); tr_load(nx_, TV, lane); } \
        asm volatile("s_waitcnt lgkmcnt(0)" ::: "memory"); \
        tr_store(D, scr, lane); \
        asm volatile("s_waitcnt lgkmcnt(0)" ::: "memory"); \
        D = nx_; } while (0)
    for (int it = gw; it < TI_TOTAL; it += 2 * ngw) {
        TR_STEP(da, ta, it + 2 * ngw);
        if (it + ngw >= TI_TOTAL) break;
        TR_STEP(db, tb, it + 3 * ngw);
    }
#undef TR_STEP
}
DI void p0_zero(unsigned char* ws, const int gtid, const int ngt) {
    if (INPROJ_FP8) { for (int i = gtid; i < 2 * 96 * 64; i += ngt) { const int j = i / (96 * 64), r = i - j * 96 * 64; *(u32x4*)(ws + WS_WIN + (size_t)(2 * j + 1) * 2304 * 1024 * 2 + (size_t)1952 * 1024 + (size_t)r * 16) = (u32x4){0u, 0u, 0u, 0u}; } }
    else for (int i = gtid; i < 2 * 96 * 128; i += ngt) { const int j = i / (96 * 128), r = i - j * 96 * 128; *(u32x4*)((bf16*)(ws + WS_WIN) + ((size_t)(2 * j + 1) * 2304 + 1952) * 1024 + (size_t)r * 8) = (u32x4){0u, 0u, 0u, 0u}; }
    for (int i = gtid; i < 2 * 1024 * 16; i += ngt) { const int row = i >> 4, ch = i & 15; *(u32x4*)((bf16*)(ws + WS_WUKV) + (size_t)row * 256 + 128 + ch * 8) = (u32x4){0u, 0u, 0u, 0u}; }
}
DI void p0b_rows(const float* x, const float* ctx, const float* mod0, bf16* X, bf16* H, const int gw, const int ngw, const int lane) {
    const int c0 = 16 * lane;
    f32x4 vn[4];
#define P0B_SRC(mm) (((mm) % TPB < CTXL) ? ctx + ((size_t)((mm) / TPB) * CTXL + (mm) % TPB) * DM : x + ((size_t)((mm) / TPB) * SEQ + ((mm) % TPB - CTXL)) * DM)
    if (gw < T) { const float* src = P0B_SRC(gw) + c0;
#pragma unroll
        for (int j = 0; j < 4; ++j) vn[j] = *(const f32x4*)(src + 4 * j); }
    for (int m = gw; m < T; m += ngw) {
        const int b = m / TPB, t = m - b * TPB;
        const float* md = mod0 + (size_t)((t < CTXL) ? 32 : b) * 6144 + c0;
        f32x4 vc[4];
#pragma unroll
        for (int j = 0; j < 4; ++j) vc[j] = vn[j];
        if (m + ngw < T) { const float* src = P0B_SRC(m + ngw) + c0;
#pragma unroll
            for (int j = 0; j < 4; ++j) vn[j] = *(const f32x4*)(src + 4 * j); }
        u32x4 xo[2], ho[2];
#pragma unroll
        for (int j = 0; j < 4; ++j) { const f32x4 v = vc[j];
            xo[j >> 1][2 * (j & 1)] = pk2(v[0], v[1]); xo[j >> 1][2 * (j & 1) + 1] = pk2(v[2], v[3]);
            const f32x4 sh = *(const f32x4*)(md + 4 * j), sc = *(const f32x4*)(md + 1024 + 4 * j); const f32x4 h = v * (sc + 1.0f) + sh;
            ho[j >> 1][2 * (j & 1)] = pk2(h[0], h[1]); ho[j >> 1][2 * (j & 1) + 1] = pk2(h[2], h[3]); }
        bf16* xr = X + (size_t)m * DM + c0; *(u32x4*)xr = xo[0]; *(u32x4*)(xr + 8) = xo[1];
        if (INPROJ_FP8) { u32x4 h8;
#pragma unroll
            for (int j = 0; j < 4; ++j) { const f32x4 sh = *(const f32x4*)(md + 4 * j), sc = *(const f32x4*)(md + 1024 + 4 * j); const f32x4 h = (vc[j] * (sc + 1.0f) + sh) * H_SCALE; h8[j] = pk4_fp8(h[0], h[1], h[2], h[3]); }
            *(u32x4*)((unsigned char*)H + (size_t)m * DM + c0) = h8; }
        else { bf16* hr = H + (size_t)m * DM + c0; *(u32x4*)hr = ho[0]; *(u32x4*)(hr + 8) = ho[1]; }
    }
#undef P0B_SRC
}
DI void unpack8(const u32x4 w, float (&v)[8]) { v[0] = bflo(w.x); v[1] = bfhi(w.x); v[2] = bflo(w.y); v[3] = bfhi(w.y); v[4] = bflo(w.z); v[5] = bfhi(w.z); v[6] = bflo(w.w); v[7] = bfhi(w.w); }
DI u32x4 pack8(const float (&v)[8]) { u32x4 w; w.x = pk2(v[0], v[1]); w.y = pk2(v[2], v[3]); w.z = pk2(v[4], v[5]); w.w = pk2(v[6], v[7]); return w; }
DI void rope_chunk(float (&y)[8], const float (&rf)[8], const float position, const bool second, const int pmask) {
#pragma unroll
    for (int e = 0; e < 8; ++e) { float rev = position * rf[e]; rev = rev - floorf(rev);
        const float sn = __builtin_amdgcn_sinf(rev), cs = __builtin_amdgcn_cosf(rev); const float partner = __shfl_xor(y[e], pmask);
        y[e] = second ? (partner * sn + y[e] * cs) : (y[e] * cs - partner * sn); }
}
DI void post_even_rows(const bf16* P, bf16* PQ, const float* qg, const float* kg, const int gw, const int ngw, const int lane) {
    const int ch = lane & 7;
    float gq[8], gk[8], rf[8];
#pragma unroll
    for (int e = 0; e < 8; ++e) { gq[e] = qg[8 * ch + e] * C2; gk[e] = kg[8 * ch + e]; rf[e] = fast_exp2(-(float)(8 * (ch & 1) + e) * (LOG2_THETA / 16.f)) * 0.15915494309189535f; }
    const bool second = (ch & 2) != 0, colpart = (ch & 4) != 0;
    u32x4 nq, nk;
    if (gw < T) { const bf16* r0 = P + (size_t)gw * NPP; nq = *(const u32x4*)(r0 + 1536 + 8 * lane); nk = *(const u32x4*)(r0 + 2048 + 8 * (lane & 15)); }
    for (int m = gw; m < T; m += ngw) {
        const int b = m / TPB, t = m - b * TPB; const bool lat = t >= CTXL; const int pos = t - CTXL;
        bf16* row = PQ + (size_t)m * NPP;
        u32x4* pq = (u32x4*)(row + 1536 + 8 * lane); u32x4* pk = (u32x4*)(row + 2048 + 8 * (lane & 15));
        const u32x4 wq = nq, wk = nk;
        if (m + ngw < T) { const bf16* r1 = P + (size_t)(m + ngw) * NPP; nq = *(const u32x4*)(r1 + 1536 + 8 * lane); nk = *(const u32x4*)(r1 + 2048 + 8 * (lane & 15)); }
        const float position = (float)(colpart ? (pos & 63) : (pos >> 6));
        float v[8];
        unpack8(wq, v);
        { float ss = 0.f;
#pragma unroll
          for (int e = 0; e < 8; ++e) ss += v[e] * v[e];
          ss += __shfl_xor(ss, 1); ss += __shfl_xor(ss, 2); ss += __shfl_xor(ss, 4);
          const float ri = 1.0f / sqrtf(ss * (1.0f / 64.0f) + RMS_EPS);
#pragma unroll
          for (int e = 0; e < 8; ++e) v[e] = v[e] * ri * gq[e];
          if (lat) rope_chunk(v, rf, position, second, 2);
          *pq = pack8(v); }
        unpack8(wk, v);
        { float ss = 0.f;
#pragma unroll
          for (int e = 0; e < 8; ++e) ss += v[e] * v[e];
          ss += __shfl_xor(ss, 1); ss += __shfl_xor(ss, 2); ss += __shfl_xor(ss, 4);
          const float ri = 1.0f / sqrtf(ss * (1.0f / 64.0f) + RMS_EPS);
#pragma unroll
          for (int e = 0; e < 8; ++e) v[e] = v[e] * ri * gk[e];
          if (lat) rope_chunk(v, rf, position, second, 2);
          if (lane < 16) *pk = pack8(v); }
    }
}
DI void post_odd_rows(const bf16* P, bf16* PQ, const float* mqg, const float* mkvg, const int gw, const int ngw, const int lane) {
    const int ch = lane & 7;
    float rf[8], rf32[8], g3[8];
#pragma unroll
    for (int e = 0; e < 8; ++e) { rf[e] = fast_exp2(-(float)(8 * (ch & 1) + e) * (LOG2_THETA / 16.f)) * 0.15915494309189535f; rf32[e] = fast_exp2(-(float)e * (LOG2_THETA / 8.f)) * 0.15915494309189535f;
        g3[e] = (lane < 32) ? mqg[8 * lane + e] : (lane < 48) ? mkvg[8 * (lane - 32) + e] : 1.0f; }
    const bool second = (ch & 2) != 0, colpart = (ch & 4) != 0;
    const int c3 = lane;
    const bool second32 = (lane & 1) != 0, colpart32 = (lane & 2) != 0;
    u32x4 n0, n1, n3;
#define PODD_LOAD(mm) do { const bf16* r_ = P + (size_t)(mm) * NPP; n3 = *(const u32x4*)(r_ + 1536 + 8 * c3); n0 = *(const u32x4*)(r_ + 8 * lane); n1 = *(const u32x4*)(r_ + 512 + 8 * lane); } while (0)
    if (gw < T) PODD_LOAD(gw);
    for (int m = gw; m < T; m += ngw) {
        const int b = m / TPB, t = m - b * TPB; const bool lat = t >= CTXL; const int pos = t - CTXL;
        bf16* row = PQ + (size_t)m * NPP;
        u32x4* p0 = (u32x4*)(row + 8 * lane); u32x4* p1 = (u32x4*)(row + 512 + 8 * lane); u32x4* p3 = (u32x4*)(row + 1536 + 8 * c3);
        const u32x4 w0 = n0, w1 = n1, w3 = n3;
        if (m + ngw < T) PODD_LOAD(m + ngw);
        float v[8];
        if (lat) {
            const float position = (float)(colpart ? (pos & 63) : (pos >> 6));
            unpack8(w0, v); rope_chunk(v, rf, position, second, 2); *p0 = pack8(v);
            unpack8(w1, v); rope_chunk(v, rf, position, second, 2); *p1 = pack8(v);
        } else { *p0 = w0; *p1 = w1; }
        unpack8(w3, v);
        float ss = 0.f;
#pragma unroll
        for (int e = 0; e < 8; ++e) ss += v[e] * v[e];
        ss += __shfl_xor(ss, 1); ss += __shfl_xor(ss, 2); ss += __shfl_xor(ss, 4); ss += __shfl_xor(ss, 8);
        const float ss16 = ss + __shfl_xor(ss, 16);
        const float ri = (lane < 32) ? 1.0f / sqrtf(ss16 * (1.0f / 256.0f) + RMS_EPS) : 1.0f / sqrtf(ss * (1.0f / 128.0f) + RMS_EPS);
        float vn[8];
#pragma unroll
        for (int e = 0; e < 8; ++e) vn[e] = v[e] * ri * g3[e];
        if (lat) { const float position32 = (float)(colpart32 ? (pos & 63) : (pos >> 6)); rope_chunk(v, rf32, position32, second32, 1); }
        if (lane < 48) *p3 = pack8(vn); else if (lane < 52) { if (lat) *p3 = pack8(v); else *p3 = w3; } else *p3 = (u32x4){0u, 0u, 0u, 0u};
    }
}
DI int ln_row(const int wg, const int i, const int last) { if (!last) return wg * 288 + i; const int idx = wg * 256 + i; return (idx >> 11) * TPB + CTXL + (idx & 2047); }

DI void ln1_router_table(LAS unsigned char* lds, const float* rw) {
    const int tid = opaque_tid();
    for (int i = 0; i < 32; ++i) { const int idx = tid + NTHR * i, e = idx & 31, k = (idx >> 5) * 2;
        *(LAS unsigned*)(lds + e * 2064 + k * 2) = pk2(rw[k * 32 + e], rw[(k + 1) * 32 + e]); }
}
DI void ln1_router_phase(LAS unsigned char* lds, bf16* X, unsigned char* H8, const float* mod_l, const float* lng, const float* lnb, const float* rw, const float* rb,
                         unsigned* cnt_l, unsigned* list, float* gsort, const int wg, const int last, const int have_table) {
    const int tid = opaque_tid(), lane = tid & 63, wid = __builtin_amdgcn_readfirstlane(tid >> 6);
    constexpr int TROW = 2064;
    LAS unsigned char* wrt = lds; LAS unsigned char* ht = lds + 66048; LAS float* logt = (LAS float*)(lds + 99072);
    LAS unsigned* ent = (LAS unsigned*)(lds + 101376); LAS float* entw = (LAS float*)(ent + 1152); LAS unsigned* lcnt = ent + 2304; LAS unsigned* lbase = lcnt + 32;
    if (!have_table) ln1_router_table(lds, rw);
    if (tid < 32) lcnt[tid] = 0u;
    const int nrows = last ? 256 : 288, nblk = nrows >> 4;
    const int c0 = 16 * lane;
    f32x4 gv[4], bv[4];
#pragma unroll
    for (int j = 0; j < 4; ++j) { gv[j] = *(const f32x4*)(lng + c0 + 4 * j); bv[j] = *(const f32x4*)(lnb + c0 + 4 * j); }
    u32x4 xnext[2][2];
#define LN1_LOAD(blk_) do { _Pragma("unroll") for (int r = 0; r < 2; ++r) { const bf16* xp_ = X + (size_t)ln_row(wg, (blk_) * 16 + 2 * wid + r, last) * DM + c0; \
        xnext[r][0] = *(const u32x4*)xp_; xnext[r][1] = *(const u32x4*)(xp_ + 8); } } while (0)
    LN1_LOAD(0);
    __syncthreads();
    for (int blk = 0; blk < nblk; ++blk) {
        u32x4 xcur[2][2];
#pragma unroll
        for (int r = 0; r < 2; ++r) { xcur[r][0] = xnext[r][0]; xcur[r][1] = xnext[r][1]; }
        if (blk + 1 < nblk) LN1_LOAD(blk + 1);
#pragma unroll
        for (int r = 0; r < 2; ++r) {
            const int m = ln_row(wg, blk * 16 + 2 * wid + r, last); const int b = m / TPB, t = m - b * TPB;
            const float* md = mod_l + (size_t)((t < CTXL) ? 32 : b) * 6144;
            f32x4 v[4]; float s = 0.f;
#pragma unroll
            for (int j = 0; j < 4; ++j) { const unsigned xa = xcur[r][j >> 1][2 * (j & 1)], xb = xcur[r][j >> 1][2 * (j & 1) + 1]; v[j] = (f32x4){bflo(xa), bfhi(xa), bflo(xb), bfhi(xb)}; s += (v[j][0] + v[j][1]) + (v[j][2] + v[j][3]); }
            const float mean = wave_sum(s) * (1.0f / DM); float s2 = 0.f;
#pragma unroll
            for (int j = 0; j < 4; ++j) { v[j] = v[j] - mean; s2 += (v[j][0] * v[j][0] + v[j][1] * v[j][1]) + (v[j][2] * v[j][2] + v[j][3] * v[j][3]); }
            const float rstd = 1.0f / sqrtf(wave_sum(s2) * (1.0f / DM) + LN_EPS);
            LAS unsigned char* hrow = ht + (2 * wid + r) * TROW + c0 * 2;
            u32x4 ho[2], h8;
#pragma unroll
            for (int j = 0; j < 4; ++j) { const f32x4 y = v[j] * rstd * gv[j] + bv[j];
                const f32x4 sh = *(const f32x4*)(md + 3072 + c0 + 4 * j), sc = *(const f32x4*)(md + 4096 + c0 + 4 * j); const f32x4 h = y * (sc + 1.0f) + sh;
                h8[j] = pk4_fp8(h[0], h[1], h[2], h[3]);
                ho[j >> 1][2 * (j & 1)] = pk2(h[0], h[1]); ho[j >> 1][2 * (j & 1) + 1] = pk2(h[2], h[3]); }
            *(u32x4*)(H8 + (size_t)m * DM + c0) = h8;
            *(LAS u32x4*)hrow = ho[0]; *(LAS u32x4*)(hrow + 16) = ho[1];
        }
        __syncthreads();
        if (wid < 2) {
            f32x4 d = {0.f, 0.f, 0.f, 0.f};
            const LAS unsigned char* ap = ht + (lane & 15) * TROW + (lane >> 4) * 16;
            const LAS unsigned char* bp = wrt + (16 * wid + (lane & 15)) * TROW + (lane >> 4) * 16;
#pragma unroll 8
            for (int s = 0; s < 32; ++s) d = __builtin_amdgcn_mfma_f32_16x16x32_bf16(*(const LAS bf16x8*)(ap + 64 * s), *(const LAS bf16x8*)(bp + 64 * s), d, 0, 0, 0);
            const float rbias = rb[16 * wid + (lane & 15)];
#pragma unroll
            for (int i = 0; i < 4; ++i) logt[(4 * (lane >> 4) + i) * 33 + 16 * wid + (lane & 15)] = d[i] + rbias;
        }
        __syncthreads();
        {
            const int half = lane >> 5, e = lane & 31, rr = 2 * wid + half;
            float v = logt[rr * 33 + e];
            float tv[4]; int te[4];
#define MX_DPP(x, ctrl, rmask) __builtin_bit_cast(float, __builtin_amdgcn_update_dpp(__builtin_bit_cast(int, x), __builtin_bit_cast(int, x), ctrl, rmask, 0xf, false))
#pragma unroll
            for (int k = 0; k < 4; ++k) {
                float m = v;
                m = fmaxf(m, MX_DPP(m, 0xB1, 0xf)); m = fmaxf(m, MX_DPP(m, 0x4E, 0xf)); m = fmaxf(m, MX_DPP(m, 0x141, 0xf)); m = fmaxf(m, MX_DPP(m, 0x140, 0xf));
                m = fmaxf(m, MX_DPP(m, 0x142, 0xa));
                const float m0 = __builtin_bit_cast(float, __builtin_amdgcn_readlane(__builtin_bit_cast(int, m), 31)), m1 = __builtin_bit_cast(float, __builtin_amdgcn_readlane(__builtin_bit_cast(int, m), 63));
                const float mh = half ? m1 : m0;
                const unsigned long long bal = __ballot(v == mh);
                const unsigned hm = half ? (unsigned)(bal >> 32) : (unsigned)bal;
                const int bi = __builtin_ctz(hm);
                tv[k] = mh; te[k] = bi;
                v = (e == bi) ? -3.0e38f : v;
            }
#undef MX_DPP
            const float e1 = __expf(tv[1] - tv[0]), e2 = __expf(tv[2] - tv[0]), e3 = __expf(tv[3] - tv[0]); const float rs = 1.0f / (1.0f + e1 + e2 + e3);
            if (e == 0) { const int irow = blk * 16 + rr;
                const float ww[4] = {rs, e1 * rs, e2 * rs, e3 * rs};
#pragma unroll
                for (int k = 0; k < 4; ++k) { const unsigned lr = __hip_atomic_fetch_add(lcnt + te[k], 1u, __ATOMIC_RELAXED, __HIP_MEMORY_SCOPE_WORKGROUP);
                    ent[irow * 4 + k] = (unsigned)te[k] | (lr << 8); entw[irow * 4 + k] = ww[k]; } }
        }
    }
#undef LN1_LOAD
    __syncthreads();
    if (tid < 32) lbase[tid] = __hip_atomic_fetch_add(cnt_l + tid * 64, lcnt[tid], __ATOMIC_RELAXED, __HIP_MEMORY_SCOPE_AGENT);
    __syncthreads();
    for (int sidx = tid; sidx < nrows * 4; sidx += NTHR) { const unsigned en = ent[sidx]; const int e = en & 255u; const unsigned lr = en >> 8;
        const int m = ln_row(wg, sidx >> 2, last); const size_t pos = (size_t)e * T + lbase[e] + lr; list[pos] = (unsigned)m * 4u + (unsigned)(sidx & 3); gsort[pos] = entw[sidx]; }
    __syncthreads();
}
DI void ln2_phase(bf16* X, const unsigned char* Y, bf16* H, float* out, const float* mod_l, const float* mod_n, const float* lng1, const float* lnb1, const float* lng, const float* lnb, const int wg, const int last, const int wid, const int lane) {
    const int nrows = last ? 256 : 288, c0 = 16 * lane;
    f32x4 gv[4], bv[4], gv1[4], bv1[4];
#pragma unroll
    for (int q = 0; q < 4; ++q) { gv[q] = *(const f32x4*)(lng + c0 + 4 * q); bv[q] = *(const f32x4*)(lnb + c0 + 4 * q); gv1[q] = *(const f32x4*)(lng1 + c0 + 4 * q); bv1[q] = *(const f32x4*)(lnb1 + c0 + 4 * q); }
    u32x4 xnext[2], ynext[4];
#define LN2_LOAD(mm) do { const bf16* xp_ = X + (size_t)(mm) * DM + c0; const unsigned char* yp_ = Y + (size_t)(mm) * 4 * DM + c0; \
        xnext[0] = *(const u32x4*)xp_; xnext[1] = *(const u32x4*)(xp_ + 8); \
        _Pragma("unroll") for (int k = 0; k < 4; ++k) ynext[k] = *(const u32x4*)(yp_ + (size_t)k * DM); } while (0)
    if (wid < nrows) LN2_LOAD(ln_row(wg, wid, last));
    for (int i = wid; i < nrows; i += NWAVES) {
        const int m = ln_row(wg, i, last); const int b = m / TPB, t = m - b * TPB; const int mrow = (t < CTXL) ? 32 : b;
        const float* md = mod_l + (size_t)mrow * 6144;
        bf16* xr = X + (size_t)m * DM + c0;
        u32x4 xcur[2], ycur[4];
        xcur[0] = xnext[0]; xcur[1] = xnext[1];
#pragma unroll
        for (int k = 0; k < 4; ++k) ycur[k] = ynext[k];
        if (i + NWAVES < nrows) LN2_LOAD(ln_row(wg, i + NWAVES, last));
        f32x4 v[4]; float s = 0.f;
        { float s1 = 0.f;
#pragma unroll
          for (int q = 0; q < 4; ++q) { const unsigned xa = xcur[q >> 1][2 * (q & 1)], xb = xcur[q >> 1][2 * (q & 1) + 1]; v[q] = (f32x4){bflo(xa), bfhi(xa), bflo(xb), bfhi(xb)}; s1 += (v[q][0] + v[q][1]) + (v[q][2] + v[q][3]); }
          const float mean1 = wave_sum(s1) * (1.0f / DM); float q1 = 0.f;
#pragma unroll
          for (int q = 0; q < 4; ++q) { v[q] = v[q] - mean1; q1 += (v[q][0] * v[q][0] + v[q][1] * v[q][1]) + (v[q][2] * v[q][2] + v[q][3] * v[q][3]); }
          const float rstd1 = 1.0f / sqrtf(wave_sum(q1) * (1.0f / DM) + LN_EPS);
#pragma unroll
          for (int q = 0; q < 4; ++q) v[q] = v[q] * rstd1 * gv1[q] + bv1[q]; }
#pragma unroll
        for (int q = 0; q < 4; ++q) { f32x4 y = (f32x4){0.f, 0.f, 0.f, 0.f};
#pragma unroll
            for (int k = 0; k < 4; ++k) { const unsigned w = ycur[k][q]; const f32x2 lo = __builtin_amdgcn_cvt_pk_f32_fp8(w, false), hi2 = __builtin_amdgcn_cvt_pk_f32_fp8(w, true); y += (f32x4){lo[0], lo[1], hi2[0], hi2[1]}; }
            const f32x4 g2 = *(const f32x4*)(md + 5120 + c0 + 4 * q) * (1.0f / Y_SCALE);
            v[q] = v[q] * DN_ALPHA + g2 * y; s += (v[q][0] + v[q][1]) + (v[q][2] + v[q][3]); }
        const float mean = wave_sum(s) * (1.0f / DM); float s2 = 0.f;
#pragma unroll
        for (int q = 0; q < 4; ++q) { v[q] = v[q] - mean; s2 += (v[q][0] * v[q][0] + v[q][1] * v[q][1]) + (v[q][2] * v[q][2] + v[q][3] * v[q][3]); }
        const float rstd = 1.0f / sqrtf(wave_sum(s2) * (1.0f / DM) + LN_EPS);
        if (last) { float* orow = out + ((size_t)b * SEQ + (t - CTXL)) * DM + c0;
#pragma unroll
            for (int q = 0; q < 4; ++q) *(f32x4*)(orow + 4 * q) = v[q] * rstd * gv[q] + bv[q];
        } else { const float* mn = mod_n + (size_t)mrow * 6144 + c0;
            u32x4 xo[2], ho[2];
#pragma unroll
            for (int q = 0; q < 4; ++q) { const f32x4 y = v[q] * rstd * gv[q] + bv[q];
                xo[q >> 1][2 * (q & 1)] = pk2(y[0], y[1]); xo[q >> 1][2 * (q & 1) + 1] = pk2(y[2], y[3]);
                const f32x4 sh = *(const f32x4*)(mn + 4 * q), sc = *(const f32x4*)(mn + 1024 + 4 * q); const f32x4 h = y * (sc + 1.0f) + sh;
                ho[q >> 1][2 * (q & 1)] = pk2(h[0], h[1]); ho[q >> 1][2 * (q & 1) + 1] = pk2(h[2], h[3]); }
            *(u32x4*)xr = xo[0]; *(u32x4*)(xr + 8) = xo[1];
            if (INPROJ_FP8) { u32x4 h8;
#pragma unroll
                for (int q = 0; q < 4; ++q) { const f32x4 y = v[q] * rstd * gv[q] + bv[q]; const f32x4 sh = *(const f32x4*)(mn + 4 * q), sc = *(const f32x4*)(mn + 1024 + 4 * q); const f32x4 h = (y * (sc + 1.0f) + sh) * H_SCALE; h8[q] = pk4_fp8(h[0], h[1], h[2], h[3]); }
                *(u32x4*)((unsigned char*)H + (size_t)m * DM + c0) = h8; }
            else { bf16* hr = H + (size_t)m * DM + c0; *(u32x4*)hr = ho[0]; *(u32x4*)(hr + 8) = ho[1]; }
        }
    }
#undef LN2_LOAD
}

DI void build_expert_table(LAS int* tab, const unsigned* cnt_l) {
    const int tid = opaque_tid();
    __syncthreads();
    if (tid < 32) tab[33 + tid] = (int)__hip_atomic_load(cnt_l + tid * 64, __ATOMIC_RELAXED, __HIP_MEMORY_SCOPE_AGENT);
    __syncthreads();
    if (tid == 0) { int acc = 0; for (int e = 0; e < 32; ++e) { tab[e] = acc; acc += (tab[33 + e] + 255) >> 8; } tab[32] = acc; }
    __syncthreads();
}


DI void attn_phase_even(LAS unsigned char* lds, const bf16* P, const bf16* PQ, unsigned char* MIX, const float* rpb_j, const int G, const int bx, const int shadow) {
    for (int i = 0;; ++i) {
        const int L = i * G + bx;
        att::AttnP p{}; bool na = false, big = false; p.shadow = shadow;
        p.qp = NPP; p.kp = NPP; p.vp = NPP; p.op = DM; p.K2 = P; p.k2p = NPP;
        if (L < 1024) { int b = L >> 5, h = (L >> 2) & 7, qb = L & 3;
            if (G == 256) { const int x = bx & 7, j = bx >> 3, g = x + 8 * (j >> 4), jq = j & 15; b = 8 * i + (g >> 1); h = 4 * (g & 1) + (jq >> 2); qb = jq & 3; }
            const int row0 = b * TPB + CTXL + qb * 512;
            p.Q = PQ + (size_t)row0 * NPP + 1536 + 64 * h; p.K = PQ + 2048 + 64 * (h >> 2); p.V = P + 2176 + 64 * (h >> 2); p.O = MIX + (size_t)row0 * DM + 512 + 64 * h; p.kt0 = b * TPB; p.ntiles = 36; big = true; }
        else if (L < 3072) { const int L2 = L - 1024; int b = L2 >> 6, h = (L2 >> 3) & 7, rg = (L2 + (L2 >> 8)) & 7  ;
            if (G == 256) { const int x = bx & 7, j = bx >> 3, g = x + 8 * (j >> 3); b = 4 * (i - 4) + (g >> 3); h = g & 7; rg = ((j & 7) + i) & 7; }
 const int qr0 = 4 * rg, row0 = b * TPB + CTXL + qr0 * 64;
            p.Q = P + (size_t)row0 * NPP + 64 * h; p.K = P + 512 + 64 * h; p.V = P + 1024 + 64 * h; p.O = MIX + (size_t)row0 * DM + 64 * h;
            p.brow0 = b * TPB; p.na_lo = min(max(qr0 - 4, 0), 24); p.na_nloc = min(max(qr0 - 1, 0), 24) + 7 - p.na_lo + 1; p.ntiles = p.na_nloc + 4; p.qr0 = qr0; p.rpb = rpb_j + h * 465; na = true; }
        else if (L < 3584) { const int L3 = L - 3072, b = L3 >> 4, hh = L3 & 15; const int row0 = b * TPB;
            if (hh < 8) { p.Q = P + (size_t)row0 * NPP + 64 * hh; p.K = P + 512 + 64 * hh; p.V = P + 1024 + 64 * hh; p.O = MIX + (size_t)row0 * DM + 64 * hh; }
            else { const int h = hh - 8; p.Q = PQ + (size_t)row0 * NPP + 1536 + 64 * h; p.K = PQ + 2048 + 64 * (h >> 2); p.V = P + 2176 + 64 * (h >> 2); p.O = MIX + (size_t)row0 * DM + 512 + 64 * h; }
            p.kt0 = row0; p.ntiles = 4; }
        else break;
#ifndef ATT_MASK
#define ATT_MASK 15
#endif
        if (na) { if (ATT_MASK & 1) att::attn_unit<64, 1>(lds, p); } else if (big) { if (ATT_MASK & 2) att::attn_unit_w64<64>(lds, p); } else { if (ATT_MASK & 2) att::attn_unit<64, 0>(lds, p); }
    }
}
DI void attn_phase_odd(LAS unsigned char* lds, const bf16* P, const bf16* PQ, const bf16* QM, const bf16* KVM, unsigned char* MIX, const float lam, const float oml, const float* subln, const int G, const int bx, const int last, const int shadow) {
    const int total = last ? 2048 : 2432;
    for (int i = 0;; ++i) {
        const int L = i * G + bx; if (L >= total) break;
        att::AttnP p{}; bool diff = false, big = false; p.shadow = shadow;
        p.op = DM; p.K2 = PQ + 1920; p.k2p = NPP;
        if (L < 1024 || (L >= 2048 && L < 2176)) { int b, h, row0;
            if (L < 1024) { b = L >> 5; h = (L >> 3) & 3; int qb = L & 7;
                if (G == 256) { const int x = bx & 7, j = bx >> 3, g = x + 8 * (j >> 3); b = 8 * i + (g >> 2); h = g & 3; qb = j & 7; }
                row0 = b * TPB + CTXL + qb * 256; p.ntiles = 36; } else { const int L3 = L - 2048; b = L3 >> 2; h = L3 & 3; row0 = b * TPB; p.ntiles = 4; }
            p.Q = PQ + (size_t)row0 * NPP + 128 * h; p.qp = NPP; p.K = PQ + 512 + 128 * h; p.kp = NPP; p.V = P + 1024 + 128 * h; p.vp = NPP; p.O = MIX + (size_t)row0 * DM + 128 * h; p.kt0 = b * TPB; diff = true; }
        else { int b, h, row0;
            if (L < 2048) { const int L2 = L - 1024; b = L2 >> 5; h = (L2 >> 2) & 7; int qb = L2 & 3;
                if (G == 256) { const int x = bx & 7, j = bx >> 3, g = x + 8 * (j >> 2); b = 8 * (i - 4) + (g >> 3); h = g & 7; qb = j & 3; }
                row0 = b * TPB + CTXL + qb * 512; p.ntiles = 36; p.rope_q = 1; p.qpos0 = qb * 512; big = true; }
            else { const int L4 = L - 2176; b = L4 >> 3; h = L4 & 7; row0 = b * TPB; p.ntiles = 4; p.rope_q = 0; p.qpos0 = 0; }
            p.Q = QM + (size_t)row0 * 768 + 96 * h; p.qp = 768; p.K = KVM + 128 * h; p.kp = DM; p.V = KVM + 128 * h + 64; p.vp = DM; p.O = MIX + (size_t)row0 * DM + 512 + 64 * h; p.kt0 = b * TPB; }
        if (diff) { if (ATT_MASK & 4) att::attn_unit_diff(lds, p, lam, oml, subln); } else if (big) { if (ATT_MASK & 8) att::attn_unit_w64<96>(lds, p); } else { if (ATT_MASK & 8) att::attn_unit<96, 0>(lds, p); }
    }
}

constexpr int NPHASE = 2 + 9 * NL;
struct Args { const float* in[32]; float* out; unsigned char* ws; int ph_lo, ph_hi, li, pad; };
__global__ void __launch_bounds__(NTHR, 2) fwd(Args a) {
    extern __shared__ __attribute__((aligned(16))) unsigned char lds_raw[];
    LAS unsigned char* lds = (LAS unsigned char*)lds_raw;
    volatile LAS unsigned* MISC = (volatile LAS unsigned*)(lds + MISC_OFF);
    LAS int* tab = (LAS int*)(lds + MISC_OFF + 256);
    LAS int* utab = (LAS int*)(lds + pg8::UTAB_OFF); LAS unsigned* rtab = (LAS unsigned*)(lds + pg8::RTAB_OFF);
    const int tid = opaque_tid(), lane = tid & 63, wid = __builtin_amdgcn_readfirstlane(tid >> 6);
    const int G = gridDim.x, bx = blockIdx.x, gw = bx * NWAVES + wid, ngw = G * NWAVES;
    for (int u = tid; u < (LDS_BYTES - MISC_OFF) / 4; u += NTHR) MISC[u] = 0u;
    __syncthreads();
    unsigned char* ws = a.ws;
    unsigned* ctl = (unsigned*)(ws + WS_CTL);
    const int lo = a.ph_lo, hi = a.ph_hi;
    XcdBarrier bar; bar.bar = ctl + CW_BAR + a.li * XCD_BAR_WORDS; bar.x = 0; bar.st = MISC;
    if (hi - lo > 1) bar = xcd_barrier_post(ctl + CW_BAR + a.li * XCD_BAR_WORDS, MISC);
#ifndef PH_MASK
#define PH_MASK 0x7ff
#endif
#define PHM(k) (((PH_MASK) >> ((k) < 2 ? (k) : 2 + ((k) - 2) % 9)) & 1)
#define IN(k) (PHM(k) && lo <= (k) && (k) < hi)
#ifndef PROBE_DUP
#define PROBE_DUP 0
#endif
#define NREP(kind) (1 + (((PROBE_DUP) >> (kind)) & 1))
#define SEAM(k) do { if (lo <= (k) && (k) + 1 < hi) xcd_barrier(bar); } while (0)
    float* mod = (float*)(ws + WS_MOD);
    bf16* X = (bf16*)(ws + WS_X); bf16* H = (bf16*)(ws + WS_H); bf16* P = (bf16*)(ws + WS_P); bf16* QM = (bf16*)(ws + WS_QM); bf16* KVM = (bf16*)(ws + WS_KVM);
    bf16* PQ = (bf16*)(ws + WS_PQ);
    unsigned char* MIX = ws + WS_MIX; unsigned char* ACT = ws + WS_ACT; unsigned char* H8 = ws + WS_H8; unsigned char* Y = ws + WS_Y;
    unsigned* list = (unsigned*)(ws + WS_LIST); float* gsort = (float*)(ws + WS_GSORT);

    if (IN(0)) for (int rep = 0; rep < NREP(0); ++rep) {
        for (int it = bx; it < 192; it += G) p0_mod_item(lds, a.in[1], a.in[3], a.in[4], a.in[5], mod, it);
        p0_transposes(lds, a.in, ws, gw, ngw, wid, lane);
        p0_zero(ws, bx * NTHR + tid, G * NTHR);
    }
    SEAM(0);
    if (IN(1)) p0b_rows(a.in[0], a.in[2], mod, X, H, gw, ngw, lane);
    SEAM(1);
    for (int l = 0; l < NL; ++l) {
        const int tid = opaque_tid(), lane = tid & 63, wid = __builtin_amdgcn_readfirstlane(tid >> 6), gw = bx * NWAVES + wid;
        const int pb = 2 + 9 * l, odd = l & 1, j = l >> 1, last = (l == NL - 1) ? 1 : 0;
        const float* mod_l = mod + (size_t)l * 33 * 6144;
        unsigned* cnt_l = ctl + CW_CNT + l * 32 * 64;
        if (IN(pb + 0)) for (int rep = 0; rep < NREP(2); ++rep) {
#if INPROJ_FP8
            pg8::DenseSched S; S.init(H, 512, (const bf16*)(ws + WS_WIN) + (size_t)l * 2304 * 1024, 512, NTILE_M, odd ? 8 : 9, G, bx, 0);
            pg8::EpiBf16 E{P, NPP, 1.0f / (WI_SCALE * H_SCALE)};
            pg8::gemm_phase<true>(lds, 1024, S, E);
#else
            pg8::DenseSched S; S.init(H, DM, (const bf16*)(ws + WS_WIN) + (size_t)l * 2304 * 1024, 1024, NTILE_M, odd ? 8 : 9, G, bx, 0);
            pg8::EpiBf16 E{P, NPP, 1.0f};
            pg8::gemm_phase<false>(lds, 2048, S, E);
#endif
        }
        SEAM(pb + 0);
        if (IN(pb + 1)) {
            if (odd) post_odd_rows(P, PQ, a.in[22] + j * 256, a.in[24] + j * 128, gw, ngw, lane);
            else post_even_rows(P, PQ, a.in[13] + j * 64, a.in[14] + j * 64, gw, ngw, lane);
        }
        SEAM(pb + 1);
        if (odd) {
            if (IN(pb + 2)) for (int rep = 0; rep < NREP(4); ++rep) {
                { pg8::DenseSched S; S.init(PQ + 1536, NPP, (const bf16*)(ws + WS_WUQ) + (size_t)j * 768 * 256, 256, NTILE_M, 3, G, bx, 0); pg8::EpiBf16 E{QM, 768, 1.0f}; pg8::gemm_phase<false>(lds, 512, S, E); }
                { pg8::DenseSched S; S.init(PQ + 1792, NPP, (const bf16*)(ws + WS_WUKV) + (size_t)j * 1024 * 256, 256, NTILE_M, 4, G, (bx + G - (NTILE_M * 3) % G) % G, 0); pg8::EpiBf16 E{KVM, DM, 1.0f}; pg8::gemm_phase<false>(lds, 512, S, E); }
            }
            SEAM(pb + 2);
        }
        if (IN(pb + 3)) for (int rep = 0; rep < NREP(5); ++rep) {
            if (odd) {
                const float s1 = wave_sum(a.in[17][j * 64 + lane] * a.in[18][j * 64 + lane]), s2 = wave_sum(a.in[19][j * 64 + lane] * a.in[20][j * 64 + lane]);
                const float lam_init = (l == 1) ? 0.35550906759310934f : 0.55605820415610350f;
                const float lam = __expf(s1) - __expf(s2) + lam_init;
#ifndef PROBE_SHADOW
#define PROBE_SHADOW 0
#endif
                attn_phase_odd(lds, P, PQ, QM, KVM, rep ? ACT : MIX, lam, 1.0f - lam_init, a.in[21] + j * 128, G, bx, last, rep ? PROBE_SHADOW : 0);
            } else attn_phase_even(lds, P, PQ, rep ? ACT : MIX, a.in[12] + (size_t)j * 8 * 465, G, bx, rep ? PROBE_SHADOW : 0);
        }
        SEAM(pb + 3 - ((odd || true) ? 0 : 0));
        if (IN(pb + 4)) {
            pg8::DenseSched S; S.init((const bf16*)MIX, 512, (const bf16*)(ws + WS_WOUT + (size_t)l * 1024 * 1024), 512, last ? 256 : NTILE_M, 4, G, bx, last);
            pg8::EpiResid E{X, mod_l};
            pg8::gemm_phase<true>(lds, 1024, S, E);
        }
        const int pre_rt = (IN(pb + 4) && IN(pb + 5) && G == 256) ? 1 : 0;
        if (pre_rt) { __syncthreads(); ln1_router_table(lds, a.in[26] + (size_t)l * 1024 * 32); }
        SEAM(pb + 4);
        if (IN(pb + 5)) {
            for (int wg = bx; wg < 256; wg += G)
                ln1_router_phase(lds, X, H8, mod_l, a.in[6] + l * 1024, a.in[7] + l * 1024, a.in[26] + (size_t)l * 1024 * 32, a.in[27] + l * 32, cnt_l, list, gsort, wg, last, pre_rt);
        }
        SEAM(pb + 5);
        if (IN(pb + 6)) for (int rep = 0; rep < NREP(8); ++rep) {
            build_expert_table(tab, cnt_l);
            const int nun = pg8::build_unit_table(tab, utab, 8, G, bx);
            pg8::GroupSched S{tab, utab, rtab, nun, 8, G, bx, 1024, (const char*)H8, list, gsort, 1, (const char*)(ws + WS_WGU + (size_t)l * 32 * 2048 * 1024), (size_t)2048 * 1024, a.in[29] + (size_t)l * 32 * 2048, 2048};
            S.fill_sync(0, tid); S.fill_sync(1, tid); __syncthreads();
            pg8::EpiSwiglu E{ACT, rtab};
            pg8::gemm_phase<true>(lds, 1024, S, E);
        }
        int nun_d = -1;
        if (IN(pb + 6) && IN(pb + 7) && NREP(9) == 1) {
            __syncthreads();
            build_expert_table(tab, cnt_l);
            nun_d = pg8::build_unit_table(tab, utab, 4, G, bx);
            pg8::GroupSched S{tab, utab, rtab, nun_d, 4, G, bx, 1024, (const char*)ACT, list, gsort, 0, (const char*)(ws + WS_WD + (size_t)l * 32 * 1024 * 1024), (size_t)1024 * 1024, a.in[31] + (size_t)l * 32 * 1024, 1024};
            S.fill_sync(0, tid);
        }
        SEAM(pb + 6);
        if (IN(pb + 7)) for (int rep = 0; rep < NREP(9); ++rep) {
            int nun = nun_d;
            if (nun_d < 0) { build_expert_table(tab, cnt_l); nun = pg8::build_unit_table(tab, utab, 4, G, bx); }
            pg8::GroupSched S{tab, utab, rtab, nun, 4, G, bx, 1024, (const char*)ACT, list, gsort, 0, (const char*)(ws + WS_WD + (size_t)l * 32 * 1024 * 1024), (size_t)1024 * 1024, a.in[31] + (size_t)l * 32 * 1024, 1024};
            if (nun_d < 0) S.fill_sync(0, tid);
            __syncthreads();
            pg8::EpiDown E{Y, rtab, tab};
            pg8::gemm_phase<true>(lds, 1024, S, E);
        }
        SEAM(pb + 7);
        if (IN(pb + 8)) {
            for (int wg = bx; wg < 256; wg += G)
                ln2_phase(X, Y, H, a.out, mod_l, mod + (size_t)(last ? l : l + 1) * 33 * 6144, a.in[6] + l * 1024, a.in[7] + l * 1024, a.in[8] + l * 1024, a.in[9] + l * 1024, wg, last, wid, lane);
        }
        SEAM(pb + 8);
    }
#undef IN
#undef SEAM
}

extern "C" void kernel_launch(void* const* d_in, const int* in_sizes, int n_in, void* d_out, int out_size, void* d_ws, size_t ws_size, hipStream_t stream) {
    static int grid = 0;
    if (grid == 0) {
        if (n_in != 32 || ws_size < WS_END || out_size != NBATCH * SEQ * DM) { fprintf(stderr, "kernel_launch: unexpected shapes (n_in %d, out %d, ws %zu)\n", n_in, out_size, ws_size); grid = -1; return; }
        int dev = 0, cus = 0, per_cu = 0;
        if (hipGetDevice(&dev) != hipSuccess || hipDeviceGetAttribute(&cus, hipDeviceAttributeMultiprocessorCount, dev) != hipSuccess) { grid = -1; return; }
        if (hipFuncSetAttribute((const void*)fwd, hipFuncAttributeMaxDynamicSharedMemorySize, LDS_BYTES) != hipSuccess) { fprintf(stderr, "kernel_launch: hipFuncSetAttribute failed\n"); grid = -1; return; }
        if (hipOccupancyMaxActiveBlocksPerMultiprocessor(&per_cu, (const void*)fwd, NTHR, LDS_BYTES) != hipSuccess || per_cu < 1) fprintf(stderr, "kernel_launch: occupancy query reports %d\n", per_cu);
        (void)hipGetLastError();
        grid = cus < 256 ? cus : 256;
    }
    if (grid < 0) return;
    (void)hipMemsetAsync((char*)d_ws + WS_CTL, 0, CTL_ZERO_BYTES, stream);
    Args a{};
    for (int i = 0; i < 32; ++i) a.in[i] = (const float*)d_in[i];
    a.out = (float*)d_out; a.ws = (unsigned char*)d_ws;
#if MK_ONE_LAUNCH
    a.ph_lo = 0; a.ph_hi = NPHASE; a.li = 0;
    hipLaunchKernelGGL(fwd, dim3(grid), dim3(NTHR), LDS_BYTES, stream, a);
#else
    int li = 0;
    for (int ph = 0; ph < NPHASE; ++ph) {
        if (ph >= 2 && ((ph - 2) % 9) == 2 && (((ph - 2) / 9) & 1) == 0) continue;
        a.ph_lo = ph; a.ph_hi = ph + 1; a.li = 0; ++li;
        hipLaunchKernelGGL(fwd, dim3(grid), dim3(NTHR), LDS_BYTES, stream, a);
    }
#endif
}
```

```cpp
#include <hip/hip_runtime.h>
#include <cstdio>
#include <cstdint>

#ifndef MK_ONE_LAUNCH
#define MK_ONE_LAUNCH 1
#endif
#ifndef PROBE_SHADOW
#define PROBE_SHADOW 0
#endif

#define GAS __attribute__((address_space(1)))
#define LAS __attribute__((address_space(3)))
#define DI __device__ __forceinline__
typedef unsigned short bf16;
typedef short bf16x8 __attribute__((ext_vector_type(8)));
typedef short s16x4 __attribute__((ext_vector_type(4)));
typedef float f32x2 __attribute__((ext_vector_type(2)));
typedef float f32x4 __attribute__((ext_vector_type(4)));
typedef float f32x16 __attribute__((ext_vector_type(16)));
typedef unsigned u32x2 __attribute__((ext_vector_type(2)));
typedef unsigned u32x4 __attribute__((ext_vector_type(4)));

constexpr int DM = 1024, NBATCH = 32, SEQ = 2048, CTXL = 256, TPB = SEQ + CTXL  ;
constexpr int T = NBATCH * TPB;
constexpr int NL = 4, NPP = 2304;
constexpr int NE = 32, DE = 1024;
constexpr int NTILE_M = T / 256;
constexpr float LOG2E = 1.4426950408889634f;
constexpr float C2 = 0.125f * LOG2E;
constexpr float C2M = 0.10206207261596575f * LOG2E;
constexpr float DN_ALPHA = 1.6817928305074290f;
constexpr float LN_EPS = 1e-6f, RMS_EPS = 1e-6f;
constexpr float LOG2_THETA = 13.287712379549449f;

constexpr size_t MiB = 1u << 20;
constexpr size_t WS_CTL = 0, CTL_ZERO_BYTES = 1 * MiB;
constexpr size_t WS_MOD = 1 * MiB;
constexpr size_t WS_WIN = 8 * MiB;
constexpr size_t WS_WOUT = 28 * MiB;
constexpr size_t WS_WUQ = 36 * MiB;
constexpr size_t WS_WUKV = 37 * MiB;
constexpr size_t WS_LIST = 40 * MiB;
constexpr size_t WS_GATE = 50 * MiB;
constexpr size_t WS_WGU = 64 * MiB;
constexpr size_t WS_WD = 576 * MiB;
constexpr size_t WS_X = 832 * MiB;
constexpr size_t WS_H = 1120 * MiB;
constexpr size_t WS_P = 1264 * MiB;
constexpr size_t WS_QM = 1588 * MiB;
constexpr size_t WS_KVM = 1696 * MiB;
constexpr size_t WS_MIX = 1840 * MiB;
constexpr size_t WS_ACT = 1984 * MiB;
constexpr size_t WS_Y = 2576 * MiB;
constexpr size_t WS_H8 = 3152 * MiB;
constexpr size_t WS_GSORT = 3224 * MiB;
constexpr size_t WS_PQ = 3234 * MiB;
constexpr size_t WS_END = 3558 * MiB;
constexpr float WGU_SCALE = 64.0f, WD_SCALE = 128.0f, Y_SCALE = 64.0f, WO_SCALE = 128.0f, MIX_SCALE = 16.0f;
#ifndef INPROJ_FP8
#define INPROJ_FP8 1
#endif
constexpr float WI_SCALE = 64.0f, H_SCALE = 8.0f;
constexpr int ACT_ROWS = T * 4 + 32 * 256;
static_assert(WS_MOD + (size_t)4 * 33 * 6144 * 4 <= WS_WIN && WS_WIN + (size_t)4 * 2304 * 1024 * 2 <= WS_WOUT && WS_LIST + (size_t)32 * T * 4 <= WS_GATE && WS_GATE + (size_t)T * 16 <= WS_WGU, "ws map 1");
static_assert(WS_X + (size_t)T * 4096 <= WS_H && WS_H + (size_t)T * 2048 <= WS_P && WS_P + (size_t)T * NPP * 2 <= WS_QM && WS_QM + (size_t)T * 768 * 2 <= WS_KVM && WS_KVM + (size_t)T * 2048 <= WS_MIX, "ws map 2");
static_assert(WS_MIX + (size_t)T * 2048 <= WS_ACT && WS_ACT + (size_t)ACT_ROWS * 2048 <= WS_Y && WS_Y + (size_t)T * 4 * 2048 <= WS_H8 && WS_H8 + (size_t)T * 1024 <= WS_GSORT && WS_GSORT + (size_t)32 * T * 4 <= WS_PQ && WS_PQ + (size_t)T * NPP * 2 <= WS_END, "ws map 3");
constexpr int CW_TMO = 0;
constexpr int CW_CNT = 1024;
constexpr int CW_BAR = 16384;
constexpr int MAX_LAUNCH = 40;
static_assert(CW_CNT + 4 * 32 * 64 <= CW_BAR && (CW_BAR + MAX_LAUNCH * 3456) * 4 <= (int)CTL_ZERO_BYTES, "ctl");

constexpr int LDS_BYTES = 147456;
constexpr int MISC_OFF = 143360;
constexpr int NWAVES = 8, NTHR = 512;

DI unsigned f2bf(float f) { unsigned u = __builtin_bit_cast(unsigned, f); return (u + 0x7fffu + ((u >> 16) & 1u)) >> 16; }
DI unsigned pk2(float lo, float hi) { return f2bf(lo) | (f2bf(hi) << 16); }
DI float bf2f(unsigned short b) { return __builtin_bit_cast(float, (unsigned)b << 16); }
DI float bflo(unsigned w) { return __builtin_bit_cast(float, w << 16); }
DI float bfhi(unsigned w) { return __builtin_bit_cast(float, w & 0xffff0000u); }
#define WS_DPP(v, ctrl, rmask) __builtin_bit_cast(float, __builtin_amdgcn_update_dpp(0, __builtin_bit_cast(int, v), ctrl, rmask, 0xf, false))
DI float wave_sum(float v) {
    v += WS_DPP(v, 0xB1, 0xf);
    v += WS_DPP(v, 0x4E, 0xf);
    v += WS_DPP(v, 0x141, 0xf);
    v += WS_DPP(v, 0x140, 0xf);
    v += WS_DPP(v, 0x142, 0xa);
    v += WS_DPP(v, 0x143, 0xc);
    return __builtin_bit_cast(float, __builtin_amdgcn_readlane(__builtin_bit_cast(int, v), 63));
}
DI float fast_exp2(float x) { return __builtin_amdgcn_exp2f(x); }
DI unsigned pk4_fp8(float a, float b, float c, float d) { unsigned w = __builtin_amdgcn_cvt_pk_fp8_f32(a, b, 0u, false); return __builtin_amdgcn_cvt_pk_fp8_f32(c, d, w, true); }
DI int opaque_tid() { int t = threadIdx.x; asm volatile("" : "+v"(t)); return t; }
DI const char* uni_ptr(const char* p) { const unsigned long long v = (unsigned long long)p; const unsigned lo = __builtin_amdgcn_readfirstlane((unsigned)v), hi = __builtin_amdgcn_readfirstlane((unsigned)(v >> 32)); return (const char*)(((unsigned long long)hi << 32) | lo); }

#define XB_TMO      128
#define XB_XCNT(j)  (256  + 64 * (j))
#define XB_XSUB(j)  (1280 + 64 * (j))
#define XB_XGEN(j)  (2304 + 64 * (j))
#define XB_TOP      3328
#define XB_TOPGEN   3392
#define XCD_BAR_WORDS 3456
#define XB_SPIN_CAP (1u << 22)
DI unsigned xb_ld(unsigned* p)              { return __hip_atomic_load(p, __ATOMIC_RELAXED, __HIP_MEMORY_SCOPE_AGENT); }
DI unsigned xb_add(unsigned* p, unsigned v) { return __hip_atomic_fetch_add(p, v, __ATOMIC_RELAXED, __HIP_MEMORY_SCOPE_AGENT); }
DI unsigned xb_xcc_id() { return (unsigned)__builtin_amdgcn_s_getreg((3 << 11) | 20) & 0xFu; }
#define XB_SPIN(cond, bar) do { unsigned _sp = 0; while (cond) { __builtin_amdgcn_s_sleep(1); \
    if ((++_sp & 255u) == 0u) { if (xb_ld(&(bar)[XB_TMO])) break; if (_sp > XB_SPIN_CAP) { atomicAdd(&(bar)[XB_TMO], 1u); break; } } } } while (0)
struct XcdBarrier { unsigned* bar; unsigned x; volatile LAS unsigned* st; };
DI XcdBarrier xcd_barrier_post(unsigned* bar, volatile LAS unsigned* st) {
    XcdBarrier b; b.bar = bar; b.x = xb_xcc_id(); b.st = st;
    if (threadIdx.x == 0) (void)xb_add(&bar[XB_XCNT(b.x)], 1u);
    return b;
}
DI void xcd_barrier_complete(unsigned* bar, unsigned x, unsigned& nloc, unsigned& nx) {
    const unsigned G = gridDim.x * gridDim.y * gridDim.z;
    unsigned sum, cnt, mine, sp = 0u;
    for (;;) {
        sum = 0u; cnt = 0u; mine = 0u;
#pragma unroll
        for (unsigned j = 0; j < 16; ++j) { const unsigned c = xb_ld(&bar[XB_XCNT(j)]); sum += c; cnt += (c > 0u) ? 1u : 0u; mine = (j == x) ? c : mine; }
        if (sum == G) break;
        __builtin_amdgcn_s_sleep(1);
        if ((++sp & 255u) == 0u) { if (xb_ld(&bar[XB_TMO])) break; if (sp > XB_SPIN_CAP) { atomicAdd(&bar[XB_TMO], 1u); break; } }
    }
    nloc = mine > 0u ? mine : 1u; nx = cnt > 0u ? cnt : 1u;
}
DI void xcd_barrier(const XcdBarrier& b) {
    asm volatile("s_waitcnt vmcnt(0)" ::: "memory");
    __syncthreads();
    if (threadIdx.x == 0) {
        unsigned* bar = b.bar;
        __builtin_amdgcn_s_waitcnt(0);
        unsigned nloc = b.st[0], nx = b.st[1];
        if (nloc == 0u) { xcd_barrier_complete(bar, b.x, nloc, nx); b.st[0] = nloc; b.st[1] = nx; }
        const unsigned old = xb_add(&bar[XB_XSUB(b.x)], 1u);
        const unsigned gen = old / nloc;
        if (old + 1u == (gen + 1u) * nloc) {
            __builtin_amdgcn_fence(__ATOMIC_RELEASE, "agent");
            asm volatile("s_waitcnt vmcnt(0)" ::: "memory");
            const unsigned og = xb_add(&bar[XB_TOP], 1u);
            const unsigned tg = og / nx;
            if (og + 1u == (tg + 1u) * nx) xb_add(&bar[XB_TOPGEN], 1u);
            else XB_SPIN(xb_ld(&bar[XB_TOPGEN]) == tg, bar);
            __builtin_amdgcn_fence(__ATOMIC_ACQUIRE, "agent");
            xb_add(&bar[XB_XGEN(b.x)], 1u);
            asm volatile("s_waitcnt vmcnt(0)" ::: "memory");
        } else {
            XB_SPIN(xb_ld(&bar[XB_XGEN(b.x)]) == gen, bar);
            __builtin_amdgcn_fence(__ATOMIC_ACQUIRE, "agent");
            asm volatile("s_waitcnt vmcnt(0)" ::: "memory");
        }
    }
    __syncthreads();
}

namespace pg8 {
constexpr int BM = 256, BK = 64, HALF = 128, HTB = HALF * BK * 2, STAGE_BYTES = 8 * HTB, NXCD = 8, WGM = 8;
DI int lds_byte(int r, int c) { const int st = (r >> 4) * 2 + (c >> 5), rr = r & 15, cc = c & 31, ob = rr * 64 + cc * 2; return st * 1024 + (ob ^ (((ob >> 9) & 1) << 5)); }
DI void stage_rc(int b, int& R, int& C) { const int st = b / 1024, sb = b % 1024, swz = sb ^ (((sb >> 9) & 1) << 5); R = (st >> 1) * 16 + swz / 64; C = (st & 1) * 32 + (swz % 64) / 2; }
DI int perm32(int rho) { const int n = rho >> 4, i = rho & 15; return 8 * (i >> 2) + 4 * n + (i & 3); }
DI void glds_s(const char* base, unsigned voff, unsigned dst) { unsigned keep;
    asm volatile("s_mov_b32 %0, m0\n\ts_mov_b32 m0, %3\n\ts_nop 4\n\tglobal_load_lds_dwordx4 %1, %2\n\ts_mov_b32 m0, %0" : "=&s"(keep) : "v"(voff), "s"(base), "s"(dst) : "memory"); }
DI void glds_dword(const char* base, unsigned voff, unsigned dst) { unsigned keep;
    asm volatile("s_mov_b32 %0, m0\n\ts_mov_b32 m0, %3\n\ts_nop 4\n\tglobal_load_lds_dword %1, %2\n\ts_mov_b32 m0, %0" : "=&s"(keep) : "v"(voff), "s"(base), "s"(dst) : "memory"); }
typedef float f32x2_cv __attribute__((ext_vector_type(2))); typedef __bf16 bf16x2_cv __attribute__((ext_vector_type(2)));
DI unsigned cvt_pk_bf16(float lo, float hi) { const f32x2_cv v = {lo, hi}; const bf16x2_cv b = __builtin_convertvector(v, bf16x2_cv); return __builtin_bit_cast(unsigned, b); }

typedef int i32x4v __attribute__((ext_vector_type(4)));
typedef int i32x8v __attribute__((ext_vector_type(8)));
DI i32x8v cat8(const bf16x8 a, const bf16x8 b) { return __builtin_shufflevector(__builtin_bit_cast(i32x4v, a), __builtin_bit_cast(i32x4v, b), 0, 1, 2, 3, 4, 5, 6, 7); }
DI void mfma_fp8_acc(f32x4& c, const i32x8v a, const i32x8v b) { asm volatile("v_mfma_f32_16x16x128_f8f6f4 %0, %1, %2, %0" : "+v"(c) : "v"(a), "v"(b)); }
DI void mfma_fp8_new(f32x4& c, const i32x8v a, const i32x8v b) { asm volatile("v_mfma_f32_16x16x128_f8f6f4 %0, %1, %2, 0" : "=&v"(c) : "v"(a), "v"(b)); }
#define MFMA_DRAIN() asm volatile("s_nop 15\n\ts_nop 15\n\ts_nop 15\n\ts_nop 15\n\ts_nop 15" ::: "memory")
struct Unit { int pm, pn, e, mt, idx; };

template <bool FP8, class Epi, class Sched>
DI void gemm_phase(LAS unsigned char* lds, const int KB_in, const Sched& S, const Epi& E) {
    int K = KB_in; asm volatile("" : "+s"(K));
    const int tid = opaque_tid(), wid = __builtin_amdgcn_readfirstlane(tid >> 6), lane = tid & 63, wr = wid >> 2, wc = wid & 3, fr = lane & 15, fq = lane >> 4;
    const int nt = K / 128;
    int Rr[2], Cc[2]; unsigned voffB[2];
#pragma unroll
    for (int i = 0; i < 2; ++i) { int R, C; stage_rc(tid * 16 + i * 8192, R, C); Rr[i] = R; Cc[i] = C; const int Rb = (R & ~31) + perm32(R & 31); voffB[i] = (unsigned)(Rb * K + C * 2); }
    const size_t kstep = (size_t)128;
    const size_t hstepB = (size_t)HALF * K;
    const unsigned ldsw = (unsigned)wid * 1024u;
    const unsigned ldsbase = (unsigned)(size_t)lds;
    const int aoff = lds_byte(wr * 64 + fr, fq * 8), boff = lds_byte(wc * 32 + fr, fq * 8);
#define PG8_SA(b, h) (((b) * 2 + (h)) * HTB)
#define PG8_SB(b, h) ((4 + (b) * 2 + (h)) * HTB)
#define PG8_STAGE(bufoff, gbase, voff) do { _Pragma("unroll") for (int _i = 0; _i < 2; ++_i) \
        glds_s((const char*)(gbase), (voff)[_i], ldsbase + (unsigned)(bufoff) + ldsw + (unsigned)(_i * 8192)); } while (0)
#define PG8_LDA(dst, b, h) do { _Pragma("unroll") for (int m = 0; m < 4; ++m) _Pragma("unroll") for (int k = 0; k < 2; ++k) dst[m][k] = *(const LAS bf16x8*)(lds + PG8_SA(b, h) + aoff + m * 2048 + k * 1024); } while (0)
#define PG8_LDB(dst, b, h) do { _Pragma("unroll") for (int n = 0; n < 2; ++n) _Pragma("unroll") for (int k = 0; k < 2; ++k) dst[n][k] = *(const LAS bf16x8*)(lds + PG8_SB(b, h) + boff + n * 2048 + k * 1024); } while (0)
#define PG8_MMA(ai, bj, At, Bt, ZC) do { __builtin_amdgcn_s_setprio(1); _Pragma("unroll") for (int m = 0; m < 4; ++m) _Pragma("unroll") for (int n = 0; n < 2; ++n) { \
        if constexpr (FP8) { if (ZC) mfma_fp8_new(acc[ai][bj][m][n], cat8(Bt[n][0], Bt[n][1]), cat8(At[m][0], At[m][1])); else mfma_fp8_acc(acc[ai][bj][m][n], cat8(Bt[n][0], Bt[n][1]), cat8(At[m][0], At[m][1])); } \
        else { acc[ai][bj][m][n] = __builtin_amdgcn_mfma_f32_16x16x32_bf16(Bt[n][0], At[m][0], acc[ai][bj][m][n], 0, 0, 0); \
               acc[ai][bj][m][n] = __builtin_amdgcn_mfma_f32_16x16x32_bf16(Bt[n][1], At[m][1], acc[ai][bj][m][n], 0, 0, 0); } } \
        __builtin_amdgcn_s_setprio(0); } while (0)
#define PG8_WAIT_V(n) asm volatile("s_waitcnt vmcnt(" #n ")" ::: "memory")
#define PG8_WAIT_L(n) asm volatile("s_waitcnt lgkmcnt(" #n ")" ::: "memory")
#define PG8_BAR __builtin_amdgcn_s_barrier()
#define PG8_SCHED __builtin_amdgcn_sched_barrier(0)
    Unit cur, nxt; int ui = 0;
    if (!S.next(0, cur)) return;
    f32x4 acc[2][2][4][2];
#define PG8_ZERO_ACC() do { if constexpr (!FP8) { _Pragma("unroll") for (int a = 0; a < 2; ++a) _Pragma("unroll") for (int b = 0; b < 2; ++b) _Pragma("unroll") for (int m = 0; m < 4; ++m) _Pragma("unroll") for (int n = 0; n < 2; ++n) acc[a][b][m][n] = (f32x4){0.f, 0.f, 0.f, 0.f}; } } while (0)
    PG8_ZERO_ACC();
    bf16x8 At[4][2], B0[2][2], B1[2][2];
    unsigned cvo0[2], cvo1[2], nvo0[2], nvo1[2];
    S.a_off(cur, Rr, Cc, cvo0, cvo1);
    asm volatile("" : "+v"(cvo0[0]), "+v"(cvo0[1]), "+v"(cvo1[0]), "+v"(cvo1[1]), "+v"(voffB[0]), "+v"(voffB[1]));
    const char* const aB = uni_ptr(S.a_base());
    const char* cB = uni_ptr(S.b_base(cur));
    PG8_STAGE(PG8_SB(0, 0), cB, voffB); PG8_STAGE(PG8_SB(0, 1), cB + hstepB, voffB); PG8_STAGE(PG8_SA(0, 0), aB, cvo0); PG8_STAGE(PG8_SA(0, 1), aB, cvo1);
    if (wr == 1) PG8_BAR;
    PG8_WAIT_V(2); PG8_BAR;
    PG8_STAGE(PG8_SB(1, 0), cB + kstep, voffB); PG8_STAGE(PG8_SA(1, 0), aB + kstep, cvo0); PG8_STAGE(PG8_SB(1, 1), cB + hstepB + kstep, voffB);
    PG8_WAIT_V(6); PG8_BAR;
    for (;;) {
        const bool has_next = S.next(ui + 1, nxt);
        const char* nB = uni_ptr(has_next ? S.b_base(nxt) : cB);
        if (has_next) { int R2[2], C2[2]; const int tid2 = opaque_tid();
#pragma unroll
            for (int i = 0; i < 2; ++i) stage_rc(tid2 * 16 + i * 8192, R2[i], C2[i]);
            S.a_off(nxt, R2, C2, nvo0, nvo1); }
        else { nvo0[0] = cvo0[0]; nvo0[1] = cvo0[1]; nvo1[0] = cvo1[0]; nvo1[1] = cvo1[1]; }
        asm volatile("" : "+v"(nvo0[0]), "+v"(nvo0[1]), "+v"(nvo1[0]), "+v"(nvo1[1]));
#define PG8_KITER(ZC_) do { \
            const bool last = (t == nt - 2); \
            const char* a1 = aB + (size_t)(t + 1) * kstep; \
            const char* a2 = last ? aB : aB + (size_t)(t + 2) * kstep; const char* b2 = last ? nB : cB + (size_t)(t + 2) * kstep; \
            const char* a3 = a2 + kstep; const char* b3 = b2 + kstep; \
            unsigned v20[2], v21[2]; \
            v20[0] = last ? nvo0[0] : cvo0[0]; v20[1] = last ? nvo0[1] : cvo0[1]; v21[0] = last ? nvo1[0] : cvo1[0]; v21[1] = last ? nvo1[1] : cvo1[1]; \
            if constexpr (Sched::HAS_FILL) { if (t == 2) S.fill_async(ui, wid, lane); } \
            PG8_LDB(B0, 0, 0); PG8_LDB(B1, 0, 1); PG8_SCHED; PG8_LDA(At, 0, 0); PG8_STAGE(PG8_SA(1, 1), a1, cvo1); \
            PG8_WAIT_V(8); PG8_WAIT_L(0); PG8_BAR; PG8_MMA(0, 0, At, B0, ZC_); PG8_MMA(0, 1, At, B1, ZC_); PG8_BAR; PG8_SCHED; \
            PG8_LDA(At, 0, 1); PG8_STAGE(PG8_SB(0, 0), b2, voffB); PG8_STAGE(PG8_SB(0, 1), b2 + hstepB, voffB); PG8_STAGE(PG8_SA(0, 0), a2, v20); \
            PG8_WAIT_V(8); PG8_WAIT_L(0); PG8_BAR; PG8_MMA(1, 0, At, B0, ZC_); PG8_MMA(1, 1, At, B1, ZC_); PG8_BAR; PG8_SCHED; \
            PG8_LDB(B0, 1, 0); PG8_LDB(B1, 1, 1); PG8_SCHED; PG8_LDA(At, 1, 0); PG8_STAGE(PG8_SA(0, 1), a2, v21); \
            PG8_WAIT_V(8); PG8_WAIT_L(0); PG8_BAR; PG8_MMA(0, 0, At, B0, false); PG8_MMA(0, 1, At, B1, false); PG8_BAR; PG8_SCHED; \
            PG8_LDA(At, 1, 1); PG8_STAGE(PG8_SB(1, 0), b3, voffB); PG8_STAGE(PG8_SB(1, 1), b3 + hstepB, voffB); PG8_STAGE(PG8_SA(1, 0), a3, v20); \
            PG8_WAIT_V(8); PG8_WAIT_L(0); PG8_BAR; PG8_MMA(1, 0, At, B0, false); PG8_MMA(1, 1, At, B1, false); PG8_BAR; PG8_SCHED; \
        } while (0)
        if constexpr (FP8) {
            { int t = 0; PG8_KITER(true); }
            for (int t = 2; t < nt; t += 2) PG8_KITER(false);
        } else {
            for (int t = 0; t < nt; t += 2) PG8_KITER(false);
        }
#undef PG8_KITER
        if (wr == 0) PG8_BAR;
        if constexpr (FP8) MFMA_DRAIN();
        { const int tid3 = opaque_tid(), wid3 = __builtin_amdgcn_readfirstlane(tid3 >> 6), lane3 = tid3 & 63; E(acc, cur, wid3 >> 2, wid3 & 3, lane3 & 15, lane3 >> 4); }
        if (!has_next) break;
        PG8_ZERO_ACC();
        cur = nxt; cB = nB; cvo0[0] = nvo0[0]; cvo0[1] = nvo0[1]; cvo1[0] = nvo1[0]; cvo1[1] = nvo1[1]; ++ui;
        if (wr == 1) PG8_BAR;
    }
    PG8_WAIT_V(0);
    PG8_BAR;
#undef PG8_SA
#undef PG8_SB
#undef PG8_STAGE
#undef PG8_LDA
#undef PG8_LDB
#undef PG8_MMA
#undef PG8_WAIT_V
#undef PG8_WAIT_L
#undef PG8_BAR
#undef PG8_SCHED
}

struct DenseSched {
    const bf16* A; int lda; const bf16* Bt; int K; int nM, nN, nwg, G, c; int skip_ctx;
    DI void init(const bf16* A_, int lda_, const bf16* Bt_, int K_, int nM_, int nN_, int G_, int c_, int skip) { A = A_; lda = lda_; Bt = Bt_; K = K_; nM = nM_; nN = nN_; nwg = nM * nN; G = G_; c = c_; skip_ctx = skip; }
    DI bool next(int i, Unit& u) const {
        const long L = (long)i * G + c; if (L >= nwg) return false;
        int wgid = (int)L; { const int q = nwg / NXCD, r = nwg % NXCD, xcd = wgid % NXCD, off = wgid / NXCD; wgid = (xcd < r ? xcd * (q + 1) : r * (q + 1) + (xcd - r) * q) + off; }
        const int nig = WGM * nN, gid = wgid / nig, fm = gid * WGM, gsz = (nM - fm) < WGM ? (nM - fm) : WGM;
        int pm = fm + ((wgid % nig) % gsz); u.pn = (wgid % nig) / gsz;
        if (skip_ctx) pm = pm + pm / 8 + 1;
        u.pm = pm; u.e = 0; u.mt = 0; u.idx = i; return true;
    }
    static constexpr bool HAS_FILL = false;
    DI void fill_async(int, int, int) const {}
    DI const char* a_base() const { return (const char*)A; }
    DI const char* b_base(const Unit& u) const { return (const char*)Bt + (size_t)u.pn * 256 * K * 2; }
    DI void a_off(const Unit& u, const int (&R)[2], const int (&C)[2], unsigned (&o0)[2], unsigned (&o1)[2]) const {
#pragma unroll
        for (int i = 0; i < 2; ++i) { o0[i] = (unsigned)((u.pm * 256 + R[i]) * lda + C[i]) * 2u; o1[i] = (unsigned)((u.pm * 256 + 128 + R[i]) * lda + C[i]) * 2u; }
    }
};

constexpr int UTAB_OFF = 131072, RTAB_OFF = 132096;
constexpr int RSLOT = 768;
struct GroupSched {
    const LAS int* tab; const LAS int* utab; LAS unsigned* rtab; int nunits;
    int nN, G, c, K;
    const char* Abase; const unsigned* list; const float* gsort; int gather;
    const char* Bbase; size_t b_estride;
    const float* bias_l; int bias_estride;
    static constexpr bool HAS_FILL = true;
    DI bool next(int i, Unit& u) const {
        if (i >= nunits) return false;
        const int w0 = __builtin_amdgcn_readfirstlane(utab[2 * i]), w1 = __builtin_amdgcn_readfirstlane(utab[2 * i + 1]);
        u.pm = w0; u.e = w1 >> 16; u.mt = (w1 >> 3) & 0x1fff; u.pn = w1 & 7; u.idx = i; return true;
    }
    DI const char* a_base() const { return Abase; }
    DI const char* b_base(const Unit& u) const { return Bbase + (size_t)u.e * b_estride + (size_t)u.pn * 256 * K; }
    DI void a_off(const Unit& u, const int (&R)[2], const int (&C)[2], unsigned (&o0)[2], unsigned (&o1)[2]) const {
        if (gather) {
            const LAS unsigned* rt = rtab + (u.idx & 1) * RSLOT;
#pragma unroll
            for (int i = 0; i < 2; ++i) { const unsigned p0 = rt[R[i]], p1 = rt[128 + R[i]];
                o0[i] = (p0 >> 2) * 1024u + (unsigned)C[i] * 2u; o1[i] = (p1 >> 2) * 1024u + (unsigned)C[i] * 2u; }
        } else {
#pragma unroll
            for (int i = 0; i < 2; ++i) { o0[i] = (unsigned)((u.pm * 256 + R[i]) * 1024 + C[i] * 2); o1[i] = (unsigned)((u.pm * 256 + 128 + R[i]) * 1024 + C[i] * 2); }
        }
    }
    DI void fill_sync(int k, int tid) const {
        Unit u; if (!next(k, u)) return;
        const int cnt = __builtin_amdgcn_readfirstlane(tab[33 + u.e]); int idx = u.mt * 256 + (tid & 255); idx = idx < cnt ? idx : cnt - 1;
        LAS unsigned* rt = rtab + (k & 1) * RSLOT;
        if (tid < 256) { rt[tid] = list[(size_t)u.e * T + idx]; rt[512 + tid] = __builtin_bit_cast(unsigned, bias_l[(size_t)u.e * bias_estride + 256 * u.pn + tid]); }
        else rt[tid] = __builtin_bit_cast(unsigned, gsort[(size_t)u.e * T + idx]);
    }
    DI void fill_async(int ui, int wid, int lane) const {
        const unsigned base = (unsigned)(size_t)rtab; const int w4 = wid & 3;
        if (gather) {
            if (wid < 4) { Unit u; if (!next(ui + 2, u)) return;
                const int cnt = __builtin_amdgcn_readfirstlane(tab[33 + u.e]); int idx = u.mt * 256 + w4 * 64 + lane; idx = idx < cnt ? idx : cnt - 1;
                glds_dword((const char*)(list + (size_t)u.e * T), (unsigned)idx * 4u, base + (unsigned)((ui & 1) * RSLOT * 4 + w4 * 256)); }
            else { Unit u; if (!next(ui + 1, u)) return;
                glds_dword((const char*)(bias_l + (size_t)u.e * bias_estride + 256 * u.pn), (unsigned)(w4 * 64 + lane) * 4u, base + (unsigned)(((ui + 1) & 1) * RSLOT * 4 + 2048 + w4 * 256)); }
        } else {
            Unit u; if (!next(ui + 1, u)) return;
            const int cnt = __builtin_amdgcn_readfirstlane(tab[33 + u.e]); int idx = u.mt * 256 + w4 * 64 + lane; idx = idx < cnt ? idx : cnt - 1;
            const unsigned dst = base + (unsigned)(((ui + 1) & 1) * RSLOT * 4 + w4 * 256);
            if (wid < 4) { glds_dword((const char*)(list + (size_t)u.e * T), (unsigned)idx * 4u, dst);
                           glds_dword((const char*)(bias_l + (size_t)u.e * bias_estride + 256 * u.pn), (unsigned)(w4 * 64 + lane) * 4u, dst + 2048u); }
            else glds_dword((const char*)(gsort + (size_t)u.e * T), (unsigned)idx * 4u, dst + 1024u);
        }
    }
};
DI int build_unit_table(const LAS int* tab, LAS int* utab, const int nN, const int G, const int c) {
    const int tid = opaque_tid();
    const int nmt = tab[32];
    int nunits;
    if ((G & 7) == 0) {
        const int x = c & 7, rk = c >> 3, W = G >> 3;
        const int mloc = (nmt > x) ? (nmt - x + 7) >> 3 : 0, total = mloc * nN;
        nunits = (total > rk) ? (total - rk + W - 1) / W : 0;
        if (tid < nunits) { const int k = tid * W + rk, ml = k / nN, pn = k - ml * nN, mtile = x + 8 * ml; int e = 0;
            for (int j = 1; j < 32; ++j) e += (tab[j] <= mtile) ? 1 : 0;
            utab[2 * tid] = mtile; utab[2 * tid + 1] = (e << 16) | ((mtile - tab[e]) << 3) | pn; }
    } else {
        const int total = nmt * nN;
        nunits = (total > c) ? (total - c + G - 1) / G : 0;
        if (tid < nunits) { const int L = tid * G + c, mtile = L / nN, pn = L - mtile * nN; int e = 0;
            for (int j = 1; j < 32; ++j) e += (tab[j] <= mtile) ? 1 : 0;
            utab[2 * tid] = mtile; utab[2 * tid + 1] = (e << 16) | ((mtile - tab[e]) << 3) | pn; }
    }
    __syncthreads();
    return __builtin_amdgcn_readfirstlane(nunits);
}

struct EpiBf16 {
    bf16* O; int ldc; float sc;
    DI void operator()(const f32x4 (&acc)[2][2][4][2], const Unit& u, int wr, int wc, int fr, int fq) const {
        const int row0 = u.pm * 256 + wr * 64 + fr, col0 = u.pn * 256 + wc * 32 + 8 * fq;
#pragma unroll
        for (int ai = 0; ai < 2; ++ai)
#pragma unroll
            for (int m = 0; m < 4; ++m) { bf16* rowp = O + (size_t)(row0 + ai * HALF + m * 16) * ldc + col0;
#pragma unroll
                for (int bj = 0; bj < 2; ++bj) { const f32x4 v0 = acc[ai][bj][m][0] * sc, v1 = acc[ai][bj][m][1] * sc;
                    u32x4 w; w.x = cvt_pk_bf16(v0[0], v0[1]); w.y = cvt_pk_bf16(v0[2], v0[3]); w.z = cvt_pk_bf16(v1[0], v1[1]); w.w = cvt_pk_bf16(v1[2], v1[3]);
                    *(u32x4*)(rowp + bj * HALF) = w; } }
    }
};
struct EpiResid {
    bf16* X; const float* mod_l;
    DI void operator()(const f32x4 (&acc)[2][2][4][2], const Unit& u, int wr, int wc, int fr, int fq) const {
        const int b = u.pm / 9, mrow = (u.pm - b * 9 == 0) ? 32 : b;
        const float* g = mod_l + (size_t)mrow * 6144 + 2048;
        const int row0 = u.pm * 256 + wr * 64 + fr, col0 = u.pn * 256 + wc * 32 + 8 * fq;
        f32x4 gv[2][2];
#pragma unroll
        for (int bj = 0; bj < 2; ++bj)
#pragma unroll
            for (int n = 0; n < 2; ++n) gv[bj][n] = *(const f32x4*)(g + col0 + bj * HALF + 4 * n) * (1.0f / (WO_SCALE * MIX_SCALE));
#pragma unroll
        for (int ai = 0; ai < 2; ++ai) {
            u32x4 xw8[4][2];
#pragma unroll
            for (int m = 0; m < 4; ++m)
#pragma unroll
                for (int bj = 0; bj < 2; ++bj) xw8[m][bj] = *(const u32x4*)(X + (size_t)(row0 + ai * HALF + m * 16) * DM + col0 + bj * HALF);
#pragma unroll
            for (int m = 0; m < 4; ++m) { bf16* rowp = X + (size_t)(row0 + ai * HALF + m * 16) * DM + col0;
#pragma unroll
                for (int bj = 0; bj < 2; ++bj) { const u32x4 xw = xw8[m][bj];
                    const f32x4 x0 = (f32x4){bflo(xw.x), bfhi(xw.x), bflo(xw.y), bfhi(xw.y)}, x1 = (f32x4){bflo(xw.z), bfhi(xw.z), bflo(xw.w), bfhi(xw.w)};
                    const f32x4 y0 = x0 * DN_ALPHA + gv[bj][0] * acc[ai][bj][m][0], y1 = x1 * DN_ALPHA + gv[bj][1] * acc[ai][bj][m][1];
                    u32x4 w; w.x = cvt_pk_bf16(y0[0], y0[1]); w.y = cvt_pk_bf16(y0[2], y0[3]); w.z = cvt_pk_bf16(y1[0], y1[1]); w.w = cvt_pk_bf16(y1[2], y1[3]);
                    *(u32x4*)(rowp + bj * HALF) = w; } }
        }
    }
};
struct EpiSwiglu {
    unsigned char* ACT; const LAS unsigned* rtab;
    DI void operator()(const f32x4 (&acc)[2][2][4][2], const Unit& u, int wr, int wc, int fr, int fq) const {
        const LAS float* bias = (const LAS float*)(rtab + (u.idx & 1) * RSLOT + 512);
        const int jc0 = u.pn * 128 + wc * 32 + 8 * fq, jl0 = wc * 32 + 8 * fq;
        f32x4 bg[2], bl[2];
#pragma unroll
        for (int n = 0; n < 2; ++n) { const f32x4 a = *(const LAS f32x4*)(bias + 2 * (jl0 + 4 * n)), b = *(const LAS f32x4*)(bias + 2 * (jl0 + 4 * n) + 4);
            bg[n] = (f32x4){a[0], a[2], b[0], b[2]}; bl[n] = (f32x4){a[1], a[3], b[1], b[3]}; }
        const int row0 = u.pm * 256 + wr * 64 + fr;
#pragma unroll
        for (int ai = 0; ai < 2; ++ai)
#pragma unroll
            for (int m = 0; m < 4; ++m) {
                float y[8];
#pragma unroll
                for (int n = 0; n < 2; ++n) { const f32x4 gl = acc[ai][0][m][n] * (1.0f / WGU_SCALE) + bg[n], li = acc[ai][1][m][n] * (1.0f / WGU_SCALE) + bl[n];
#pragma unroll
                    for (int i = 0; i < 4; i += 2) {
                        const f32x2 seven = {7.0f, 7.0f}, one = {1.0f, 1.0f};
                        const f32x2 gg = __builtin_elementwise_min((f32x2){gl[i], gl[i + 1]}, seven);
                        const f32x2 ll = __builtin_elementwise_min(__builtin_elementwise_max((f32x2){li[i], li[i + 1]}, -seven), seven);
                        const f32x2 t = gg * (-1.702f * LOG2E);
                        const f32x2 d = (f32x2){fast_exp2(t[0]), fast_exp2(t[1])} + one;
                        const f32x2 r = {__builtin_amdgcn_rcpf(d[0]), __builtin_amdgcn_rcpf(d[1])};
                        const f32x2 yy = (ll + one) * (gg * r);
                        y[4 * n + i] = yy[0]; y[4 * n + i + 1] = yy[1]; } }
                u32x2 w; w.x = pk4_fp8(y[0], y[1], y[2], y[3]); w.y = pk4_fp8(y[4], y[5], y[6], y[7]);
                *(u32x2*)(ACT + (size_t)(row0 + ai * HALF + m * 16) * DE + jc0) = w; }
    }
};
struct EpiDown {
    unsigned char* Y; const LAS unsigned* rtab; const LAS int* tab;
    DI void operator()(const f32x4 (&acc)[2][2][4][2], const Unit& u, int wr, int wc, int fr, int fq) const {
        const int nrows = __builtin_amdgcn_readfirstlane(tab[33 + u.e]) - u.mt * 256;
        const LAS unsigned* rt = rtab + (u.idx & 1) * RSLOT;
        const LAS float* bias = (const LAS float*)(rt + 512);
        const int cl0 = wc * 64 + 16 * fq, col0 = u.pn * 256 + cl0;
        f32x4 bv[2][2];
#pragma unroll
        for (int bj = 0; bj < 2; ++bj)
#pragma unroll
            for (int n = 0; n < 2; ++n) bv[bj][n] = *(const LAS f32x4*)(bias + cl0 + 8 * bj + 4 * n);
#pragma unroll
        for (int ai = 0; ai < 2; ++ai)
#pragma unroll
            for (int m = 0; m < 4; ++m) { const int rloc = ai * HALF + wr * 64 + m * 16 + fr;
                if (rloc < nrows) { const unsigned pair = rt[rloc]; float g = __builtin_bit_cast(float, rt[256 + rloc]); asm volatile("" : "+v"(g)); g *= Y_SCALE; const float sg = g * (1.0f / WD_SCALE);
                    u32x4 w;
#pragma unroll
                    for (int bj = 0; bj < 2; ++bj) { const f32x4 v0 = acc[ai][bj][m][0] * sg + bv[bj][0] * g, v1 = acc[ai][bj][m][1] * sg + bv[bj][1] * g;
                        w[2 * bj] = pk4_fp8(v0[0], v0[1], v0[2], v0[3]); w[2 * bj + 1] = pk4_fp8(v1[0], v1[1], v1[2], v1[3]); }
                    *(u32x4*)(Y + (size_t)pair * DM + col0) = w; } }
    }
};
}

namespace att {
typedef short v4i16_t __attribute__((ext_vector_type(4)));
DI int crow(int r, int hi) { return (r & 3) + 8 * (r >> 2) + 4 * hi; }
DI s16x4 vtr(const LAS unsigned char* p) { return __builtin_bit_cast(s16x4, __builtin_amdgcn_ds_read_tr16_b64_v4i16((LAS v4i16_t*)p)); }
#ifndef ATT_K8
#define ATT_K8 1
#endif
constexpr float Q8_SCALE = 4.0f, K8_SCALE = 0.25f;
DI u32x2 bf8x8(const u32x4 w, const float sc) {
    u32x2 o;
    o.x = pk4_fp8(bflo(w.x) * sc, bfhi(w.x) * sc, bflo(w.y) * sc, bfhi(w.y) * sc);
    o.y = pk4_fp8(bflo(w.z) * sc, bfhi(w.z) * sc, bflo(w.w) * sc, bfhi(w.w) * sc);
    return o;
}
DI pg8::i32x8v q_to_fp8(const bf16x8 (&qf)[4]) {
    pg8::i32x8v q;
#pragma unroll
    for (int d0 = 0; d0 < 4; ++d0) { const u32x2 t = bf8x8(__builtin_bit_cast(u32x4, qf[d0]), Q8_SCALE); q[2 * d0] = (int)t.x; q[2 * d0 + 1] = (int)t.y; }
    return q;
}
DI pg8::i32x8v k8_read(const LAS unsigned char* p) { const u32x4 a = *(const LAS u32x4*)p, b = *(const LAS u32x4*)(p + 16); return (pg8::i32x8v){(int)a.x, (int)a.y, (int)a.z, (int)a.w, (int)b.x, (int)b.y, (int)b.z, (int)b.w}; }
#define MFMA_QK8(kf, qf8, c) __builtin_amdgcn_mfma_scale_f32_32x32x64_f8f6f4(kf, qf8, c, 0, 0, 0, 0, 0, 0)
#define ATT_BAR() asm volatile("s_waitcnt lgkmcnt(0)\n\ts_barrier" ::: "memory")

struct AttnP {
    const bf16* Q; int qp;
    const bf16* K; int kp;
    const bf16* K2; int k2p;
    const bf16* V; int vp;
    unsigned char* O; int op;
    int kt0, ntiles;
    int brow0, na_lo, na_nloc, qr0;
    const float* rpb;
    int rope_q, qpos0;
    int shadow;
};
constexpr int RPB_OFF = 60 * 1024;
constexpr int O1_OFF = 64 * 1024;

template <int DQK, int DV, int MODE>
DI void attn_core(LAS unsigned char* lds, const AttnP& p, const bf16x8 (&qf)[DQK / 16], f32x16 (&o)[DV / 32], float& m_run, float& l_run, const int tid, const int wid, const int lane) {
    constexpr bool K8 = ATT_K8 && (DQK == 64);
    constexpr int KROWB = K8 ? 80 : (DQK + 8) * 2, VROWB = (DV == 64) ? 192 : 320, TILEB = 64 * (KROWB + VROWB), CPR = DQK / 8, VPR = DV / 8;
    constexpr int NKC = (DQK == 64) ? 1 : 2, NVC = DV / 64;
    static_assert(2 * TILEB <= RPB_OFF, "attention LDS");
    const int r32 = lane & 31, hi = lane >> 5;
    int krow[NKC], kch[NKC], vrow[NVC], vch[NVC];
#pragma unroll
    for (int i = 0; i < NKC; ++i) { const int c = tid + 512 * i; krow[i] = c / CPR; kch[i] = c - krow[i] * CPR; }
#pragma unroll
    for (int i = 0; i < NVC; ++i) { const int c = tid + 512 * i; vrow[i] = c / VPR; vch[i] = c - vrow[i] * VPR; }
    u32x4 krA[NKC], vrA[NVC], krB[NKC], vrB[NVC];
    const int ntiles = p.ntiles;
#define ATT_TROW(j) ((MODE == 0) ? (p.kt0 + 64 * (j)) : (((j) < p.na_nloc) ? (p.brow0 + 256 + (p.na_lo + (j)) * 64) : (p.brow0 + ((j) - p.na_nloc) * 64)))
#define ATT_LOAD(j, kr, vr) do { const int trow_ = ATT_TROW(j); \
        _Pragma("unroll") for (int i = 0; i < NKC; ++i) { if (DQK == 64 || i == 0 || tid < 256) { \
            const bf16* src_ = (kch[i] < 8) ? (p.K + (size_t)(trow_ + krow[i]) * p.kp + kch[i] * 8) : (p.K2 + (size_t)(trow_ + krow[i]) * p.k2p + (kch[i] - 8) * 8); \
            kr[i] = *(const u32x4*)src_; } } \
        _Pragma("unroll") for (int i = 0; i < NVC; ++i) vr[i] = *(const u32x4*)(p.V + (size_t)(trow_ + vrow[i]) * p.vp + vch[i] * 8); } while (0)
#define ATT_WRITE(b, kr, vr) do { LAS unsigned char* kb_ = lds + (b) * TILEB; LAS unsigned char* vb_ = kb_ + 64 * KROWB; \
        if constexpr (K8) { *(LAS u32x2*)(kb_ + krow[0] * KROWB + 32 * (kch[0] & 1) + 8 * (kch[0] >> 1)) = bf8x8(kr[0], K8_SCALE); } else { \
        _Pragma("unroll") for (int i = 0; i < NKC; ++i) { if (DQK == 64 || i == 0 || tid < 256) *(LAS u32x4*)(kb_ + krow[i] * KROWB + kch[i] * 16) = kr[i]; } } \
        _Pragma("unroll") for (int i = 0; i < NVC; ++i) *(LAS u32x4*)(vb_ + vrow[i] * VROWB + vch[i] * 16) = vr[i]; } while (0)
    ATT_LOAD(0, krA, vrA); ATT_WRITE(0, krA, vrA);
    if (ntiles > 1) ATT_LOAD(1, krB, vrB);
    if (ntiles > 2) ATT_LOAD(2, krA, vrA);
    ATT_BAR();
    pg8::i32x8v q8 = {0, 0, 0, 0, 0, 0, 0, 0};
    if constexpr (K8) q8 = q_to_fp8(qf);
    const bool sh_noload = PROBE_SHADOW && (p.shadow == 2), sh_nocomp = PROBE_SHADOW && (p.shadow == 1);
    f32x16 negm;
#pragma unroll
    for (int r = 0; r < 16; ++r) negm[r] = -m_run;
    bool first = true;
    const int qr = p.qr0 + (wid >> 1), rs = min(max(qr - 4, 0), 24);
    const int qc = 32 * (wid & 1) + r32, cs = min(max(qc - 8, 0), 48);
    const int q4 = (lane & 15) >> 2, p4 = lane & 3, blk = (lane >> 4) & 1;
    unsigned boff0[(MODE == 1 && DV == 64) ? 16 : 1], boff1[(MODE == 1 && DV == 64) ? 16 : 1];
    if (MODE == 1 && DV == 64) {
#pragma unroll
        for (int r = 0; r < 16; ++r) { const int kc0 = crow(r, hi), kc1 = kc0 + 32;
            boff0[r] = ((kc0 >= cs) && (kc0 < cs + 16)) ? (unsigned)(kc0 - qc + 15) * 4u : 124u;
            boff1[r] = ((kc1 >= cs) && (kc1 < cs + 16)) ? (unsigned)(kc1 - qc + 15) * 4u : 124u; }
    }
    auto tile = [&](const int j) __attribute__((always_inline)) {
        bool active = true; int krg = 0;
        if (MODE == 1) { krg = p.na_lo + j; active = (j >= p.na_nloc) || (krg >= rs && krg < rs + 8); }
        if (sh_nocomp) active = false;
        if (active && DV == 64) {
            const LAS unsigned char* kb = lds + (j & 1) * TILEB; const LAS unsigned char* vb = kb + 64 * KROWB;
            f32x16 s0 = negm, s1 = negm;
            if constexpr (K8) {
                s0 = MFMA_QK8(k8_read(kb + r32 * KROWB + 32 * hi), q8, s0);
                s1 = MFMA_QK8(k8_read(kb + (32 + r32) * KROWB + 32 * hi), q8, s1);
            } else {
#pragma unroll
            for (int d0 = 0; d0 < DQK / 16; ++d0) {
                const bf16x8 k0 = *(const LAS bf16x8*)(kb + r32 * KROWB + (16 * d0 + 8 * hi) * 2);
                const bf16x8 k1 = *(const LAS bf16x8*)(kb + (32 + r32) * KROWB + (16 * d0 + 8 * hi) * 2);
                s0 = __builtin_amdgcn_mfma_f32_32x32x16_bf16(k0, qf[d0], s0, 0, 0, 0);
                s1 = __builtin_amdgcn_mfma_f32_32x32x16_bf16(k1, qf[d0], s1, 0, 0, 0);
            } }
            if (MODE == 1 && j < p.na_nloc) {
                const LAS unsigned char* brow = lds + RPB_OFF + (krg - qr + 7) * 128;
#pragma unroll
                for (int r = 0; r < 16; ++r) { s0[r] += *(const LAS float*)(brow + boff0[r]); s1[r] += *(const LAS float*)(brow + boff1[r]); }
            }
            if (first) {
                float mt = fmaxf(fmaxf(s0[0], s1[0]), fmaxf(s0[1], s1[1]));
#pragma unroll
                for (int r = 2; r < 16; r += 2) mt = fmaxf(fmaxf(mt, fmaxf(s0[r], s1[r])), fmaxf(s0[r + 1], s1[r + 1]));
                mt = fmaxf(mt, __shfl_xor(mt, 32));
                const float dl = (mt > -__builtin_inff()) ? mt : 0.f;
                m_run += dl;
#pragma unroll
                for (int r = 0; r < 16; ++r) { s0[r] -= dl; s1[r] -= dl; negm[r] = -m_run; }
                first = false;
            }
            float ps0 = 0.f, ps1 = 0.f, ps2 = 0.f, ps3 = 0.f;
#pragma unroll
            for (int r = 0; r < 16; r += 2) { s0[r] = fast_exp2(s0[r]); s0[r + 1] = fast_exp2(s0[r + 1]); s1[r] = fast_exp2(s1[r]); s1[r + 1] = fast_exp2(s1[r + 1]);
                ps0 += s0[r]; ps1 += s0[r + 1]; ps2 += s1[r]; ps3 += s1[r + 1]; }
            const float ps = (ps0 + ps1) + (ps2 + ps3);
            l_run += ps;
            const float pt = ps + __shfl_xor(ps, 32);
            const bool need = pt > 65536.0f;
            bf16x8 pa[2][2];
#pragma unroll
            for (int s = 0; s < 2; ++s) {
                u32x4 w0, w1;
                w0.x = pg8::cvt_pk_bf16(s0[8 * s + 0], s0[8 * s + 1]); w0.y = pg8::cvt_pk_bf16(s0[8 * s + 2], s0[8 * s + 3]); w0.z = pg8::cvt_pk_bf16(s0[8 * s + 4], s0[8 * s + 5]); w0.w = pg8::cvt_pk_bf16(s0[8 * s + 6], s0[8 * s + 7]);
                w1.x = pg8::cvt_pk_bf16(s1[8 * s + 0], s1[8 * s + 1]); w1.y = pg8::cvt_pk_bf16(s1[8 * s + 2], s1[8 * s + 3]); w1.z = pg8::cvt_pk_bf16(s1[8 * s + 4], s1[8 * s + 5]); w1.w = pg8::cvt_pk_bf16(s1[8 * s + 6], s1[8 * s + 7]);
                pa[0][s] = __builtin_bit_cast(bf16x8, w0); pa[1][s] = __builtin_bit_cast(bf16x8, w1);
            }
            const LAS unsigned char* vbase = vb + (4 * hi + q4) * VROWB + 32 * blk + 8 * p4;
#pragma unroll
            for (int u = 0; u < 2; ++u)
#pragma unroll
                for (int s = 0; s < 2; ++s)
#pragma unroll
                    for (int c = 0; c < 2; ++c) {
                        const LAS unsigned char* a0 = vbase + (32 * u + 16 * s) * VROWB + 64 * c;
                        const s16x4 lo = vtr(a0), hh = vtr(a0 + 8 * VROWB);
                        const bf16x8 vf = (bf16x8){lo[0], lo[1], lo[2], lo[3], hh[0], hh[1], hh[2], hh[3]};
                        o[c % (DV / 32)] = __builtin_amdgcn_mfma_f32_32x32x16_bf16(pa[u][s], vf, o[c % (DV / 32)], 0, 0, 0);
                    }
            if (__any(need)) {
                const int ex = (int)((__builtin_bit_cast(unsigned, pt) >> 23) & 255u) - 127;
                const float dl = need ? (float)ex : 0.f, f = fast_exp2(-dl);
                m_run += dl; l_run *= f;
#pragma unroll
                for (int r = 0; r < 16; ++r) negm[r] = -m_run;
                int hio = hi; asm volatile("" : "+v"(hio));
#pragma unroll
                for (int r = 0; r < 16; ++r) { const float fr_ = __shfl(f, crow(r, hio)); o[0][r] *= fr_; o[1 % (DV / 32)][r] *= fr_; }
            }
        }
        if (active && DV != 64) {
            const LAS unsigned char* kb = lds + (j & 1) * TILEB; const LAS unsigned char* vb = kb + 64 * KROWB;
#pragma unroll
            for (int u = 0; u < 2; ++u) {
                const LAS unsigned char* kbu = kb + u * 32 * KROWB;
                f32x16 s0 = negm;
                if constexpr (K8) { s0 = MFMA_QK8(k8_read(kbu + r32 * KROWB + 32 * hi), q8, s0); } else {
#pragma unroll
                for (int d0 = 0; d0 < DQK / 16; ++d0) {
                    const bf16x8 k0 = *(const LAS bf16x8*)(kbu + r32 * KROWB + (16 * d0 + 8 * hi) * 2);
                    s0 = __builtin_amdgcn_mfma_f32_32x32x16_bf16(k0, qf[d0], s0, 0, 0, 0);
                } }
                if (MODE == 1 && j < p.na_nloc) {
                    const LAS float* brow = (const LAS float*)(lds + RPB_OFF) + (krg - qr + 7) * 32;
                    int hio = hi; asm volatile("" : "+v"(hio));
#pragma unroll
                    for (int r = 0; r < 16; ++r) {
                        const int kc0 = crow(r, hio) + 32 * u;
                        const bool v0 = (kc0 >= cs) && (kc0 < cs + 16);
                        const int i0 = min(max(kc0 - qc + 15, 0), 30);
                        s0[r] = v0 ? s0[r] + brow[i0] : -__builtin_inff();
                    }
                }
                if (first) {
                    float mt = fmaxf(fmaxf(s0[0], s0[1]), s0[2]);
#pragma unroll
                    for (int r = 3; r < 15; r += 2) mt = fmaxf(fmaxf(mt, s0[r]), s0[r + 1]);
                    mt = fmaxf(mt, s0[15]);
                    mt = fmaxf(mt, __shfl_xor(mt, 32));
                    const float dl = (mt > -__builtin_inff()) ? mt : 0.f;
                    m_run += dl;
#pragma unroll
                    for (int r = 0; r < 16; ++r) { s0[r] -= dl; negm[r] = -m_run; }
                    first = false;
                }
                float ps0 = 0.f, ps1 = 0.f;
#pragma unroll
                for (int r = 0; r < 16; r += 2) { s0[r] = fast_exp2(s0[r]); s0[r + 1] = fast_exp2(s0[r + 1]); ps0 += s0[r]; ps1 += s0[r + 1]; }
                const float ps = ps0 + ps1;
                l_run += ps;
                const float pt = ps + __shfl_xor(ps, 32);
                const bool need = pt > 65536.0f;
                bf16x8 pa[2];
#pragma unroll
                for (int s = 0; s < 2; ++s) {
                    u32x4 w0;
                    w0.x = pg8::cvt_pk_bf16(s0[8 * s + 0], s0[8 * s + 1]); w0.y = pg8::cvt_pk_bf16(s0[8 * s + 2], s0[8 * s + 3]); w0.z = pg8::cvt_pk_bf16(s0[8 * s + 4], s0[8 * s + 5]); w0.w = pg8::cvt_pk_bf16(s0[8 * s + 6], s0[8 * s + 7]);
                    pa[s] = __builtin_bit_cast(bf16x8, w0);
                }
                const LAS unsigned char* vbase = vb + (32 * u + 4 * hi + q4) * VROWB + 32 * blk + 8 * p4;
#pragma unroll
                for (int c = 0; c < DV / 32; ++c)
#pragma unroll
                    for (int s = 0; s < 2; ++s) {
                        const LAS unsigned char* a0 = vbase + (16 * s) * VROWB + 64 * c;
                        const s16x4 lo = vtr(a0), hh = vtr(a0 + 8 * VROWB);
                        const bf16x8 vf = (bf16x8){lo[0], lo[1], lo[2], lo[3], hh[0], hh[1], hh[2], hh[3]};
                        o[c] = __builtin_amdgcn_mfma_f32_32x32x16_bf16(pa[s], vf, o[c], 0, 0, 0);
                    }
                if (__any(need)) {
                    const int ex = (int)((__builtin_bit_cast(unsigned, pt) >> 23) & 255u) - 127;
                    const float dl = need ? (float)ex : 0.f, f = fast_exp2(-dl);
                    m_run += dl; l_run *= f;
#pragma unroll
                    for (int r = 0; r < 16; ++r) negm[r] = -m_run;
                    int hio = hi; asm volatile("" : "+v"(hio));
#pragma unroll
                    for (int r = 0; r < 16; ++r) { const float fr_ = __shfl(f, crow(r, hio));
#pragma unroll
                        for (int c = 0; c < DV / 32; ++c) o[c][r] *= fr_; }
                }
            }
        }
    };
    for (int j = 0; j < ntiles; j += 2) {
        tile(j);
        if (j + 1 < ntiles) ATT_WRITE((j + 1) & 1, krB, vrB);
        if (j + 3 < ntiles) ATT_LOAD(j + 3, krB, vrB);
        ATT_BAR();
        if (j + 1 >= ntiles) break;
        tile(j + 1);
        if (j + 2 < ntiles) ATT_WRITE((j + 2) & 1, krA, vrA);
        if (j + 4 < ntiles) ATT_LOAD(j + 4, krA, vrA);
        ATT_BAR();
    }
#undef ATT_TROW
#undef ATT_LOAD
#undef ATT_WRITE
}

template <int DQK>
DI void attn_core_pipe(LAS unsigned char* lds, const AttnP& p, const bf16x8 (&qf)[DQK / 16], f32x16 (&o)[2], float& m_run, float& l_run, const int tid, const int wid, const int lane) {
    constexpr int KROWB = (DQK + 8) * 2, VROWB = 192, TILEB = 64 * (KROWB + VROWB), CPR = DQK / 8;
    constexpr int NKC = (DQK == 64) ? 1 : 2;
    static_assert(2 * TILEB <= RPB_OFF, "attention LDS");
    const int r32 = lane & 31, hi = lane >> 5;
    int krow[NKC], kch[NKC];
#pragma unroll
    for (int i = 0; i < NKC; ++i) { const int c = tid + 512 * i; krow[i] = c / CPR; kch[i] = c - krow[i] * CPR; }
    const int vrow = tid >> 3, vch = tid & 7;
    u32x4 kr[NKC], vr;
    const int nt = p.ntiles;
#define AP_LOADK(j) do { const int trow_ = p.kt0 + 64 * min((j), nt - 1); \
        _Pragma("unroll") for (int i = 0; i < NKC; ++i) { if (DQK == 64 || i == 0 || tid < 256) { \
            const bf16* src_ = (kch[i] < 8) ? (p.K + (size_t)(trow_ + krow[i]) * p.kp + kch[i] * 8) : (p.K2 + (size_t)(trow_ + krow[i]) * p.k2p + (kch[i] - 8) * 8); \
            kr[i] = *(const u32x4*)src_; } } } while (0)
#define AP_LOADV(j) do { const int trow_ = p.kt0 + 64 * min((j), nt - 1); vr = *(const u32x4*)(p.V + (size_t)(trow_ + vrow) * p.vp + vch * 8); } while (0)
#define AP_WRITEK(b) do { LAS unsigned char* kb_ = lds + (b) * TILEB; \
        _Pragma("unroll") for (int i = 0; i < NKC; ++i) { if (DQK == 64 || i == 0 || tid < 256) *(LAS u32x4*)(kb_ + krow[i] * KROWB + kch[i] * 16) = kr[i]; } } while (0)
#define AP_WRITEV(b) do { *(LAS u32x4*)(lds + (b) * TILEB + 64 * KROWB + vrow * VROWB + vch * 16) = vr; } while (0)
#define AP_QK(b, S0, S1) do { const LAS unsigned char* kb_ = lds + (b) * TILEB; \
        _Pragma("unroll") for (int d0 = 0; d0 < DQK / 16; ++d0) { \
            const bf16x8 k0_ = *(const LAS bf16x8*)(kb_ + r32 * KROWB + (16 * d0 + 8 * hi) * 2); \
            const bf16x8 k1_ = *(const LAS bf16x8*)(kb_ + (32 + r32) * KROWB + (16 * d0 + 8 * hi) * 2); \
            S0 = __builtin_amdgcn_mfma_f32_32x32x16_bf16(k0_, qf[d0], S0, 0, 0, 0); \
            S1 = __builtin_amdgcn_mfma_f32_32x32x16_bf16(k1_, qf[d0], S1, 0, 0, 0); } } while (0)
    AP_LOADK(0); AP_LOADV(0); AP_WRITEK(0); AP_WRITEV(0); AP_LOADK(1);
    ATT_BAR();
    f32x16 negm, s0, s1;
#pragma unroll
    for (int r = 0; r < 16; ++r) { s0[r] = 0.f; s1[r] = 0.f; }
    AP_QK(0, s0, s1);
    {
        float mt = fmaxf(fmaxf(s0[0], s1[0]), fmaxf(s0[1], s1[1]));
#pragma unroll
        for (int r = 2; r < 16; r += 2) mt = fmaxf(fmaxf(mt, fmaxf(s0[r], s1[r])), fmaxf(s0[r + 1], s1[r + 1]));
        mt = fmaxf(mt, __shfl_xor(mt, 32));
        m_run = mt;
#pragma unroll
        for (int r = 0; r < 16; ++r) { s0[r] -= mt; s1[r] -= mt; negm[r] = -mt; }
    }
    AP_WRITEK(1); AP_LOADK(2); AP_LOADV(1);
    ATT_BAR();
    const int q4 = (lane & 15) >> 2, p4 = lane & 3, blk = (lane >> 4) & 1;
    const LAS unsigned char* vlane = lds + 64 * KROWB + (4 * hi + q4) * VROWB + 32 * blk + 8 * p4;
#define AP_SOFTMAX_PV(J) \
        float ps0 = 0.f, ps1 = 0.f, ps2 = 0.f, ps3 = 0.f; \
        _Pragma("unroll") for (int r = 0; r < 16; r += 2) { s0[r] = fast_exp2(s0[r]); s0[r + 1] = fast_exp2(s0[r + 1]); s1[r] = fast_exp2(s1[r]); s1[r + 1] = fast_exp2(s1[r + 1]); \
            ps0 += s0[r]; ps1 += s0[r + 1]; ps2 += s1[r]; ps3 += s1[r + 1]; } \
        const float ps = (ps0 + ps1) + (ps2 + ps3); \
        l_run += ps; \
        bf16x8 pa[2][2]; \
        _Pragma("unroll") for (int s = 0; s < 2; ++s) { \
            u32x4 w0, w1; \
            w0.x = pg8::cvt_pk_bf16(s0[8 * s + 0], s0[8 * s + 1]); w0.y = pg8::cvt_pk_bf16(s0[8 * s + 2], s0[8 * s + 3]); w0.z = pg8::cvt_pk_bf16(s0[8 * s + 4], s0[8 * s + 5]); w0.w = pg8::cvt_pk_bf16(s0[8 * s + 6], s0[8 * s + 7]); \
            w1.x = pg8::cvt_pk_bf16(s1[8 * s + 0], s1[8 * s + 1]); w1.y = pg8::cvt_pk_bf16(s1[8 * s + 2], s1[8 * s + 3]); w1.z = pg8::cvt_pk_bf16(s1[8 * s + 4], s1[8 * s + 5]); w1.w = pg8::cvt_pk_bf16(s1[8 * s + 6], s1[8 * s + 7]); \
            pa[0][s] = __builtin_bit_cast(bf16x8, w0); pa[1][s] = __builtin_bit_cast(bf16x8, w1); } \
        const LAS unsigned char* vbase = vlane + ((J) & 1) * TILEB; \
        _Pragma("unroll") for (int u = 0; u < 2; ++u) _Pragma("unroll") for (int s = 0; s < 2; ++s) _Pragma("unroll") for (int c = 0; c < 2; ++c) { \
                    const LAS unsigned char* a0 = vbase + (32 * u + 16 * s) * VROWB + 64 * c; \
                    const s16x4 lo = vtr(a0), hh = vtr(a0 + 8 * VROWB); \
                    const bf16x8 vf = (bf16x8){lo[0], lo[1], lo[2], lo[3], hh[0], hh[1], hh[2], hh[3]}; \
                    o[c] = __builtin_amdgcn_mfma_f32_32x32x16_bf16(pa[u][s], vf, o[c], 0, 0, 0); }
    for (int j = 0; j < nt - 1; ++j) {
        AP_WRITEK(j & 1); AP_WRITEV((j + 1) & 1);
        AP_LOADK(j + 3); AP_LOADV(j + 2);
        f32x16 sn0 = negm, sn1 = negm;
        AP_QK((j + 1) & 1, sn0, sn1);
        AP_SOFTMAX_PV(j)
        const float pt = ps + __shfl_xor(ps, 32);
        const bool need = pt > 65536.0f;
        s0 = sn0; s1 = sn1;
        if (__any(need)) {
            const int ex = (int)((__builtin_bit_cast(unsigned, pt) >> 23) & 255u) - 127;
            const float dl = need ? (float)ex : 0.f, f = fast_exp2(-dl);
            m_run += dl; l_run *= f;
#pragma unroll
            for (int r = 0; r < 16; ++r) { negm[r] = -m_run; s0[r] -= dl; s1[r] -= dl; }
            int hio = hi; asm volatile("" : "+v"(hio));
#pragma unroll
            for (int r = 0; r < 16; ++r) { const float fr_ = __shfl(f, crow(r, hio)); o[0][r] *= fr_; o[1][r] *= fr_; }
        }
        ATT_BAR();
    }
    {
        AP_SOFTMAX_PV(nt - 1)
        ATT_BAR();
    }
#undef AP_SOFTMAX_PV
#undef AP_LOADK
#undef AP_LOADV
#undef AP_WRITEK
#undef AP_WRITEV
#undef AP_QK
}

DI void rope_frag(bf16x8& frag, const int position, const int hi, const float freq_step  ) {
    u32x4 mine = __builtin_bit_cast(u32x4, frag), oth;
#pragma unroll
    for (int w = 0; w < 4; ++w) oth[w] = (unsigned)__shfl_xor((int)mine[w], 32);
    float res[8];
#pragma unroll
    for (int i = 0; i < 8; ++i) {
        const float x = (i & 1) ? bfhi(mine[i >> 1]) : bflo(mine[i >> 1]);
        const float y = (i & 1) ? bfhi(oth[i >> 1]) : bflo(oth[i >> 1]);
        float rev = (float)position * fast_exp2(-(float)i * freq_step) * 0.15915494309189535f; rev = rev - floorf(rev);
        const float sn = __builtin_amdgcn_sinf(rev), cs = __builtin_amdgcn_cosf(rev);
        res[i] = hi ? (y * sn + x * cs) : (x * cs - y * sn);
    }
    u32x4 w; w.x = pk2(res[0], res[1]); w.y = pk2(res[2], res[3]); w.z = pk2(res[4], res[5]); w.w = pk2(res[6], res[7]);
    frag = __builtin_bit_cast(bf16x8, w);
}

template <int DQK, int MODE>
DI void attn_unit(LAS unsigned char* lds, const AttnP& p) {
    const int tid = opaque_tid(), lane = tid & 63, wid = __builtin_amdgcn_readfirstlane(tid >> 6), r32 = lane & 31, hi = lane >> 5;
    bf16x8 qf[DQK / 16];
    const bf16* qrow = p.Q + (size_t)(32 * wid + r32) * p.qp;
#pragma unroll
    for (int d0 = 0; d0 < DQK / 16; ++d0) qf[d0] = *(const bf16x8*)(qrow + 16 * d0 + 8 * hi);
    if (DQK == 96) { if (p.rope_q) { const int pos = p.qpos0 + 32 * wid + r32; rope_frag(qf[4], pos >> 6, hi, LOG2_THETA / 8.f); rope_frag(qf[5], pos & 63, hi, LOG2_THETA / 8.f); } }
    if (MODE == 1) { if (tid < 465) { const int dr = tid / 31, dc = tid - dr * 31; ((LAS float*)(lds + RPB_OFF))[dr * 32 + dc] = p.rpb[tid] * LOG2E; }
                     if (tid < 15) ((LAS float*)(lds + RPB_OFF))[tid * 32 + 31] = -__builtin_inff(); }
    f32x16 o[2];
#pragma unroll
    for (int r = 0; r < 16; ++r) { o[0][r] = 0.f; o[1][r] = 0.f; }
    float m_run = 0.f, l_run = 0.f;
    if constexpr (MODE == 0) attn_core_pipe<DQK>(lds, p, qf, o, m_run, l_run, tid, wid, lane); else attn_core<DQK, 64, MODE>(lds, p, qf, o, m_run, l_run, tid, wid, lane);
    const float l = l_run + __shfl_xor(l_run, 32), inv = 1.0f / l;
    unsigned char* orow = p.O + (size_t)(32 * wid) * p.op + r32;
#pragma unroll
    for (int r = 0; r < 16; ++r) { int hio = hi; asm volatile("" : "+v"(hio)); const int q = crow(r, hio); const float iv = __shfl(inv, q) * MIX_SCALE;
#pragma unroll
        for (int c = 0; c < 2; ++c) orow[(size_t)q * p.op + 32 * c] = (unsigned char)__builtin_amdgcn_cvt_pk_fp8_f32(o[c][r] * iv, 0.f, 0u, false);
        __builtin_amdgcn_sched_barrier(0); }
}

template <int DQK>
DI void attn_core_w64(LAS unsigned char* lds, const AttnP& p, const bf16x8 (&qa)[DQK / 16], const bf16x8 (&qb)[DQK / 16], f32x16 (&oa)[2], f32x16 (&ob)[2], float (&m_run)[2], float (&l_run)[2],
                      const int tid, const int wid, const int lane) {
    constexpr bool K8 = ATT_K8 && (DQK == 64), K8M = ATT_K8 && (DQK == 96);
    constexpr int KROWB = K8 ? 80 : K8M ? 112 : (DQK + 8) * 2, VROWB = 192, TILEB = 64 * (KROWB + VROWB), CPR = DQK / 8;
    constexpr int NKC = (DQK == 64) ? 1 : 2;
    constexpr bool USE_NEGM = (DQK == 64);
    static_assert(2 * TILEB <= RPB_OFF, "attention LDS");
    const int r32 = lane & 31, hi = lane >> 5;
    int krow[NKC], kch[NKC];
#pragma unroll
    for (int i = 0; i < NKC; ++i) { const int c = tid + 512 * i; krow[i] = c / CPR; kch[i] = c - krow[i] * CPR; }
    const int vrow = tid >> 3, vch = tid & 7;
    u32x4 krA[NKC], vrA, krB[NKC], vrB;
    const int nt = p.ntiles;
#define AW_LOAD(j, kr, vr) do { const int trow_ = p.kt0 + 64 * (j); \
        _Pragma("unroll") for (int i = 0; i < NKC; ++i) { if (DQK == 64 || i == 0 || tid < 256) { \
            const bf16* src_ = (kch[i] < 8) ? (p.K + (size_t)(trow_ + krow[i]) * p.kp + kch[i] * 8) : (p.K2 + (size_t)(trow_ + krow[i]) * p.k2p + (kch[i] - 8) * 8); \
            kr[i] = *(const u32x4*)src_; } } \
        vr = *(const u32x4*)(p.V + (size_t)(trow_ + vrow) * p.vp + vch * 8); } while (0)
#define AW_WRITE(b, kr, vr) do { LAS unsigned char* kb_ = lds + (b) * TILEB; \
        if constexpr (K8) { *(LAS u32x2*)(kb_ + krow[0] * KROWB + 32 * (kch[0] & 1) + 8 * (kch[0] >> 1)) = bf8x8(kr[0], K8_SCALE); } \
        else if constexpr (K8M) { _Pragma("unroll") for (int i = 0; i < NKC; ++i) { if (i == 0 || tid < 256) { const int kc_ = kch[i] - 8; \
            const int off_ = (kch[i] < 8) ? (32 * (kch[i] & 1) + 8 * (kch[i] >> 1)) : (64 + 16 * (kc_ & 1) + 8 * (kc_ >> 1)); \
            *(LAS u32x2*)(kb_ + krow[i] * KROWB + off_) = bf8x8(kr[i], K8_SCALE); } } } else { \
        _Pragma("unroll") for (int i = 0; i < NKC; ++i) { if (DQK == 64 || i == 0 || tid < 256) *(LAS u32x4*)(kb_ + krow[i] * KROWB + kch[i] * 16) = kr[i]; } } \
        *(LAS u32x4*)(kb_ + 64 * KROWB + vrow * VROWB + vch * 16) = vr; } while (0)
    AW_LOAD(0, krA, vrA); AW_WRITE(0, krA, vrA);
    if (nt > 1) AW_LOAD(1, krB, vrB);
    if (nt > 2) AW_LOAD(2, krA, vrA);
    ATT_BAR();
    pg8::i32x8v q8a = {0, 0, 0, 0, 0, 0, 0, 0}, q8b = {0, 0, 0, 0, 0, 0, 0, 0};
    pg8::i32x8v q8a1 = {0, 0, 0, 0, 0, 0, 0, 0}, q8b1 = {0, 0, 0, 0, 0, 0, 0, 0};
    if constexpr (K8) { q8a = q_to_fp8(qa); q8b = q_to_fp8(qb); }
    if constexpr (K8M) {
#pragma unroll
        for (int d0 = 0; d0 < 4; ++d0) { const u32x2 ta = bf8x8(__builtin_bit_cast(u32x4, qa[d0]), Q8_SCALE), tb = bf8x8(__builtin_bit_cast(u32x4, qb[d0]), Q8_SCALE); q8a[2 * d0] = (int)ta.x; q8a[2 * d0 + 1] = (int)ta.y; q8b[2 * d0] = (int)tb.x; q8b[2 * d0 + 1] = (int)tb.y; }
#pragma unroll
        for (int d0 = 4; d0 < 6; ++d0) { const u32x2 ta = bf8x8(__builtin_bit_cast(u32x4, qa[d0]), Q8_SCALE), tb = bf8x8(__builtin_bit_cast(u32x4, qb[d0]), Q8_SCALE); q8a1[2 * (d0 - 4)] = (int)ta.x; q8a1[2 * (d0 - 4) + 1] = (int)ta.y; q8b1[2 * (d0 - 4)] = (int)tb.x; q8b1[2 * (d0 - 4) + 1] = (int)tb.y; }
    }
    f32x16 nma, nmb;
#pragma unroll
    for (int r = 0; r < 16; ++r) { nma[r] = 0.f; nmb[r] = 0.f; }
    bool first = true;
    const int q4 = (lane & 15) >> 2, p4 = lane & 3, blk = (lane >> 4) & 1;
    auto half = [&](const int j, const int u) __attribute__((always_inline)) {
        const LAS unsigned char* kb = lds + (j & 1) * TILEB; const LAS unsigned char* vb = kb + 64 * KROWB;
        {
            const LAS unsigned char* kbu = kb + u * 32 * KROWB + r32 * KROWB + ((K8 || K8M) ? 32 : 16) * hi;
            f32x16 sa, sb;
            if (USE_NEGM) { sa = nma; sb = nmb; } else {
#pragma unroll
                for (int r = 0; r < 16; ++r) { sa[r] = 0.f; sb[r] = 0.f; } }
            if constexpr (K8) { const pg8::i32x8v k8 = k8_read(kbu); sa = MFMA_QK8(k8, q8a, sa); sb = MFMA_QK8(k8, q8b, sb); }
            else if constexpr (K8M) { const pg8::i32x8v k8 = k8_read(kbu); const u32x4 kt = *(const LAS u32x4*)(kbu + 64 - 16 * hi);
                const pg8::i32x8v k81 = {(int)kt.x, (int)kt.y, (int)kt.z, (int)kt.w, 0, 0, 0, 0};
                sa = MFMA_QK8(k8, q8a, sa); sb = MFMA_QK8(k8, q8b, sb); sa = MFMA_QK8(k81, q8a1, sa); sb = MFMA_QK8(k81, q8b1, sb); } else {
#pragma unroll
            for (int d0 = 0; d0 < DQK / 16; ++d0) {
                const bf16x8 k0 = *(const LAS bf16x8*)(kbu + 32 * d0);
                sa = __builtin_amdgcn_mfma_f32_32x32x16_bf16(k0, qa[d0], sa, 0, 0, 0);
                sb = __builtin_amdgcn_mfma_f32_32x32x16_bf16(k0, qb[d0], sb, 0, 0, 0);
            } }
            if (first) {
                float ma = fmaxf(fmaxf(sa[0], sa[1]), sa[2]), mb = fmaxf(fmaxf(sb[0], sb[1]), sb[2]);
#pragma unroll
                for (int r = 3; r < 15; r += 2) { ma = fmaxf(fmaxf(ma, sa[r]), sa[r + 1]); mb = fmaxf(fmaxf(mb, sb[r]), sb[r + 1]); }
                ma = fmaxf(ma, sa[15]); mb = fmaxf(mb, sb[15]);
                ma = fmaxf(ma, __shfl_xor(ma, 32)); mb = fmaxf(mb, __shfl_xor(mb, 32));
                m_run[0] = ma; m_run[1] = mb;
                if (USE_NEGM) {
#pragma unroll
                    for (int r = 0; r < 16; ++r) { sa[r] -= ma; sb[r] -= mb; nma[r] = -ma; nmb[r] = -mb; } }
                first = false;
            }
            float pa0 = 0.f, pa1 = 0.f, pb0 = 0.f, pb1 = 0.f;
            if (USE_NEGM) {
#pragma unroll
                for (int r = 0; r < 16; r += 2) { sa[r] = fast_exp2(sa[r]); sa[r + 1] = fast_exp2(sa[r + 1]); sb[r] = fast_exp2(sb[r]); sb[r + 1] = fast_exp2(sb[r + 1]);
                    pa0 += sa[r]; pa1 += sa[r + 1]; pb0 += sb[r]; pb1 += sb[r + 1]; }
            } else { const float ma = m_run[0], mb = m_run[1];
#pragma unroll
                for (int r = 0; r < 16; r += 2) { sa[r] = fast_exp2(sa[r] - ma); sa[r + 1] = fast_exp2(sa[r + 1] - ma); sb[r] = fast_exp2(sb[r] - mb); sb[r + 1] = fast_exp2(sb[r + 1] - mb);
                    pa0 += sa[r]; pa1 += sa[r + 1]; pb0 += sb[r]; pb1 += sb[r + 1]; }
            }
            const float psa = pa0 + pa1, psb = pb0 + pb1;
            l_run[0] += psa; l_run[1] += psb;
            const float pta = psa + __shfl_xor(psa, 32), ptb = psb + __shfl_xor(psb, 32);
            const bool needa = pta > 65536.0f, needb = ptb > 65536.0f;
            bf16x8 fa[2], fb[2];
#pragma unroll
            for (int s = 0; s < 2; ++s) {
                u32x4 w0, w1;
                w0.x = pg8::cvt_pk_bf16(sa[8 * s + 0], sa[8 * s + 1]); w0.y = pg8::cvt_pk_bf16(sa[8 * s + 2], sa[8 * s + 3]); w0.z = pg8::cvt_pk_bf16(sa[8 * s + 4], sa[8 * s + 5]); w0.w = pg8::cvt_pk_bf16(sa[8 * s + 6], sa[8 * s + 7]);
                w1.x = pg8::cvt_pk_bf16(sb[8 * s + 0], sb[8 * s + 1]); w1.y = pg8::cvt_pk_bf16(sb[8 * s + 2], sb[8 * s + 3]); w1.z = pg8::cvt_pk_bf16(sb[8 * s + 4], sb[8 * s + 5]); w1.w = pg8::cvt_pk_bf16(sb[8 * s + 6], sb[8 * s + 7]);
                fa[s] = __builtin_bit_cast(bf16x8, w0); fb[s] = __builtin_bit_cast(bf16x8, w1);
            }
            const LAS unsigned char* vbase = vb + (32 * u + 4 * hi + q4) * VROWB + 32 * blk + 8 * p4;
#pragma unroll
            for (int s = 0; s < 2; ++s)
#pragma unroll
                for (int c = 0; c < 2; ++c) {
                    const LAS unsigned char* a0 = vbase + (16 * s) * VROWB + 64 * c;
                    const s16x4 lo = vtr(a0), hh = vtr(a0 + 8 * VROWB);
                    const bf16x8 vf = (bf16x8){lo[0], lo[1], lo[2], lo[3], hh[0], hh[1], hh[2], hh[3]};
                    oa[c] = __builtin_amdgcn_mfma_f32_32x32x16_bf16(fa[s], vf, oa[c], 0, 0, 0);
                    ob[c] = __builtin_amdgcn_mfma_f32_32x32x16_bf16(fb[s], vf, ob[c], 0, 0, 0);
                }
            if (__any(needa || needb)) {
                const int exa = (int)((__builtin_bit_cast(unsigned, pta) >> 23) & 255u) - 127, exb = (int)((__builtin_bit_cast(unsigned, ptb) >> 23) & 255u) - 127;
                const float dla = needa ? (float)exa : 0.f, dlb = needb ? (float)exb : 0.f, fsa = fast_exp2(-dla), fsb = fast_exp2(-dlb);
                m_run[0] += dla; m_run[1] += dlb; l_run[0] *= fsa; l_run[1] *= fsb;
                if (USE_NEGM) {
#pragma unroll
                    for (int r = 0; r < 16; ++r) { nma[r] = -m_run[0]; nmb[r] = -m_run[1]; } }
                int hio = hi; asm volatile("" : "+v"(hio));
#pragma unroll
                for (int r = 0; r < 16; ++r) { const float fra = __shfl(fsa, crow(r, hio)), frb = __shfl(fsb, crow(r, hio)); oa[0][r] *= fra; oa[1][r] *= fra; ob[0][r] *= frb; ob[1][r] *= frb; }
            }
        }
    };
    for (int j = 0; j < nt; j += 2) {
        half(j, 0);
        if (j + 1 < nt) AW_WRITE((j + 1) & 1, krB, vrB);
        if (j + 3 < nt) AW_LOAD(j + 3, krB, vrB);
        half(j, 1);
        ATT_BAR();
        if (j + 1 >= nt) break;
        half(j + 1, 0);
        if (j + 2 < nt) AW_WRITE((j + 2) & 1, krA, vrA);
        if (j + 4 < nt) AW_LOAD(j + 4, krA, vrA);
        half(j + 1, 1);
        ATT_BAR();
    }
#undef AW_LOAD
#undef AW_WRITE
}

template <int DQK>
DI void attn_unit_w64(LAS unsigned char* lds, const AttnP& p) {
    const int tid = opaque_tid(), lane = tid & 63, wid = __builtin_amdgcn_readfirstlane(tid >> 6), r32 = lane & 31, hi = lane >> 5;
    bf16x8 qa[DQK / 16], qb[DQK / 16];
    const bf16* qrow = p.Q + (size_t)(64 * wid + r32) * p.qp;
#pragma unroll
    for (int d0 = 0; d0 < DQK / 16; ++d0) { qa[d0] = *(const bf16x8*)(qrow + 16 * d0 + 8 * hi); qb[d0] = *(const bf16x8*)(qrow + (size_t)32 * p.qp + 16 * d0 + 8 * hi); }
    if (DQK == 96) { if (p.rope_q) { const int pos = p.qpos0 + 64 * wid + r32;
        rope_frag(qa[4], pos >> 6, hi, LOG2_THETA / 8.f); rope_frag(qa[5], pos & 63, hi, LOG2_THETA / 8.f);
        rope_frag(qb[4], (pos + 32) >> 6, hi, LOG2_THETA / 8.f); rope_frag(qb[5], (pos + 32) & 63, hi, LOG2_THETA / 8.f); } }
    f32x16 oa[2], ob[2];
#pragma unroll
    for (int r = 0; r < 16; ++r) { oa[0][r] = 0.f; oa[1][r] = 0.f; ob[0][r] = 0.f; ob[1][r] = 0.f; }
    float m_run[2] = {0.f, 0.f}, l_run[2] = {0.f, 0.f};
    attn_core_w64<DQK>(lds, p, qa, qb, oa, ob, m_run, l_run, tid, wid, lane);
    const float inva = 1.0f / (l_run[0] + __shfl_xor(l_run[0], 32)), invb = 1.0f / (l_run[1] + __shfl_xor(l_run[1], 32));
    unsigned char* orow = p.O + (size_t)(64 * wid) * p.op + r32;
#pragma unroll
    for (int r = 0; r < 16; ++r) { int hio = hi; asm volatile("" : "+v"(hio)); const int q = crow(r, hio); const float iva = __shfl(inva, q) * MIX_SCALE, ivb = __shfl(invb, q) * MIX_SCALE;
#pragma unroll
        for (int c = 0; c < 2; ++c) { orow[(size_t)q * p.op + 32 * c] = (unsigned char)__builtin_amdgcn_cvt_pk_fp8_f32(oa[c][r] * iva, 0.f, 0u, false);
                                      orow[(size_t)(q + 32) * p.op + 32 * c] = (unsigned char)__builtin_amdgcn_cvt_pk_fp8_f32(ob[c][r] * ivb, 0.f, 0u, false); }
        __builtin_amdgcn_sched_barrier(0); }
}

DI void attn_unit_diff(LAS unsigned char* lds, const AttnP& p, const float lam, const float oml, const float* subln) {
    const int tid = opaque_tid(), lane = tid & 63, wid = __builtin_amdgcn_readfirstlane(tid >> 6), r32 = lane & 31, hi = lane >> 5;
    LAS unsigned* stash = (LAS unsigned*)(lds + O1_OFF) + tid;
    for (int jh = 0; jh < 2; ++jh) {
        AttnP pj = p; pj.K = p.K + 64 * jh;
        bf16x8 qf[4];
        const bf16* qrow = p.Q + (size_t)(32 * wid + r32) * p.qp + 64 * jh;
#pragma unroll
        for (int d0 = 0; d0 < 4; ++d0) qf[d0] = *(const bf16x8*)(qrow + 16 * d0 + 8 * hi);
        f32x16 o[4];
#pragma unroll
        for (int c = 0; c < 4; ++c)
#pragma unroll
            for (int r = 0; r < 16; ++r) o[c][r] = 0.f;
        float m_run = 0.f, l_run = 0.f;
        attn_core<64, 128, 0>(lds, pj, qf, o, m_run, l_run, tid, wid, lane);
        const float l = l_run + __shfl_xor(l_run, 32), inv = 1.0f / l;
        if (jh == 0) {
#pragma unroll
            for (int r = 0; r < 8; ++r) { int hio = hi; asm volatile("" : "+v"(hio)); const float iv0 = __shfl(inv, crow(2 * r, hio)), iv1 = __shfl(inv, crow(2 * r + 1, hio));
#pragma unroll
                for (int c = 0; c < 4; ++c) stash[512 * (c * 8 + r)] = pk2(o[c][2 * r] * iv0, o[c][2 * r + 1] * iv1);
                __builtin_amdgcn_sched_barrier(0); }
        } else {
            float sg[4];
#pragma unroll
            for (int c = 0; c < 4; ++c) sg[c] = subln[32 * c + r32] * (oml * MIX_SCALE);
            unsigned char* orow = p.O + (size_t)(32 * wid) * p.op + r32;
#pragma unroll
            for (int r = 0; r < 16; ++r) { int hio = hi; asm volatile("" : "+v"(hio)); const int q = crow(r, hio); const float iv = __shfl(inv, q);
                float v[4]; float ss = 0.f;
#pragma unroll
                for (int c = 0; c < 4; ++c) { const unsigned w1 = stash[512 * (c * 8 + (r >> 1))]; const float o1 = (r & 1) ? bfhi(w1) : bflo(w1); v[c] = o1 - lam * (o[c][r] * iv); ss += v[c] * v[c]; }
                ss += __shfl_xor(ss, 1); ss += __shfl_xor(ss, 2); ss += __shfl_xor(ss, 4); ss += __shfl_xor(ss, 8); ss += __shfl_xor(ss, 16);
                const float rinv = 1.0f / sqrtf(ss * (1.0f / 128.0f) + RMS_EPS);
#pragma unroll
                for (int c = 0; c < 4; ++c) orow[(size_t)q * p.op + 32 * c] = (unsigned char)__builtin_amdgcn_cvt_pk_fp8_f32(v[c] * rinv * sg[c], 0.f, 0u, false);
                __builtin_amdgcn_sched_barrier(0); }
        }
    }
}
}


DI void p0_mod_item(LAS unsigned char* lds, const float* c, const float* c_ctx, const float* mod_w, const float* mod_b, float* mod, const int item) {
    const int tid = opaque_tid(), lane = tid & 63, wid = __builtin_amdgcn_readfirstlane(tid >> 6), l = item / 48, col0 = (item - l * 48) * 128;
    constexpr int SP = 1026;
    LAS float* s = (LAS float*)lds;
    __syncthreads();
    for (int idx = tid; idx < 33 * 1024; idx += NTHR) { const int r = idx >> 10, kk = idx & 1023; const float cv = (r < 32) ? c[r * 1024 + kk] : c_ctx[kk]; s[r * SP + kk] = cv / (1.0f + __expf(-cv)); }
    __syncthreads();
    const int i32 = lane & 31, hi = lane >> 5;
    f32x16 acc[4];
#pragma unroll
    for (int cb = 0; cb < 4; ++cb)
#pragma unroll
        for (int r = 0; r < 16; ++r) acc[cb][r] = 0.f;
    float a32[4] = {0.f, 0.f, 0.f, 0.f};
    const float* w = mod_w + ((size_t)l * 1024 + wid * 128) * 6144 + col0 + i32;
    const LAS float* sa = s + i32 * SP + wid * 128 + 2 * hi;
    const LAS float* sc = s + 32 * SP + wid * 128 + 2 * hi;
#pragma unroll 4
    for (int q = 0; q < 32; ++q) {
        const float* wp = w + (size_t)(4 * q + 2 * hi) * 6144;
        float b0[4], b1[4];
#pragma unroll
        for (int cb = 0; cb < 4; ++cb) { b0[cb] = wp[32 * cb]; b1[cb] = wp[6144 + 32 * cb]; }
        const f32x2 av = *(const LAS f32x2*)(sa + 4 * q), cv = *(const LAS f32x2*)(sc + 4 * q);
#pragma unroll
        for (int cb = 0; cb < 4; ++cb) {
            acc[cb] = __builtin_amdgcn_mfma_f32_32x32x2f32(av[0], b0[cb], acc[cb], 0, 0, 0);
            acc[cb] = __builtin_amdgcn_mfma_f32_32x32x2f32(av[1], b1[cb], acc[cb], 0, 0, 0);
            a32[cb] += cv[0] * b0[cb] + cv[1] * b1[cb];
        }
    }
#pragma unroll
    for (int cb = 0; cb < 4; ++cb) a32[cb] += __shfl_xor(a32[cb], 32);
    __syncthreads();
    LAS float* red = s + (size_t)wid * 33 * 128;
#pragma unroll
    for (int cb = 0; cb < 4; ++cb) {
#pragma unroll
        for (int r = 0; r < 16; ++r) red[((r & 3) + 8 * (r >> 2) + 4 * hi) * 128 + 32 * cb + i32] = acc[cb][r];
        if (hi == 0) red[32 * 128 + 32 * cb + i32] = a32[cb];
    }
    __syncthreads();
    for (int idx = tid; idx < 33 * 128; idx += NTHR) { const int r = idx >> 7, cc = idx & 127; float v = 0.f;
#pragma unroll
        for (int wv = 0; wv < 8; ++wv) v += s[(wv * 33 + r) * 128 + cc];
        mod[((size_t)l * 33 + r) * 6144 + col0 + cc] = v + mod_b[l * 6144 + col0 + cc]; }
    __syncthreads();
}
struct TrDesc { const float* W; unsigned char* WT; int K, N, dK, mode, scale_n, fp8, item; float scale, scale2; };
constexpr int TI_GU = 128 * 1024, TI_D = 128 * 512, TI_WE = 2 * 1152, TI_WO_ = 2 * 976, TI_OUT = 4 * 512, TI_UQ = 2 * 96, TI_UKV = 2 * 64;
constexpr int TI_TOTAL = TI_GU + TI_D + TI_WE + TI_WO_ + TI_OUT + TI_UQ + TI_UKV;
DI TrDesc tr_decode(const float* const* in, unsigned char* ws, int r) {
    TrDesc d; d.scale_n = 0; d.scale = 1.f; d.scale2 = 1.f; d.mode = 0; d.fp8 = 0;
    if (r < TI_GU) { const int le = r >> 10; d.W = in[28] + (size_t)le * 1024 * 2048; d.K = 1024; d.N = 2048; d.WT = ws + WS_WGU + (size_t)le * 2048 * 1024; d.dK = 1024; d.mode = 1; d.scale_n = 1 << 30; d.scale = WGU_SCALE; d.fp8 = 1; d.item = r & 1023; return d; } r -= TI_GU;
    if (r < TI_D) { const int le = r >> 9; d.W = in[30] + (size_t)le * 1024 * 1024; d.K = 1024; d.N = 1024; d.WT = ws + WS_WD + (size_t)le * 1024 * 1024; d.dK = 1024; d.mode = 2; d.scale_n = 1 << 30; d.scale = WD_SCALE; d.fp8 = 1; d.item = r & 511; return d; } r -= TI_D;
    if (r < TI_WE) { const int j = r / 1152; d.W = in[10] + (size_t)j * 1024 * 2304; d.K = 1024; d.N = 2304; d.WT = ws + WS_WIN + (size_t)(2 * j) * 2304 * 1024 * 2; d.dK = 1024; d.scale_n = 512; d.scale = C2; d.item = r - j * 1152; if (INPROJ_FP8) { d.fp8 = 1; d.scale = C2 * WI_SCALE; d.scale2 = WI_SCALE; } return d; } r -= TI_WE;
    if (r < TI_WO_) { const int j = r / 976; d.W = in[15] + (size_t)j * 1024 * 1952; d.K = 1024; d.N = 1952; d.WT = ws + WS_WIN + (size_t)(2 * j + 1) * 2304 * 1024 * 2; d.dK = 1024; d.scale_n = 512; d.scale = C2; d.item = r - j * 976; if (INPROJ_FP8) { d.fp8 = 1; d.scale = C2 * WI_SCALE; d.scale2 = WI_SCALE; } return d; } r -= TI_WO_;
    if (r < TI_OUT) { const int q = r >> 9, j = q >> 1, odd = q & 1; d.W = in[odd ? 16 : 11] + (size_t)j * 1024 * 1024; d.K = 1024; d.N = 1024; d.WT = ws + WS_WOUT + (size_t)(2 * j + odd) * 1024 * 1024; d.dK = 1024; d.scale_n = 1 << 30; d.scale = WO_SCALE; d.fp8 = 1; d.item = r & 511; return d; } r -= TI_OUT;
    if (r < TI_UQ) { const int j = r / 96; d.W = in[23] + (size_t)j * 256 * 768; d.K = 256; d.N = 768; d.WT = ws + WS_WUQ + (size_t)j * 768 * 256 * 2; d.dK = 256; d.scale_n = 768; d.scale = C2M; d.item = r - j * 96; return d; } r -= TI_UQ;
    { const int j = r / 64; d.W = in[25] + (size_t)j * 128 * 1024; d.K = 128; d.N = 1024; d.WT = ws + WS_WUKV + (size_t)j * 1024 * 256 * 2; d.dK = 256; d.item = r - j * 64; return d; }
}
DI void tr_load(const TrDesc& d, f32x4 (&tv)[8], const int lane) {
    const int nblk = d.N / 32, kb = d.item / nblk, nb = d.item - kb * nblk, k0 = 64 * kb, n0 = 32 * nb;
    const float* p = d.W + (size_t)(k0 + (lane >> 3)) * d.N + n0 + 4 * (lane & 7);
#pragma unroll
    for (int i = 0; i < 8; ++i) tv[i] = *(const f32x4*)(p + (size_t)(8 * i) * d.N);
}
DI void tr_store(const TrDesc& d, LAS float* scr, const int lane) {
    const int nblk = d.N / 32, kb = d.item / nblk, nb = d.item - kb * nblk, k0 = 64 * kb, n0 = 32 * nb;
    if (d.fp8) {
        const int cch = lane & 3;
#pragma unroll
        for (int j = 0; j < 2; ++j) { const int nl = (lane >> 2) + 16 * j, n = n0 + nl; const LAS float* s = scr + (16 * cch) * 33 + nl; const float sc = (n < d.scale_n) ? d.scale : d.scale2;
            int row = n; if (d.mode == 1) { const int jj = n >> 1, sh = n & 1; row = 256 * (jj >> 7) + 128 * sh + (jj & 127); }
            if (d.mode == 2) { const int na = n & 255; row = (n & ~255) + 128 * ((na >> 3) & 1) + 32 * (na >> 6) + 8 * ((na >> 4) & 3) + (na & 7); }
            u32x4 o;
            o.x = pk4_fp8(s[0 * 33] * sc, s[1 * 33] * sc, s[2 * 33] * sc, s[3 * 33] * sc); o.y = pk4_fp8(s[4 * 33] * sc, s[5 * 33] * sc, s[6 * 33] * sc, s[7 * 33] * sc);
            o.z = pk4_fp8(s[8 * 33] * sc, s[9 * 33] * sc, s[10 * 33] * sc, s[11 * 33] * sc); o.w = pk4_fp8(s[12 * 33] * sc, s[13 * 33] * sc, s[14 * 33] * sc, s[15 * 33] * sc);
            *(u32x4*)(d.WT + (size_t)row * d.dK + k0 + 16 * cch) = o; }
    } else {
        const int cch = lane & 7;
#pragma unroll
        for (int j = 0; j < 4; ++j) { const int nl = (lane >> 3) + 8 * j, n = n0 + nl; const LAS float* s = scr + (8 * cch) * 33 + nl;
            const float sc = (n < d.scale_n) ? d.scale : 1.0f;
            u32x4 o; o.x = pk2(s[0 * 33] * sc, s[1 * 33] * sc); o.y = pk2(s[2 * 33] * sc, s[3 * 33] * sc); o.z = pk2(s[4 * 33] * sc, s[5 * 33] * sc); o.w = pk2(s[6 * 33] * sc, s[7 * 33] * sc);
            *(u32x4*)((bf16*)d.WT + (size_t)n * d.dK + k0 + 8 * cch) = o; }
    }
}
DI void p0_transposes(LAS unsigned char* lds, const float* const* in, unsigned char* ws, const int gw, const int ngw, const int wid, const int lane) {
    LAS float* scr = (LAS float*)(lds + wid * 16384);
    if (gw >= TI_TOTAL) return;
    f32x4 ta[8], tb[8];
    TrDesc da = tr_decode(in, ws, gw), db = da;
    tr_load(da, ta, lane);
    if (gw + ngw < TI_TOTAL) { db = tr_decode(in, ws, gw + ngw); tr_load(db, tb, lane); }
#define TR_STEP(D, TV, NEXT) do { \
        _Pragma("unroll") for (int i = 0; i < 8; ++i) { LAS float* sp = scr + ((lane >> 3) + 8 * i) * 33 + 4 * (lane & 7); sp[0] = TV[i][0]; sp[1] = TV[i][1]; sp[2] = TV[i][2]; sp[3] = TV[i][3]; } \
        TrDesc nx_ = D; \
        if ((NEXT) < TI_TOTAL) { nx_ = tr_decode(in, ws, (NEXT)); tr_load(nx_, TV, lane); } \
        asm volatile("s_waitcnt lgkmcnt(0)" ::: "memory"); \
        tr_store(D, scr, lane); \
        asm volatile("s_waitcnt lgkmcnt(0)" ::: "memory"); \
        D = nx_; } while (0)
    for (int it = gw; it < TI_TOTAL; it += 2 * ngw) {
        TR_STEP(da, ta, it + 2 * ngw);
        if (it + ngw >= TI_TOTAL) break;
        TR_STEP(db, tb, it + 3 * ngw);
    }
#undef TR_STEP
}
DI void p0_zero(unsigned char* ws, const int gtid, const int ngt) {
    if (INPROJ_FP8) { for (int i = gtid; i < 2 * 96 * 64; i += ngt) { const int j = i / (96 * 64), r = i - j * 96 * 64; *(u32x4*)(ws + WS_WIN + (size_t)(2 * j + 1) * 2304 * 1024 * 2 + (size_t)1952 * 1024 + (size_t)r * 16) = (u32x4){0u, 0u, 0u, 0u}; } }
    else for (int i = gtid; i < 2 * 96 * 128; i += ngt) { const int j = i / (96 * 128), r = i - j * 96 * 128; *(u32x4*)((bf16*)(ws + WS_WIN) + ((size_t)(2 * j + 1) * 2304 + 1952) * 1024 + (size_t)r * 8) = (u32x4){0u, 0u, 0u, 0u}; }
    for (int i = gtid; i < 2 * 1024 * 16; i += ngt) { const int row = i >> 4, ch = i & 15; *(u32x4*)((bf16*)(ws + WS_WUKV) + (size_t)row * 256 + 128 + ch * 8) = (u32x4){0u, 0u, 0u, 0u}; }
}
DI void p0b_rows(const float* x, const float* ctx, const float* mod0, bf16* X, bf16* H, const int gw, const int ngw, const int lane) {
    const int c0 = 16 * lane;
    f32x4 vn[4];
#define P0B_SRC(mm) (((mm) % TPB < CTXL) ? ctx + ((size_t)((mm) / TPB) * CTXL + (mm) % TPB) * DM : x + ((size_t)((mm) / TPB) * SEQ + ((mm) % TPB - CTXL)) * DM)
    if (gw < T) { const float* src = P0B_SRC(gw) + c0;
#pragma unroll
        for (int j = 0; j < 4; ++j) vn[j] = *(const f32x4*)(src + 4 * j); }
    for (int m = gw; m < T; m += ngw) {
        const int b = m / TPB, t = m - b * TPB;
        const float* md = mod0 + (size_t)((t < CTXL) ? 32 : b) * 6144 + c0;
        f32x4 vc[4];
#pragma unroll
        for (int j = 0; j < 4; ++j) vc[j] = vn[j];
        if (m + ngw < T) { const float* src = P0B_SRC(m + ngw) + c0;
#pragma unroll
            for (int j = 0; j < 4; ++j) vn[j] = *(const f32x4*)(src + 4 * j); }
        u32x4 xo[2], ho[2];
#pragma unroll
        for (int j = 0; j < 4; ++j) { const f32x4 v = vc[j];
            xo[j >> 1][2 * (j & 1)] = pk2(v[0], v[1]); xo[j >> 1][2 * (j & 1) + 1] = pk2(v[2], v[3]);
            const f32x4 sh = *(const f32x4*)(md + 4 * j), sc = *(const f32x4*)(md + 1024 + 4 * j); const f32x4 h = v * (sc + 1.0f) + sh;
            ho[j >> 1][2 * (j & 1)] = pk2(h[0], h[1]); ho[j >> 1][2 * (j & 1) + 1] = pk2(h[2], h[3]); }
        bf16* xr = X + (size_t)m * DM + c0; *(u32x4*)xr = xo[0]; *(u32x4*)(xr + 8) = xo[1];
        if (INPROJ_FP8) { u32x4 h8;
#pragma unroll
            for (int j = 0; j < 4; ++j) { const f32x4 sh = *(const f32x4*)(md + 4 * j), sc = *(const f32x4*)(md + 1024 + 4 * j); const f32x4 h = (vc[j] * (sc + 1.0f) + sh) * H_SCALE; h8[j] = pk4_fp8(h[0], h[1], h[2], h[3]); }
            *(u32x4*)((unsigned char*)H + (size_t)m * DM + c0) = h8; }
        else { bf16* hr = H + (size_t)m * DM + c0; *(u32x4*)hr = ho[0]; *(u32x4*)(hr + 8) = ho[1]; }
    }
#undef P0B_SRC
}
DI void unpack8(const u32x4 w, float (&v)[8]) { v[0] = bflo(w.x); v[1] = bfhi(w.x); v[2] = bflo(w.y); v[3] = bfhi(w.y); v[4] = bflo(w.z); v[5] = bfhi(w.z); v[6] = bflo(w.w); v[7] = bfhi(w.w); }
DI u32x4 pack8(const float (&v)[8]) { u32x4 w; w.x = pk2(v[0], v[1]); w.y = pk2(v[2], v[3]); w.z = pk2(v[4], v[5]); w.w = pk2(v[6], v[7]); return w; }
DI void rope_chunk(float (&y)[8], const float (&rf)[8], const float position, const bool second, const int pmask) {
#pragma unroll
    for (int e = 0; e < 8; ++e) { float rev = position * rf[e]; rev = rev - floorf(rev);
        const float sn = __builtin_amdgcn_sinf(rev), cs = __builtin_amdgcn_cosf(rev); const float partner = __shfl_xor(y[e], pmask);
        y[e] = second ? (partner * sn + y[e] * cs) : (y[e] * cs - partner * sn); }
}
DI void post_even_rows(const bf16* P, bf16* PQ, const float* qg, const float* kg, const int gw, const int ngw, const int lane) {
    const int ch = lane & 7;
    float gq[8], gk[8], rf[8];
#pragma unroll
    for (int e = 0; e < 8; ++e) { gq[e] = qg[8 * ch + e] * C2; gk[e] = kg[8 * ch + e]; rf[e] = fast_exp2(-(float)(8 * (ch & 1) + e) * (LOG2_THETA / 16.f)) * 0.15915494309189535f; }
    const bool second = (ch & 2) != 0, colpart = (ch & 4) != 0;
    u32x4 nq, nk;
    if (gw < T) { const bf16* r0 = P + (size_t)gw * NPP; nq = *(const u32x4*)(r0 + 1536 + 8 * lane); nk = *(const u32x4*)(r0 + 2048 + 8 * (lane & 15)); }
    for (int m = gw; m < T; m += ngw) {
        const int b = m / TPB, t = m - b * TPB; const bool lat = t >= CTXL; const int pos = t - CTXL;
        bf16* row = PQ + (size_t)m * NPP;
        u32x4* pq = (u32x4*)(row + 1536 + 8 * lane); u32x4* pk = (u32x4*)(row + 2048 + 8 * (lane & 15));
        const u32x4 wq = nq, wk = nk;
        if (m + ngw < T) { const bf16* r1 = P + (size_t)(m + ngw) * NPP; nq = *(const u32x4*)(r1 + 1536 + 8 * lane); nk = *(const u32x4*)(r1 + 2048 + 8 * (lane & 15)); }
        const float position = (float)(colpart ? (pos & 63) : (pos >> 6));
        float v[8];
        unpack8(wq, v);
        { float ss = 0.f;
#pragma unroll
          for (int e = 0; e < 8; ++e) ss += v[e] * v[e];
          ss += __shfl_xor(ss, 1); ss += __shfl_xor(ss, 2); ss += __shfl_xor(ss, 4);
          const float ri = 1.0f / sqrtf(ss * (1.0f / 64.0f) + RMS_EPS);
#pragma unroll
          for (int e = 0; e < 8; ++e) v[e] = v[e] * ri * gq[e];
          if (lat) rope_chunk(v, rf, position, second, 2);
          *pq = pack8(v); }
        unpack8(wk, v);
        { float ss = 0.f;
#pragma unroll
          for (int e = 0; e < 8; ++e) ss += v[e] * v[e];
          ss += __shfl_xor(ss, 1); ss += __shfl_xor(ss, 2); ss += __shfl_xor(ss, 4);
          const float ri = 1.0f / sqrtf(ss * (1.0f / 64.0f) + RMS_EPS);
#pragma unroll
          for (int e = 0; e < 8; ++e) v[e] = v[e] * ri * gk[e];
          if (lat) rope_chunk(v, rf, position, second, 2);
          if (lane < 16) *pk = pack8(v); }
    }
}
DI void post_odd_rows(const bf16* P, bf16* PQ, const float* mqg, const float* mkvg, const int gw, const int ngw, const int lane) {
    const int ch = lane & 7;
    float rf[8], rf32[8], g3[8];
#pragma unroll
    for (int e = 0; e < 8; ++e) { rf[e] = fast_exp2(-(float)(8 * (ch & 1) + e) * (LOG2_THETA / 16.f)) * 0.15915494309189535f; rf32[e] = fast_exp2(-(float)e * (LOG2_THETA / 8.f)) * 0.15915494309189535f;
        g3[e] = (lane < 32) ? mqg[8 * lane + e] : (lane < 48) ? mkvg[8 * (lane - 32) + e] : 1.0f; }
    const bool second = (ch & 2) != 0, colpart = (ch & 4) != 0;
    const int c3 = lane;
    const bool second32 = (lane & 1) != 0, colpart32 = (lane & 2) != 0;
    u32x4 n0, n1, n3;
#define PODD_LOAD(mm) do { const bf16* r_ = P + (size_t)(mm) * NPP; n3 = *(const u32x4*)(r_ + 1536 + 8 * c3); n0 = *(const u32x4*)(r_ + 8 * lane); n1 = *(const u32x4*)(r_ + 512 + 8 * lane); } while (0)
    if (gw < T) PODD_LOAD(gw);
    for (int m = gw; m < T; m += ngw) {
        const int b = m / TPB, t = m - b * TPB; const bool lat = t >= CTXL; const int pos = t - CTXL;
        bf16* row = PQ + (size_t)m * NPP;
        u32x4* p0 = (u32x4*)(row + 8 * lane); u32x4* p1 = (u32x4*)(row + 512 + 8 * lane); u32x4* p3 = (u32x4*)(row + 1536 + 8 * c3);
        const u32x4 w0 = n0, w1 = n1, w3 = n3;
        if (m + ngw < T) PODD_LOAD(m + ngw);
        float v[8];
        if (lat) {
            const float position = (float)(colpart ? (pos & 63) : (pos >> 6));
            unpack8(w0, v); rope_chunk(v, rf, position, second, 2); *p0 = pack8(v);
            unpack8(w1, v); rope_chunk(v, rf, position, second, 2); *p1 = pack8(v);
        } else { *p0 = w0; *p1 = w1; }
        unpack8(w3, v);
        float ss = 0.f;
#pragma unroll
        for (int e = 0; e < 8; ++e) ss += v[e] * v[e];
        ss += __shfl_xor(ss, 1); ss += __shfl_xor(ss, 2); ss += __shfl_xor(ss, 4); ss += __shfl_xor(ss, 8);
        const float ss16 = ss + __shfl_xor(ss, 16);
        const float ri = (lane < 32) ? 1.0f / sqrtf(ss16 * (1.0f / 256.0f) + RMS_EPS) : 1.0f / sqrtf(ss * (1.0f / 128.0f) + RMS_EPS);
        float vn[8];
#pragma unroll
        for (int e = 0; e < 8; ++e) vn[e] = v[e] * ri * g3[e];
        if (lat) { const float position32 = (float)(colpart32 ? (pos & 63) : (pos >> 6)); rope_chunk(v, rf32, position32, second32, 1); }
        if (lane < 48) *p3 = pack8(vn); else if (lane < 52) { if (lat) *p3 = pack8(v); else *p3 = w3; } else *p3 = (u32x4){0u, 0u, 0u, 0u};
    }
}
DI int ln_row(const int wg, const int i, const int last) { if (!last) return wg * 288 + i; const int idx = wg * 256 + i; return (idx >> 11) * TPB + CTXL + (idx & 2047); }

DI void ln1_router_table(LAS unsigned char* lds, const float* rw) {
    const int tid = opaque_tid();
    for (int i = 0; i < 32; ++i) { const int idx = tid + NTHR * i, e = idx & 31, k = (idx >> 5) * 2;
        *(LAS unsigned*)(lds + e * 2064 + k * 2) = pk2(rw[k * 32 + e], rw[(k + 1) * 32 + e]); }
}
DI void ln1_router_phase(LAS unsigned char* lds, bf16* X, unsigned char* H8, const float* mod_l, const float* lng, const float* lnb, const float* rw, const float* rb,
                         unsigned* cnt_l, unsigned* list, float* gsort, const int wg, const int last, const int have_table) {
    const int tid = opaque_tid(), lane = tid & 63, wid = __builtin_amdgcn_readfirstlane(tid >> 6);
    constexpr int TROW = 2064;
    LAS unsigned char* wrt = lds; LAS unsigned char* ht = lds + 66048; LAS float* logt = (LAS float*)(lds + 99072);
    LAS unsigned* ent = (LAS unsigned*)(lds + 101376); LAS float* entw = (LAS float*)(ent + 1152); LAS unsigned* lcnt = ent + 2304; LAS unsigned* lbase = lcnt + 32;
    if (!have_table) ln1_router_table(lds, rw);
    if (tid < 32) lcnt[tid] = 0u;
    const int nrows = last ? 256 : 288, nblk = nrows >> 4;
    const int c0 = 16 * lane;
    f32x4 gv[4], bv[4];
#pragma unroll
    for (int j = 0; j < 4; ++j) { gv[j] = *(const f32x4*)(lng + c0 + 4 * j); bv[j] = *(const f32x4*)(lnb + c0 + 4 * j); }
    u32x4 xnext[2][2];
#define LN1_LOAD(blk_) do { _Pragma("unroll") for (int r = 0; r < 2; ++r) { const bf16* xp_ = X + (size_t)ln_row(wg, (blk_) * 16 + 2 * wid + r, last) * DM + c0; \
        xnext[r][0] = *(const u32x4*)xp_; xnext[r][1] = *(const u32x4*)(xp_ + 8); } } while (0)
    LN1_LOAD(0);
    __syncthreads();
    for (int blk = 0; blk < nblk; ++blk) {
        u32x4 xcur[2][2];
#pragma unroll
        for (int r = 0; r < 2; ++r) { xcur[r][0] = xnext[r][0]; xcur[r][1] = xnext[r][1]; }
        if (blk + 1 < nblk) LN1_LOAD(blk + 1);
#pragma unroll
        for (int r = 0; r < 2; ++r) {
            const int m = ln_row(wg, blk * 16 + 2 * wid + r, last); const int b = m / TPB, t = m - b * TPB;
            const float* md = mod_l + (size_t)((t < CTXL) ? 32 : b) * 6144;
            f32x4 v[4]; float s = 0.f;
#pragma unroll
            for (int j = 0; j < 4; ++j) { const unsigned xa = xcur[r][j >> 1][2 * (j & 1)], xb = xcur[r][j >> 1][2 * (j & 1) + 1]; v[j] = (f32x4){bflo(xa), bfhi(xa), bflo(xb), bfhi(xb)}; s += (v[j][0] + v[j][1]) + (v[j][2] + v[j][3]); }
            const float mean = wave_sum(s) * (1.0f / DM); float s2 = 0.f;
#pragma unroll
            for (int j = 0; j < 4; ++j) { v[j] = v[j] - mean; s2 += (v[j][0] * v[j][0] + v[j][1] * v[j][1]) + (v[j][2] * v[j][2] + v[j][3] * v[j][3]); }
            const float rstd = 1.0f / sqrtf(wave_sum(s2) * (1.0f / DM) + LN_EPS);
            LAS unsigned char* hrow = ht + (2 * wid + r) * TROW + c0 * 2;
            u32x4 ho[2], h8;
#pragma unroll
            for (int j = 0; j < 4; ++j) { const f32x4 y = v[j] * rstd * gv[j] + bv[j];
                const f32x4 sh = *(const f32x4*)(md + 3072 + c0 + 4 * j), sc = *(const f32x4*)(md + 4096 + c0 + 4 * j); const f32x4 h = y * (sc + 1.0f) + sh;
                h8[j] = pk4_fp8(h[0], h[1], h[2], h[3]);
                ho[j >> 1][2 * (j & 1)] = pk2(h[0], h[1]); ho[j >> 1][2 * (j & 1) + 1] = pk2(h[2], h[3]); }
            *(u32x4*)(H8 + (size_t)m * DM + c0) = h8;
            *(LAS u32x4*)hrow = ho[0]; *(LAS u32x4*)(hrow + 16) = ho[1];
        }
        __syncthreads();
        if (wid < 2) {
            f32x4 d = {0.f, 0.f, 0.f, 0.f};
            const LAS unsigned char* ap = ht + (lane & 15) * TROW + (lane >> 4) * 16;
            const LAS unsigned char* bp = wrt + (16 * wid + (lane & 15)) * TROW + (lane >> 4) * 16;
#pragma unroll 8
            for (int s = 0; s < 32; ++s) d = __builtin_amdgcn_mfma_f32_16x16x32_bf16(*(const LAS bf16x8*)(ap + 64 * s), *(const LAS bf16x8*)(bp + 64 * s), d, 0, 0, 0);
            const float rbias = rb[16 * wid + (lane & 15)];
#pragma unroll
            for (int i = 0; i < 4; ++i) logt[(4 * (lane >> 4) + i) * 33 + 16 * wid + (lane & 15)] = d[i] + rbias;
        }
        __syncthreads();
        {
            const int half = lane >> 5, e = lane & 31, rr = 2 * wid + half;
            float v = logt[rr * 33 + e];
            float tv[4]; int te[4];
#define MX_DPP(x, ctrl, rmask) __builtin_bit_cast(float, __builtin_amdgcn_update_dpp(__builtin_bit_cast(int, x), __builtin_bit_cast(int, x), ctrl, rmask, 0xf, false))
#pragma unroll
            for (int k = 0; k < 4; ++k) {
                float m = v;
                m = fmaxf(m, MX_DPP(m, 0xB1, 0xf)); m = fmaxf(m, MX_DPP(m, 0x4E, 0xf)); m = fmaxf(m, MX_DPP(m, 0x141, 0xf)); m = fmaxf(m, MX_DPP(m, 0x140, 0xf));
                m = fmaxf(m, MX_DPP(m, 0x142, 0xa));
                const float m0 = __builtin_bit_cast(float, __builtin_amdgcn_readlane(__builtin_bit_cast(int, m), 31)), m1 = __builtin_bit_cast(float, __builtin_amdgcn_readlane(__builtin_bit_cast(int, m), 63));
                const float mh = half ? m1 : m0;
                const unsigned long long bal = __ballot(v == mh);
                const unsigned hm = half ? (unsigned)(bal >> 32) : (unsigned)bal;
                const int bi = __builtin_ctz(hm);
                tv[k] = mh; te[k] = bi;
                v = (e == bi) ? -3.0e38f : v;
            }
#undef MX_DPP
            const float e1 = __expf(tv[1] - tv[0]), e2 = __expf(tv[2] - tv[0]), e3 = __expf(tv[3] - tv[0]); const float rs = 1.0f / (1.0f + e1 + e2 + e3);
            if (e == 0) { const int irow = blk * 16 + rr;
                const float ww[4] = {rs, e1 * rs, e2 * rs, e3 * rs};
#pragma unroll
                for (int k = 0; k < 4; ++k) { const unsigned lr = __hip_atomic_fetch_add(lcnt + te[k], 1u, __ATOMIC_RELAXED, __HIP_MEMORY_SCOPE_WORKGROUP);
                    ent[irow * 4 + k] = (unsigned)te[k] | (lr << 8); entw[irow * 4 + k] = ww[k]; } }
        }
    }
#undef LN1_LOAD
    __syncthreads();
    if (tid < 32) lbase[tid] = __hip_atomic_fetch_add(cnt_l + tid * 64, lcnt[tid], __ATOMIC_RELAXED, __HIP_MEMORY_SCOPE_AGENT);
    __syncthreads();
    for (int sidx = tid; sidx < nrows * 4; sidx += NTHR) { const unsigned en = ent[sidx]; const int e = en & 255u; const unsigned lr = en >> 8;
        const int m = ln_row(wg, sidx >> 2, last); const size_t pos = (size_t)e * T + lbase[e] + lr; list[pos] = (unsigned)m * 4u + (unsigned)(sidx & 3); gsort[pos] = entw[sidx]; }
    __syncthreads();
}
DI void ln2_phase(bf16* X, const unsigned char* Y, bf16* H, float* out, const float* mod_l, const float* mod_n, const float* lng1, const float* lnb1, const float* lng, const float* lnb, const int wg, const int last, const int wid, const int lane) {
    const int nrows = last ? 256 : 288, c0 = 16 * lane;
    f32x4 gv[4], bv[4], gv1[4], bv1[4];
#pragma unroll
    for (int q = 0; q < 4; ++q) { gv[q] = *(const f32x4*)(lng + c0 + 4 * q); bv[q] = *(const f32x4*)(lnb + c0 + 4 * q); gv1[q] = *(const f32x4*)(lng1 + c0 + 4 * q); bv1[q] = *(const f32x4*)(lnb1 + c0 + 4 * q); }
    u32x4 xnext[2], ynext[4];
#define LN2_LOAD(mm) do { const bf16* xp_ = X + (size_t)(mm) * DM + c0; const unsigned char* yp_ = Y + (size_t)(mm) * 4 * DM + c0; \
        xnext[0] = *(const u32x4*)xp_; xnext[1] = *(const u32x4*)(xp_ + 8); \
        _Pragma("unroll") for (int k = 0; k < 4; ++k) ynext[k] = *(const u32x4*)(yp_ + (size_t)k * DM); } while (0)
    if (wid < nrows) LN2_LOAD(ln_row(wg, wid, last));
    for (int i = wid; i < nrows; i += NWAVES) {
        const int m = ln_row(wg, i, last); const int b = m / TPB, t = m - b * TPB; const int mrow = (t < CTXL) ? 32 : b;
        const float* md = mod_l + (size_t)mrow * 6144;
        bf16* xr = X + (size_t)m * DM + c0;
        u32x4 xcur[2], ycur[4];
        xcur[0] = xnext[0]; xcur[1] = xnext[1];
#pragma unroll
        for (int k = 0; k < 4; ++k) ycur[k] = ynext[k];
        if (i + NWAVES < nrows) LN2_LOAD(ln_row(wg, i + NWAVES, last));
        f32x4 v[4]; float s = 0.f;
        { float s1 = 0.f;
#pragma unroll
          for (int q = 0; q < 4; ++q) { const unsigned xa = xcur[q >> 1][2 * (q & 1)], xb = xcur[q >> 1][2 * (q & 1) + 1]; v[q] = (f32x4){bflo(xa), bfhi(xa), bflo(xb), bfhi(xb)}; s1 += (v[q][0] + v[q][1]) + (v[q][2] + v[q][3]); }
          const float mean1 = wave_sum(s1) * (1.0f / DM); float q1 = 0.f;
#pragma unroll
          for (int q = 0; q < 4; ++q) { v[q] = v[q] - mean1; q1 += (v[q][0] * v[q][0] + v[q][1] * v[q][1]) + (v[q][2] * v[q][2] + v[q][3] * v[q][3]); }
          const float rstd1 = 1.0f / sqrtf(wave_sum(q1) * (1.0f / DM) + LN_EPS);
#pragma unroll
          for (int q = 0; q < 4; ++q) v[q] = v[q] * rstd1 * gv1[q] + bv1[q]; }
#pragma unroll
        for (int q = 0; q < 4; ++q) { f32x4 y = (f32x4){0.f, 0.f, 0.f, 0.f};
#pragma unroll
            for (int k = 0; k < 4; ++k) { const unsigned w = ycur[k][q]; const f32x2 lo = __builtin_amdgcn_cvt_pk_f32_fp8(w, false), hi2 = __builtin_amdgcn_cvt_pk_f32_fp8(w, true); y += (f32x4){lo[0], lo[1], hi2[0], hi2[1]}; }
            const f32x4 g2 = *(const f32x4*)(md + 5120 + c0 + 4 * q) * (1.0f / Y_SCALE);
            v[q] = v[q] * DN_ALPHA + g2 * y; s += (v[q][0] + v[q][1]) + (v[q][2] + v[q][3]); }
        const float mean = wave_sum(s) * (1.0f / DM); float s2 = 0.f;
#pragma unroll
        for (int q = 0; q < 4; ++q) { v[q] = v[q] - mean; s2 += (v[q][0] * v[q][0] + v[q][1] * v[q][1]) + (v[q][2] * v[q][2] + v[q][3] * v[q][3]); }
        const float rstd = 1.0f / sqrtf(wave_sum(s2) * (1.0f / DM) + LN_EPS);
        if (last) { float* orow = out + ((size_t)b * SEQ + (t - CTXL)) * DM + c0;
#pragma unroll
            for (int q = 0; q < 4; ++q) *(f32x4*)(orow + 4 * q) = v[q] * rstd * gv[q] + bv[q];
        } else { const float* mn = mod_n + (size_t)mrow * 6144 + c0;
            u32x4 xo[2], ho[2];
#pragma unroll
            for (int q = 0; q < 4; ++q) { const f32x4 y = v[q] * rstd * gv[q] + bv[q];
                xo[q >> 1][2 * (q & 1)] = pk2(y[0], y[1]); xo[q >> 1][2 * (q & 1) + 1] = pk2(y[2], y[3]);
                const f32x4 sh = *(const f32x4*)(mn + 4 * q), sc = *(const f32x4*)(mn + 1024 + 4 * q); const f32x4 h = y * (sc + 1.0f) + sh;
                ho[q >> 1][2 * (q & 1)] = pk2(h[0], h[1]); ho[q >> 1][2 * (q & 1) + 1] = pk2(h[2], h[3]); }
            *(u32x4*)xr = xo[0]; *(u32x4*)(xr + 8) = xo[1];
            if (INPROJ_FP8) { u32x4 h8;
#pragma unroll
                for (int q = 0; q < 4; ++q) { const f32x4 y = v[q] * rstd * gv[q] + bv[q]; const f32x4 sh = *(const f32x4*)(mn + 4 * q), sc = *(const f32x4*)(mn + 1024 + 4 * q); const f32x4 h = (y * (sc + 1.0f) + sh) * H_SCALE; h8[q] = pk4_fp8(h[0], h[1], h[2], h[3]); }
                *(u32x4*)((unsigned char*)H + (size_t)m * DM + c0) = h8; }
            else { bf16* hr = H + (size_t)m * DM + c0; *(u32x4*)hr = ho[0]; *(u32x4*)(hr + 8) = ho[1]; }
        }
    }
#undef LN2_LOAD
}

DI void build_expert_table(LAS int* tab, const unsigned* cnt_l) {
    const int tid = opaque_tid();
    __syncthreads();
    if (tid < 32) tab[33 + tid] = (int)__hip_atomic_load(cnt_l + tid * 64, __ATOMIC_RELAXED, __HIP_MEMORY_SCOPE_AGENT);
    __syncthreads();
    if (tid == 0) { int acc = 0; for (int e = 0; e < 32; ++e) { tab[e] = acc; acc += (tab[33 + e] + 255) >> 8; } tab[32] = acc; }
    __syncthreads();
}


DI void attn_phase_even(LAS unsigned char* lds, const bf16* P, const bf16* PQ, unsigned char* MIX, const float* rpb_j, const int G, const int bx, const int shadow) {
    for (int i = 0;; ++i) {
        const int L = i * G + bx;
        att::AttnP p{}; bool na = false, big = false; p.shadow = shadow;
        p.qp = NPP; p.kp = NPP; p.vp = NPP; p.op = DM; p.K2 = P; p.k2p = NPP;
        if (L < 1024) { int b = L >> 5, h = (L >> 2) & 7, qb = L & 3;
            if (G == 256) { const int x = bx & 7, j = bx >> 3, g = x + 8 * (j >> 4), jq = j & 15; b = 8 * i + (g >> 1); h = 4 * (g & 1) + (jq >> 2); qb = jq & 3; }
            const int row0 = b * TPB + CTXL + qb * 512;
            p.Q = PQ + (size_t)row0 * NPP + 1536 + 64 * h; p.K = PQ + 2048 + 64 * (h >> 2); p.V = P + 2176 + 64 * (h >> 2); p.O = MIX + (size_t)row0 * DM + 512 + 64 * h; p.kt0 = b * TPB; p.ntiles = 36; big = true; }
        else if (L < 3072) { const int L2 = L - 1024; int b = L2 >> 6, h = (L2 >> 3) & 7, rg = (L2 + (L2 >> 8)) & 7  ;
            if (G == 256) { const int x = bx & 7, j = bx >> 3, g = x + 8 * (j >> 3); b = 4 * (i - 4) + (g >> 3); h = g & 7; rg = ((j & 7) + i) & 7; }
 const int qr0 = 4 * rg, row0 = b * TPB + CTXL + qr0 * 64;
            p.Q = P + (size_t)row0 * NPP + 64 * h; p.K = P + 512 + 64 * h; p.V = P + 1024 + 64 * h; p.O = MIX + (size_t)row0 * DM + 64 * h;
            p.brow0 = b * TPB; p.na_lo = min(max(qr0 - 4, 0), 24); p.na_nloc = min(max(qr0 - 1, 0), 24) + 7 - p.na_lo + 1; p.ntiles = p.na_nloc + 4; p.qr0 = qr0; p.rpb = rpb_j + h * 465; na = true; }
        else if (L < 3584) { const int L3 = L - 3072, b = L3 >> 4, hh = L3 & 15; const int row0 = b * TPB;
            if (hh < 8) { p.Q = P + (size_t)row0 * NPP + 64 * hh; p.K = P + 512 + 64 * hh; p.V = P + 1024 + 64 * hh; p.O = MIX + (size_t)row0 * DM + 64 * hh; }
            else { const int h = hh - 8; p.Q = PQ + (size_t)row0 * NPP + 1536 + 64 * h; p.K = PQ + 2048 + 64 * (h >> 2); p.V = P + 2176 + 64 * (h >> 2); p.O = MIX + (size_t)row0 * DM + 512 + 64 * h; }
            p.kt0 = row0; p.ntiles = 4; }
        else break;
#ifndef ATT_MASK
#define ATT_MASK 15
#endif
        if (na) { if (ATT_MASK & 1) att::attn_unit<64, 1>(lds, p); } else if (big) { if (ATT_MASK & 2) att::attn_unit_w64<64>(lds, p); } else { if (ATT_MASK & 2) att::attn_unit<64, 0>(lds, p); }
    }
}
DI void attn_phase_odd(LAS unsigned char* lds, const bf16* P, const bf16* PQ, const bf16* QM, const bf16* KVM, unsigned char* MIX, const float lam, const float oml, const float* subln, const int G, const int bx, const int last, const int shadow) {
    const int total = last ? 2048 : 2432;
    for (int i = 0;; ++i) {
        const int L = i * G + bx; if (L >= total) break;
        att::AttnP p{}; bool diff = false, big = false; p.shadow = shadow;
        p.op = DM; p.K2 = PQ + 1920; p.k2p = NPP;
        if (L < 1024 || (L >= 2048 && L < 2176)) { int b, h, row0;
            if (L < 1024) { b = L >> 5; h = (L >> 3) & 3; int qb = L & 7;
                if (G == 256) { const int x = bx & 7, j = bx >> 3, g = x + 8 * (j >> 3); b = 8 * i + (g >> 2); h = g & 3; qb = j & 7; }
                row0 = b * TPB + CTXL + qb * 256; p.ntiles = 36; } else { const int L3 = L - 2048; b = L3 >> 2; h = L3 & 3; row0 = b * TPB; p.ntiles = 4; }
            p.Q = PQ + (size_t)row0 * NPP + 128 * h; p.qp = NPP; p.K = PQ + 512 + 128 * h; p.kp = NPP; p.V = P + 1024 + 128 * h; p.vp = NPP; p.O = MIX + (size_t)row0 * DM + 128 * h; p.kt0 = b * TPB; diff = true; }
        else { int b, h, row0;
            if (L < 2048) { const int L2 = L - 1024; b = L2 >> 5; h = (L2 >> 2) & 7; int qb = L2 & 3;
                if (G == 256) { const int x = bx & 7, j = bx >> 3, g = x + 8 * (j >> 2); b = 8 * (i - 4) + (g >> 3); h = g & 7; qb = j & 3; }
                row0 = b * TPB + CTXL + qb * 512; p.ntiles = 36; p.rope_q = 1; p.qpos0 = qb * 512; big = true; }
            else { const int L4 = L - 2176; b = L4 >> 3; h = L4 & 7; row0 = b * TPB; p.ntiles = 4; p.rope_q = 0; p.qpos0 = 0; }
            p.Q = QM + (size_t)row0 * 768 + 96 * h; p.qp = 768; p.K = KVM + 128 * h; p.kp = DM; p.V = KVM + 128 * h + 64; p.vp = DM; p.O = MIX + (size_t)row0 * DM + 512 + 64 * h; p.kt0 = b * TPB; }
        if (diff) { if (ATT_MASK & 4) att::attn_unit_diff(lds, p, lam, oml, subln); } else if (big) { if (ATT_MASK & 8) att::attn_unit_w64<96>(lds, p); } else { if (ATT_MASK & 8) att::attn_unit<96, 0>(lds, p); }
    }
}

constexpr int NPHASE = 2 + 9 * NL;
struct Args { const float* in[32]; float* out; unsigned char* ws; int ph_lo, ph_hi, li, pad; };
__global__ void __launch_bounds__(NTHR, 2) fwd(Args a) {
    extern __shared__ __attribute__((aligned(16))) unsigned char lds_raw[];
    LAS unsigned char* lds = (LAS unsigned char*)lds_raw;
    volatile LAS unsigned* MISC = (volatile LAS unsigned*)(lds + MISC_OFF);
    LAS int* tab = (LAS int*)(lds + MISC_OFF + 256);
    LAS int* utab = (LAS int*)(lds + pg8::UTAB_OFF); LAS unsigned* rtab = (LAS unsigned*)(lds + pg8::RTAB_OFF);
    const int tid = opaque_tid(), lane = tid & 63, wid = __builtin_amdgcn_readfirstlane(tid >> 6);
    const int G = gridDim.x, bx = blockIdx.x, gw = bx * NWAVES + wid, ngw = G * NWAVES;
    for (int u = tid; u < (LDS_BYTES - MISC_OFF) / 4; u += NTHR) MISC[u] = 0u;
    __syncthreads();
    unsigned char* ws = a.ws;
    unsigned* ctl = (unsigned*)(ws + WS_CTL);
    const int lo = a.ph_lo, hi = a.ph_hi;
    XcdBarrier bar; bar.bar = ctl + CW_BAR + a.li * XCD_BAR_WORDS; bar.x = 0; bar.st = MISC;
    if (hi - lo > 1) bar = xcd_barrier_post(ctl + CW_BAR + a.li * XCD_BAR_WORDS, MISC);
#ifndef PH_MASK
#define PH_MASK 0x7ff
#endif
#define PHM(k) (((PH_MASK) >> ((k) < 2 ? (k) : 2 + ((k) - 2) % 9)) & 1)
#define IN(k) (PHM(k) && lo <= (k) && (k) < hi)
#ifndef PROBE_DUP
#define PROBE_DUP 0
#endif
#define NREP(kind) (1 + (((PROBE_DUP) >> (kind)) & 1))
#define SEAM(k) do { if (lo <= (k) && (k) + 1 < hi) xcd_barrier(bar); } while (0)
    float* mod = (float*)(ws + WS_MOD);
    bf16* X = (bf16*)(ws + WS_X); bf16* H = (bf16*)(ws + WS_H); bf16* P = (bf16*)(ws + WS_P); bf16* QM = (bf16*)(ws + WS_QM); bf16* KVM = (bf16*)(ws + WS_KVM);
    bf16* PQ = (bf16*)(ws + WS_PQ);
    unsigned char* MIX = ws + WS_MIX; unsigned char* ACT = ws + WS_ACT; unsigned char* H8 = ws + WS_H8; unsigned char* Y = ws + WS_Y;
    unsigned* list = (unsigned*)(ws + WS_LIST); float* gsort = (float*)(ws + WS_GSORT);

    if (IN(0)) for (int rep = 0; rep < NREP(0); ++rep) {
        for (int it = bx; it < 192; it += G) p0_mod_item(lds, a.in[1], a.in[3], a.in[4], a.in[5], mod, it);
        p0_transposes(lds, a.in, ws, gw, ngw, wid, lane);
        p0_zero(ws, bx * NTHR + tid, G * NTHR);
    }
    SEAM(0);
    if (IN(1)) p0b_rows(a.in[0], a.in[2], mod, X, H, gw, ngw, lane);
    SEAM(1);
    for (int l = 0; l < NL; ++l) {
        const int tid = opaque_tid(), lane = tid & 63, wid = __builtin_amdgcn_readfirstlane(tid >> 6), gw = bx * NWAVES + wid;
        const int pb = 2 + 9 * l, odd = l & 1, j = l >> 1, last = (l == NL - 1) ? 1 : 0;
        const float* mod_l = mod + (size_t)l * 33 * 6144;
        unsigned* cnt_l = ctl + CW_CNT + l * 32 * 64;
        if (IN(pb + 0)) for (int rep = 0; rep < NREP(2); ++rep) {
#if INPROJ_FP8
            pg8::DenseSched S; S.init(H, 512, (const bf16*)(ws + WS_WIN) + (size_t)l * 2304 * 1024, 512, NTILE_M, odd ? 8 : 9, G, bx, 0);
            pg8::EpiBf16 E{P, NPP, 1.0f / (WI_SCALE * H_SCALE)};
            pg8::gemm_phase<true>(lds, 1024, S, E);
#else
            pg8::DenseSched S; S.init(H, DM, (const bf16*)(ws + WS_WIN) + (size_t)l * 2304 * 1024, 1024, NTILE_M, odd ? 8 : 9, G, bx, 0);
            pg8::EpiBf16 E{P, NPP, 1.0f};
            pg8::gemm_phase<false>(lds, 2048, S, E);
#endif
        }
        SEAM(pb + 0);
        if (IN(pb + 1)) {
            if (odd) post_odd_rows(P, PQ, a.in[22] + j * 256, a.in[24] + j * 128, gw, ngw, lane);
            else post_even_rows(P, PQ, a.in[13] + j * 64, a.in[14] + j * 64, gw, ngw, lane);
        }
        SEAM(pb + 1);
        if (odd) {
            if (IN(pb + 2)) for (int rep = 0; rep < NREP(4); ++rep) {
                { pg8::DenseSched S; S.init(PQ + 1536, NPP, (const bf16*)(ws + WS_WUQ) + (size_t)j * 768 * 256, 256, NTILE_M, 3, G, bx, 0); pg8::EpiBf16 E{QM, 768, 1.0f}; pg8::gemm_phase<false>(lds, 512, S, E); }
                { pg8::DenseSched S; S.init(PQ + 1792, NPP, (const bf16*)(ws + WS_WUKV) + (size_t)j * 1024 * 256, 256, NTILE_M, 4, G, (bx + G - (NTILE_M * 3) % G) % G, 0); pg8::EpiBf16 E{KVM, DM, 1.0f}; pg8::gemm_phase<false>(lds, 512, S, E); }
            }
            SEAM(pb + 2);
        }
        if (IN(pb + 3)) for (int rep = 0; rep < NREP(5); ++rep) {
            if (odd) {
                const float s1 = wave_sum(a.in[17][j * 64 + lane] * a.in[18][j * 64 + lane]), s2 = wave_sum(a.in[19][j * 64 + lane] * a.in[20][j * 64 + lane]);
                const float lam_init = (l == 1) ? 0.35550906759310934f : 0.55605820415610350f;
                const float lam = __expf(s1) - __expf(s2) + lam_init;
#ifndef PROBE_SHADOW
#define PROBE_SHADOW 0
#endif
                attn_phase_odd(lds, P, PQ, QM, KVM, rep ? ACT : MIX, lam, 1.0f - lam_init, a.in[21] + j * 128, G, bx, last, rep ? PROBE_SHADOW : 0);
            } else attn_phase_even(lds, P, PQ, rep ? ACT : MIX, a.in[12] + (size_t)j * 8 * 465, G, bx, rep ? PROBE_SHADOW : 0);
        }
        SEAM(pb + 3 - ((odd || true) ? 0 : 0));
        if (IN(pb + 4)) {
            pg8::DenseSched S; S.init((const bf16*)MIX, 512, (const bf16*)(ws + WS_WOUT + (size_t)l * 1024 * 1024), 512, last ? 256 : NTILE_M, 4, G, bx, last);
            pg8::EpiResid E{X, mod_l};
            pg8::gemm_phase<true>(lds, 1024, S, E);
        }
        const int pre_rt = (IN(pb + 4) && IN(pb + 5) && G == 256) ? 1 : 0;
        if (pre_rt) { __syncthreads(); ln1_router_table(lds, a.in[26] + (size_t)l * 1024 * 32); }
        SEAM(pb + 4);
        if (IN(pb + 5)) {
            for (int wg = bx; wg < 256; wg += G)
                ln1_router_phase(lds, X, H8, mod_l, a.in[6] + l * 1024, a.in[7] + l * 1024, a.in[26] + (size_t)l * 1024 * 32, a.in[27] + l * 32, cnt_l, list, gsort, wg, last, pre_rt);
        }
        SEAM(pb + 5);
        if (IN(pb + 6)) for (int rep = 0; rep < NREP(8); ++rep) {
            build_expert_table(tab, cnt_l);
            const int nun = pg8::build_unit_table(tab, utab, 8, G, bx);
            pg8::GroupSched S{tab, utab, rtab, nun, 8, G, bx, 1024, (const char*)H8, list, gsort, 1, (const char*)(ws + WS_WGU + (size_t)l * 32 * 2048 * 1024), (size_t)2048 * 1024, a.in[29] + (size_t)l * 32 * 2048, 2048};
            S.fill_sync(0, tid); S.fill_sync(1, tid); __syncthreads();
            pg8::EpiSwiglu E{ACT, rtab};
            pg8::gemm_phase<true>(lds, 1024, S, E);
        }
        int nun_d = -1;
        if (IN(pb + 6) && IN(pb + 7) && NREP(9) == 1) {
            __syncthreads();
            build_expert_table(tab, cnt_l);
            nun_d = pg8::build_unit_table(tab, utab, 4, G, bx);
            pg8::GroupSched S{tab, utab, rtab, nun_d, 4, G, bx, 1024, (const char*)ACT, list, gsort, 0, (const char*)(ws + WS_WD + (size_t)l * 32 * 1024 * 1024), (size_t)1024 * 1024, a.in[31] + (size_t)l * 32 * 1024, 1024};
            S.fill_sync(0, tid);
        }
        SEAM(pb + 6);
        if (IN(pb + 7)) for (int rep = 0; rep < NREP(9); ++rep) {
            int nun = nun_d;
            if (nun_d < 0) { build_expert_table(tab, cnt_l); nun = pg8::build_unit_table(tab, utab, 4, G, bx); }
            pg8::GroupSched S{tab, utab, rtab, nun, 4, G, bx, 1024, (const char*)ACT, list, gsort, 0, (const char*)(ws + WS_WD + (size_t)l * 32 * 1024 * 1024), (size_t)1024 * 1024, a.in[31] + (size_t)l * 32 * 1024, 1024};
            if (nun_d < 0) S.fill_sync(0, tid);
            __syncthreads();
            pg8::EpiDown E{Y, rtab, tab};
            pg8::gemm_phase<true>(lds, 1024, S, E);
        }
        SEAM(pb + 7);
        if (IN(pb + 8)) {
            for (int wg = bx; wg < 256; wg += G)
                ln2_phase(X, Y, H, a.out, mod_l, mod + (size_t)(last ? l : l + 1) * 33 * 6144, a.in[6] + l * 1024, a.in[7] + l * 1024, a.in[8] + l * 1024, a.in[9] + l * 1024, wg, last, wid, lane);
        }
        SEAM(pb + 8);
    }
#undef IN
#undef SEAM
}

extern "C" void kernel_launch(void* const* d_in, const int* in_sizes, int n_in, void* d_out, int out_size, void* d_ws, size_t ws_size, hipStream_t stream) {
    static int grid = 0;
    if (grid == 0) {
        if (n_in != 32 || ws_size < WS_END || out_size != NBATCH * SEQ * DM) { fprintf(stderr, "kernel_launch: unexpected shapes (n_in %d, out %d, ws %zu)\n", n_in, out_size, ws_size); grid = -1; return; }
        int dev = 0, cus = 0, per_cu = 0;
        if (hipGetDevice(&dev) != hipSuccess || hipDeviceGetAttribute(&cus, hipDeviceAttributeMultiprocessorCount, dev) != hipSuccess) { grid = -1; return; }
        if (hipFuncSetAttribute((const void*)fwd, hipFuncAttributeMaxDynamicSharedMemorySize, LDS_BYTES) != hipSuccess) { fprintf(stderr, "kernel_launch: hipFuncSetAttribute failed\n"); grid = -1; return; }
        if (hipOccupancyMaxActiveBlocksPerMultiprocessor(&per_cu, (const void*)fwd, NTHR, LDS_BYTES) != hipSuccess || per_cu < 1) fprintf(stderr, "kernel_launch: occupancy query reports %d\n", per_cu);
        (void)hipGetLastError();
        grid = cus < 256 ? cus : 256;
    }
    if (grid < 0) return;
    (void)hipMemsetAsync((char*)d_ws + WS_CTL, 0, CTL_ZERO_BYTES, stream);
    Args a{};
    for (int i = 0; i < 32; ++i) a.in[i] = (const float*)d_in[i];
    a.out = (float*)d_out; a.ws = (unsigned char*)d_ws;
#if MK_ONE_LAUNCH
    a.ph_lo = 0; a.ph_hi = NPHASE; a.li = 0;
    hipLaunchKernelGGL(fwd, dim3(grid), dim3(NTHR), LDS_BYTES, stream, a);
#else
    int li = 0;
    for (int ph = 0; ph < NPHASE; ++ph) {
        if (ph >= 2 && ((ph - 2) % 9) == 2 && (((ph - 2) / 9) & 1) == 0) continue;
        a.ph_lo = ph; a.ph_hi = ph + 1; a.li = 0; ++li;
        hipLaunchKernelGGL(fwd, dim3(grid), dim3(NTHR), LDS_BYTES, stream, a);
    }
#endif
}
```

```cpp
#include <hip/hip_runtime.h>
#include <cstdio>
#include <cstdint>

#ifndef MK_ONE_LAUNCH
#define MK_ONE_LAUNCH 1
#endif
#ifndef PROBE_SHADOW
#define PROBE_SHADOW 0
#endif

#define GAS __attribute__((address_space(1)))
#define LAS __attribute__((address_space(3)))
#define DI __device__ __forceinline__
typedef unsigned short bf16;
typedef short bf16x8 __attribute__((ext_vector_type(8)));
typedef short s16x4 __attribute__((ext_vector_type(4)));
typedef float f32x2 __attribute__((ext_vector_type(2)));
typedef float f32x4 __attribute__((ext_vector_type(4)));
typedef float f32x16 __attribute__((ext_vector_type(16)));
typedef unsigned u32x2 __attribute__((ext_vector_type(2)));
typedef unsigned u32x4 __attribute__((ext_vector_type(4)));

constexpr int DM = 1024, NBATCH = 32, SEQ = 2048, CTXL = 256, TPB = SEQ + CTXL  ;
constexpr int T = NBATCH * TPB;
constexpr int NL = 4, NPP = 2304;
constexpr int NE = 32, DE = 1024;
constexpr int NTILE_M = T / 256;
constexpr float LOG2E = 1.4426950408889634f;
constexpr float C2 = 0.125f * LOG2E;
constexpr float C2M = 0.10206207261596575f * LOG2E;
constexpr float DN_ALPHA = 1.6817928305074290f;
constexpr float LN_EPS = 1e-6f, RMS_EPS = 1e-6f;
constexpr float LOG2_THETA = 13.287712379549449f;

constexpr size_t MiB = 1u << 20;
constexpr size_t WS_CTL = 0, CTL_ZERO_BYTES = 1 * MiB;
constexpr size_t WS_MOD = 1 * MiB;
constexpr size_t WS_WIN = 8 * MiB;
constexpr size_t WS_WOUT = 28 * MiB;
constexpr size_t WS_WUQ = 36 * MiB;
constexpr size_t WS_WUKV = 37 * MiB;
constexpr size_t WS_LIST = 40 * MiB;
constexpr size_t WS_GATE = 50 * MiB;
constexpr size_t WS_WGU = 64 * MiB;
constexpr size_t WS_WD = 576 * MiB;
constexpr size_t WS_X = 832 * MiB;
constexpr size_t WS_H = 1120 * MiB;
constexpr size_t WS_P = 1264 * MiB;
constexpr size_t WS_QM = 1588 * MiB;
constexpr size_t WS_KVM = 1696 * MiB;
constexpr size_t WS_MIX = 1840 * MiB;
constexpr size_t WS_ACT = 1984 * MiB;
constexpr size_t WS_Y = 2576 * MiB;
constexpr size_t WS_H8 = 3152 * MiB;
constexpr size_t WS_GSORT = 3224 * MiB;
constexpr size_t WS_PQ = 3234 * MiB;
constexpr size_t WS_END = 3558 * MiB;
constexpr float WGU_SCALE = 64.0f, WD_SCALE = 128.0f, Y_SCALE = 64.0f, WO_SCALE = 128.0f, MIX_SCALE = 16.0f;
#ifndef INPROJ_FP8
#define INPROJ_FP8 1
#endif
constexpr float WI_SCALE = 64.0f, H_SCALE = 8.0f;
constexpr int ACT_ROWS = T * 4 + 32 * 256;
static_assert(WS_MOD + (size_t)4 * 33 * 6144 * 4 <= WS_WIN && WS_WIN + (size_t)4 * 2304 * 1024 * 2 <= WS_WOUT && WS_LIST + (size_t)32 * T * 4 <= WS_GATE && WS_GATE + (size_t)T * 16 <= WS_WGU, "ws map 1");
static_assert(WS_X + (size_t)T * 4096 <= WS_H && WS_H + (size_t)T * 2048 <= WS_P && WS_P + (size_t)T * NPP * 2 <= WS_QM && WS_QM + (size_t)T * 768 * 2 <= WS_KVM && WS_KVM + (size_t)T * 2048 <= WS_MIX, "ws map 2");
static_assert(WS_MIX + (size_t)T * 2048 <= WS_ACT && WS_ACT + (size_t)ACT_ROWS * 2048 <= WS_Y && WS_Y + (size_t)T * 4 * 2048 <= WS_H8 && WS_H8 + (size_t)T * 1024 <= WS_GSORT && WS_GSORT + (size_t)32 * T * 4 <= WS_PQ && WS_PQ + (size_t)T * NPP * 2 <= WS_END, "ws map 3");
constexpr int CW_TMO = 0;
constexpr int CW_CNT = 1024;
constexpr int CW_BAR = 16384;
constexpr int MAX_LAUNCH = 40;
static_assert(CW_CNT + 4 * 32 * 64 <= CW_BAR && (CW_BAR + MAX_LAUNCH * 3456) * 4 <= (int)CTL_ZERO_BYTES, "ctl");

constexpr int LDS_BYTES = 147456;
constexpr int MISC_OFF = 143360;
constexpr int NWAVES = 8, NTHR = 512;

DI unsigned f2bf(float f) { unsigned u = __builtin_bit_cast(unsigned, f); return (u + 0x7fffu + ((u >> 16) & 1u)) >> 16; }
DI unsigned pk2(float lo, float hi) { return f2bf(lo) | (f2bf(hi) << 16); }
DI float bf2f(unsigned short b) { return __builtin_bit_cast(float, (unsigned)b << 16); }
DI float bflo(unsigned w) { return __builtin_bit_cast(float, w << 16); }
DI float bfhi(unsigned w) { return __builtin_bit_cast(float, w & 0xffff0000u); }
#define WS_DPP(v, ctrl, rmask) __builtin_bit_cast(float, __builtin_amdgcn_update_dpp(0, __builtin_bit_cast(int, v), ctrl, rmask, 0xf, false))
DI float wave_sum(float v) {
    v += WS_DPP(v, 0xB1, 0xf);
    v += WS_DPP(v, 0x4E, 0xf);
    v += WS_DPP(v, 0x141, 0xf);
    v += WS_DPP(v, 0x140, 0xf);
    v += WS_DPP(v, 0x142, 0xa);
    v += WS_DPP(v, 0x143, 0xc);
    return __builtin_bit_cast(float, __builtin_amdgcn_readlane(__builtin_bit_cast(int, v), 63));
}
DI float fast_exp2(float x) { return __builtin_amdgcn_exp2f(x); }
DI unsigned pk4_fp8(float a, float b, float c, float d) { unsigned w = __builtin_amdgcn_cvt_pk_fp8_f32(a, b, 0u, false); return __builtin_amdgcn_cvt_pk_fp8_f32(c, d, w, true); }
DI int opaque_tid() { int t = threadIdx.x; asm volatile("" : "+v"(t)); return t; }
DI const char* uni_ptr(const char* p) { const unsigned long long v = (unsigned long long)p; const unsigned lo = __builtin_amdgcn_readfirstlane((unsigned)v), hi = __builtin_amdgcn_readfirstlane((unsigned)(v >> 32)); return (const char*)(((unsigned long long)hi << 32) | lo); }

#define XB_TMO      128
#define XB_XCNT(j)  (256  + 64 * (j))
#define XB_XSUB(j)  (1280 + 64 * (j))
#define XB_XGEN(j)  (2304 + 64 * (j))
#define XB_TOP      3328
#define XB_TOPGEN   3392
#define XCD_BAR_WORDS 3456
#define XB_SPIN_CAP (1u << 22)
DI unsigned xb_ld(unsigned* p)              { return __hip_atomic_load(p, __ATOMIC_RELAXED, __HIP_MEMORY_SCOPE_AGENT); }
DI unsigned xb_add(unsigned* p, unsigned v) { return __hip_atomic_fetch_add(p, v, __ATOMIC_RELAXED, __HIP_MEMORY_SCOPE_AGENT); }
DI unsigned xb_xcc_id() { return (unsigned)__builtin_amdgcn_s_getreg((3 << 11) | 20) & 0xFu; }
#define XB_SPIN(cond, bar) do { unsigned _sp = 0; while (cond) { __builtin_amdgcn_s_sleep(1); \
    if ((++_sp & 255u) == 0u) { if (xb_ld(&(bar)[XB_TMO])) break; if (_sp > XB_SPIN_CAP) { atomicAdd(&(bar)[XB_TMO], 1u); break; } } } } while (0)
struct XcdBarrier { unsigned* bar; unsigned x; volatile LAS unsigned* st; };
DI XcdBarrier xcd_barrier_post(unsigned* bar, volatile LAS unsigned* st) {
    XcdBarrier b; b.bar = bar; b.x = xb_xcc_id(); b.st = st;
    if (threadIdx.x == 0) (void)xb_add(&bar[XB_XCNT(b.x)], 1u);
    return b;
}
DI void xcd_barrier_complete(unsigned* bar, unsigned x, unsigned& nloc, unsigned& nx) {
    const unsigned G = gridDim.x * gridDim.y * gridDim.z;
    unsigned sum, cnt, mine, sp = 0u;
    for (;;) {
        sum = 0u; cnt = 0u; mine = 0u;
#pragma unroll
        for (unsigned j = 0; j < 16; ++j) { const unsigned c = xb_ld(&bar[XB_XCNT(j)]); sum += c; cnt += (c > 0u) ? 1u : 0u; mine = (j == x) ? c : mine; }
        if (sum == G) break;
        __builtin_amdgcn_s_sleep(1);
        if ((++sp & 255u) == 0u) { if (xb_ld(&bar[XB_TMO])) break; if (sp > XB_SPIN_CAP) { atomicAdd(&bar[XB_TMO], 1u); break; } }
    }
    nloc = mine > 0u ? mine : 1u; nx = cnt > 0u ? cnt : 1u;
}
DI void xcd_barrier(const XcdBarrier& b) {
    asm volatile("s_waitcnt vmcnt(0)" ::: "memory");
    __syncthreads();
    if (threadIdx.x == 0) {
        unsigned* bar = b.bar;
        __builtin_amdgcn_s_waitcnt(0);
        unsigned nloc = b.st[0], nx = b.st[1];
        if (nloc == 0u) { xcd_barrier_complete(bar, b.x, nloc, nx); b.st[0] = nloc; b.st[1] = nx; }
        const unsigned old = xb_add(&bar[XB_XSUB(b.x)], 1u);
        const unsigned gen = old / nloc;
        if (old + 1u == (gen + 1u) * nloc) {
            __builtin_amdgcn_fence(__ATOMIC_RELEASE, "agent");
            asm volatile("s_waitcnt vmcnt(0)" ::: "memory");
            const unsigned og = xb_add(&bar[XB_TOP], 1u);
            const unsigned tg = og / nx;
            if (og + 1u == (tg + 1u) * nx) xb_add(&bar[XB_TOPGEN], 1u);
            else XB_SPIN(xb_ld(&bar[XB_TOPGEN]) == tg, bar);
            __builtin_amdgcn_fence(__ATOMIC_ACQUIRE, "agent");
            xb_add(&bar[XB_XGEN(b.x)], 1u);
            asm volatile("s_waitcnt vmcnt(0)" ::: "memory");
        } else {
            XB_SPIN(xb_ld(&bar[XB_XGEN(b.x)]) == gen, bar);
            __builtin_amdgcn_fence(__ATOMIC_ACQUIRE, "agent");
            asm volatile("s_waitcnt vmcnt(0)" ::: "memory");
        }
    }
    __syncthreads();
}

namespace pg8 {
constexpr int BM = 256, BK = 64, HALF = 128, HTB = HALF * BK * 2, STAGE_BYTES = 8 * HTB, NXCD = 8, WGM = 8;
DI int lds_byte(int r, int c) { const int st = (r >> 4) * 2 + (c >> 5), rr = r & 15, cc = c & 31, ob = rr * 64 + cc * 2; return st * 1024 + (ob ^ (((ob >> 9) & 1) << 5)); }
DI void stage_rc(int b, int& R, int& C) { const int st = b / 1024, sb = b % 1024, swz = sb ^ (((sb >> 9) & 1) << 5); R = (st >> 1) * 16 + swz / 64; C = (st & 1) * 32 + (swz % 64) / 2; }
DI int perm32(int rho) { const int n = rho >> 4, i = rho & 15; return 8 * (i >> 2) + 4 * n + (i & 3); }
DI void glds_s(const char* base, unsigned voff, unsigned dst) { unsigned keep;
    asm volatile("s_mov_b32 %0, m0\n\ts_mov_b32 m0, %3\n\ts_nop 4\n\tglobal_load_lds_dwordx4 %1, %2\n\ts_mov_b32 m0, %0" : "=&s"(keep) : "v"(voff), "s"(base), "s"(dst) : "memory"); }
DI void glds_dword(const char* base, unsigned voff, unsigned dst) { unsigned keep;
    asm volatile("s_mov_b32 %0, m0\n\ts_mov_b32 m0, %3\n\ts_nop 4\n\tglobal_load_lds_dword %1, %2\n\ts_mov_b32 m0, %0" : "=&s"(keep) : "v"(voff), "s"(base), "s"(dst) : "memory"); }
typedef float f32x2_cv __attribute__((ext_vector_type(2))); typedef __bf16 bf16x2_cv __attribute__((ext_vector_type(2)));
DI unsigned cvt_pk_bf16(float lo, float hi) { const f32x2_cv v = {lo, hi}; const bf16x2_cv b = __builtin_convertvector(v, bf16x2_cv); return __builtin_bit_cast(unsigned, b); }

typedef int i32x4v __attribute__((ext_vector_type(4)));
typedef int i32x8v __attribute__((ext_vector_type(8)));
DI i32x8v cat8(const bf16x8 a, const bf16x8 b) { return __builtin_shufflevector(__builtin_bit_cast(i32x4v, a), __builtin_bit_cast(i32x4v, b), 0, 1, 2, 3, 4, 5, 6, 7); }
DI void mfma_fp8_acc(f32x4& c, const i32x8v a, const i32x8v b) { asm volatile("v_mfma_f32_16x16x128_f8f6f4 %0, %1, %2, %0" : "+v"(c) : "v"(a), "v"(b)); }
DI void mfma_fp8_new(f32x4& c, const i32x8v a, const i32x8v b) { asm volatile("v_mfma_f32_16x16x128_f8f6f4 %0, %1, %2, 0" : "=&v"(c) : "v"(a), "v"(b)); }
#define MFMA_DRAIN() asm volatile("s_nop 15\n\ts_nop 15\n\ts_nop 15\n\ts_nop 15\n\ts_nop 15" ::: "memory")
struct Unit { int pm, pn, e, mt, idx; };

template <bool FP8, class Epi, class Sched>
DI void gemm_phase(LAS unsigned char* lds, const int KB_in, const Sched& S, const Epi& E) {
    int K = KB_in; asm volatile("" : "+s"(K));
    const int tid = opaque_tid(), wid = __builtin_amdgcn_readfirstlane(tid >> 6), lane = tid & 63, wr = wid >> 2, wc = wid & 3, fr = lane & 15, fq = lane >> 4;
    const int nt = K / 128;
    int Rr[2], Cc[2]; unsigned voffB[2];
#pragma unroll
    for (int i = 0; i < 2; ++i) { int R, C; stage_rc(tid * 16 + i * 8192, R, C); Rr[i] = R; Cc[i] = C; const int Rb = (R & ~31) + perm32(R & 31); voffB[i] = (unsigned)(Rb * K + C * 2); }
    const size_t kstep = (size_t)128;
    const size_t hstepB = (size_t)HALF * K;
    const unsigned ldsw = (unsigned)wid * 1024u;
    const unsigned ldsbase = (unsigned)(size_t)lds;
    const int aoff = lds_byte(wr * 64 + fr, fq * 8), boff = lds_byte(wc * 32 + fr, fq * 8);
#define PG8_SA(b, h) (((b) * 2 + (h)) * HTB)
#define PG8_SB(b, h) ((4 + (b) * 2 + (h)) * HTB)
#define PG8_STAGE(bufoff, gbase, voff) do { _Pragma("unroll") for (int _i = 0; _i < 2; ++_i) \
        glds_s((const char*)(gbase), (voff)[_i], ldsbase + (unsigned)(bufoff) + ldsw + (unsigned)(_i * 8192)); } while (0)
#define PG8_LDA(dst, b, h) do { _Pragma("unroll") for (int m = 0; m < 4; ++m) _Pragma("unroll") for (int k = 0; k < 2; ++k) dst[m][k] = *(const LAS bf16x8*)(lds + PG8_SA(b, h) + aoff + m * 2048 + k * 1024); } while (0)
#define PG8_LDB(dst, b, h) do { _Pragma("unroll") for (int n = 0; n < 2; ++n) _Pragma("unroll") for (int k = 0; k < 2; ++k) dst[n][k] = *(const LAS bf16x8*)(lds + PG8_SB(b, h) + boff + n * 2048 + k * 1024); } while (0)
#define PG8_MMA(ai, bj, At, Bt, ZC) do { __builtin_amdgcn_s_setprio(1); _Pragma("unroll") for (int m = 0; m < 4; ++m) _Pragma("unroll") for (int n = 0; n < 2; ++n) { \
        if constexpr (FP8) { if (ZC) mfma_fp8_new(acc[ai][bj][m][n], cat8(Bt[n][0], Bt[n][1]), cat8(At[m][0], At[m][1])); else mfma_fp8_acc(acc[ai][bj][m][n], cat8(Bt[n][0], Bt[n][1]), cat8(At[m][0], At[m][1])); } \
        else { acc[ai][bj][m][n] = __builtin_amdgcn_mfma_f32_16x16x32_bf16(Bt[n][0], At[m][0], acc[ai][bj][m][n], 0, 0, 0); \
               acc[ai][bj][m][n] = __builtin_amdgcn_mfma_f32_16x16x32_bf16(Bt[n][1], At[m][1], acc[ai][bj][m][n], 0, 0, 0); } } \
        __builtin_amdgcn_s_setprio(0); } while (0)
#define PG8_WAIT_V(n) asm volatile("s_waitcnt vmcnt(" #n ")" ::: "memory")
#define PG8_WAIT_L(n) asm volatile("s_waitcnt lgkmcnt(" #n ")" ::: "memory")
#define PG8_BAR __builtin_amdgcn_s_barrier()
#define PG8_SCHED __builtin_amdgcn_sched_barrier(0)
    Unit cur, nxt; int ui = 0;
    if (!S.next(0, cur)) return;
    f32x4 acc[2][2][4][2];
#define PG8_ZERO_ACC() do { if constexpr (!FP8) { _Pragma("unroll") for (int a = 0; a < 2; ++a) _Pragma("unroll") for (int b = 0; b < 2; ++b) _Pragma("unroll") for (int m = 0; m < 4; ++m) _Pragma("unroll") for (int n = 0; n < 2; ++n) acc[a][b][m][n] = (f32x4){0.f, 0.f, 0.f, 0.f}; } } while (0)
    PG8_ZERO_ACC();
    bf16x8 At[4][2], B0[2][2], B1[2][2];
    unsigned cvo0[2], cvo1[2], nvo0[2], nvo1[2];
    S.a_off(cur, Rr, Cc, cvo0, cvo1);
    asm volatile("" : "+v"(cvo0[0]), "+v"(cvo0[1]), "+v"(cvo1[0]), "+v"(cvo1[1]), "+v"(voffB[0]), "+v"(voffB[1]));
    const char* const aB = uni_ptr(S.a_base());
    const char* cB = uni_ptr(S.b_base(cur));
    PG8_STAGE(PG8_SB(0, 0), cB, voffB); PG8_STAGE(PG8_SB(0, 1), cB + hstepB, voffB); PG8_STAGE(PG8_SA(0, 0), aB, cvo0); PG8_STAGE(PG8_SA(0, 1), aB, cvo1);
    if (wr == 1) PG8_BAR;
    PG8_WAIT_V(2); PG8_BAR;
    PG8_STAGE(PG8_SB(1, 0), cB + kstep, voffB); PG8_STAGE(PG8_SA(1, 0), aB + kstep, cvo0); PG8_STAGE(PG8_SB(1, 1), cB + hstepB + kstep, voffB);
    PG8_WAIT_V(6); PG8_BAR;
    for (;;) {
        const bool has_next = S.next(ui + 1, nxt);
        const char* nB = uni_ptr(has_next ? S.b_base(nxt) : cB);
        if (has_next) { int R2[2], C2[2]; const int tid2 = opaque_tid();
#pragma unroll
            for (int i = 0; i < 2; ++i) stage_rc(tid2 * 16 + i * 8192, R2[i], C2[i]);
            S.a_off(nxt, R2, C2, nvo0, nvo1); }
        else { nvo0[0] = cvo0[0]; nvo0[1] = cvo0[1]; nvo1[0] = cvo1[0]; nvo1[1] = cvo1[1]; }
        asm volatile("" : "+v"(nvo0[0]), "+v"(nvo0[1]), "+v"(nvo1[0]), "+v"(nvo1[1]));
#define PG8_KITER(ZC_) do { \
            const bool last = (t == nt - 2); \
            const char* a1 = aB + (size_t)(t + 1) * kstep; \
            const char* a2 = last ? aB : aB + (size_t)(t + 2) * kstep; const char* b2 = last ? nB : cB + (size_t)(t + 2) * kstep; \
            const char* a3 = a2 + kstep; const char* b3 = b2 + kstep; \
            unsigned v20[2], v21[2]; \
            v20[0] = last ? nvo0[0] : cvo0[0]; v20[1] = last ? nvo0[1] : cvo0[1]; v21[0] = last ? nvo1[0] : cvo1[0]; v21[1] = last ? nvo1[1] : cvo1[1]; \
            if constexpr (Sched::HAS_FILL) { if (t == 2) S.fill_async(ui, wid, lane); } \
            PG8_LDB(B0, 0, 0); PG8_LDB(B1, 0, 1); PG8_SCHED; PG8_LDA(At, 0, 0); PG8_STAGE(PG8_SA(1, 1), a1, cvo1); \
            PG8_WAIT_V(8); PG8_WAIT_L(0); PG8_BAR; PG8_MMA(0, 0, At, B0, ZC_); PG8_MMA(0, 1, At, B1, ZC_); PG8_BAR; PG8_SCHED; \
            PG8_LDA(At, 0, 1); PG8_STAGE(PG8_SB(0, 0), b2, voffB); PG8_STAGE(PG8_SB(0, 1), b2 + hstepB, voffB); PG8_STAGE(PG8_SA(0, 0), a2, v20); \
            PG8_WAIT_V(8); PG8_WAIT_L(0); PG8_BAR; PG8_MMA(1, 0, At, B0, ZC_); PG8_MMA(1, 1, At, B1, ZC_); PG8_BAR; PG8_SCHED; \
            PG8_LDB(B0, 1, 0); PG8_LDB(B1, 1, 1); PG8_SCHED; PG8_LDA(At, 1, 0); PG8_STAGE(PG8_SA(0, 1), a2, v21); \
            PG8_WAIT_V(8); PG8_WAIT_L(0); PG8_BAR; PG8_MMA(0, 0, At, B0, false); PG8_MMA(0, 1, At, B1, false); PG8_BAR; PG8_SCHED; \
            PG8_LDA(At, 1, 1); PG8_STAGE(PG8_SB(1, 0), b3, voffB); PG8_STAGE(PG8_SB(1, 1), b3 + hstepB, voffB); PG8_STAGE(PG8_SA(1, 0), a3, v20); \
            PG8_WAIT_V(8); PG8_WAIT_L(0); PG8_BAR; PG8_MMA(1, 0, At, B0, false); PG8_MMA(1, 1, At, B1, false); PG8_BAR; PG8_SCHED; \
        } while (0)
        if constexpr (FP8) {
            { int t = 0; PG8_KITER(true); }
            for (int t = 2; t < nt; t += 2) PG8_KITER(false);
        } else {
            for (int t = 0; t < nt; t += 2) PG8_KITER(false);
        }
#undef PG8_KITER
        if (wr == 0) PG8_BAR;
        if constexpr (FP8) MFMA_DRAIN();
        { const int tid3 = opaque_tid(), wid3 = __builtin_amdgcn_readfirstlane(tid3 >> 6), lane3 = tid3 & 63; E(acc, cur, wid3 >> 2, wid3 & 3, lane3 & 15, lane3 >> 4); }
        if (!has_next) break;
        PG8_ZERO_ACC();
        cur = nxt; cB = nB; cvo0[0] = nvo0[0]; cvo0[1] = nvo0[1]; cvo1[0] = nvo1[0]; cvo1[1] = nvo1[1]; ++ui;
        if (wr == 1) PG8_BAR;
    }
    PG8_WAIT_V(0);
    PG8_BAR;
#undef PG8_SA
#undef PG8_SB
#undef PG8_STAGE
#undef PG8_LDA
#undef PG8_LDB
#undef PG8_MMA
#undef PG8_WAIT_V
#undef PG8_WAIT_L
#undef PG8_BAR
#undef PG8_SCHED
}

struct DenseSched {
    const bf16* A; int lda; const bf16* Bt; int K; int nM, nN, nwg, G, c; int skip_ctx;
    DI void init(const bf16* A_, int lda_, const bf16* Bt_, int K_, int nM_, int nN_, int G_, int c_, int skip) { A = A_; lda = lda_; Bt = Bt_; K = K_; nM = nM_; nN = nN_; nwg = nM * nN; G = G_; c = c_; skip_ctx = skip; }
    DI bool next(int i, Unit& u) const {
        const long L = (long)i * G + c; if (L >= nwg) return false;
        int wgid = (int)L; { const int q = nwg / NXCD, r = nwg % NXCD, xcd = wgid % NXCD, off = wgid / NXCD; wgid = (xcd < r ? xcd * (q + 1) : r * (q + 1) + (xcd - r) * q) + off; }
        const int nig = WGM * nN, gid = wgid / nig, fm = gid * WGM, gsz = (nM - fm) < WGM ? (nM - fm) : WGM;
        int pm = fm + ((wgid % nig) % gsz); u.pn = (wgid % nig) / gsz;
        if (skip_ctx) pm = pm + pm / 8 + 1;
        u.pm = pm; u.e = 0; u.mt = 0; u.idx = i; return true;
    }
    static constexpr bool HAS_FILL = false;
    DI void fill_async(int, int, int) const {}
    DI const char* a_base() const { return (const char*)A; }
    DI const char* b_base(const Unit& u) const { return (const char*)Bt + (size_t)u.pn * 256 * K * 2; }
    DI void a_off(const Unit& u, const int (&R)[2], const int (&C)[2], unsigned (&o0)[2], unsigned (&o1)[2]) const {
#pragma unroll
        for (int i = 0; i < 2; ++i) { o0[i] = (unsigned)((u.pm * 256 + R[i]) * lda + C[i]) * 2u; o1[i] = (unsigned)((u.pm * 256 + 128 + R[i]) * lda + C[i]) * 2u; }
    }
};

constexpr int UTAB_OFF = 131072, RTAB_OFF = 132096;
constexpr int RSLOT = 768;
struct GroupSched {
    const LAS int* tab; const LAS int* utab; LAS unsigned* rtab; int nunits;
    int nN, G, c, K;
    const char* Abase; const unsigned* list; const float* gsort; int gather;
    const char* Bbase; size_t b_estride;
    const float* bias_l; int bias_estride;
    static constexpr bool HAS_FILL = true;
    DI bool next(int i, Unit& u) const {
        if (i >= nunits) return false;
        const int w0 = __builtin_amdgcn_readfirstlane(utab[2 * i]), w1 = __builtin_amdgcn_readfirstlane(utab[2 * i + 1]);
        u.pm = w0; u.e = w1 >> 16; u.mt = (w1 >> 3) & 0x1fff; u.pn = w1 & 7; u.idx = i; return true;
    }
    DI const char* a_base() const { return Abase; }
    DI const char* b_base(const Unit& u) const { return Bbase + (size_t)u.e * b_estride + (size_t)u.pn * 256 * K; }
    DI void a_off(const Unit& u, const int (&R)[2], const int (&C)[2], unsigned (&o0)[2], unsigned (&o1)[2]) const {
        if (gather) {
            const LAS unsigned* rt = rtab + (u.idx & 1) * RSLOT;
#pragma unroll
            for (int i = 0; i < 2; ++i) { const unsigned p0 = rt[R[i]], p1 = rt[128 + R[i]];
                o0[i] = (p0 >> 2) * 1024u + (unsigned)C[i] * 2u; o1[i] = (p1 >> 2) * 1024u + (unsigned)C[i] * 2u; }
        } else {
#pragma unroll
            for (int i = 0; i < 2; ++i) { o0[i] = (unsigned)((u.pm * 256 + R[i]) * 1024 + C[i] * 2); o1[i] = (unsigned)((u.pm * 256 + 128 + R[i]) * 1024 + C[i] * 2); }
        }
    }
    DI void fill_sync(int k, int tid) const {
        Unit u; if (!next(k, u)) return;
        const int cnt = __builtin_amdgcn_readfirstlane(tab[33 + u.e]); int idx = u.mt * 256 + (tid & 255); idx = idx < cnt ? idx : cnt - 1;
        LAS unsigned* rt = rtab + (k & 1) * RSLOT;
        if (tid < 256) { rt[tid] = list[(size_t)u.e * T + idx]; rt[512 + tid] = __builtin_bit_cast(unsigned, bias_l[(size_t)u.e * bias_estride + 256 * u.pn + tid]); }
        else rt[tid] = __builtin_bit_cast(unsigned, gsort[(size_t)u.e * T + idx]);
    }
    DI void fill_async(int ui, int wid, int lane) const {
        const unsigned base = (unsigned)(size_t)rtab; const int w4 = wid & 3;
        if (gather) {
            if (wid < 4) { Unit u; if (!next(ui + 2, u)) return;
                const int cnt = __builtin_amdgcn_readfirstlane(tab[33 + u.e]); int idx = u.mt * 256 + w4 * 64 + lane; idx = idx < cnt ? idx : cnt - 1;
                glds_dword((const char*)(list + (size_t)u.e * T), (unsigned)idx * 4u, base + (unsigned)((ui & 1) * RSLOT * 4 + w4 * 256)); }
            else { Unit u; if (!next(ui + 1, u)) return;
                glds_dword((const char*)(bias_l + (size_t)u.e * bias_estride + 256 * u.pn), (unsigned)(w4 * 64 + lane) * 4u, base + (unsigned)(((ui + 1) & 1) * RSLOT * 4 + 2048 + w4 * 256)); }
        } else {
            Unit u; if (!next(ui + 1, u)) return;
            const int cnt = __builtin_amdgcn_readfirstlane(tab[33 + u.e]); int idx = u.mt * 256 + w4 * 64 + lane; idx = idx < cnt ? idx : cnt - 1;
            const unsigned dst = base + (unsigned)(((ui + 1) & 1) * RSLOT * 4 + w4 * 256);
            if (wid < 4) { glds_dword((const char*)(list + (size_t)u.e * T), (unsigned)idx * 4u, dst);
                           glds_dword((const char*)(bias_l + (size_t)u.e * bias_estride + 256 * u.pn), (unsigned)(w4 * 64 + lane) * 4u, dst + 2048u); }
            else glds_dword((const char*)(gsort + (size_t)u.e * T), (unsigned)idx * 4u, dst + 1024u);
        }
    }
};
DI int build_unit_table(const LAS int* tab, LAS int* utab, const int nN, const int G, const int c) {
    const int tid = opaque_tid();
    const int nmt = tab[32];
    int nunits;
    if ((G & 7) == 0) {
        const int x = c & 7, rk = c >> 3, W = G >> 3;
        const int mloc = (nmt > x) ? (nmt - x + 7) >> 3 : 0, total = mloc * nN;
        nunits = (total > rk) ? (total - rk + W - 1) / W : 0;
        if (tid < nunits) { const int k = tid * W + rk, ml = k / nN, pn = k - ml * nN, mtile = x + 8 * ml; int e = 0;
            for (int j = 1; j < 32; ++j) e += (tab[j] <= mtile) ? 1 : 0;
            utab[2 * tid] = mtile; utab[2 * tid + 1] = (e << 16) | ((mtile - tab[e]) << 3) | pn; }
    } else {
        const int total = nmt * nN;
        nunits = (total > c) ? (total - c + G - 1) / G : 0;
        if (tid < nunits) { const int L = tid * G + c, mtile = L / nN, pn = L - mtile * nN; int e = 0;
            for (int j = 1; j < 32; ++j) e += (tab[j] <= mtile) ? 1 : 0;
            utab[2 * tid] = mtile; utab[2 * tid + 1] = (e << 16) | ((mtile - tab[e]) << 3) | pn; }
    }
    __syncthreads();
    return __builtin_amdgcn_readfirstlane(nunits);
}

struct EpiBf16 {
    bf16* O; int ldc; float sc;
    DI void operator()(const f32x4 (&acc)[2][2][4][2], const Unit& u, int wr, int wc, int fr, int fq) const {
        const int row0 = u.pm * 256 + wr * 64 + fr, col0 = u.pn * 256 + wc * 32 + 8 * fq;
#pragma unroll
        for (int ai = 0; ai < 2; ++ai)
#pragma unroll
            for (int m = 0; m < 4; ++m) { bf16* rowp = O + (size_t)(row0 + ai * HALF + m * 16) * ldc + col0;
#pragma unroll
                for (int bj = 0; bj < 2; ++bj) { const f32x4 v0 = acc[ai][bj][m][0] * sc, v1 = acc[ai][bj][m][1] * sc;
                    u32x4 w; w.x = cvt_pk_bf16(v0[0], v0[1]); w.y = cvt_pk_bf16(v0[2], v0[3]); w.z = cvt_pk_bf16(v1[0], v1[1]); w.w = cvt_pk_bf16(v1[2], v1[3]);
                    *(u32x4*)(rowp + bj * HALF) = w; } }
    }
};
struct EpiResid {
    bf16* X; const float* mod_l;
    DI void operator()(const f32x4 (&acc)[2][2][4][2], const Unit& u, int wr, int wc, int fr, int fq) const {
        const int b = u.pm / 9, mrow = (u.pm - b * 9 == 0) ? 32 : b;
        const float* g = mod_l + (size_t)mrow * 6144 + 2048;
        const int row0 = u.pm * 256 + wr * 64 + fr, col0 = u.pn * 256 + wc * 32 + 8 * fq;
        f32x4 gv[2][2];
#pragma unroll
        for (int bj = 0; bj < 2; ++bj)
#pragma unroll
            for (int n = 0; n < 2; ++n) gv[bj][n] = *(const f32x4*)(g + col0 + bj * HALF + 4 * n) * (1.0f / (WO_SCALE * MIX_SCALE));
#pragma unroll
        for (int ai = 0; ai < 2; ++ai) {
            u32x4 xw8[4][2];
#pragma unroll
            for (int m = 0; m < 4; ++m)
#pragma unroll
                for (int bj = 0; bj < 2; ++bj) xw8[m][bj] = *(const u32x4*)(X + (size_t)(row0 + ai * HALF + m * 16) * DM + col0 + bj * HALF);
#pragma unroll
            for (int m = 0; m < 4; ++m) { bf16* rowp = X + (size_t)(row0 + ai * HALF + m * 16) * DM + col0;
#pragma unroll
                for (int bj = 0; bj < 2; ++bj) { const u32x4 xw = xw8[m][bj];
                    const f32x4 x0 = (f32x4){bflo(xw.x), bfhi(xw.x), bflo(xw.y), bfhi(xw.y)}, x1 = (f32x4){bflo(xw.z), bfhi(xw.z), bflo(xw.w), bfhi(xw.w)};
                    const f32x4 y0 = x0 * DN_ALPHA + gv[bj][0] * acc[ai][bj][m][0], y1 = x1 * DN_ALPHA + gv[bj][1] * acc[ai][bj][m][1];
                    u32x4 w; w.x = cvt_pk_bf16(y0[0], y0[1]); w.y = cvt_pk_bf16(y0[2], y0[3]); w.z = cvt_pk_bf16(y1[0], y1[1]); w.w = cvt_pk_bf16(y1[2], y1[3]);
                    *(u32x4*)(rowp + bj * HALF) = w; } }
        }
    }
};
struct EpiSwiglu {
    unsigned char* ACT; const LAS unsigned* rtab;
    DI void operator()(const f32x4 (&acc)[2][2][4][2], const Unit& u, int wr, int wc, int fr, int fq) const {
        const LAS float* bias = (const LAS float*)(rtab + (u.idx & 1) * RSLOT + 512);
        const int jc0 = u.pn * 128 + wc * 32 + 8 * fq, jl0 = wc * 32 + 8 * fq;
        f32x4 bg[2], bl[2];
#pragma unroll
        for (int n = 0; n < 2; ++n) { const f32x4 a = *(const LAS f32x4*)(bias + 2 * (jl0 + 4 * n)), b = *(const LAS f32x4*)(bias + 2 * (jl0 + 4 * n) + 4);
            bg[n] = (f32x4){a[0], a[2], b[0], b[2]}; bl[n] = (f32x4){a[1], a[3], b[1], b[3]}; }
        const int row0 = u.pm * 256 + wr * 64 + fr;
#pragma unroll
        for (int ai = 0; ai < 2; ++ai)
#pragma unroll
            for (int m = 0; m < 4; ++m) {
                float y[8];
#pragma unroll
                for (int n = 0; n < 2; ++n) { const f32x4 gl = acc[ai][0][m][n] * (1.0f / WGU_SCALE) + bg[n], li = acc[ai][1][m][n] * (1.0f / WGU_SCALE) + bl[n];
#pragma unroll
                    for (int i = 0; i < 4; i += 2) {
                        const f32x2 seven = {7.0f, 7.0f}, one = {1.0f, 1.0f};
                        const f32x2 gg = __builtin_elementwise_min((f32x2){gl[i], gl[i + 1]}, seven);
                        const f32x2 ll = __builtin_elementwise_min(__builtin_elementwise_max((f32x2){li[i], li[i + 1]}, -seven), seven);
                        const f32x2 t = gg * (-1.702f * LOG2E);
                        const f32x2 d = (f32x2){fast_exp2(t[0]), fast_exp2(t[1])} + one;
                        const f32x2 r = {__builtin_amdgcn_rcpf(d[0]), __builtin_amdgcn_rcpf(d[1])};
                        const f32x2 yy = (ll + one) * (gg * r);
                        y[4 * n + i] = yy[0]; y[4 * n + i + 1] = yy[1]; } }
                u32x2 w; w.x = pk4_fp8(y[0], y[1], y[2], y[3]); w.y = pk4_fp8(y[4], y[5], y[6], y[7]);
                *(u32x2*)(ACT + (size_t)(row0 + ai * HALF + m * 16) * DE + jc0) = w; }
    }
};
struct EpiDown {
    unsigned char* Y; const LAS unsigned* rtab; const LAS int* tab;
    DI void operator()(const f32x4 (&acc)[2][2][4][2], const Unit& u, int wr, int wc, int fr, int fq) const {
        const int nrows = __builtin_amdgcn_readfirstlane(tab[33 + u.e]) - u.mt * 256;
        const LAS unsigned* rt = rtab + (u.idx & 1) * RSLOT;
        const LAS float* bias = (const LAS float*)(rt + 512);
        const int cl0 = wc * 64 + 16 * fq, col0 = u.pn * 256 + cl0;
        f32x4 bv[2][2];
#pragma unroll
        for (int bj = 0; bj < 2; ++bj)
#pragma unroll
            for (int n = 0; n < 2; ++n) bv[bj][n] = *(const LAS f32x4*)(bias + cl0 + 8 * bj + 4 * n);
#pragma unroll
        for (int ai = 0; ai < 2; ++ai)
#pragma unroll
            for (int m = 0; m < 4; ++m) { const int rloc = ai * HALF + wr * 64 + m * 16 + fr;
                if (rloc < nrows) { const unsigned pair = rt[rloc]; float g = __builtin_bit_cast(float, rt[256 + rloc]); asm volatile("" : "+v"(g)); g *= Y_SCALE; const float sg = g * (1.0f / WD_SCALE);
                    u32x4 w;
#pragma unroll
                    for (int bj = 0; bj < 2; ++bj) { const f32x4 v0 = acc[ai][bj][m][0] * sg + bv[bj][0] * g, v1 = acc[ai][bj][m][1] * sg + bv[bj][1] * g;
                        w[2 * bj] = pk4_fp8(v0[0], v0[1], v0[2], v0[3]); w[2 * bj + 1] = pk4_fp8(v1[0], v1[1], v1[2], v1[3]); }
                    *(u32x4*)(Y + (size_t)pair * DM + col0) = w; } }
    }
};
}

namespace att {
typedef short v4i16_t __attribute__((ext_vector_type(4)));
DI int crow(int r, int hi) { return (r & 3) + 8 * (r >> 2) + 4 * hi; }
DI s16x4 vtr(const LAS unsigned char* p) { return __builtin_bit_cast(s16x4, __builtin_amdgcn_ds_read_tr16_b64_v4i16((LAS v4i16_t*)p)); }
#ifndef ATT_K8
#define ATT_K8 1
#endif
constexpr float Q8_SCALE = 4.0f, K8_SCALE = 0.25f;
DI u32x2 bf8x8(const u32x4 w, const float sc) {
    u32x2 o;
    o.x = pk4_fp8(bflo(w.x) * sc, bfhi(w.x) * sc, bflo(w.y) * sc, bfhi(w.y) * sc);
    o.y = pk4_fp8(bflo(w.z) * sc, bfhi(w.z) * sc, bflo(w.w) * sc, bfhi(w.w) * sc);
    return o;
}
DI pg8::i32x8v q_to_fp8(const bf16x8 (&qf)[4]) {
    pg8::i32x8v q;
#pragma unroll
    for (int d0 = 0; d0 < 4; ++d0) { const u32x2 t = bf8x8(__builtin_bit_cast(u32x4, qf[d0]), Q8_SCALE); q[2 * d0] = (int)t.x; q[2 * d0 + 1] = (int)t.y; }
    return q;
}
DI pg8::i32x8v k8_read(const LAS unsigned char* p) { const u32x4 a = *(const LAS u32x4*)p, b = *(const LAS u32x4*)(p + 16); return (pg8::i32x8v){(int)a.x, (int)a.y, (int)a.z, (int)a.w, (int)b.x, (int)b.y, (int)b.z, (int)b.w}; }
#define MFMA_QK8(kf, qf8, c) __builtin_amdgcn_mfma_scale_f32_32x32x64_f8f6f4(kf, qf8, c, 0, 0, 0, 0, 0, 0)
#define ATT_BAR() asm volatile("s_waitcnt lgkmcnt(0)\n\ts_barrier" ::: "memory")

struct AttnP {
    const bf16* Q; int qp;
    const bf16* K; int kp;
    const bf16* K2; int k2p;
    const bf16* V; int vp;
    unsigned char* O; int op;
    int kt0, ntiles;
    int brow0, na_lo, na_nloc, qr0;
    const float* rpb;
    int rope_q, qpos0;
    int shadow;
};
constexpr int RPB_OFF = 60 * 1024;
constexpr int O1_OFF = 64 * 1024;

template <int DQK, int DV, int MODE>
DI void attn_core(LAS unsigned char* lds, const AttnP& p, const bf16x8 (&qf)[DQK / 16], f32x16 (&o)[DV / 32], float& m_run, float& l_run, const int tid, const int wid, const int lane) {
    constexpr bool K8 = ATT_K8 && (DQK == 64);
    constexpr int KROWB = K8 ? 80 : (DQK + 8) * 2, VROWB = (DV == 64) ? 192 : 320, TILEB = 64 * (KROWB + VROWB), CPR = DQK / 8, VPR = DV / 8;
    constexpr int NKC = (DQK == 64) ? 1 : 2, NVC = DV / 64;
    static_assert(2 * TILEB <= RPB_OFF, "attention LDS");
    const int r32 = lane & 31, hi = lane >> 5;
    int krow[NKC], kch[NKC], vrow[NVC], vch[NVC];
#pragma unroll
    for (int i = 0; i < NKC; ++i) { const int c = tid + 512 * i; krow[i] = c / CPR; kch[i] = c - krow[i] * CPR; }
#pragma unroll
    for (int i = 0; i < NVC; ++i) { const int c = tid + 512 * i; vrow[i] = c / VPR; vch[i] = c - vrow[i] * VPR; }
    u32x4 krA[NKC], vrA[NVC], krB[NKC], vrB[NVC];
    const int ntiles = p.ntiles;
#define ATT_TROW(j) ((MODE == 0) ? (p.kt0 + 64 * (j)) : (((j) < p.na_nloc) ? (p.brow0 + 256 + (p.na_lo + (j)) * 64) : (p.brow0 + ((j) - p.na_nloc) * 64)))
#define ATT_LOAD(j, kr, vr) do { const int trow_ = ATT_TROW(j); \
        _Pragma("unroll") for (int i = 0; i < NKC; ++i) { if (DQK == 64 || i == 0 || tid < 256) { \
            const bf16* src_ = (kch[i] < 8) ? (p.K + (size_t)(trow_ + krow[i]) * p.kp + kch[i] * 8) : (p.K2 + (size_t)(trow_ + krow[i]) * p.k2p + (kch[i] - 8) * 8); \
            kr[i] = *(const u32x4*)src_; } } \
        _Pragma("unroll") for (int i = 0; i < NVC; ++i) vr[i] = *(const u32x4*)(p.V + (size_t)(trow_ + vrow[i]) * p.vp + vch[i] * 8); } while (0)
#define ATT_WRITE(b, kr, vr) do { LAS unsigned char* kb_ = lds + (b) * TILEB; LAS unsigned char* vb_ = kb_ + 64 * KROWB; \
        if constexpr (K8) { *(LAS u32x2*)(kb_ + krow[0] * KROWB + 32 * (kch[0] & 1) + 8 * (kch[0] >> 1)) = bf8x8(kr[0], K8_SCALE); } else { \
        _Pragma("unroll") for (int i = 0; i < NKC; ++i) { if (DQK == 64 || i == 0 || tid < 256) *(LAS u32x4*)(kb_ + krow[i] * KROWB + kch[i] * 16) = kr[i]; } } \
        _Pragma("unroll") for (int i = 0; i < NVC; ++i) *(LAS u32x4*)(vb_ + vrow[i] * VROWB + vch[i] * 16) = vr[i]; } while (0)
    ATT_LOAD(0, krA, vrA); ATT_WRITE(0, krA, vrA);
    if (ntiles > 1) ATT_LOAD(1, krB, vrB);
    if (ntiles > 2) ATT_LOAD(2, krA, vrA);
    ATT_BAR();
    pg8::i32x8v q8 = {0, 0, 0, 0, 0, 0, 0, 0};
    if constexpr (K8) q8 = q_to_fp8(qf);
    const bool sh_noload = PROBE_SHADOW && (p.shadow == 2), sh_nocomp = PROBE_SHADOW && (p.shadow == 1);
    f32x16 negm;
#pragma unroll
    for (int r = 0; r < 16; ++r) negm[r] = -m_run;
    bool first = true;
    const int qr = p.qr0 + (wid >> 1), rs = min(max(qr - 4, 0), 24);
    const int qc = 32 * (wid & 1) + r32, cs = min(max(qc - 8, 0), 48);
    const int q4 = (lane & 15) >> 2, p4 = lane & 3, blk = (lane >> 4) & 1;
    unsigned boff0[(MODE == 1 && DV == 64) ? 16 : 1], boff1[(MODE == 1 && DV == 64) ? 16 : 1];
    if (MODE == 1 && DV == 64) {
#pragma unroll
        for (int r = 0; r < 16; ++r) { const int kc0 = crow(r, hi), kc1 = kc0 + 32;
            boff0[r] = ((kc0 >= cs) && (kc0 < cs + 16)) ? (unsigned)(kc0 - qc + 15) * 4u : 124u;
            boff1[r] = ((kc1 >= cs) && (kc1 < cs + 16)) ? (unsigned)(kc1 - qc + 15) * 4u : 124u; }
    }
    auto tile = [&](const int j) __attribute__((always_inline)) {
        bool active = true; int krg = 0;
        if (MODE == 1) { krg = p.na_lo + j; active = (j >= p.na_nloc) || (krg >= rs && krg < rs + 8); }
        if (sh_nocomp) active = false;
        if (active && DV == 64) {
            const LAS unsigned char* kb = lds + (j & 1) * TILEB; const LAS unsigned char* vb = kb + 64 * KROWB;
            f32x16 s0 = negm, s1 = negm;
            if constexpr (K8) {
                s0 = MFMA_QK8(k8_read(kb + r32 * KROWB + 32 * hi), q8, s0);
                s1 = MFMA_QK8(k8_read(kb + (32 + r32) * KROWB + 32 * hi), q8, s1);
            } else {
#pragma unroll
            for (int d0 = 0; d0 < DQK / 16; ++d0) {
                const bf16x8 k0 = *(const LAS bf16x8*)(kb + r32 * KROWB + (16 * d0 + 8 * hi) * 2);
                const bf16x8 k1 = *(const LAS bf16x8*)(kb + (32 + r32) * KROWB + (16 * d0 + 8 * hi) * 2);
                s0 = __builtin_amdgcn_mfma_f32_32x32x16_bf16(k0, qf[d0], s0, 0, 0, 0);
                s1 = __builtin_amdgcn_mfma_f32_32x32x16_bf16(k1, qf[d0], s1, 0, 0, 0);
            } }
            if (MODE == 1 && j < p.na_nloc) {
                const LAS unsigned char* brow = lds + RPB_OFF + (krg - qr + 7) * 128;
#pragma unroll
                for (int r = 0; r < 16; ++r) { s0[r] += *(const LAS float*)(brow + boff0[r]); s1[r] += *(const LAS float*)(brow + boff1[r]); }
            }
            if (first) {
                float mt = fmaxf(fmaxf(s0[0], s1[0]), fmaxf(s0[1], s1[1]));
#pragma unroll
                for (int r = 2; r < 16; r += 2) mt = fmaxf(fmaxf(mt, fmaxf(s0[r], s1[r])), fmaxf(s0[r + 1], s1[r + 1]));
                mt = fmaxf(mt, __shfl_xor(mt, 32));
                const float dl = (mt > -__builtin_inff()) ? mt : 0.f;
                m_run += dl;
#pragma unroll
                for (int r = 0; r < 16; ++r) { s0[r] -= dl; s1[r] -= dl; negm[r] = -m_run; }
                first = false;
            }
            float ps0 = 0.f, ps1 = 0.f, ps2 = 0.f, ps3 = 0.f;
#pragma unroll
            for (int r = 0; r < 16; r += 2) { s0[r] = fast_exp2(s0[r]); s0[r + 1] = fast_exp2(s0[r + 1]); s1[r] = fast_exp2(s1[r]); s1[r + 1] = fast_exp2(s1[r + 1]);
                ps0 += s0[r]; ps1 += s0[r + 1]; ps2 += s1[r]; ps3 += s1[r + 1]; }
            const float ps = (ps0 + ps1) + (ps2 + ps3);
            l_run += ps;
            const float pt = ps + __shfl_xor(ps, 32);
            const bool need = pt > 65536.0f;
            bf16x8 pa[2][2];
#pragma unroll
            for (int s = 0; s < 2; ++s) {
                u32x4 w0, w1;
                w0.x = pg8::cvt_pk_bf16(s0[8 * s + 0], s0[8 * s + 1]); w0.y = pg8::cvt_pk_bf16(s0[8 * s + 2], s0[8 * s + 3]); w0.z = pg8::cvt_pk_bf16(s0[8 * s + 4], s0[8 * s + 5]); w0.w = pg8::cvt_pk_bf16(s0[8 * s + 6], s0[8 * s + 7]);
                w1.x = pg8::cvt_pk_bf16(s1[8 * s + 0], s1[8 * s + 1]); w1.y = pg8::cvt_pk_bf16(s1[8 * s + 2], s1[8 * s + 3]); w1.z = pg8::cvt_pk_bf16(s1[8 * s + 4], s1[8 * s + 5]); w1.w = pg8::cvt_pk_bf16(s1[8 * s + 6], s1[8 * s + 7]);
                pa[0][s] = __builtin_bit_cast(bf16x8, w0); pa[1][s] = __builtin_bit_cast(bf16x8, w1);
            }
            const LAS unsigned char* vbase = vb + (4 * hi + q4) * VROWB + 32 * blk + 8 * p4;
#pragma unroll
            for (int u = 0; u < 2; ++u)
#pragma unroll
                for (int s = 0; s < 2; ++s)
#pragma unroll
                    for (int c = 0; c < 2; ++c) {
                        const LAS unsigned char* a0 = vbase + (32 * u + 16 * s) * VROWB + 64 * c;
                        const s16x4 lo = vtr(a0), hh = vtr(a0 + 8 * VROWB);
                        const bf16x8 vf = (bf16x8){lo[0], lo[1], lo[2], lo[3], hh[0], hh[1], hh[2], hh[3]};
                        o[c % (DV / 32)] = __builtin_amdgcn_mfma_f32_32x32x16_bf16(pa[u][s], vf, o[c % (DV / 32)], 0, 0, 0);
                    }
            if (__any(need)) {
                const int ex = (int)((__builtin_bit_cast(unsigned, pt) >> 23) & 255u) - 127;
                const float dl = need ? (float)ex : 0.f, f = fast_exp2(-dl);
                m_run += dl; l_run *= f;
#pragma unroll
                for (int r = 0; r < 16; ++r) negm[r] = -m_run;
                int hio = hi; asm volatile("" : "+v"(hio));
#pragma unroll
                for (int r = 0; r < 16; ++r) { const float fr_ = __shfl(f, crow(r, hio)); o[0][r] *= fr_; o[1 % (DV / 32)][r] *= fr_; }
            }
        }
        if (active && DV != 64) {
            const LAS unsigned char* kb = lds + (j & 1) * TILEB; const LAS unsigned char* vb = kb + 64 * KROWB;
#pragma unroll
            for (int u = 0; u < 2; ++u) {
                const LAS unsigned char* kbu = kb + u * 32 * KROWB;
                f32x16 s0 = negm;
                if constexpr (K8) { s0 = MFMA_QK8(k8_read(kbu + r32 * KROWB + 32 * hi), q8, s0); } else {
#pragma unroll
                for (int d0 = 0; d0 < DQK / 16; ++d0) {
                    const bf16x8 k0 = *(const LAS bf16x8*)(kbu + r32 * KROWB + (16 * d0 + 8 * hi) * 2);
                    s0 = __builtin_amdgcn_mfma_f32_32x32x16_bf16(k0, qf[d0], s0, 0, 0, 0);
                } }
                if (MODE == 1 && j < p.na_nloc) {
                    const LAS float* brow = (const LAS float*)(lds + RPB_OFF) + (krg - qr + 7) * 32;
                    int hio = hi; asm volatile("" : "+v"(hio));
#pragma unroll
                    for (int r = 0; r < 16; ++r) {
                        const int kc0 = crow(r, hio) + 32 * u;
                        const bool v0 = (kc0 >= cs) && (kc0 < cs + 16);
                        const int i0 = min(max(kc0 - qc + 15, 0), 30);
                        s0[r] = v0 ? s0[r] + brow[i0] : -__builtin_inff();
                    }
                }
                if (first) {
                    float mt = fmaxf(fmaxf(s0[0], s0[1]), s0[2]);
#pragma unroll
                    for (int r = 3; r < 15; r += 2) mt = fmaxf(fmaxf(mt, s0[r]), s0[r + 1]);
                    mt = fmaxf(mt, s0[15]);
                    mt = fmaxf(mt, __shfl_xor(mt, 32));
                    const float dl = (mt > -__builtin_inff()) ? mt : 0.f;
                    m_run += dl;
#pragma unroll
                    for (int r = 0; r < 16; ++r) { s0[r] -= dl; negm[r] = -m_run; }
                    first = false;
                }
                float ps0 = 0.f, ps1 = 0.f;
#pragma unroll
                for (int r = 0; r < 16; r += 2) { s0[r] = fast_exp2(s0[r]); s0[r + 1] = fast_exp2(s0[r + 1]); ps0 += s0[r]; ps1 += s0[r + 1]; }
                const float ps = ps0 + ps1;
                l_run += ps;
                const float pt = ps + __shfl_xor(ps, 32);
                const bool need = pt > 65536.0f;
                bf16x8 pa[2];
#pragma unroll
                for (int s = 0; s < 2; ++s) {
                    u32x4 w0;
                    w0.x = pg8::cvt_pk_bf16(s0[8 * s + 0], s0[8 * s + 1]); w0.y = pg8::cvt_pk_bf16(s0[8 * s + 2], s0[8 * s + 3]); w0.z = pg8::cvt_pk_bf16(s0[8 * s + 4], s0[8 * s + 5]); w0.w = pg8::cvt_pk_bf16(s0[8 * s + 6], s0[8 * s + 7]);
                    pa[s] = __builtin_bit_cast(bf16x8, w0);
                }
                const LAS unsigned char* vbase = vb + (32 * u + 4 * hi + q4) * VROWB + 32 * blk + 8 * p4;
#pragma unroll
                for (int c = 0; c < DV / 32; ++c)
#pragma unroll
                    for (int s = 0; s < 2; ++s) {
                        const LAS unsigned char* a0 = vbase + (16 * s) * VROWB + 64 * c;
                        const s16x4 lo = vtr(a0), hh = vtr(a0 + 8 * VROWB);
                        const bf16x8 vf = (bf16x8){lo[0], lo[1], lo[2], lo[3], hh[0], hh[1], hh[2], hh[3]};
                        o[c] = __builtin_amdgcn_mfma_f32_32x32x16_bf16(pa[s], vf, o[c], 0, 0, 0);
                    }
                if (__any(need)) {
                    const int ex = (int)((__builtin_bit_cast(unsigned, pt) >> 23) & 255u) - 127;
                    const float dl = need ? (float)ex : 0.f, f = fast_exp2(-dl);
                    m_run += dl; l_run *= f;
#pragma unroll
                    for (int r = 0; r < 16; ++r) negm[r] = -m_run;
                    int hio = hi; asm volatile("" : "+v"(hio));
#pragma unroll
                    for (int r = 0; r < 16; ++r) { const float fr_ = __shfl(f, crow(r, hio));
#pragma unroll
                        for (int c = 0; c < DV / 32; ++c) o[c][r] *= fr_; }
                }
            }
        }
    };
    for (int j = 0; j < ntiles; j += 2) {
        tile(j);
        if (j + 1 < ntiles) ATT_WRITE((j + 1) & 1, krB, vrB);
        if (j + 3 < ntiles) ATT_LOAD(j + 3, krB, vrB);
        ATT_BAR();
        if (j + 1 >= ntiles) break;
        tile(j + 1);
        if (j + 2 < ntiles) ATT_WRITE((j + 2) & 1, krA, vrA);
        if (j + 4 < ntiles) ATT_LOAD(j + 4, krA, vrA);
        ATT_BAR();
    }
#undef ATT_TROW
#undef ATT_LOAD
#undef ATT_WRITE
}

template <int DQK>
DI void attn_core_pipe(LAS unsigned char* lds, const AttnP& p, const bf16x8 (&qf)[DQK / 16], f32x16 (&o)[2], float& m_run, float& l_run, const int tid, const int wid, const int lane) {
    constexpr int KROWB = (DQK + 8) * 2, VROWB = 192, TILEB = 64 * (KROWB + VROWB), CPR = DQK / 8;
    constexpr int NKC = (DQK == 64) ? 1 : 2;
    static_assert(2 * TILEB <= RPB_OFF, "attention LDS");
    const int r32 = lane & 31, hi = lane >> 5;
    int krow[NKC], kch[NKC];
#pragma unroll
    for (int i = 0; i < NKC; ++i) { const int c = tid + 512 * i; krow[i] = c / CPR; kch[i] = c - krow[i] * CPR; }
    const int vrow = tid >> 3, vch = tid & 7;
    u32x4 kr[NKC], vr;
    const int nt = p.ntiles;
#define AP_LOADK(j) do { const int trow_ = p.kt0 + 64 * min((j), nt - 1); \
        _Pragma("unroll") for (int i = 0; i < NKC; ++i) { if (DQK == 64 || i == 0 || tid < 256) { \
            const bf16* src_ = (kch[i] < 8) ? (p.K + (size_t)(trow_ + krow[i]) * p.kp + kch[i] * 8) : (p.K2 + (size_t)(trow_ + krow[i]) * p.k2p + (kch[i] - 8) * 8); \
            kr[i] = *(const u32x4*)src_; } } } while (0)
#define AP_LOADV(j) do { const int trow_ = p.kt0 + 64 * min((j), nt - 1); vr = *(const u32x4*)(p.V + (size_t)(trow_ + vrow) * p.vp + vch * 8); } while (0)
#define AP_WRITEK(b) do { LAS unsigned char* kb_ = lds + (b) * TILEB; \
        _Pragma("unroll") for (int i = 0; i < NKC; ++i) { if (DQK == 64 || i == 0 || tid < 256) *(LAS u32x4*)(kb_ + krow[i] * KROWB + kch[i] * 16) = kr[i]; } } while (0)
#define AP_WRITEV(b) do { *(LAS u32x4*)(lds + (b) * TILEB + 64 * KROWB + vrow * VROWB + vch * 16) = vr; } while (0)
#define AP_QK(b, S0, S1) do { const LAS unsigned char* kb_ = lds + (b) * TILEB; \
        _Pragma("unroll") for (int d0 = 0; d0 < DQK / 16; ++d0) { \
            const bf16x8 k0_ = *(const LAS bf16x8*)(kb_ + r32 * KROWB + (16 * d0 + 8 * hi) * 2); \
            const bf16x8 k1_ = *(const LAS bf16x8*)(kb_ + (32 + r32) * KROWB + (16 * d0 + 8 * hi) * 2); \
            S0 = __builtin_amdgcn_mfma_f32_32x32x16_bf16(k0_, qf[d0], S0, 0, 0, 0); \
            S1 = __builtin_amdgcn_mfma_f32_32x32x16_bf16(k1_, qf[d0], S1, 0, 0, 0); } } while (0)
    AP_LOADK(0); AP_LOADV(0); AP_WRITEK(0); AP_WRITEV(0); AP_LOADK(1);
    ATT_BAR();
    f32x16 negm, s0, s1;
#pragma unroll
    for (int r = 0; r < 16; ++r) { s0[r] = 0.f; s1[r] = 0.f; }
    AP_QK(0, s0, s1);
    {
        float mt = fmaxf(fmaxf(s0[0], s1[0]), fmaxf(s0[1], s1[1]));
#pragma unroll
        for (int r = 2; r < 16; r += 2) mt = fmaxf(fmaxf(mt, fmaxf(s0[r], s1[r])), fmaxf(s0[r + 1], s1[r + 1]));
        mt = fmaxf(mt, __shfl_xor(mt, 32));
        m_run = mt;
#pragma unroll
        for (int r = 0; r < 16; ++r) { s0[r] -= mt; s1[r] -= mt; negm[r] = -mt; }
    }
    AP_WRITEK(1); AP_LOADK(2); AP_LOADV(1);
    ATT_BAR();
    const int q4 = (lane & 15) >> 2, p4 = lane & 3, blk = (lane >> 4) & 1;
    const LAS unsigned char* vlane = lds + 64 * KROWB + (4 * hi + q4) * VROWB + 32 * blk + 8 * p4;
#define AP_SOFTMAX_PV(J) \
        float ps0 = 0.f, ps1 = 0.f, ps2 = 0.f, ps3 = 0.f; \
        _Pragma("unroll") for (int r = 0; r < 16; r += 2) { s0[r] = fast_exp2(s0[r]); s0[r + 1] = fast_exp2(s0[r + 1]); s1[r] = fast_exp2(s1[r]); s1[r + 1] = fast_exp2(s1[r + 1]); \
            ps0 += s0[r]; ps1 += s0[r + 1]; ps2 += s1[r]; ps3 += s1[r + 1]; } \
        const float ps = (ps0 + ps1) + (ps2 + ps3); \
        l_run += ps; \
        bf16x8 pa[2][2]; \
        _Pragma("unroll") for (int s = 0; s < 2; ++s) { \
            u32x4 w0, w1; \
            w0.x = pg8::cvt_pk_bf16(s0[8 * s + 0], s0[8 * s + 1]); w0.y = pg8::cvt_pk_bf16(s0[8 * s + 2], s0[8 * s + 3]); w0.z = pg8::cvt_pk_bf16(s0[8 * s + 4], s0[8 * s + 5]); w0.w = pg8::cvt_pk_bf16(s0[8 * s + 6], s0[8 * s + 7]); \
            w1.x = pg8::cvt_pk_bf16(s1[8 * s + 0], s1[8 * s + 1]); w1.y = pg8::cvt_pk_bf16(s1[8 * s + 2], s1[8 * s + 3]); w1.z = pg8::cvt_pk_bf16(s1[8 * s + 4], s1[8 * s + 5]); w1.w = pg8::cvt_pk_bf16(s1[8 * s + 6], s1[8 * s + 7]); \
            pa[0][s] = __builtin_bit_cast(bf16x8, w0); pa[1][s] = __builtin_bit_cast(bf16x8, w1); } \
        const LAS unsigned char* vbase = vlane + ((J) & 1) * TILEB; \
        _Pragma("unroll") for (int u = 0; u < 2; ++u) _Pragma("unroll") for (int s = 0; s < 2; ++s) _Pragma("unroll") for (int c = 0; c < 2; ++c) { \
                    const LAS unsigned char* a0 = vbase + (32 * u + 16 * s) * VROWB + 64 * c; \
                    const s16x4 lo = vtr(a0), hh = vtr(a0 + 8 * VROWB); \
                    const bf16x8 vf = (bf16x8){lo[0], lo[1], lo[2], lo[3], hh[0], hh[1], hh[2], hh[3]}; \
                    o[c] = __builtin_amdgcn_mfma_f32_32x32x16_bf16(pa[u][s], vf, o[c], 0, 0, 0); }
    for (int j = 0; j < nt - 1; ++j) {
        AP_WRITEK(j & 1); AP_WRITEV((j + 1) & 1);
        AP_LOADK(j + 3); AP_LOADV(j + 2);
        f32x16 sn0 = negm, sn1 = negm;
        AP_QK((j + 1) & 1, sn0, sn1);
        AP_SOFTMAX_PV(j)
        const float pt = ps + __shfl_xor(ps, 32);
        const bool need = pt > 65536.0f;
        s0 = sn0; s1 = sn1;
        if (__any(need)) {
            const int ex = (int)((__builtin_bit_cast(unsigned, pt) >> 23) & 255u) - 127;
            const float dl = need ? (float)ex : 0.f, f = fast_exp2(-dl);
            m_run += dl; l_run *= f;
#pragma unroll
            for (int r = 0; r < 16; ++r) { negm[r] = -m_run; s0[r] -= dl; s1[r] -= dl; }
            int hio = hi; asm volatile("" : "+v"(hio));
#pragma unroll
            for (int r = 0; r < 16; ++r) { const float fr_ = __shfl(f, crow(r, hio)); o[0][r] *= fr_; o[1][r] *= fr_; }
        }
        ATT_BAR();
    }
    {
        AP_SOFTMAX_PV(nt - 1)
        ATT_BAR();
    }
#undef AP_SOFTMAX_PV
#undef AP_LOADK
#undef AP_LOADV
#undef AP_WRITEK
#undef AP_WRITEV
#undef AP_QK
}

DI void rope_frag(bf16x8& frag, const int position, const int hi, const float freq_step  ) {
    u32x4 mine = __builtin_bit_cast(u32x4, frag), oth;
#pragma unroll
    for (int w = 0; w < 4; ++w) oth[w] = (unsigned)__shfl_xor((int)mine[w], 32);
    float res[8];
#pragma unroll
    for (int i = 0; i < 8; ++i) {
        const float x = (i & 1) ? bfhi(mine[i >> 1]) : bflo(mine[i >> 1]);
        const float y = (i & 1) ? bfhi(oth[i >> 1]) : bflo(oth[i >> 1]);
        float rev = (float)position * fast_exp2(-(float)i * freq_step) * 0.15915494309189535f; rev = rev - floorf(rev);
        const float sn = __builtin_amdgcn_sinf(rev), cs = __builtin_amdgcn_cosf(rev);
        res[i] = hi ? (y * sn + x * cs) : (x * cs - y * sn);
    }
    u32x4 w; w.x = pk2(res[0], res[1]); w.y = pk2(res[2], res[3]); w.z = pk2(res[4], res[5]); w.w = pk2(res[6], res[7]);
    frag = __builtin_bit_cast(bf16x8, w);
}

template <int DQK, int MODE>
DI void attn_unit(LAS unsigned char* lds, const AttnP& p) {
    const int tid = opaque_tid(), lane = tid & 63, wid = __builtin_amdgcn_readfirstlane(tid >> 6), r32 = lane & 31, hi = lane >> 5;
    bf16x8 qf[DQK / 16];
    const bf16* qrow = p.Q + (size_t)(32 * wid + r32) * p.qp;
#pragma unroll
    for (int d0 = 0; d0 < DQK / 16; ++d0) qf[d0] = *(const bf16x8*)(qrow + 16 * d0 + 8 * hi);
    if (DQK == 96) { if (p.rope_q) { const int pos = p.qpos0 + 32 * wid + r32; rope_frag(qf[4], pos >> 6, hi, LOG2_THETA / 8.f); rope_frag(qf[5], pos & 63, hi, LOG2_THETA / 8.f); } }
    if (MODE == 1) { if (tid < 465) { const int dr = tid / 31, dc = tid - dr * 31; ((LAS float*)(lds + RPB_OFF))[dr * 32 + dc] = p.rpb[tid] * LOG2E; }
                     if (tid < 15) ((LAS float*)(lds + RPB_OFF))[tid * 32 + 31] = -__builtin_inff(); }
    f32x16 o[2];
#pragma unroll
    for (int r = 0; r < 16; ++r) { o[0][r] = 0.f; o[1][r] = 0.f; }
    float m_run = 0.f, l_run = 0.f;
    if constexpr (MODE == 0) attn_core_pipe<DQK>(lds, p, qf, o, m_run, l_run, tid, wid, lane); else attn_core<DQK, 64, MODE>(lds, p, qf, o, m_run, l_run, tid, wid, lane);
    const float l = l_run + __shfl_xor(l_run, 32), inv = 1.0f / l;
    unsigned char* orow = p.O + (size_t)(32 * wid) * p.op + r32;
#pragma unroll
    for (int r = 0; r < 16; ++r) { int hio = hi; asm volatile("" : "+v"(hio)); const int q = crow(r, hio); const float iv = __shfl(inv, q) * MIX_SCALE;
#pragma unroll
        for (int c = 0; c < 2; ++c) orow[(size_t)q * p.op + 32 * c] = (unsigned char)__builtin_amdgcn_cvt_pk_fp8_f32(o[c][r] * iv, 0.f, 0u, false);
        __builtin_amdgcn_sched_barrier(0); }
}

template <int DQK>
DI void attn_core_w64(LAS unsigned char* lds, const AttnP& p, const bf16x8 (&qa)[DQK / 16], const bf16x8 (&qb)[DQK / 16], f32x16 (&oa)[2], f32x16 (&ob)[2], float (&m_run)[2], float (&l_run)[2],
                      const int tid, const int wid, const int lane) {
    constexpr bool K8 = ATT_K8 && (DQK == 64), K8M = ATT_K8 && (DQK == 96);
    constexpr int KROWB = K8 ? 80 : K8M ? 112 : (DQK + 8) * 2, VROWB = 192, TILEB = 64 * (KROWB + VROWB), CPR = DQK / 8;
    constexpr int NKC = (DQK == 64) ? 1 : 2;
    constexpr bool USE_NEGM = (DQK == 64);
    static_assert(2 * TILEB <= RPB_OFF, "attention LDS");
    const int r32 = lane & 31, hi = lane >> 5;
    int krow[NKC], kch[NKC];
#pragma unroll
    for (int i = 0; i < NKC; ++i) { const int c = tid + 512 * i; krow[i] = c / CPR; kch[i] = c - krow[i] * CPR; }
    const int vrow = tid >> 3, vch = tid & 7;
    u32x4 krA[NKC], vrA, krB[NKC], vrB;
    const int nt = p.ntiles;
#define AW_LOAD(j, kr, vr) do { const int trow_ = p.kt0 + 64 * (j); \
        _Pragma("unroll") for (int i = 0; i < NKC; ++i) { if (DQK == 64 || i == 0 || tid < 256) { \
            const bf16* src_ = (kch[i] < 8) ? (p.K + (size_t)(trow_ + krow[i]) * p.kp + kch[i] * 8) : (p.K2 + (size_t)(trow_ + krow[i]) * p.k2p + (kch[i] - 8) * 8); \
            kr[i] = *(const u32x4*)src_; } } \
        vr = *(const u32x4*)(p.V + (size_t)(trow_ + vrow) * p.vp + vch * 8); } while (0)
#define AW_WRITE(b, kr, vr) do { LAS unsigned char* kb_ = lds + (b) * TILEB; \
        if constexpr (K8) { *(LAS u32x2*)(kb_ + krow[0] * KROWB + 32 * (kch[0] & 1) + 8 * (kch[0] >> 1)) = bf8x8(kr[0], K8_SCALE); } \
        else if constexpr (K8M) { _Pragma("unroll") for (int i = 0; i < NKC; ++i) { if (i == 0 || tid < 256) { const int kc_ = kch[i] - 8; \
            const int off_ = (kch[i] < 8) ? (32 * (kch[i] & 1) + 8 * (kch[i] >> 1)) : (64 + 16 * (kc_ & 1) + 8 * (kc_ >> 1)); \
            *(LAS u32x2*)(kb_ + krow[i] * KROWB + off_) = bf8x8(kr[i], K8_SCALE); } } } else { \
        _Pragma("unroll") for (int i = 0; i < NKC; ++i) { if (DQK == 64 || i == 0 || tid < 256) *(LAS u32x4*)(kb_ + krow[i] * KROWB + kch[i] * 16) = kr[i]; } } \
        *(LAS u32x4*)(kb_ + 64 * KROWB + vrow * VROWB + vch * 16) = vr; } while (0)
    AW_LOAD(0, krA, vrA); AW_WRITE(0, krA, vrA);
    if (nt > 1) AW_LOAD(1, krB, vrB);
    if (nt > 2) AW_LOAD(2, krA, vrA);
    ATT_BAR();
    pg8::i32x8v q8a = {0, 0, 0, 0, 0, 0, 0, 0}, q8b = {0, 0, 0, 0, 0, 0, 0, 0};
    pg8::i32x8v q8a1 = {0, 0, 0, 0, 0, 0, 0, 0}, q8b1 = {0, 0, 0, 0, 0, 0, 0, 0};
    if constexpr (K8) { q8a = q_to_fp8(qa); q8b = q_to_fp8(qb); }
    if constexpr (K8M) {
#pragma unroll
        for (int d0 = 0; d0 < 4; ++d0) { const u32x2 ta = bf8x8(__builtin_bit_cast(u32x4, qa[d0]), Q8_SCALE), tb = bf8x8(__builtin_bit_cast(u32x4, qb[d0]), Q8_SCALE); q8a[2 * d0] = (int)ta.x; q8a[2 * d0 + 1] = (int)ta.y; q8b[2 * d0] = (int)tb.x; q8b[2 * d0 + 1] = (int)tb.y; }
#pragma unroll
        for (int d0 = 4; d0 < 6; ++d0) { const u32x2 ta = bf8x8(__builtin_bit_cast(u32x4, qa[d0]), Q8_SCALE), tb = bf8x8(__builtin_bit_cast(u32x4, qb[d0]), Q8_SCALE); q8a1[2 * (d0 - 4)] = (int)ta.x; q8a1[2 * (d0 - 4) + 1] = (int)ta.y; q8b1[2 * (d0 - 4)] = (int)tb.x; q8b1[2 * (d0 - 4) + 1] = (int)tb.y; }
    }
    f32x16 nma, nmb;
#pragma unroll
    for (int r = 0; r < 16; ++r) { nma[r] = 0.f; nmb[r] = 0.f; }
    bool first = true;
    const int q4 = (lane & 15) >> 2, p4 = lane & 3, blk = (lane >> 4) & 1;
    auto half = [&](const int j, const int u) __attribute__((always_inline)) {
        const LAS unsigned char* kb = lds + (j & 1) * TILEB; const LAS unsigned char* vb = kb + 64 * KROWB;
        {
            const LAS unsigned char* kbu = kb + u * 32 * KROWB + r32 * KROWB + ((K8 || K8M) ? 32 : 16) * hi;
            f32x16 sa, sb;
            if (USE_NEGM) { sa = nma; sb = nmb; } else {
#pragma unroll
                for (int r = 0; r < 16; ++r) { sa[r] = 0.f; sb[r] = 0.f; } }
            if constexpr (K8) { const pg8::i32x8v k8 = k8_read(kbu); sa = MFMA_QK8(k8, q8a, sa); sb = MFMA_QK8(k8, q8b, sb); }
            else if constexpr (K8M) { const pg8::i32x8v k8 = k8_read(kbu); const u32x4 kt = *(const LAS u32x4*)(kbu + 64 - 16 * hi);
                const pg8::i32x8v k81 = {(int)kt.x, (int)kt.y, (int)kt.z, (int)kt.w, 0, 0, 0, 0};
                sa = MFMA_QK8(k8, q8a, sa); sb = MFMA_QK8(k8, q8b, sb); sa = MFMA_QK8(k81, q8a1, sa); sb = MFMA_QK8(k81, q8b1, sb); } else {
#pragma unroll
            for (int d0 = 0; d0 < DQK / 16; ++d0) {
                const bf16x8 k0 = *(const LAS bf16x8*)(kbu + 32 * d0);
                sa = __builtin_amdgcn_mfma_f32_32x32x16_bf16(k0, qa[d0], sa, 0, 0, 0);
                sb = __builtin_amdgcn_mfma_f32_32x32x16_bf16(k0, qb[d0], sb, 0, 0, 0);
            } }
            if (first) {
                float ma = fmaxf(fmaxf(sa[0], sa[1]), sa[2]), mb = fmaxf(fmaxf(sb[0], sb[1]), sb[2]);
#pragma unroll
                for (int r = 3; r < 15; r += 2) { ma = fmaxf(fmaxf(ma, sa[r]), sa[r + 1]); mb = fmaxf(fmaxf(mb, sb[r]), sb[r + 1]); }
                ma = fmaxf(ma, sa[15]); mb = fmaxf(mb, sb[15]);
                ma = fmaxf(ma, __shfl_xor(ma, 32)); mb = fmaxf(mb, __shfl_xor(mb, 32));
                m_run[0] = ma; m_run[1] = mb;
                if (USE_NEGM) {
#pragma unroll
                    for (int r = 0; r < 16; ++r) { sa[r] -= ma; sb[r] -= mb; nma[r] = -ma; nmb[r] = -mb; } }
                first = false;
            }
            float pa0 = 0.f, pa1 = 0.f, pb0 = 0.f, pb1 = 0.f;
            if (USE_NEGM) {
#pragma unroll
                for (int r = 0; r < 16; r += 2) { sa[r] = fast_exp2(sa[r]); sa[r + 1] = fast_exp2(sa[r + 1]); sb[r] = fast_exp2(sb[r]); sb[r + 1] = fast_exp2(sb[r + 1]);
                    pa0 += sa[r]; pa1 += sa[r + 1]; pb0 += sb[r]; pb1 += sb[r + 1]; }
            } else { const float ma = m_run[0], mb = m_run[1];
#pragma unroll
                for (int r = 0; r < 16; r += 2) { sa[r] = fast_exp2(sa[r] - ma); sa[r + 1] = fast_exp2(sa[r + 1] - ma); sb[r] = fast_exp2(sb[r] - mb); sb[r + 1] = fast_exp2(sb[r + 1] - mb);
                    pa0 += sa[r]; pa1 += sa[r + 1]; pb0 += sb[r]; pb1 += sb[r + 1]; }
            }
            const float psa = pa0 + pa1, psb = pb0 + pb1;
            l_run[0] += psa; l_run[1] += psb;
            const float pta = psa + __shfl_xor(psa, 32), ptb = psb + __shfl_xor(psb, 32);
            const bool needa = pta > 65536.0f, needb = ptb > 65536.0f;
            bf16x8 fa[2], fb[2];
#pragma unroll
            for (int s = 0; s < 2; ++s) {
                u32x4 w0, w1;
                w0.x = pg8::cvt_pk_bf16(sa[8 * s + 0], sa[8 * s + 1]); w0.y = pg8::cvt_pk_bf16(sa[8 * s + 2], sa[8 * s + 3]); w0.z = pg8::cvt_pk_bf16(sa[8 * s + 4], sa[8 * s + 5]); w0.w = pg8::cvt_pk_bf16(sa[8 * s + 6], sa[8 * s + 7]);
                w1.x = pg8::cvt_pk_bf16(sb[8 * s + 0], sb[8 * s + 1]); w1.y = pg8::cvt_pk_bf16(sb[8 * s + 2], sb[8 * s + 3]); w1.z = pg8::cvt_pk_bf16(sb[8 * s + 4], sb[8 * s + 5]); w1.w = pg8::cvt_pk_bf16(sb[8 * s + 6], sb[8 * s + 7]);
                fa[s] = __builtin_bit_cast(bf16x8, w0); fb[s] = __builtin_bit_cast(bf16x8, w1);
            }
            const LAS unsigned char* vbase = vb + (32 * u + 4 * hi + q4) * VROWB + 32 * blk + 8 * p4;
#pragma unroll
            for (int s = 0; s < 2; ++s)
#pragma unroll
                for (int c = 0; c < 2; ++c) {
                    const LAS unsigned char* a0 = vbase + (16 * s) * VROWB + 64 * c;
                    const s16x4 lo = vtr(a0), hh = vtr(a0 + 8 * VROWB);
                    const bf16x8 vf = (bf16x8){lo[0], lo[1], lo[2], lo[3], hh[0], hh[1], hh[2], hh[3]};
                    oa[c] = __builtin_amdgcn_mfma_f32_32x32x16_bf16(fa[s], vf, oa[c], 0, 0, 0);
                    ob[c] = __builtin_amdgcn_mfma_f32_32x32x16_bf16(fb[s], vf, ob[c], 0, 0, 0);
                }
            if (__any(needa || needb)) {
                const int exa = (int)((__builtin_bit_cast(unsigned, pta) >> 23) & 255u) - 127, exb = (int)((__builtin_bit_cast(unsigned, ptb) >> 23) & 255u) - 127;
                const float dla = needa ? (float)exa : 0.f, dlb = needb ? (float)exb : 0.f, fsa = fast_exp2(-dla), fsb = fast_exp2(-dlb);
                m_run[0] += dla; m_run[1] += dlb; l_run[0] *= fsa; l_run[1] *= fsb;
                if (USE_NEGM) {
#pragma unroll
                    for (int r = 0; r < 16; ++r) { nma[r] = -m_run[0]; nmb[r] = -m_run[1]; } }
                int hio = hi; asm volatile("" : "+v"(hio));
#pragma unroll
                for (int r = 0; r < 16; ++r) { const float fra = __shfl(fsa, crow(r, hio)), frb = __shfl(fsb, crow(r, hio)); oa[0][r] *= fra; oa[1][r] *= fra; ob[0][r] *= frb; ob[1][r] *= frb; }
            }
        }
    };
    for (int j = 0; j < nt; j += 2) {
        half(j, 0);
        if (j + 1 < nt) AW_WRITE((j + 1) & 1, krB, vrB);
        if (j + 3 < nt) AW_LOAD(j + 3, krB, vrB);
        half(j, 1);
        ATT_BAR();
        if (j + 1 >= nt) break;
        half(j + 1, 0);
        if (j + 2 < nt) AW_WRITE((j + 2) & 1, krA, vrA);
        if (j + 4 < nt) AW_LOAD(j + 4, krA, vrA);
        half(j + 1, 1);
        ATT_BAR();
    }
#undef AW_LOAD
#undef AW_WRITE
}

template <int DQK>
DI void attn_unit_w64(LAS unsigned char* lds, const AttnP& p) {
    const int tid = opaque_tid(), lane = tid & 63, wid = __builtin_amdgcn_readfirstlane(tid >> 6), r32 = lane & 31, hi = lane >> 5;
    bf16x8 qa[DQK / 16], qb[DQK / 16];
    const bf16* qrow = p.Q + (size_t)(64 * wid + r32) * p.qp;
#pragma unroll
    for (int d0 = 0; d0 < DQK / 16; ++d0) { qa[d0] = *(const bf16x8*)(qrow + 16 * d0 + 8 * hi); qb[d0] = *(const bf16x8*)(qrow + (size_t)32 * p.qp + 16 * d0 + 8 * hi); }
    if (DQK == 96) { if (p.rope_q) { const int pos = p.qpos0 + 64 * wid + r32;
        rope_frag(qa[4], pos >> 6, hi, LOG2_THETA / 8.f); rope_frag(qa[5], pos & 63, hi, LOG2_THETA / 8.f);
        rope_frag(qb[4], (pos + 32) >> 6, hi, LOG2_THETA / 8.f); rope_frag(qb[5], (pos + 32) & 63, hi, LOG2_THETA / 8.f); } }
    f32x16 oa[2], ob[2];
#pragma unroll
    for (int r = 0; r < 16; ++r) { oa[0][r] = 0.f; oa[1][r] = 0.f; ob[0][r] = 0.f; ob[1][r] = 0.f; }
    float m_run[2] = {0.f, 0.f}, l_run[2] = {0.f, 0.f};
    attn_core_w64<DQK>(lds, p, qa, qb, oa, ob, m_run, l_run, tid, wid, lane);
    const float inva = 1.0f / (l_run[0] + __shfl_xor(l_run[0], 32)), invb = 1.0f / (l_run[1] + __shfl_xor(l_run[1], 32));
    unsigned char* orow = p.O + (size_t)(64 * wid) * p.op + r32;
#pragma unroll
    for (int r = 0; r < 16; ++r) { int hio = hi; asm volatile("" : "+v"(hio)); const int q = crow(r, hio); const float iva = __shfl(inva, q) * MIX_SCALE, ivb = __shfl(invb, q) * MIX_SCALE;
#pragma unroll
        for (int c = 0; c < 2; ++c) { orow[(size_t)q * p.op + 32 * c] = (unsigned char)__builtin_amdgcn_cvt_pk_fp8_f32(oa[c][r] * iva, 0.f, 0u, false);
                                      orow[(size_t)(q + 32) * p.op + 32 * c] = (unsigned char)__builtin_amdgcn_cvt_pk_fp8_f32(ob[c][r] * ivb, 0.f, 0u, false); }
        __builtin_amdgcn_sched_barrier(0); }
}

DI void attn_unit_diff(LAS unsigned char* lds, const AttnP& p, const float lam, const float oml, const float* subln) {
    const int tid = opaque_tid(), lane = tid & 63, wid = __builtin_amdgcn_readfirstlane(tid >> 6), r32 = lane & 31, hi = lane >> 5;
    LAS unsigned* stash = (LAS unsigned*)(lds + O1_OFF) + tid;
    for (int jh = 0; jh < 2; ++jh) {
        AttnP pj = p; pj.K = p.K + 64 * jh;
        bf16x8 qf[4];
        const bf16* qrow = p.Q + (size_t)(32 * wid + r32) * p.qp + 64 * jh;
#pragma unroll
        for (int d0 = 0; d0 < 4; ++d0) qf[d0] = *(const bf16x8*)(qrow + 16 * d0 + 8 * hi);
        f32x16 o[4];
#pragma unroll
        for (int c = 0; c < 4; ++c)
#pragma unroll
            for (int r = 0; r < 16; ++r) o[c][r] = 0.f;
        float m_run = 0.f, l_run = 0.f;
        attn_core<64, 128, 0>(lds, pj, qf, o, m_run, l_run, tid, wid, lane);
        const float l = l_run + __shfl_xor(l_run, 32), inv = 1.0f / l;
        if (jh == 0) {
#pragma unroll
            for (int r = 0; r < 8; ++r) { int hio = hi; asm volatile("" : "+v"(hio)); const float iv0 = __shfl(inv, crow(2 * r, hio)), iv1 = __shfl(inv, crow(2 * r + 1, hio));
#pragma unroll
                for (int c = 0; c < 4; ++c) stash[512 * (c * 8 + r)] = pk2(o[c][2 * r] * iv0, o[c][2 * r + 1] * iv1);
                __builtin_amdgcn_sched_barrier(0); }
        } else {
            float sg[4];
#pragma unroll
            for (int c = 0; c < 4; ++c) sg[c] = subln[32 * c + r32] * (oml * MIX_SCALE);
            unsigned char* orow = p.O + (size_t)(32 * wid) * p.op + r32;
#pragma unroll
            for (int r = 0; r < 16; ++r) { int hio = hi; asm volatile("" : "+v"(hio)); const int q = crow(r, hio); const float iv = __shfl(inv, q);
                float v[4]; float ss = 0.f;
#pragma unroll
                for (int c = 0; c < 4; ++c) { const unsigned w1 = stash[512 * (c * 8 + (r >> 1))]; const float o1 = (r & 1) ? bfhi(w1) : bflo(w1); v[c] = o1 - lam * (o[c][r] * iv); ss += v[c] * v[c]; }
                ss += __shfl_xor(ss, 1); ss += __shfl_xor(ss, 2); ss += __shfl_xor(ss, 4); ss += __shfl_xor(ss, 8); ss += __shfl_xor(ss, 16);
                const float rinv = 1.0f / sqrtf(ss * (1.0f / 128.0f) + RMS_EPS);
#pragma unroll
                for (int c = 0; c < 4; ++c) orow[(size_t)q * p.op + 32 * c] = (unsigned char)__builtin_amdgcn_cvt_pk_fp8_f32(v[c] * rinv * sg[c], 0.f, 0u, false);
                __builtin_amdgcn_sched_barrier(0); }
        }
    }
}
}


DI void p0_mod_item(LAS unsigned char* lds, const float* c, const float* c_ctx, const float* mod_w, const float* mod_b, float* mod, const int item) {
    const int tid = opaque_tid(), lane = tid & 63, wid = __builtin_amdgcn_readfirstlane(tid >> 6), l = item / 48, col0 = (item - l * 48) * 128;
    constexpr int SP = 1026;
    LAS float* s = (LAS float*)lds;
    __syncthreads();
    for (int idx = tid; idx < 33 * 1024; idx += NTHR) { const int r = idx >> 10, kk = idx & 1023; const float cv = (r < 32) ? c[r * 1024 + kk] : c_ctx[kk]; s[r * SP + kk] = cv / (1.0f + __expf(-cv)); }
    __syncthreads();
    const int i32 = lane & 31, hi = lane >> 5;
    f32x16 acc[4];
#pragma unroll
    for (int cb = 0; cb < 4; ++cb)
#pragma unroll
        for (int r = 0; r < 16; ++r) acc[cb][r] = 0.f;
    float a32[4] = {0.f, 0.f, 0.f, 0.f};
    const float* w = mod_w + ((size_t)l * 1024 + wid * 128) * 6144 + col0 + i32;
    const LAS float* sa = s + i32 * SP + wid * 128 + 2 * hi;
    const LAS float* sc = s + 32 * SP + wid * 128 + 2 * hi;
#pragma unroll 4
    for (int q = 0; q < 32; ++q) {
        const float* wp = w + (size_t)(4 * q + 2 * hi) * 6144;
        float b0[4], b1[4];
#pragma unroll
        for (int cb = 0; cb < 4; ++cb) { b0[cb] = wp[32 * cb]; b1[cb] = wp[6144 + 32 * cb]; }
        const f32x2 av = *(const LAS f32x2*)(sa + 4 * q), cv = *(const LAS f32x2*)(sc + 4 * q);
#pragma unroll
        for (int cb = 0; cb < 4; ++cb) {
            acc[cb] = __builtin_amdgcn_mfma_f32_32x32x2f32(av[0], b0[cb], acc[cb], 0, 0, 0);
            acc[cb] = __builtin_amdgcn_mfma_f32_32x32x2f32(av[1], b1[cb], acc[cb], 0, 0, 0);
            a32[cb] += cv[0] * b0[cb] + cv[1] * b1[cb];
        }
    }
#pragma unroll
    for (int cb = 0; cb < 4; ++cb) a32[cb] += __shfl_xor(a32[cb], 32);
    __syncthreads();
    LAS float* red = s + (size_t)wid * 33 * 128;
#pragma unroll
    for (int cb = 0; cb < 4; ++cb) {
#pragma unroll
        for (int r = 0; r < 16; ++r) red[((r & 3) + 8 * (r >> 2) + 4 * hi) * 128 + 32 * cb + i32] = acc[cb][r];
        if (hi == 0) red[32 * 128 + 32 * cb + i32] = a32[cb];
    }
    __syncthreads();
    for (int idx = tid; idx < 33 * 128; idx += NTHR) { const int r = idx >> 7, cc = idx & 127; float v = 0.f;
#pragma unroll
        for (int wv = 0; wv < 8; ++wv) v += s[(wv * 33 + r) * 128 + cc];
        mod[((size_t)l * 33 + r) * 6144 + col0 + cc] = v + mod_b[l * 6144 + col0 + cc]; }
    __syncthreads();
}
struct TrDesc { const float* W; unsigned char* WT; int K, N, dK, mode, scale_n, fp8, item; float scale, scale2; };
constexpr int TI_GU = 128 * 1024, TI_D = 128 * 512, TI_WE = 2 * 1152, TI_WO_ = 2 * 976, TI_OUT = 4 * 512, TI_UQ = 2 * 96, TI_UKV = 2 * 64;
constexpr int TI_TOTAL = TI_GU + TI_D + TI_WE + TI_WO_ + TI_OUT + TI_UQ + TI_UKV;
DI TrDesc tr_decode(const float* const* in, unsigned char* ws, int r) {
    TrDesc d; d.scale_n = 0; d.scale = 1.f; d.scale2 = 1.f; d.mode = 0; d.fp8 = 0;
    if (r < TI_GU) { const int le = r >> 10; d.W = in[28] + (size_t)le * 1024 * 2048; d.K = 1024; d.N = 2048; d.WT = ws + WS_WGU + (size_t)le * 2048 * 1024; d.dK = 1024; d.mode = 1; d.scale_n = 1 << 30; d.scale = WGU_SCALE; d.fp8 = 1; d.item = r & 1023; return d; } r -= TI_GU;
    if (r < TI_D) { const int le = r >> 9; d.W = in[30] + (size_t)le * 1024 * 1024; d.K = 1024; d.N = 1024; d.WT = ws + WS_WD + (size_t)le * 1024 * 1024; d.dK = 1024; d.mode = 2; d.scale_n = 1 << 30; d.scale = WD_SCALE; d.fp8 = 1; d.item = r & 511; return d; } r -= TI_D;
    if (r < TI_WE) { const int j = r / 1152; d.W = in[10] + (size_t)j * 1024 * 2304; d.K = 1024; d.N = 2304; d.WT = ws + WS_WIN + (size_t)(2 * j) * 2304 * 1024 * 2; d.dK = 1024; d.scale_n = 512; d.scale = C2; d.item = r - j * 1152; if (INPROJ_FP8) { d.fp8 = 1; d.scale = C2 * WI_SCALE; d.scale2 = WI_SCALE; } return d; } r -= TI_WE;
    if (r < TI_WO_) { const int j = r / 976; d.W = in[15] + (size_t)j * 1024 * 1952; d.K = 1024; d.N = 1952; d.WT = ws + WS_WIN + (size_t)(2 * j + 1) * 2304 * 1024 * 2; d.dK = 1024; d.scale_n = 512; d.scale = C2; d.item = r - j * 976; if (INPROJ_FP8) { d.fp8 = 1; d.scale = C2 * WI_SCALE; d.scale2 = WI_SCALE; } return d; } r -= TI_WO_;
    if (r < TI_OUT) { const int q = r >> 9, j = q >> 1, odd = q & 1; d.W = in[odd ? 16 : 11] + (size_t)j * 1024 * 1024; d.K = 1024; d.N = 1024; d.WT = ws + WS_WOUT + (size_t)(2 * j + odd) * 1024 * 1024; d.dK = 1024; d.scale_n = 1 << 30; d.scale = WO_SCALE; d.fp8 = 1; d.item = r & 511; return d; } r -= TI_OUT;
    if (r < TI_UQ) { const int j = r / 96; d.W = in[23] + (size_t)j * 256 * 768; d.K = 256; d.N = 768; d.WT = ws + WS_WUQ + (size_t)j * 768 * 256 * 2; d.dK = 256; d.scale_n = 768; d.scale = C2M; d.item = r - j * 96; return d; } r -= TI_UQ;
    { const int j = r / 64; d.W = in[25] + (size_t)j * 128 * 1024; d.K = 128; d.N = 1024; d.WT = ws + WS_WUKV + (size_t)j * 1024 * 256 * 2; d.dK = 256; d.item = r - j * 64; return d; }
}
DI void tr_load(const TrDesc& d, f32x4 (&tv)[8], const int lane) {
    const int nblk = d.N / 32, kb = d.item / nblk, nb = d.item - kb * nblk, k0 = 64 * kb, n0 = 32 * nb;
    const float* p = d.W + (size_t)(k0 + (lane >> 3)) * d.N + n0 + 4 * (lane & 7);
#pragma unroll
    for (int i = 0; i < 8; ++i) tv[i] = *(const f32x4*)(p + (size_t)(8 * i) * d.N);
}
DI void tr_store(const TrDesc& d, LAS float* scr, const int lane) {
    const int nblk = d.N / 32, kb = d.item / nblk, nb = d.item - kb * nblk, k0 = 64 * kb, n0 = 32 * nb;
    if (d.fp8) {
        const int cch = lane & 3;
#pragma unroll
        for (int j = 0; j < 2; ++j) { const int nl = (lane >> 2) + 16 * j, n = n0 + nl; const LAS float* s = scr + (16 * cch) * 33 + nl; const float sc = (n < d.scale_n) ? d.scale : d.scale2;
            int row = n; if (d.mode == 1) { const int jj = n >> 1, sh = n & 1; row = 256 * (jj >> 7) + 128 * sh + (jj & 127); }
            if (d.mode == 2) { const int na = n & 255; row = (n & ~255) + 128 * ((na >> 3) & 1) + 32 * (na >> 6) + 8 * ((na >> 4) & 3) + (na & 7); }
            u32x4 o;
            o.x = pk4_fp8(s[0 * 33] * sc, s[1 * 33] * sc, s[2 * 33] * sc, s[3 * 33] * sc); o.y = pk4_fp8(s[4 * 33] * sc, s[5 * 33] * sc, s[6 * 33] * sc, s[7 * 33] * sc);
            o.z = pk4_fp8(s[8 * 33] * sc, s[9 * 33] * sc, s[10 * 33] * sc, s[11 * 33] * sc); o.w = pk4_fp8(s[12 * 33] * sc, s[13 * 33] * sc, s[14 * 33] * sc, s[15 * 33] * sc);
            *(u32x4*)(d.WT + (size_t)row * d.dK + k0 + 16 * cch) = o; }
    } else {
        const int cch = lane & 7;
#pragma unroll
        for (int j = 0; j < 4; ++j) { const int nl = (lane >> 3) + 8 * j, n = n0 + nl; const LAS float* s = scr + (8 * cch) * 33 + nl;
            const float sc = (n < d.scale_n) ? d.scale : 1.0f;
            u32x4 o; o.x = pk2(s[0 * 33] * sc, s[1 * 33] * sc); o.y = pk2(s[2 * 33] * sc, s[3 * 33] * sc); o.z = pk2(s[4 * 33] * sc, s[5 * 33] * sc); o.w = pk2(s[6 * 33] * sc, s[7 * 33] * sc);
            *(u32x4*)((bf16*)d.WT + (size_t)n * d.dK + k0 + 8 * cch) = o; }
    }
}
DI void p0_transposes(LAS unsigned char* lds, const float* const* in, unsigned char* ws, const int gw, const int ngw, const int wid, const int lane) {
    LAS float* scr = (LAS float*)(lds + wid * 16384);
    if (gw >= TI_TOTAL) return;
    f32x4 ta[8], tb[8];
    TrDesc da = tr_decode(in, ws, gw), db = da;
    tr_load(da, ta, lane);
    if (gw + ngw < TI_TOTAL) { db = tr_decode(in, ws, gw + ngw); tr_load(db, tb, lane); }
#define TR_STEP(D, TV, NEXT) do { \
        _Pragma("unroll") for (int i = 0; i < 8; ++i) { LAS float* sp = scr + ((lane >> 3) + 8 * i) * 33 + 4 * (lane & 7); sp[0] = TV[i][0]; sp[1] = TV[i][1]; sp[2] = TV[i][2]; sp[3] = TV[i][3]; } \
        TrDesc nx_ = D; \
        if ((NEXT) < TI_TOTAL) { nx_ = tr_decode(in, ws, (NEXT)); tr_load(nx_, TV, lane); } \
        asm volatile("s_waitcnt lgkmcnt(0)" ::: "memory"); \
        tr_store(D, scr, lane); \
        asm volatile("s_waitcnt lgkmcnt(0)" ::: "memory"); \
        D = nx_; } while (0)
    for (int it = gw; it < TI_TOTAL; it += 2 * ngw) {
        TR_STEP(da, ta, it + 2 * ngw);
        if (it + ngw >= TI_TOTAL) break;
        TR_STEP(db, tb, it + 3 * ngw);
    }
#undef TR_STEP
}
DI void p0_zero(unsigned char* ws, const int gtid, const int ngt) {
    if (INPROJ_FP8) { for (int i = gtid; i < 2 * 96 * 64; i += ngt) { const int j = i / (96 * 64), r = i - j * 96 * 64; *(u32x4*)(ws + WS_WIN + (size_t)(2 * j + 1) * 2304 * 1024 * 2 + (size_t)1952 * 1024 + (size_t)r * 16) = (u32x4){0u, 0u, 0u, 0u}; } }
    else for (int i = gtid; i < 2 * 96 * 128; i += ngt) { const int j = i / (96 * 128), r = i - j * 96 * 128; *(u32x4*)((bf16*)(ws + WS_WIN) + ((size_t)(2 * j + 1) * 2304 + 1952) * 1024 + (size_t)r * 8) = (u32x4){0u, 0u, 0u, 0u}; }
    for (int i = gtid; i < 2 * 1024 * 16; i += ngt) { const int row = i >> 4, ch = i & 15; *(u32x4*)((bf16*)(ws + WS_WUKV) + (size_t)row * 256 + 128 + ch * 8) = (u32x4){0u, 0u, 0u, 0u}; }
}
DI void p0b_rows(const float* x, const float* ctx, const float* mod0, bf16* X, bf16* H, const int gw, const int ngw, const int lane) {
    const int c0 = 16 * lane;
    f32x4 vn[4];
#define P0B_SRC(mm) (((mm) % TPB < CTXL) ? ctx + ((size_t)((mm) / TPB) * CTXL + (mm) % TPB) * DM : x + ((size_t)((mm) / TPB) * SEQ + ((mm) % TPB - CTXL)) * DM)
    if (gw < T) { const float* src = P0B_SRC(gw) + c0;
#pragma unroll
        for (int j = 0; j < 4; ++j) vn[j] = *(const f32x4*)(src + 4 * j); }
    for (int m = gw; m < T; m += ngw) {
        const int b = m / TPB, t = m - b * TPB;
        const float* md = mod0 + (size_t)((t < CTXL) ? 32 : b) * 6144 + c0;
        f32x4 vc[4];
#pragma unroll
        for (int j = 0; j < 4; ++j) vc[j] = vn[j];
        if (m + ngw < T) { const float* src = P0B_SRC(m + ngw) + c0;
#pragma unroll
            for (int j = 0; j < 4; ++j) vn[j] = *(const f32x4*)(src + 4 * j); }
        u32x4 xo[2], ho[2];
#pragma unroll
        for (int j = 0; j < 4; ++j) { const f32x4 v = vc[j];
            xo[j >> 1][2 * (j & 1)] = pk2(v[0], v[1]); xo[j >> 1][2 * (j & 1) + 1] = pk2(v[2], v[3]);
            const f32x4 sh = *(const f32x4*)(md + 4 * j), sc = *(const f32x4*)(md + 1024 + 4 * j); const f32x4 h = v * (sc + 1.0f) + sh;
            ho[j >> 1][2 * (j & 1)] = pk2(h[0], h[1]); ho[j >> 1][2 * (j & 1) + 1] = pk2(h[2], h[3]); }
        bf16* xr = X + (size_t)m * DM + c0; *(u32x4*)xr = xo[0]; *(u32x4*)(xr + 8) = xo[1];
        if (INPROJ_FP8) { u32x4 h8;
#pragma unroll
            for (int j = 0; j < 4; ++j) { const f32x4 sh = *(const f32x4*)(md + 4 * j), sc = *(const f32x4*)(md + 1024 + 4 * j); const f32x4 h = (vc[j] * (sc + 1.0f) + sh) * H_SCALE; h8[j] = pk4_fp8(h[0], h[1], h[2], h[3]); }
            *(u32x4*)((unsigned char*)H + (size_t)m * DM + c0) = h8; }
        else { bf16* hr = H + (size_t)m * DM + c0; *(u32x4*)hr = ho[0]; *(u32x4*)(hr + 8) = ho[1]; }
    }
#undef P0B_SRC
}
DI void unpack8(const u32x4 w, float (&v)[8]) { v[0] = bflo(w.x); v[1] = bfhi(w.x); v[2] = bflo(w.y); v[3] = bfhi(w.y); v[4] = bflo(w.z); v[5] = bfhi(w.z); v[6] = bflo(w.w); v[7] = bfhi(w.w); }
DI u32x4 pack8(const float (&v)[8]) { u32x4 w; w.x = pk2(v[0], v[1]); w.y = pk2(v[2], v[3]); w.z = pk2(v[4], v[5]); w.w = pk2(v[6], v[7]); return w; }
DI void rope_chunk(float (&y)[8], const float (&rf)[8], const float position, const bool second, const int pmask) {
#pragma unroll
    for (int e = 0; e < 8; ++e) { float rev = position * rf[e]; rev = rev - floorf(rev);
        const float sn = __builtin_amdgcn_sinf(rev), cs = __builtin_amdgcn_cosf(rev); const float partner = __shfl_xor(y[e], pmask);
        y[e] = second ? (partner * sn + y[e] * cs) : (y[e] * cs - partner * sn); }
}
DI void post_even_rows(const bf16* P, bf16* PQ, const float* qg, const float* kg, const int gw, const int ngw, const int lane) {
    const int ch = lane & 7;
    float gq[8], gk[8], rf[8];
#pragma unroll
    for (int e = 0; e < 8; ++e) { gq[e] = qg[8 * ch + e] * C2; gk[e] = kg[8 * ch + e]; rf[e] = fast_exp2(-(float)(8 * (ch & 1) + e) * (LOG2_THETA / 16.f)) * 0.15915494309189535f; }
    const bool second = (ch & 2) != 0, colpart = (ch & 4) != 0;
    u32x4 nq, nk;
    if (gw < T) { const bf16* r0 = P + (size_t)gw * NPP; nq = *(const u32x4*)(r0 + 1536 + 8 * lane); nk = *(const u32x4*)(r0 + 2048 + 8 * (lane & 15)); }
    for (int m = gw; m < T; m += ngw) {
        const int b = m / TPB, t = m - b * TPB; const bool lat = t >= CTXL; const int pos = t - CTXL;
        bf16* row = PQ + (size_t)m * NPP;
        u32x4* pq = (u32x4*)(row + 1536 + 8 * lane); u32x4* pk = (u32x4*)(row + 2048 + 8 * (lane & 15));
        const u32x4 wq = nq, wk = nk;
        if (m + ngw < T) { const bf16* r1 = P + (size_t)(m + ngw) * NPP; nq = *(const u32x4*)(r1 + 1536 + 8 * lane); nk = *(const u32x4*)(r1 + 2048 + 8 * (lane & 15)); }
        const float position = (float)(colpart ? (pos & 63) : (pos >> 6));
        float v[8];
        unpack8(wq, v);
        { float ss = 0.f;
#pragma unroll
          for (int e = 0; e < 8; ++e) ss += v[e] * v[e];
          ss += __shfl_xor(ss, 1); ss += __shfl_xor(ss, 2); ss += __shfl_xor(ss, 4);
          const float ri = 1.0f / sqrtf(ss * (1.0f / 64.0f) + RMS_EPS);
#pragma unroll
          for (int e = 0; e < 8; ++e) v[e] = v[e] * ri * gq[e];
          if (lat) rope_chunk(v, rf, position, second, 2);
          *pq = pack8(v); }
        unpack8(wk, v);
        { float ss = 0.f;
#pragma unroll
          for (int e = 0; e < 8; ++e) ss += v[e] * v[e];
          ss += __shfl_xor(ss, 1); ss += __shfl_xor(ss, 2); ss += __shfl_xor(ss, 4);
          const float ri = 1.0f / sqrtf(ss * (1.0f / 64.0f) + RMS_EPS);
#pragma unroll
          for (int e = 0; e < 8; ++e) v[e] = v[e] * ri * gk[e];
          if (lat) rope_chunk(v, rf, position, second, 2);
          if (lane < 16) *pk = pack8(v); }
    }
}
DI void post_odd_rows(const bf16* P, bf16* PQ, const float* mqg, const float* mkvg, const int gw, const int ngw, const int lane) {
    const int ch = lane & 7;
    float rf[8], rf32[8], g3[8];
#pragma unroll
    for (int e = 0; e < 8; ++e) { rf[e] = fast_exp2(-(float)(8 * (ch & 1) + e) * (LOG2_THETA / 16.f)) * 0.15915494309189535f; rf32[e] = fast_exp2(-(float)e * (LOG2_THETA / 8.f)) * 0.15915494309189535f;
        g3[e] = (lane < 32) ? mqg[8 * lane + e] : (lane < 48) ? mkvg[8 * (lane - 32) + e] : 1.0f; }
    const bool second = (ch & 2) != 0, colpart = (ch & 4) != 0;
    const int c3 = lane;
    const bool second32 = (lane & 1) != 0, colpart32 = (lane & 2) != 0;
    u32x4 n0, n1, n3;
#define PODD_LOAD(mm) do { const bf16* r_ = P + (size_t)(mm) * NPP; n3 = *(const u32x4*)(r_ + 1536 + 8 * c3); n0 = *(const u32x4*)(r_ + 8 * lane); n1 = *(const u32x4*)(r_ + 512 + 8 * lane); } while (0)
    if (gw < T) PODD_LOAD(gw);
    for (int m = gw; m < T; m += ngw) {
        const int b = m / TPB, t = m - b * TPB; const bool lat = t >= CTXL; const int pos = t - CTXL;
        bf16* row = PQ + (size_t)m * NPP;
        u32x4* p0 = (u32x4*)(row + 8 * lane); u32x4* p1 = (u32x4*)(row + 512 + 8 * lane); u32x4* p3 = (u32x4*)(row + 1536 + 8 * c3);
        const u32x4 w0 = n0, w1 = n1, w3 = n3;
        if (m + ngw < T) PODD_LOAD(m + ngw);
        float v[8];
        if (lat) {
            const float position = (float)(colpart ? (pos & 63) : (pos >> 6));
            unpack8(w0, v); rope_chunk(v, rf, position, second, 2); *p0 = pack8(v);
            unpack8(w1, v); rope_chunk(v, rf, position, second, 2); *p1 = pack8(v);
        } else { *p0 = w0; *p1 = w1; }
        unpack8(w3, v);
        float ss = 0.f;
#pragma unroll
        for (int e = 0; e < 8; ++e) ss += v[e] * v[e];
        ss += __shfl_xor(ss, 1); ss += __shfl_xor(ss, 2); ss += __shfl_xor(ss, 4); ss += __shfl_xor(ss, 8);
        const float ss16 = ss + __shfl_xor(ss, 16);
        const float ri = (lane < 32) ? 1.0f / sqrtf(ss16 * (1.0f / 256.0f) + RMS_EPS) : 1.0f / sqrtf(ss * (1.0f / 128.0f) + RMS_EPS);
        float vn[8];
#pragma unroll
        for (int e = 0; e < 8; ++e) vn[e] = v[e] * ri * g3[e];
        if (lat) { const float position32 = (float)(colpart32 ? (pos & 63) : (pos >> 6)); rope_chunk(v, rf32, position32, second32, 1); }
        if (lane < 48) *p3 = pack8(vn); else if (lane < 52) { if (lat) *p3 = pack8(v); else *p3 = w3; } else *p3 = (u32x4){0u, 0u, 0u, 0u};
    }
}
DI int ln_row(const int wg, const int i, const int last) { if (!last) return wg * 288 + i; const int idx = wg * 256 + i; return (idx >> 11) * TPB + CTXL + (idx & 2047); }

DI void ln1_router_table(LAS unsigned char* lds, const float* rw) {
    const int tid = opaque_tid();
    for (int i = 0; i < 32; ++i) { const int idx = tid + NTHR * i, e = idx & 31, k = (idx >> 5) * 2;
        *(LAS unsigned*)(lds + e * 2064 + k * 2) = pk2(rw[k * 32 + e], rw[(k + 1) * 32 + e]); }
}
DI void ln1_router_phase(LAS unsigned char* lds, bf16* X, unsigned char* H8, const float* mod_l, const float* lng, const float* lnb, const float* rw, const float* rb,
                         unsigned* cnt_l, unsigned* list, float* gsort, const int wg, const int last, const int have_table) {
    const int tid = opaque_tid(), lane = tid & 63, wid = __builtin_amdgcn_readfirstlane(tid >> 6);
    constexpr int TROW = 2064;
    LAS unsigned char* wrt = lds; LAS unsigned char* ht = lds + 66048; LAS float* logt = (LAS float*)(lds + 99072);
    LAS unsigned* ent = (LAS unsigned*)(lds + 101376); LAS float* entw = (LAS float*)(ent + 1152); LAS unsigned* lcnt = ent + 2304; LAS unsigned* lbase = lcnt + 32;
    if (!have_table) ln1_router_table(lds, rw);
    if (tid < 32) lcnt[tid] = 0u;
    const int nrows = last ? 256 : 288, nblk = nrows >> 4;
    const int c0 = 16 * lane;
    f32x4 gv[4], bv[4];
#pragma unroll
    for (int j = 0; j < 4; ++j) { gv[j] = *(const f32x4*)(lng + c0 + 4 * j); bv[j] = *(const f32x4*)(lnb + c0 + 4 * j); }
    u32x4 xnext[2][2];
#define LN1_LOAD(blk_) do { _Pragma("unroll") for (int r = 0; r < 2; ++r) { const bf16* xp_ = X + (size_t)ln_row(wg, (blk_) * 16 + 2 * wid + r, last) * DM + c0; \
        xnext[r][0] = *(const u32x4*)xp_; xnext[r][1] = *(const u32x4*)(xp_ + 8); } } while (0)
    LN1_LOAD(0);
    __syncthreads();
    for (int blk = 0; blk < nblk; ++blk) {
        u32x4 xcur[2][2];
#pragma unroll
        for (int r = 0; r < 2; ++r) { xcur[r][0] = xnext[r][0]; xcur[r][1] = xnext[r][1]; }
        if (blk + 1 < nblk) LN1_LOAD(blk + 1);
#pragma unroll
        for (int r = 0; r < 2; ++r) {
            const int m = ln_row(wg, blk * 16 + 2 * wid + r, last); const int b = m / TPB, t = m - b * TPB;
            const float* md = mod_l + (size_t)((t < CTXL) ? 32 : b) * 6144;
            f32x4 v[4]; float s = 0.f;
#pragma unroll
            for (int j = 0; j < 4; ++j) { const unsigned xa = xcur[r][j >> 1][2 * (j & 1)], xb = xcur[r][j >> 1][2 * (j & 1) + 1]; v[j] = (f32x4){bflo(xa), bfhi(xa), bflo(xb), bfhi(xb)}; s += (v[j][0] + v[j][1]) + (v[j][2] + v[j][3]); }
            const float mean = wave_sum(s) * (1.0f / DM); float s2 = 0.f;
#pragma unroll
            for (int j = 0; j < 4; ++j) { v[j] = v[j] - mean; s2 += (v[j][0] * v[j][0] + v[j][1] * v[j][1]) + (v[j][2] * v[j][2] + v[j][3] * v[j][3]); }
            const float rstd = 1.0f / sqrtf(wave_sum(s2) * (1.0f / DM) + LN_EPS);
            LAS unsigned char* hrow = ht + (2 * wid + r) * TROW + c0 * 2;
            u32x4 ho[2], h8;
#pragma unroll
            for (int j = 0; j < 4; ++j) { const f32x4 y = v[j] * rstd * gv[j] + bv[j];
                const f32x4 sh = *(const f32x4*)(md + 3072 + c0 + 4 * j), sc = *(const f32x4*)(md + 4096 + c0 + 4 * j); const f32x4 h = y * (sc + 1.0f) + sh;
                h8[j] = pk4_fp8(h[0], h[1], h[2], h[3]);
                ho[j >> 1][2 * (j & 1)] = pk2(h[0], h[1]); ho[j >> 1][2 * (j & 1) + 1] = pk2(h[2], h[3]); }
            *(u32x4*)(H8 + (size_t)m * DM + c0) = h8;
            *(LAS u32x4*)hrow = ho[0]; *(LAS u32x4*)(hrow + 16) = ho[1];
        }
        __syncthreads();
        if (wid < 2) {
            f32x4 d = {0.f, 0.f, 0.f, 0.f};
            const LAS unsigned char* ap = ht + (lane & 15) * TROW + (lane >> 4) * 16;
            const LAS unsigned char* bp = wrt + (16 * wid + (lane & 15)) * TROW + (lane >> 4) * 16;
#pragma unroll 8
            for (int s = 0; s < 32; ++s) d = __builtin_amdgcn_mfma_f32_16x16x32_bf16(*(const LAS bf16x8*)(ap + 64 * s), *(const LAS bf16x8*)(bp + 64 * s), d, 0, 0, 0);
            const float rbias = rb[16 * wid + (lane & 15)];
#pragma unroll
            for (int i = 0; i < 4; ++i) logt[(4 * (lane >> 4) + i) * 33 + 16 * wid + (lane & 15)] = d[i] + rbias;
        }
        __syncthreads();
        {
            const int half = lane >> 5, e = lane & 31, rr = 2 * wid + half;
            float v = logt[rr * 33 + e];
            float tv[4]; int te[4];
#define MX_DPP(x, ctrl, rmask) __builtin_bit_cast(float, __builtin_amdgcn_update_dpp(__builtin_bit_cast(int, x), __builtin_bit_cast(int, x), ctrl, rmask, 0xf, false))
#pragma unroll
            for (int k = 0; k < 4; ++k) {
                float m = v;
                m = fmaxf(m, MX_DPP(m, 0xB1, 0xf)); m = fmaxf(m, MX_DPP(m, 0x4E, 0xf)); m = fmaxf(m, MX_DPP(m, 0x141, 0xf)); m = fmaxf(m, MX_DPP(m, 0x140, 0xf));
                m = fmaxf(m, MX_DPP(m, 0x142, 0xa));
                const float m0 = __builtin_bit_cast(float, __builtin_amdgcn_readlane(__builtin_bit_cast(int, m), 31)), m1 = __builtin_bit_cast(float, __builtin_amdgcn_readlane(__builtin_bit_cast(int, m), 63));
                const float mh = half ? m1 : m0;
                const unsigned long long bal = __ballot(v == mh);
                const unsigned hm = half ? (unsigned)(bal >> 32) : (unsigned)bal;
                const int bi = __builtin_ctz(hm);
                tv[k] = mh; te[k] = bi;
                v = (e == bi) ? -3.0e38f : v;
            }
#undef MX_DPP
            const float e1 = __expf(tv[1] - tv[0]), e2 = __expf(tv[2] - tv[0]), e3 = __expf(tv[3] - tv[0]); const float rs = 1.0f / (1.0f + e1 + e2 + e3);
            if (e == 0) { const int irow = blk * 16 + rr;
                const float ww[4] = {rs, e1 * rs, e2 * rs, e3 * rs};
#pragma unroll
                for (int k = 0; k < 4; ++k) { const unsigned lr = __hip_atomic_fetch_add(lcnt + te[k], 1u, __ATOMIC_RELAXED, __HIP_MEMORY_SCOPE_WORKGROUP);
                    ent[irow * 4 + k] = (unsigned)te[k] | (lr << 8); entw[irow * 4 + k] = ww[k]; } }
        }
    }
#undef LN1_LOAD
    __syncthreads();
    if (tid < 32) lbase[tid] = __hip_atomic_fetch_add(cnt_l + tid * 64, lcnt[tid], __ATOMIC_RELAXED, __HIP_MEMORY_SCOPE_AGENT);
    __syncthreads();
    for (int sidx = tid; sidx < nrows * 4; sidx += NTHR) { const unsigned en = ent[sidx]; const int e = en & 255u; const unsigned lr = en >> 8;
        const int m = ln_row(wg, sidx >> 2, last); const size_t pos = (size_t)e * T + lbase[e] + lr; list[pos] = (unsigned)m * 4u + (unsigned)(sidx & 3); gsort[pos] = entw[sidx]; }
    __syncthreads();
}
DI void ln2_phase(bf16* X, const unsigned char* Y, bf16* H, float* out, const float* mod_l, const float* mod_n, const float* lng1, const float* lnb1, const float* lng, const float* lnb, const int wg, const int last, const int wid, const int lane) {
    const int nrows = last ? 256 : 288, c0 = 16 * lane;
    f32x4 gv[4], bv[4], gv1[4], bv1[4];
#pragma unroll
    for (int q = 0; q < 4; ++q) { gv[q] = *(const f32x4*)(lng + c0 + 4 * q); bv[q] = *(const f32x4*)(lnb + c0 + 4 * q); gv1[q] = *(const f32x4*)(lng1 + c0 + 4 * q); bv1[q] = *(const f32x4*)(lnb1 + c0 + 4 * q); }
    u32x4 xa[2], ya[4], xb[2], yb[4];
#define LN2_LOAD(mm, XN, YN) do { const bf16* xp_ = X + (size_t)(mm) * DM + c0; const unsigned char* yp_ = Y + (size_t)(mm) * 4 * DM + c0; \
        XN[0] = *(const u32x4*)xp_; XN[1] = *(const u32x4*)(xp_ + 8); \
        _Pragma("unroll") for (int k = 0; k < 4; ++k) YN[k] = *(const u32x4*)(yp_ + (size_t)k * DM); } while (0)
    if (wid < nrows) LN2_LOAD(ln_row(wg, wid, last), xa, ya);
    if (wid + NWAVES < nrows) LN2_LOAD(ln_row(wg, wid + NWAVES, last), xb, yb);
    auto row = [&](const int i, const u32x4 (&xcur)[2], const u32x4 (&ycur)[4]) __attribute__((always_inline)) {
        const int m = ln_row(wg, i, last); const int b = m / TPB, t = m - b * TPB; const int mrow = (t < CTXL) ? 32 : b;
        const float* md = mod_l + (size_t)mrow * 6144;
        bf16* xr = X + (size_t)m * DM + c0;
        f32x4 v[4]; float s = 0.f;
        { float s1 = 0.f;
#pragma unroll
          for (int q = 0; q < 4; ++q) { const unsigned xa = xcur[q >> 1][2 * (q & 1)], xb = xcur[q >> 1][2 * (q & 1) + 1]; v[q] = (f32x4){bflo(xa), bfhi(xa), bflo(xb), bfhi(xb)}; s1 += (v[q][0] + v[q][1]) + (v[q][2] + v[q][3]); }
          const float mean1 = wave_sum(s1) * (1.0f / DM); float q1 = 0.f;
#pragma unroll
          for (int q = 0; q < 4; ++q) { v[q] = v[q] - mean1; q1 += (v[q][0] * v[q][0] + v[q][1] * v[q][1]) + (v[q][2] * v[q][2] + v[q][3] * v[q][3]); }
          const float rstd1 = 1.0f / sqrtf(wave_sum(q1) * (1.0f / DM) + LN_EPS);
#pragma unroll
          for (int q = 0; q < 4; ++q) v[q] = v[q] * rstd1 * gv1[q] + bv1[q]; }
#pragma unroll
        for (int q = 0; q < 4; ++q) { f32x4 y = (f32x4){0.f, 0.f, 0.f, 0.f};
#pragma unroll
            for (int k = 0; k < 4; ++k) { const unsigned w = ycur[k][q]; const f32x2 lo = __builtin_amdgcn_cvt_pk_f32_fp8(w, false), hi2 = __builtin_amdgcn_cvt_pk_f32_fp8(w, true); y += (f32x4){lo[0], lo[1], hi2[0], hi2[1]}; }
            const f32x4 g2 = *(const f32x4*)(md + 5120 + c0 + 4 * q) * (1.0f / Y_SCALE);
            v[q] = v[q] * DN_ALPHA + g2 * y; s += (v[q][0] + v[q][1]) + (v[q][2] + v[q][3]); }
        const float mean = wave_sum(s) * (1.0f / DM); float s2 = 0.f;
#pragma unroll
        for (int q = 0; q < 4; ++q) { v[q] = v[q] - mean; s2 += (v[q][0] * v[q][0] + v[q][1] * v[q][1]) + (v[q][2] * v[q][2] + v[q][3] * v[q][3]); }
        const float rstd = 1.0f / sqrtf(wave_sum(s2) * (1.0f / DM) + LN_EPS);
        if (last) { float* orow = out + ((size_t)b * SEQ + (t - CTXL)) * DM + c0;
#pragma unroll
            for (int q = 0; q < 4; ++q) *(f32x4*)(orow + 4 * q) = v[q] * rstd * gv[q] + bv[q];
        } else { const float* mn = mod_n + (size_t)mrow * 6144 + c0;
            u32x4 xo[2], ho[2];
#pragma unroll
            for (int q = 0; q < 4; ++q) { const f32x4 y = v[q] * rstd * gv[q] + bv[q];
                xo[q >> 1][2 * (q & 1)] = pk2(y[0], y[1]); xo[q >> 1][2 * (q & 1) + 1] = pk2(y[2], y[3]);
                const f32x4 sh = *(const f32x4*)(mn + 4 * q), sc = *(const f32x4*)(mn + 1024 + 4 * q); const f32x4 h = y * (sc + 1.0f) + sh;
                ho[q >> 1][2 * (q & 1)] = pk2(h[0], h[1]); ho[q >> 1][2 * (q & 1) + 1] = pk2(h[2], h[3]); }
            *(u32x4*)xr = xo[0]; *(u32x4*)(xr + 8) = xo[1];
            if (INPROJ_FP8) { u32x4 h8;
#pragma unroll
                for (int q = 0; q < 4; ++q) { const f32x4 y = v[q] * rstd * gv[q] + bv[q]; const f32x4 sh = *(const f32x4*)(mn + 4 * q), sc = *(const f32x4*)(mn + 1024 + 4 * q); const f32x4 h = (y * (sc + 1.0f) + sh) * H_SCALE; h8[q] = pk4_fp8(h[0], h[1], h[2], h[3]); }
                *(u32x4*)((unsigned char*)H + (size_t)m * DM + c0) = h8; }
            else { bf16* hr = H + (size_t)m * DM + c0; *(u32x4*)hr = ho[0]; *(u32x4*)(hr + 8) = ho[1]; }
        }
    };
    for (int i = wid; i < nrows; i += 2 * NWAVES) {
        { u32x4 xc[2], yc[4]; xc[0] = xa[0]; xc[1] = xa[1];
#pragma unroll
          for (int k = 0; k < 4; ++k) yc[k] = ya[k];
          if (i + 2 * NWAVES < nrows) LN2_LOAD(ln_row(wg, i + 2 * NWAVES, last), xa, ya);
          row(i, xc, yc); }
        if (i + NWAVES >= nrows) break;
        { u32x4 xc[2], yc[4]; xc[0] = xb[0]; xc[1] = xb[1];
#pragma unroll
          for (int k = 0; k < 4; ++k) yc[k] = yb[k];
          if (i + 3 * NWAVES < nrows) LN2_LOAD(ln_row(wg, i + 3 * NWAVES, last), xb, yb);
          row(i + NWAVES, xc, yc); }
    }
#undef LN2_LOAD
}

DI void build_expert_table(LAS int* tab, const unsigned* cnt_l) {
    const int tid = opaque_tid();
    __syncthreads();
    if (tid < 32) tab[33 + tid] = (int)__hip_atomic_load(cnt_l + tid * 64, __ATOMIC_RELAXED, __HIP_MEMORY_SCOPE_AGENT);
    __syncthreads();
    if (tid == 0) { int acc = 0; for (int e = 0; e < 32; ++e) { tab[e] = acc; acc += (tab[33 + e] + 255) >> 8; } tab[32] = acc; }
    __syncthreads();
}


DI void attn_phase_even(LAS unsigned char* lds, const bf16* P, const bf16* PQ, unsigned char* MIX, const float* rpb_j, const int G, const int bx, const int shadow) {
    for (int i = 0;; ++i) {
        const int L = i * G + bx;
        att::AttnP p{}; bool na = false, big = false; p.shadow = shadow;
        p.qp = NPP; p.kp = NPP; p.vp = NPP; p.op = DM; p.K2 = P; p.k2p = NPP;
        if (L < 1024) { int b = L >> 5, h = (L >> 2) & 7, qb = L & 3;
            if (G == 256) { const int x = bx & 7, j = bx >> 3, g = x + 8 * (j >> 4), jq = j & 15; b = 8 * i + (g >> 1); h = 4 * (g & 1) + (jq >> 2); qb = jq & 3; }
            const int row0 = b * TPB + CTXL + qb * 512;
            p.Q = PQ + (size_t)row0 * NPP + 1536 + 64 * h; p.K = PQ + 2048 + 64 * (h >> 2); p.V = P + 2176 + 64 * (h >> 2); p.O = MIX + (size_t)row0 * DM + 512 + 64 * h; p.kt0 = b * TPB; p.ntiles = 36; big = true; }
        else if (L < 3072) { const int L2 = L - 1024; int b = L2 >> 6, h = (L2 >> 3) & 7, rg = (L2 + (L2 >> 8)) & 7  ;
            if (G == 256) { const int x = bx & 7, j = bx >> 3, g = x + 8 * (j >> 3); b = 4 * (i - 4) + (g >> 3); h = g & 7; rg = ((j & 7) + i) & 7; }
 const int qr0 = 4 * rg, row0 = b * TPB + CTXL + qr0 * 64;
            p.Q = P + (size_t)row0 * NPP + 64 * h; p.K = P + 512 + 64 * h; p.V = P + 1024 + 64 * h; p.O = MIX + (size_t)row0 * DM + 64 * h;
            p.brow0 = b * TPB; p.na_lo = min(max(qr0 - 4, 0), 24); p.na_nloc = min(max(qr0 - 1, 0), 24) + 7 - p.na_lo + 1; p.ntiles = p.na_nloc + 4; p.qr0 = qr0; p.rpb = rpb_j + h * 465; na = true; }
        else if (L < 3584) { const int L3 = L - 3072, b = L3 >> 4, hh = L3 & 15; const int row0 = b * TPB;
            if (hh < 8) { p.Q = P + (size_t)row0 * NPP + 64 * hh; p.K = P + 512 + 64 * hh; p.V = P + 1024 + 64 * hh; p.O = MIX + (size_t)row0 * DM + 64 * hh; }
            else { const int h = hh - 8; p.Q = PQ + (size_t)row0 * NPP + 1536 + 64 * h; p.K = PQ + 2048 + 64 * (h >> 2); p.V = P + 2176 + 64 * (h >> 2); p.O = MIX + (size_t)row0 * DM + 512 + 64 * h; }
            p.kt0 = row0; p.ntiles = 4; }
        else break;
#ifndef ATT_MASK
#define ATT_MASK 15
#endif
        if (na) { if (ATT_MASK & 1) att::attn_unit<64, 1>(lds, p); } else if (big) { if (ATT_MASK & 2) att::attn_unit_w64<64>(lds, p); } else { if (ATT_MASK & 2) att::attn_unit<64, 0>(lds, p); }
    }
}
DI void attn_phase_odd(LAS unsigned char* lds, const bf16* P, const bf16* PQ, const bf16* QM, const bf16* KVM, unsigned char* MIX, const float lam, const float oml, const float* subln, const int G, const int bx, const int last, const int shadow) {
    const int total = last ? 2048 : 2432;
    for (int i = 0;; ++i) {
        const int L = i * G + bx; if (L >= total) break;
        att::AttnP p{}; bool diff = false, big = false; p.shadow = shadow;
        p.op = DM; p.K2 = PQ + 1920; p.k2p = NPP;
        if (L < 1024 || (L >= 2048 && L < 2176)) { int b, h, row0;
            if (L < 1024) { b = L >> 5; h = (L >> 3) & 3; int qb = L & 7;
                if (G == 256) { const int x = bx & 7, j = bx >> 3, g = x + 8 * (j >> 3); b = 8 * i + (g >> 2); h = g & 3; qb = j & 7; }
                row0 = b * TPB + CTXL + qb * 256; p.ntiles = 36; } else { const int L3 = L - 2048; b = L3 >> 2; h = L3 & 3; row0 = b * TPB; p.ntiles = 4; }
            p.Q = PQ + (size_t)row0 * NPP + 128 * h; p.qp = NPP; p.K = PQ + 512 + 128 * h; p.kp = NPP; p.V = P + 1024 + 128 * h; p.vp = NPP; p.O = MIX + (size_t)row0 * DM + 128 * h; p.kt0 = b * TPB; diff = true; }
        else { int b, h, row0;
            if (L < 2048) { const int L2 = L - 1024; b = L2 >> 5; h = (L2 >> 2) & 7; int qb = L2 & 3;
                if (G == 256) { const int x = bx & 7, j = bx >> 3, g = x + 8 * (j >> 2); b = 8 * (i - 4) + (g >> 3); h = g & 7; qb = j & 3; }
                row0 = b * TPB + CTXL + qb * 512; p.ntiles = 36; p.rope_q = 1; p.qpos0 = qb * 512; big = true; }
            else { const int L4 = L - 2176; b = L4 >> 3; h = L4 & 7; row0 = b * TPB; p.ntiles = 4; p.rope_q = 0; p.qpos0 = 0; }
            p.Q = QM + (size_t)row0 * 768 + 96 * h; p.qp = 768; p.K = KVM + 128 * h; p.kp = DM; p.V = KVM + 128 * h + 64; p.vp = DM; p.O = MIX + (size_t)row0 * DM + 512 + 64 * h; p.kt0 = b * TPB; }
        if (diff) { if (ATT_MASK & 4) att::attn_unit_diff(lds, p, lam, oml, subln); } else if (big) { if (ATT_MASK & 8) att::attn_unit_w64<96>(lds, p); } else { if (ATT_MASK & 8) att::attn_unit<96, 0>(lds, p); }
    }
}

constexpr int NPHASE = 2 + 9 * NL;
struct Args { const float* in[32]; float* out; unsigned char* ws; int ph_lo, ph_hi, li, pad; };
__global__ void __launch_bounds__(NTHR, 2) fwd(Args a) {
    extern __shared__ __attribute__((aligned(16))) unsigned char lds_raw[];
    LAS unsigned char* lds = (LAS unsigned char*)lds_raw;
    volatile LAS unsigned* MISC = (volatile LAS unsigned*)(lds + MISC_OFF);
    LAS int* tab = (LAS int*)(lds + MISC_OFF + 256);
    LAS int* utab = (LAS int*)(lds + pg8::UTAB_OFF); LAS unsigned* rtab = (LAS unsigned*)(lds + pg8::RTAB_OFF);
    const int tid = opaque_tid(), lane = tid & 63, wid = __builtin_amdgcn_readfirstlane(tid >> 6);
    const int G = gridDim.x, bx = blockIdx.x, gw = bx * NWAVES + wid, ngw = G * NWAVES;
    for (int u = tid; u < (LDS_BYTES - MISC_OFF) / 4; u += NTHR) MISC[u] = 0u;
    __syncthreads();
    unsigned char* ws = a.ws;
    unsigned* ctl = (unsigned*)(ws + WS_CTL);
    const int lo = a.ph_lo, hi = a.ph_hi;
    XcdBarrier bar; bar.bar = ctl + CW_BAR + a.li * XCD_BAR_WORDS; bar.x = 0; bar.st = MISC;
    if (hi - lo > 1) bar = xcd_barrier_post(ctl + CW_BAR + a.li * XCD_BAR_WORDS, MISC);
#ifndef PH_MASK
#define PH_MASK 0x7ff
#endif
#define PHM(k) (((PH_MASK) >> ((k) < 2 ? (k) : 2 + ((k) - 2) % 9)) & 1)
#define IN(k) (PHM(k) && lo <= (k) && (k) < hi)
#ifndef PROBE_DUP
#define PROBE_DUP 0
#endif
#define NREP(kind) (1 + (((PROBE_DUP) >> (kind)) & 1))
#define SEAM(k) do { if (lo <= (k) && (k) + 1 < hi) xcd_barrier(bar); } while (0)
    float* mod = (float*)(ws + WS_MOD);
    bf16* X = (bf16*)(ws + WS_X); bf16* H = (bf16*)(ws + WS_H); bf16* P = (bf16*)(ws + WS_P); bf16* QM = (bf16*)(ws + WS_QM); bf16* KVM = (bf16*)(ws + WS_KVM);
    bf16* PQ = (bf16*)(ws + WS_PQ);
    unsigned char* MIX = ws + WS_MIX; unsigned char* ACT = ws + WS_ACT; unsigned char* H8 = ws + WS_H8; unsigned char* Y = ws + WS_Y;
    unsigned* list = (unsigned*)(ws + WS_LIST); float* gsort = (float*)(ws + WS_GSORT);

    if (IN(0)) for (int rep = 0; rep < NREP(0); ++rep) {
        for (int it = bx; it < 192; it += G) p0_mod_item(lds, a.in[1], a.in[3], a.in[4], a.in[5], mod, it);
        p0_transposes(lds, a.in, ws, gw, ngw, wid, lane);
        p0_zero(ws, bx * NTHR + tid, G * NTHR);
    }
    SEAM(0);
    if (IN(1)) p0b_rows(a.in[0], a.in[2], mod, X, H, gw, ngw, lane);
    SEAM(1);
    for (int l = 0; l < NL; ++l) {
        const int tid = opaque_tid(), lane = tid & 63, wid = __builtin_amdgcn_readfirstlane(tid >> 6), gw = bx * NWAVES + wid;
        const int pb = 2 + 9 * l, odd = l & 1, j = l >> 1, last = (l == NL - 1) ? 1 : 0;
        const float* mod_l = mod + (size_t)l * 33 * 6144;
        unsigned* cnt_l = ctl + CW_CNT + l * 32 * 64;
        if (IN(pb + 0)) for (int rep = 0; rep < NREP(2); ++rep) {
#if INPROJ_FP8
            pg8::DenseSched S; S.init(H, 512, (const bf16*)(ws + WS_WIN) + (size_t)l * 2304 * 1024, 512, NTILE_M, odd ? 8 : 9, G, bx, 0);
            pg8::EpiBf16 E{P, NPP, 1.0f / (WI_SCALE * H_SCALE)};
            pg8::gemm_phase<true>(lds, 1024, S, E);
#else
            pg8::DenseSched S; S.init(H, DM, (const bf16*)(ws + WS_WIN) + (size_t)l * 2304 * 1024, 1024, NTILE_M, odd ? 8 : 9, G, bx, 0);
            pg8::EpiBf16 E{P, NPP, 1.0f};
            pg8::gemm_phase<false>(lds, 2048, S, E);
#endif
        }
        SEAM(pb + 0);
        if (IN(pb + 1)) {
            if (odd) post_odd_rows(P, PQ, a.in[22] + j * 256, a.in[24] + j * 128, gw, ngw, lane);
            else post_even_rows(P, PQ, a.in[13] + j * 64, a.in[14] + j * 64, gw, ngw, lane);
        }
        SEAM(pb + 1);
        if (odd) {
            if (IN(pb + 2)) for (int rep = 0; rep < NREP(4); ++rep) {
                { pg8::DenseSched S; S.init(PQ + 1536, NPP, (const bf16*)(ws + WS_WUQ) + (size_t)j * 768 * 256, 256, NTILE_M, 3, G, bx, 0); pg8::EpiBf16 E{QM, 768, 1.0f}; pg8::gemm_phase<false>(lds, 512, S, E); }
                { pg8::DenseSched S; S.init(PQ + 1792, NPP, (const bf16*)(ws + WS_WUKV) + (size_t)j * 1024 * 256, 256, NTILE_M, 4, G, (bx + G - (NTILE_M * 3) % G) % G, 0); pg8::EpiBf16 E{KVM, DM, 1.0f}; pg8::gemm_phase<false>(lds, 512, S, E); }
            }
            SEAM(pb + 2);
        }
        if (IN(pb + 3)) for (int rep = 0; rep < NREP(5); ++rep) {
            if (odd) {
                const float s1 = wave_sum(a.in[17][j * 64 + lane] * a.in[18][j * 64 + lane]), s2 = wave_sum(a.in[19][j * 64 + lane] * a.in[20][j * 64 + lane]);
                const float lam_init = (l == 1) ? 0.35550906759310934f : 0.55605820415610350f;
                const float lam = __expf(s1) - __expf(s2) + lam_init;
#ifndef PROBE_SHADOW
#define PROBE_SHADOW 0
#endif
                attn_phase_odd(lds, P, PQ, QM, KVM, rep ? ACT : MIX, lam, 1.0f - lam_init, a.in[21] + j * 128, G, bx, last, rep ? PROBE_SHADOW : 0);
            } else attn_phase_even(lds, P, PQ, rep ? ACT : MIX, a.in[12] + (size_t)j * 8 * 465, G, bx, rep ? PROBE_SHADOW : 0);
        }
        SEAM(pb + 3 - ((odd || true) ? 0 : 0));
        if (IN(pb + 4)) {
            pg8::DenseSched S; S.init((const bf16*)MIX, 512, (const bf16*)(ws + WS_WOUT + (size_t)l * 1024 * 1024), 512, last ? 256 : NTILE_M, 4, G, bx, last);
            pg8::EpiResid E{X, mod_l};
            pg8::gemm_phase<true>(lds, 1024, S, E);
        }
        const int pre_rt = (IN(pb + 4) && IN(pb + 5) && G == 256) ? 1 : 0;
        if (pre_rt) { __syncthreads(); ln1_router_table(lds, a.in[26] + (size_t)l * 1024 * 32); }
        SEAM(pb + 4);
        if (IN(pb + 5)) {
            for (int wg = bx; wg < 256; wg += G)
                ln1_router_phase(lds, X, H8, mod_l, a.in[6] + l * 1024, a.in[7] + l * 1024, a.in[26] + (size_t)l * 1024 * 32, a.in[27] + l * 32, cnt_l, list, gsort, wg, last, pre_rt);
        }
        SEAM(pb + 5);
        if (IN(pb + 6)) for (int rep = 0; rep < NREP(8); ++rep) {
            build_expert_table(tab, cnt_l);
            const int nun = pg8::build_unit_table(tab, utab, 8, G, bx);
            pg8::GroupSched S{tab, utab, rtab, nun, 8, G, bx, 1024, (const char*)H8, list, gsort, 1, (const char*)(ws + WS_WGU + (size_t)l * 32 * 2048 * 1024), (size_t)2048 * 1024, a.in[29] + (size_t)l * 32 * 2048, 2048};
            S.fill_sync(0, tid); S.fill_sync(1, tid); __syncthreads();
            pg8::EpiSwiglu E{ACT, rtab};
            pg8::gemm_phase<true>(lds, 1024, S, E);
        }
        int nun_d = -1;
        if (IN(pb + 6) && IN(pb + 7) && NREP(9) == 1) {
            __syncthreads();
            build_expert_table(tab, cnt_l);
            nun_d = pg8::build_unit_table(tab, utab, 4, G, bx);
            pg8::GroupSched S{tab, utab, rtab, nun_d, 4, G, bx, 1024, (const char*)ACT, list, gsort, 0, (const char*)(ws + WS_WD + (size_t)l * 32 * 1024 * 1024), (size_t)1024 * 1024, a.in[31] + (size_t)l * 32 * 1024, 1024};
            S.fill_sync(0, tid);
        }
        SEAM(pb + 6);
        if (IN(pb + 7)) for (int rep = 0; rep < NREP(9); ++rep) {
            int nun = nun_d;
            if (nun_d < 0) { build_expert_table(tab, cnt_l); nun = pg8::build_unit_table(tab, utab, 4, G, bx); }
            pg8::GroupSched S{tab, utab, rtab, nun, 4, G, bx, 1024, (const char*)ACT, list, gsort, 0, (const char*)(ws + WS_WD + (size_t)l * 32 * 1024 * 1024), (size_t)1024 * 1024, a.in[31] + (size_t)l * 32 * 1024, 1024};
            if (nun_d < 0) S.fill_sync(0, tid);
            __syncthreads();
            pg8::EpiDown E{Y, rtab, tab};
            pg8::gemm_phase<true>(lds, 1024, S, E);
        }
        SEAM(pb + 7);
        if (IN(pb + 8)) {
            for (int wg = bx; wg < 256; wg += G)
                ln2_phase(X, Y, H, a.out, mod_l, mod + (size_t)(last ? l : l + 1) * 33 * 6144, a.in[6] + l * 1024, a.in[7] + l * 1024, a.in[8] + l * 1024, a.in[9] + l * 1024, wg, last, wid, lane);
        }
        SEAM(pb + 8);
    }
#undef IN
#undef SEAM
}

extern "C" void kernel_launch(void* const* d_in, const int* in_sizes, int n_in, void* d_out, int out_size, void* d_ws, size_t ws_size, hipStream_t stream) {
    static int grid = 0;
    if (grid == 0) {
        if (n_in != 32 || ws_size < WS_END || out_size != NBATCH * SEQ * DM) { fprintf(stderr, "kernel_launch: unexpected shapes (n_in %d, out %d, ws %zu)\n", n_in, out_size, ws_size); grid = -1; return; }
        int dev = 0, cus = 0, per_cu = 0;
        if (hipGetDevice(&dev) != hipSuccess || hipDeviceGetAttribute(&cus, hipDeviceAttributeMultiprocessorCount, dev) != hipSuccess) { grid = -1; return; }
        if (hipFuncSetAttribute((const void*)fwd, hipFuncAttributeMaxDynamicSharedMemorySize, LDS_BYTES) != hipSuccess) { fprintf(stderr, "kernel_launch: hipFuncSetAttribute failed\n"); grid = -1; return; }
        if (hipOccupancyMaxActiveBlocksPerMultiprocessor(&per_cu, (const void*)fwd, NTHR, LDS_BYTES) != hipSuccess || per_cu < 1) fprintf(stderr, "kernel_launch: occupancy query reports %d\n", per_cu);
        (void)hipGetLastError();
        grid = cus < 256 ? cus : 256;
    }
    if (grid < 0) return;
    (void)hipMemsetAsync((char*)d_ws + WS_CTL, 0, CTL_ZERO_BYTES, stream);
    Args a{};
    for (int i = 0; i < 32; ++i) a.in[i] = (const float*)d_in[i];
    a.out = (float*)d_out; a.ws = (unsigned char*)d_ws;
#if MK_ONE_LAUNCH
    a.ph_lo = 0; a.ph_hi = NPHASE; a.li = 0;
    hipLaunchKernelGGL(fwd, dim3(grid), dim3(NTHR), LDS_BYTES, stream, a);
#else
    int li = 0;
    for (int ph = 0; ph < NPHASE; ++ph) {
        if (ph >= 2 && ((ph - 2) % 9) == 2 && (((ph - 2) / 9) & 1) == 0) continue;
        a.ph_lo = ph; a.ph_hi = ph + 1; a.li = 0; ++li;
        hipLaunchKernelGGL(fwd, dim3(grid), dim3(NTHR), LDS_BYTES, stream, a);
    }
#endif
}
```

```cpp
#include <hip/hip_runtime.h>
#include <cstdio>
#include <cstdint>

#ifndef MK_ONE_LAUNCH
#define MK_ONE_LAUNCH 1
#endif
#ifndef PROBE_SHADOW
#define PROBE_SHADOW 0
#endif

#define GAS __attribute__((address_space(1)))
#define LAS __attribute__((address_space(3)))
#define DI __device__ __forceinline__
typedef unsigned short bf16;
typedef short bf16x8 __attribute__((ext_vector_type(8)));
typedef short s16x4 __attribute__((ext_vector_type(4)));
typedef float f32x2 __attribute__((ext_vector_type(2)));
typedef float f32x4 __attribute__((ext_vector_type(4)));
typedef float f32x16 __attribute__((ext_vector_type(16)));
typedef unsigned u32x2 __attribute__((ext_vector_type(2)));
typedef unsigned u32x4 __attribute__((ext_vector_type(4)));

constexpr int DM = 1024, NBATCH = 32, SEQ = 2048, CTXL = 256, TPB = SEQ + CTXL  ;
constexpr int T = NBATCH * TPB;
constexpr int NL = 4, NPP = 2304;
constexpr int NE = 32, DE = 1024;
constexpr int NTILE_M = T / 256;
constexpr float LOG2E = 1.4426950408889634f;
constexpr float C2 = 0.125f * LOG2E;
constexpr float C2M = 0.10206207261596575f * LOG2E;
constexpr float DN_ALPHA = 1.6817928305074290f;
constexpr float LN_EPS = 1e-6f, RMS_EPS = 1e-6f;
constexpr float LOG2_THETA = 13.287712379549449f;

constexpr size_t MiB = 1u << 20;
constexpr size_t WS_CTL = 0, CTL_ZERO_BYTES = 1 * MiB;
constexpr size_t WS_MOD = 1 * MiB;
constexpr size_t WS_WIN = 8 * MiB;
constexpr size_t WS_WOUT = 28 * MiB;
constexpr size_t WS_WUQ = 36 * MiB;
constexpr size_t WS_WUKV = 37 * MiB;
constexpr size_t WS_LIST = 40 * MiB;
constexpr size_t WS_GATE = 50 * MiB;
constexpr size_t WS_WGU = 64 * MiB;
constexpr size_t WS_WD = 576 * MiB;
constexpr size_t WS_X = 832 * MiB;
constexpr size_t WS_H = 1120 * MiB;
constexpr size_t WS_P = 1264 * MiB;
constexpr size_t WS_QM = 1588 * MiB;
constexpr size_t WS_KVM = 1696 * MiB;
constexpr size_t WS_MIX = 1840 * MiB;
constexpr size_t WS_ACT = 1984 * MiB;
constexpr size_t WS_Y = 2576 * MiB;
constexpr size_t WS_H8 = 3152 * MiB;
constexpr size_t WS_GSORT = 3224 * MiB;
constexpr size_t WS_PQ = 3234 * MiB;
constexpr size_t WS_END = 3558 * MiB;
constexpr float WGU_SCALE = 64.0f, WD_SCALE = 128.0f, Y_SCALE = 64.0f, WO_SCALE = 128.0f, MIX_SCALE = 16.0f;
#ifndef INPROJ_FP8
#define INPROJ_FP8 1
#endif
constexpr float WI_SCALE = 64.0f, H_SCALE = 8.0f;
constexpr int ACT_ROWS = T * 4 + 32 * 256;
static_assert(WS_MOD + (size_t)4 * 33 * 6144 * 4 <= WS_WIN && WS_WIN + (size_t)4 * 2304 * 1024 * 2 <= WS_WOUT && WS_LIST + (size_t)32 * T * 4 <= WS_GATE && WS_GATE + (size_t)T * 16 <= WS_WGU, "ws map 1");
static_assert(WS_X + (size_t)T * 4096 <= WS_H && WS_H + (size_t)T * 2048 <= WS_P && WS_P + (size_t)T * NPP * 2 <= WS_QM && WS_QM + (size_t)T * 768 * 2 <= WS_KVM && WS_KVM + (size_t)T * 2048 <= WS_MIX, "ws map 2");
static_assert(WS_MIX + (size_t)T * 2048 <= WS_ACT && WS_ACT + (size_t)ACT_ROWS * 2048 <= WS_Y && WS_Y + (size_t)T * 4 * 2048 <= WS_H8 && WS_H8 + (size_t)T * 1024 <= WS_GSORT && WS_GSORT + (size_t)32 * T * 4 <= WS_PQ && WS_PQ + (size_t)T * NPP * 2 <= WS_END, "ws map 3");
constexpr int CW_TMO = 0;
constexpr int CW_CNT = 1024;
constexpr int CW_BAR = 16384;
constexpr int MAX_LAUNCH = 40;
static_assert(CW_CNT + 4 * 32 * 64 <= CW_BAR && (CW_BAR + MAX_LAUNCH * 3456) * 4 <= (int)CTL_ZERO_BYTES, "ctl");

constexpr int LDS_BYTES = 147456;
constexpr int MISC_OFF = 143360;
constexpr int NWAVES = 8, NTHR = 512;

DI unsigned f2bf(float f) { unsigned u = __builtin_bit_cast(unsigned, f); return (u + 0x7fffu + ((u >> 16) & 1u)) >> 16; }
DI unsigned pk2(float lo, float hi) { return f2bf(lo) | (f2bf(hi) << 16); }
DI float bf2f(unsigned short b) { return __builtin_bit_cast(float, (unsigned)b << 16); }
DI float bflo(unsigned w) { return __builtin_bit_cast(float, w << 16); }
DI float bfhi(unsigned w) { return __builtin_bit_cast(float, w & 0xffff0000u); }
#define WS_DPP(v, ctrl, rmask) __builtin_bit_cast(float, __builtin_amdgcn_update_dpp(0, __builtin_bit_cast(int, v), ctrl, rmask, 0xf, false))
DI float wave_sum(float v) {
    v += WS_DPP(v, 0xB1, 0xf);
    v += WS_DPP(v, 0x4E, 0xf);
    v += WS_DPP(v, 0x141, 0xf);
    v += WS_DPP(v, 0x140, 0xf);
    v += WS_DPP(v, 0x142, 0xa);
    v += WS_DPP(v, 0x143, 0xc);
    return __builtin_bit_cast(float, __builtin_amdgcn_readlane(__builtin_bit_cast(int, v), 63));
}
DI float fast_exp2(float x) { return __builtin_amdgcn_exp2f(x); }
DI unsigned pk4_fp8(float a, float b, float c, float d) { unsigned w = __builtin_amdgcn_cvt_pk_fp8_f32(a, b, 0u, false); return __builtin_amdgcn_cvt_pk_fp8_f32(c, d, w, true); }
DI int opaque_tid() { int t = threadIdx.x; asm volatile("" : "+v"(t)); return t; }
DI const char* uni_ptr(const char* p) { const unsigned long long v = (unsigned long long)p; const unsigned lo = __builtin_amdgcn_readfirstlane((unsigned)v), hi = __builtin_amdgcn_readfirstlane((unsigned)(v >> 32)); return (const char*)(((unsigned long long)hi << 32) | lo); }

#define XB_TMO      128
#define XB_XCNT(j)  (256  + 64 * (j))
#define XB_XSUB(j)  (1280 + 64 * (j))
#define XB_XGEN(j)  (2304 + 64 * (j))
#define XB_TOP      3328
#define XB_TOPGEN   3392
#define XCD_BAR_WORDS 3456
#define XB_SPIN_CAP (1u << 22)
DI unsigned xb_ld(unsigned* p)              { return __hip_atomic_load(p, __ATOMIC_RELAXED, __HIP_MEMORY_SCOPE_AGENT); }
DI unsigned xb_add(unsigned* p, unsigned v) { return __hip_atomic_fetch_add(p, v, __ATOMIC_RELAXED, __HIP_MEMORY_SCOPE_AGENT); }
DI unsigned xb_xcc_id() { return (unsigned)__builtin_amdgcn_s_getreg((3 << 11) | 20) & 0xFu; }
#define XB_SPIN(cond, bar) do { unsigned _sp = 0; while (cond) { __builtin_amdgcn_s_sleep(1); \
    if ((++_sp & 255u) == 0u) { if (xb_ld(&(bar)[XB_TMO])) break; if (_sp > XB_SPIN_CAP) { atomicAdd(&(bar)[XB_TMO], 1u); break; } } } } while (0)
struct XcdBarrier { unsigned* bar; unsigned x; volatile LAS unsigned* st; };
DI XcdBarrier xcd_barrier_post(unsigned* bar, volatile LAS unsigned* st) {
    XcdBarrier b; b.bar = bar; b.x = xb_xcc_id(); b.st = st;
    if (threadIdx.x == 0) (void)xb_add(&bar[XB_XCNT(b.x)], 1u);
    return b;
}
DI void xcd_barrier_complete(unsigned* bar, unsigned x, unsigned& nloc, unsigned& nx) {
    const unsigned G = gridDim.x * gridDim.y * gridDim.z;
    unsigned sum, cnt, mine, sp = 0u;
    for (;;) {
        sum = 0u; cnt = 0u; mine = 0u;
#pragma unroll
        for (unsigned j = 0; j < 16; ++j) { const unsigned c = xb_ld(&bar[XB_XCNT(j)]); sum += c; cnt += (c > 0u) ? 1u : 0u; mine = (j == x) ? c : mine; }
        if (sum == G) break;
        __builtin_amdgcn_s_sleep(1);
        if ((++sp & 255u) == 0u) { if (xb_ld(&bar[XB_TMO])) break; if (sp > XB_SPIN_CAP) { atomicAdd(&bar[XB_TMO], 1u); break; } }
    }
    nloc = mine > 0u ? mine : 1u; nx = cnt > 0u ? cnt : 1u;
}
DI void xcd_barrier(const XcdBarrier& b) {
    asm volatile("s_waitcnt vmcnt(0)" ::: "memory");
    __syncthreads();
    if (threadIdx.x == 0) {
        unsigned* bar = b.bar;
        __builtin_amdgcn_s_waitcnt(0);
        unsigned nloc = b.st[0], nx = b.st[1];
        if (nloc == 0u) { xcd_barrier_complete(bar, b.x, nloc, nx); b.st[0] = nloc; b.st[1] = nx; }
        const unsigned old = xb_add(&bar[XB_XSUB(b.x)], 1u);
        const unsigned gen = old / nloc;
        if (old + 1u == (gen + 1u) * nloc) {
            __builtin_amdgcn_fence(__ATOMIC_RELEASE, "agent");
            asm volatile("s_waitcnt vmcnt(0)" ::: "memory");
            const unsigned og = xb_add(&bar[XB_TOP], 1u);
            const unsigned tg = og / nx;
            if (og + 1u == (tg + 1u) * nx) xb_add(&bar[XB_TOPGEN], 1u);
            else XB_SPIN(xb_ld(&bar[XB_TOPGEN]) == tg, bar);
            __builtin_amdgcn_fence(__ATOMIC_ACQUIRE, "agent");
            xb_add(&bar[XB_XGEN(b.x)], 1u);
            asm volatile("s_waitcnt vmcnt(0)" ::: "memory");
        } else {
            XB_SPIN(xb_ld(&bar[XB_XGEN(b.x)]) == gen, bar);
            __builtin_amdgcn_fence(__ATOMIC_ACQUIRE, "agent");
            asm volatile("s_waitcnt vmcnt(0)" ::: "memory");
        }
    }
    __syncthreads();
}

namespace pg8 {
constexpr int BM = 256, BK = 64, HALF = 128, HTB = HALF * BK * 2, STAGE_BYTES = 8 * HTB, NXCD = 8, WGM = 8;
DI int lds_byte(int r, int c) { const int st = (r >> 4) * 2 + (c >> 5), rr = r & 15, cc = c & 31, ob = rr * 64 + cc * 2; return st * 1024 + (ob ^ (((ob >> 9) & 1) << 5)); }
DI void stage_rc(int b, int& R, int& C) { const int st = b / 1024, sb = b % 1024, swz = sb ^ (((sb >> 9) & 1) << 5); R = (st >> 1) * 16 + swz / 64; C = (st & 1) * 32 + (swz % 64) / 2; }
DI int perm32(int rho) { const int n = rho >> 4, i = rho & 15; return 8 * (i >> 2) + 4 * n + (i & 3); }
DI void glds_s(const char* base, unsigned voff, unsigned dst) { unsigned keep;
    asm volatile("s_mov_b32 %0, m0\n\ts_mov_b32 m0, %3\n\ts_nop 4\n\tglobal_load_lds_dwordx4 %1, %2\n\ts_mov_b32 m0, %0" : "=&s"(keep) : "v"(voff), "s"(base), "s"(dst) : "memory"); }
DI void glds_dword(const char* base, unsigned voff, unsigned dst) { unsigned keep;
    asm volatile("s_mov_b32 %0, m0\n\ts_mov_b32 m0, %3\n\ts_nop 4\n\tglobal_load_lds_dword %1, %2\n\ts_mov_b32 m0, %0" : "=&s"(keep) : "v"(voff), "s"(base), "s"(dst) : "memory"); }
typedef float f32x2_cv __attribute__((ext_vector_type(2))); typedef __bf16 bf16x2_cv __attribute__((ext_vector_type(2)));
DI unsigned cvt_pk_bf16(float lo, float hi) { const f32x2_cv v = {lo, hi}; const bf16x2_cv b = __builtin_convertvector(v, bf16x2_cv); return __builtin_bit_cast(unsigned, b); }

typedef int i32x4v __attribute__((ext_vector_type(4)));
typedef int i32x8v __attribute__((ext_vector_type(8)));
DI i32x8v cat8(const bf16x8 a, const bf16x8 b) { return __builtin_shufflevector(__builtin_bit_cast(i32x4v, a), __builtin_bit_cast(i32x4v, b), 0, 1, 2, 3, 4, 5, 6, 7); }
DI void mfma_fp8_acc(f32x4& c, const i32x8v a, const i32x8v b) { asm volatile("v_mfma_f32_16x16x128_f8f6f4 %0, %1, %2, %0" : "+v"(c) : "v"(a), "v"(b)); }
DI void mfma_fp8_new(f32x4& c, const i32x8v a, const i32x8v b) { asm volatile("v_mfma_f32_16x16x128_f8f6f4 %0, %1, %2, 0" : "=&v"(c) : "v"(a), "v"(b)); }
#define MFMA_DRAIN() asm volatile("s_nop 15\n\ts_nop 15\n\ts_nop 15\n\ts_nop 15\n\ts_nop 15" ::: "memory")
struct Unit { int pm, pn, e, mt, idx; };

template <bool FP8, class Epi, class Sched>
DI void gemm_phase(LAS unsigned char* lds, const int KB_in, const Sched& S, const Epi& E) {
    int K = KB_in; asm volatile("" : "+s"(K));
    const int tid = opaque_tid(), wid = __builtin_amdgcn_readfirstlane(tid >> 6), lane = tid & 63, wr = wid >> 2, wc = wid & 3, fr = lane & 15, fq = lane >> 4;
    const int nt = K / 128;
    int Rr[2], Cc[2]; unsigned voffB[2];
#pragma unroll
    for (int i = 0; i < 2; ++i) { int R, C; stage_rc(tid * 16 + i * 8192, R, C); Rr[i] = R; Cc[i] = C; const int Rb = (R & ~31) + perm32(R & 31); voffB[i] = (unsigned)(Rb * K + C * 2); }
    const size_t kstep = (size_t)128;
    const size_t hstepB = (size_t)HALF * K;
    const unsigned ldsw = (unsigned)wid * 1024u;
    const unsigned ldsbase = (unsigned)(size_t)lds;
    const int aoff = lds_byte(wr * 64 + fr, fq * 8), boff = lds_byte(wc * 32 + fr, fq * 8);
#define PG8_SA(b, h) (((b) * 2 + (h)) * HTB)
#define PG8_SB(b, h) ((4 + (b) * 2 + (h)) * HTB)
#define PG8_STAGE(bufoff, gbase, voff) do { _Pragma("unroll") for (int _i = 0; _i < 2; ++_i) \
        glds_s((const char*)(gbase), (voff)[_i], ldsbase + (unsigned)(bufoff) + ldsw + (unsigned)(_i * 8192)); } while (0)
#define PG8_LDA(dst, b, h) do { _Pragma("unroll") for (int m = 0; m < 4; ++m) _Pragma("unroll") for (int k = 0; k < 2; ++k) dst[m][k] = *(const LAS bf16x8*)(lds + PG8_SA(b, h) + aoff + m * 2048 + k * 1024); } while (0)
#define PG8_LDB(dst, b, h) do { _Pragma("unroll") for (int n = 0; n < 2; ++n) _Pragma("unroll") for (int k = 0; k < 2; ++k) dst[n][k] = *(const LAS bf16x8*)(lds + PG8_SB(b, h) + boff + n * 2048 + k * 1024); } while (0)
#define PG8_MMA(ai, bj, At, Bt, ZC) do { __builtin_amdgcn_s_setprio(1); _Pragma("unroll") for (int m = 0; m < 4; ++m) _Pragma("unroll") for (int n = 0; n < 2; ++n) { \
        if constexpr (FP8) { if (ZC) mfma_fp8_new(acc[ai][bj][m][n], cat8(Bt[n][0], Bt[n][1]), cat8(At[m][0], At[m][1])); else mfma_fp8_acc(acc[ai][bj][m][n], cat8(Bt[n][0], Bt[n][1]), cat8(At[m][0], At[m][1])); } \
        else { acc[ai][bj][m][n] = __builtin_amdgcn_mfma_f32_16x16x32_bf16(Bt[n][0], At[m][0], acc[ai][bj][m][n], 0, 0, 0); \
               acc[ai][bj][m][n] = __builtin_amdgcn_mfma_f32_16x16x32_bf16(Bt[n][1], At[m][1], acc[ai][bj][m][n], 0, 0, 0); } } \
        __builtin_amdgcn_s_setprio(0); } while (0)
#define PG8_WAIT_V(n) asm volatile("s_waitcnt vmcnt(" #n ")" ::: "memory")
#define PG8_WAIT_L(n) asm volatile("s_waitcnt lgkmcnt(" #n ")" ::: "memory")
#define PG8_BAR __builtin_amdgcn_s_barrier()
#define PG8_SCHED __builtin_amdgcn_sched_barrier(0)
    Unit cur, nxt; int ui = 0;
    if (!S.next(0, cur)) return;
    f32x4 acc[2][2][4][2];
#define PG8_ZERO_ACC() do { if constexpr (!FP8) { _Pragma("unroll") for (int a = 0; a < 2; ++a) _Pragma("unroll") for (int b = 0; b < 2; ++b) _Pragma("unroll") for (int m = 0; m < 4; ++m) _Pragma("unroll") for (int n = 0; n < 2; ++n) acc[a][b][m][n] = (f32x4){0.f, 0.f, 0.f, 0.f}; } } while (0)
    PG8_ZERO_ACC();
    bf16x8 At[4][2], B0[2][2], B1[2][2];
    unsigned cvo0[2], cvo1[2], nvo0[2], nvo1[2];
    S.a_off(cur, Rr, Cc, cvo0, cvo1);
    asm volatile("" : "+v"(cvo0[0]), "+v"(cvo0[1]), "+v"(cvo1[0]), "+v"(cvo1[1]), "+v"(voffB[0]), "+v"(voffB[1]));
    const char* const aB = uni_ptr(S.a_base());
    const char* cB = uni_ptr(S.b_base(cur));
    PG8_STAGE(PG8_SB(0, 0), cB, voffB); PG8_STAGE(PG8_SB(0, 1), cB + hstepB, voffB); PG8_STAGE(PG8_SA(0, 0), aB, cvo0); PG8_STAGE(PG8_SA(0, 1), aB, cvo1);
    if (wr == 1) PG8_BAR;
    PG8_WAIT_V(2); PG8_BAR;
    PG8_STAGE(PG8_SB(1, 0), cB + kstep, voffB); PG8_STAGE(PG8_SA(1, 0), aB + kstep, cvo0); PG8_STAGE(PG8_SB(1, 1), cB + hstepB + kstep, voffB);
    PG8_WAIT_V(6); PG8_BAR;
    for (;;) {
        const bool has_next = S.next(ui + 1, nxt);
        const char* nB = uni_ptr(has_next ? S.b_base(nxt) : cB);
        if (has_next) { int R2[2], C2[2]; const int tid2 = opaque_tid();
#pragma unroll
            for (int i = 0; i < 2; ++i) stage_rc(tid2 * 16 + i * 8192, R2[i], C2[i]);
            S.a_off(nxt, R2, C2, nvo0, nvo1); }
        else { nvo0[0] = cvo0[0]; nvo0[1] = cvo0[1]; nvo1[0] = cvo1[0]; nvo1[1] = cvo1[1]; }
        asm volatile("" : "+v"(nvo0[0]), "+v"(nvo0[1]), "+v"(nvo1[0]), "+v"(nvo1[1]));
#define PG8_KITER(ZC_) do { \
            const bool last = (t == nt - 2); \
            const char* a1 = aB + (size_t)(t + 1) * kstep; \
            const char* a2 = last ? aB : aB + (size_t)(t + 2) * kstep; const char* b2 = last ? nB : cB + (size_t)(t + 2) * kstep; \
            const char* a3 = a2 + kstep; const char* b3 = b2 + kstep; \
            unsigned v20[2], v21[2]; \
            v20[0] = last ? nvo0[0] : cvo0[0]; v20[1] = last ? nvo0[1] : cvo0[1]; v21[0] = last ? nvo1[0] : cvo1[0]; v21[1] = last ? nvo1[1] : cvo1[1]; \
            if constexpr (Sched::HAS_FILL) { if (t == 2) S.fill_async(ui, wid, lane); } \
            PG8_LDB(B0, 0, 0); PG8_LDB(B1, 0, 1); PG8_SCHED; PG8_LDA(At, 0, 0); PG8_STAGE(PG8_SA(1, 1), a1, cvo1); \
            PG8_WAIT_V(8); PG8_WAIT_L(0); PG8_BAR; PG8_MMA(0, 0, At, B0, ZC_); PG8_MMA(0, 1, At, B1, ZC_); PG8_BAR; PG8_SCHED; \
            PG8_LDA(At, 0, 1); PG8_STAGE(PG8_SB(0, 0), b2, voffB); PG8_STAGE(PG8_SB(0, 1), b2 + hstepB, voffB); PG8_STAGE(PG8_SA(0, 0), a2, v20); \
            PG8_WAIT_V(8); PG8_WAIT_L(0); PG8_BAR; PG8_MMA(1, 0, At, B0, ZC_); PG8_MMA(1, 1, At, B1, ZC_); PG8_BAR; PG8_SCHED; \
            PG8_LDB(B0, 1, 0); PG8_LDB(B1, 1, 1); PG8_SCHED; PG8_LDA(At, 1, 0); PG8_STAGE(PG8_SA(0, 1), a2, v21); \
            PG8_WAIT_V(8); PG8_WAIT_L(0); PG8_BAR; PG8_MMA(0, 0, At, B0, false); PG8_MMA(0, 1, At, B1, false); PG8_BAR; PG8_SCHED; \
            PG8_LDA(At, 1, 1); PG8_STAGE(PG8_SB(1, 0), b3, voffB); PG8_STAGE(PG8_SB(1, 1), b3 + hstepB, voffB); PG8_STAGE(PG8_SA(1, 0), a3, v20); \
            PG8_WAIT_V(8); PG8_WAIT_L(0); PG8_BAR; PG8_MMA(1, 0, At, B0, false); PG8_MMA(1, 1, At, B1, false); PG8_BAR; PG8_SCHED; \
        } while (0)
        if constexpr (FP8) {
            { int t = 0; PG8_KITER(true); }
            for (int t = 2; t < nt; t += 2) PG8_KITER(false);
        } else {
            for (int t = 0; t < nt; t += 2) PG8_KITER(false);
        }
#undef PG8_KITER
        if (wr == 0) PG8_BAR;
        if constexpr (FP8) MFMA_DRAIN();
        { const int tid3 = opaque_tid(), wid3 = __builtin_amdgcn_readfirstlane(tid3 >> 6), lane3 = tid3 & 63; E(acc, cur, wid3 >> 2, wid3 & 3, lane3 & 15, lane3 >> 4); }
        if (!has_next) break;
        PG8_ZERO_ACC();
        cur = nxt; cB = nB; cvo0[0] = nvo0[0]; cvo0[1] = nvo0[1]; cvo1[0] = nvo1[0]; cvo1[1] = nvo1[1]; ++ui;
        if (wr == 1) PG8_BAR;
    }
    PG8_WAIT_V(0);
    PG8_BAR;
#undef PG8_SA
#undef PG8_SB
#undef PG8_STAGE
#undef PG8_LDA
#undef PG8_LDB
#undef PG8_MMA
#undef PG8_WAIT_V
#undef PG8_WAIT_L
#undef PG8_BAR
#undef PG8_SCHED
}

struct DenseSched {
    const bf16* A; int lda; const bf16* Bt; int K; int nM, nN, nwg, G, c; int skip_ctx;
    DI void init(const bf16* A_, int lda_, const bf16* Bt_, int K_, int nM_, int nN_, int G_, int c_, int skip) { A = A_; lda = lda_; Bt = Bt_; K = K_; nM = nM_; nN = nN_; nwg = nM * nN; G = G_; c = c_; skip_ctx = skip; }
    DI bool next(int i, Unit& u) const {
        const long L = (long)i * G + c; if (L >= nwg) return false;
        int wgid = (int)L; { const int q = nwg / NXCD, r = nwg % NXCD, xcd = wgid % NXCD, off = wgid / NXCD; wgid = (xcd < r ? xcd * (q + 1) : r * (q + 1) + (xcd - r) * q) + off; }
        const int nig = WGM * nN, gid = wgid / nig, fm = gid * WGM, gsz = (nM - fm) < WGM ? (nM - fm) : WGM;
        int pm = fm + ((wgid % nig) % gsz); u.pn = (wgid % nig) / gsz;
        if (skip_ctx) pm = pm + pm / 8 + 1;
        u.pm = pm; u.e = 0; u.mt = 0; u.idx = i; return true;
    }
    static constexpr bool HAS_FILL = false;
    DI void fill_async(int, int, int) const {}
    DI const char* a_base() const { return (const char*)A; }
    DI const char* b_base(const Unit& u) const { return (const char*)Bt + (size_t)u.pn * 256 * K * 2; }
    DI void a_off(const Unit& u, const int (&R)[2], const int (&C)[2], unsigned (&o0)[2], unsigned (&o1)[2]) const {
#pragma unroll
        for (int i = 0; i < 2; ++i) { o0[i] = (unsigned)((u.pm * 256 + R[i]) * lda + C[i]) * 2u; o1[i] = (unsigned)((u.pm * 256 + 128 + R[i]) * lda + C[i]) * 2u; }
    }
};

constexpr int UTAB_OFF = 131072, RTAB_OFF = 132096;
constexpr int RSLOT = 768;
struct GroupSched {
    const LAS int* tab; const LAS int* utab; LAS unsigned* rtab; int nunits;
    int nN, G, c, K;
    const char* Abase; const unsigned* list; const float* gsort; int gather;
    const char* Bbase; size_t b_estride;
    const float* bias_l; int bias_estride;
    static constexpr bool HAS_FILL = true;
    DI bool next(int i, Unit& u) const {
        if (i >= nunits) return false;
        const int w0 = __builtin_amdgcn_readfirstlane(utab[2 * i]), w1 = __builtin_amdgcn_readfirstlane(utab[2 * i + 1]);
        u.pm = w0; u.e = w1 >> 16; u.mt = (w1 >> 3) & 0x1fff; u.pn = w1 & 7; u.idx = i; return true;
    }
    DI const char* a_base() const { return Abase; }
    DI const char* b_base(const Unit& u) const { return Bbase + (size_t)u.e * b_estride + (size_t)u.pn * 256 * K; }
    DI void a_off(const Unit& u, const int (&R)[2], const int (&C)[2], unsigned (&o0)[2], unsigned (&o1)[2]) const {
        if (gather) {
            const LAS unsigned* rt = rtab + (u.idx & 1) * RSLOT;
#pragma unroll
            for (int i = 0; i < 2; ++i) { const unsigned p0 = rt[R[i]], p1 = rt[128 + R[i]];
                o0[i] = (p0 >> 2) * 1024u + (unsigned)C[i] * 2u; o1[i] = (p1 >> 2) * 1024u + (unsigned)C[i] * 2u; }
        } else {
#pragma unroll
            for (int i = 0; i < 2; ++i) { o0[i] = (unsigned)((u.pm * 256 + R[i]) * 1024 + C[i] * 2); o1[i] = (unsigned)((u.pm * 256 + 128 + R[i]) * 1024 + C[i] * 2); }
        }
    }
    DI void fill_sync(int k, int tid) const {
        Unit u; if (!next(k, u)) return;
        const int cnt = __builtin_amdgcn_readfirstlane(tab[33 + u.e]); int idx = u.mt * 256 + (tid & 255); idx = idx < cnt ? idx : cnt - 1;
        LAS unsigned* rt = rtab + (k & 1) * RSLOT;
        if (tid < 256) { rt[tid] = list[(size_t)u.e * T + idx]; rt[512 + tid] = __builtin_bit_cast(unsigned, bias_l[(size_t)u.e * bias_estride + 256 * u.pn + tid]); }
        else rt[tid] = __builtin_bit_cast(unsigned, gsort[(size_t)u.e * T + idx]);
    }
    DI void fill_async(int ui, int wid, int lane) const {
        const unsigned base = (unsigned)(size_t)rtab; const int w4 = wid & 3;
        if (gather) {
            if (wid < 4) { Unit u; if (!next(ui + 2, u)) return;
                const int cnt = __builtin_amdgcn_readfirstlane(tab[33 + u.e]); int idx = u.mt * 256 + w4 * 64 + lane; idx = idx < cnt ? idx : cnt - 1;
                glds_dword((const char*)(list + (size_t)u.e * T), (unsigned)idx * 4u, base + (unsigned)((ui & 1) * RSLOT * 4 + w4 * 256)); }
            else { Unit u; if (!next(ui + 1, u)) return;
                glds_dword((const char*)(bias_l + (size_t)u.e * bias_estride + 256 * u.pn), (unsigned)(w4 * 64 + lane) * 4u, base + (unsigned)(((ui + 1) & 1) * RSLOT * 4 + 2048 + w4 * 256)); }
        } else {
            Unit u; if (!next(ui + 1, u)) return;
            const int cnt = __builtin_amdgcn_readfirstlane(tab[33 + u.e]); int idx = u.mt * 256 + w4 * 64 + lane; idx = idx < cnt ? idx : cnt - 1;
            const unsigned dst = base + (unsigned)(((ui + 1) & 1) * RSLOT * 4 + w4 * 256);
            if (wid < 4) { glds_dword((const char*)(list + (size_t)u.e * T), (unsigned)idx * 4u, dst);
                           glds_dword((const char*)(bias_l + (size_t)u.e * bias_estride + 256 * u.pn), (unsigned)(w4 * 64 + lane) * 4u, dst + 2048u); }
            else glds_dword((const char*)(gsort + (size_t)u.e * T), (unsigned)idx * 4u, dst + 1024u);
        }
    }
};
DI int build_unit_table(const LAS int* tab, LAS int* utab, const int nN, const int G, const int c) {
    const int tid = opaque_tid();
    const int nmt = tab[32];
    int nunits;
    if ((G & 7) == 0) {
        const int x = c & 7, rk = c >> 3, W = G >> 3;
        const int mloc = (nmt > x) ? (nmt - x + 7) >> 3 : 0, total = mloc * nN;
        nunits = (total > rk) ? (total - rk + W - 1) / W : 0;
        if (tid < nunits) { const int k = tid * W + rk, ml = k / nN, pn = k - ml * nN, mtile = x + 8 * ml; int e = 0;
            for (int j = 1; j < 32; ++j) e += (tab[j] <= mtile) ? 1 : 0;
            utab[2 * tid] = mtile; utab[2 * tid + 1] = (e << 16) | ((mtile - tab[e]) << 3) | pn; }
    } else {
        const int total = nmt * nN;
        nunits = (total > c) ? (total - c + G - 1) / G : 0;
        if (tid < nunits) { const int L = tid * G + c, mtile = L / nN, pn = L - mtile * nN; int e = 0;
            for (int j = 1; j < 32; ++j) e += (tab[j] <= mtile) ? 1 : 0;
            utab[2 * tid] = mtile; utab[2 * tid + 1] = (e << 16) | ((mtile - tab[e]) << 3) | pn; }
    }
    __syncthreads();
    return __builtin_amdgcn_readfirstlane(nunits);
}

struct EpiBf16 {
    bf16* O; int ldc; float sc;
    DI void operator()(const f32x4 (&acc)[2][2][4][2], const Unit& u, int wr, int wc, int fr, int fq) const {
        const int row0 = u.pm * 256 + wr * 64 + fr, col0 = u.pn * 256 + wc * 32 + 8 * fq;
#pragma unroll
        for (int ai = 0; ai < 2; ++ai)
#pragma unroll
            for (int m = 0; m < 4; ++m) { bf16* rowp = O + (size_t)(row0 + ai * HALF + m * 16) * ldc + col0;
#pragma unroll
                for (int bj = 0; bj < 2; ++bj) { const f32x4 v0 = acc[ai][bj][m][0] * sc, v1 = acc[ai][bj][m][1] * sc;
                    u32x4 w; w.x = cvt_pk_bf16(v0[0], v0[1]); w.y = cvt_pk_bf16(v0[2], v0[3]); w.z = cvt_pk_bf16(v1[0], v1[1]); w.w = cvt_pk_bf16(v1[2], v1[3]);
                    *(u32x4*)(rowp + bj * HALF) = w; } }
    }
};
struct EpiResid {
    bf16* X; const float* mod_l;
    DI void operator()(const f32x4 (&acc)[2][2][4][2], const Unit& u, int wr, int wc, int fr, int fq) const {
        const int b = u.pm / 9, mrow = (u.pm - b * 9 == 0) ? 32 : b;
        const float* g = mod_l + (size_t)mrow * 6144 + 2048;
        const int row0 = u.pm * 256 + wr * 64 + fr, col0 = u.pn * 256 + wc * 32 + 8 * fq;
        f32x4 gv[2][2];
#pragma unroll
        for (int bj = 0; bj < 2; ++bj)
#pragma unroll
            for (int n = 0; n < 2; ++n) gv[bj][n] = *(const f32x4*)(g + col0 + bj * HALF + 4 * n) * (1.0f / (WO_SCALE * MIX_SCALE));
#pragma unroll
        for (int ai = 0; ai < 2; ++ai) {
            u32x4 xw8[4][2];
#pragma unroll
            for (int m = 0; m < 4; ++m)
#pragma unroll
                for (int bj = 0; bj < 2; ++bj) xw8[m][bj] = *(const u32x4*)(X + (size_t)(row0 + ai * HALF + m * 16) * DM + col0 + bj * HALF);
#pragma unroll
            for (int m = 0; m < 4; ++m) { bf16* rowp = X + (size_t)(row0 + ai * HALF + m * 16) * DM + col0;
#pragma unroll
                for (int bj = 0; bj < 2; ++bj) { const u32x4 xw = xw8[m][bj];
                    const f32x4 x0 = (f32x4){bflo(xw.x), bfhi(xw.x), bflo(xw.y), bfhi(xw.y)}, x1 = (f32x4){bflo(xw.z), bfhi(xw.z), bflo(xw.w), bfhi(xw.w)};
                    const f32x4 y0 = x0 * DN_ALPHA + gv[bj][0] * acc[ai][bj][m][0], y1 = x1 * DN_ALPHA + gv[bj][1] * acc[ai][bj][m][1];
                    u32x4 w; w.x = cvt_pk_bf16(y0[0], y0[1]); w.y = cvt_pk_bf16(y0[2], y0[3]); w.z = cvt_pk_bf16(y1[0], y1[1]); w.w = cvt_pk_bf16(y1[2], y1[3]);
                    *(u32x4*)(rowp + bj * HALF) = w; } }
        }
    }
};
struct EpiSwiglu {
    unsigned char* ACT; const LAS unsigned* rtab;
    DI void operator()(const f32x4 (&acc)[2][2][4][2], const Unit& u, int wr, int wc, int fr, int fq) const {
        const LAS float* bias = (const LAS float*)(rtab + (u.idx & 1) * RSLOT + 512);
        const int jc0 = u.pn * 128 + wc * 32 + 8 * fq, jl0 = wc * 32 + 8 * fq;
        f32x4 bg[2], bl[2];
#pragma unroll
        for (int n = 0; n < 2; ++n) { const f32x4 a = *(const LAS f32x4*)(bias + 2 * (jl0 + 4 * n)), b = *(const LAS f32x4*)(bias + 2 * (jl0 + 4 * n) + 4);
            bg[n] = (f32x4){a[0], a[2], b[0], b[2]}; bl[n] = (f32x4){a[1], a[3], b[1], b[3]}; }
        const int row0 = u.pm * 256 + wr * 64 + fr;
#pragma unroll
        for (int ai = 0; ai < 2; ++ai)
#pragma unroll
            for (int m = 0; m < 4; ++m) {
                float y[8];
#pragma unroll
                for (int n = 0; n < 2; ++n) { const f32x4 gl = acc[ai][0][m][n] * (1.0f / WGU_SCALE) + bg[n], li = acc[ai][1][m][n] * (1.0f / WGU_SCALE) + bl[n];
#pragma unroll
                    for (int i = 0; i < 4; i += 2) {
                        const f32x2 seven = {7.0f, 7.0f}, one = {1.0f, 1.0f};
                        const f32x2 gg = __builtin_elementwise_min((f32x2){gl[i], gl[i + 1]}, seven);
                        const f32x2 ll = __builtin_elementwise_min(__builtin_elementwise_max((f32x2){li[i], li[i + 1]}, -seven), seven);
                        const f32x2 t = gg * (-1.702f * LOG2E);
                        const f32x2 d = (f32x2){fast_exp2(t[0]), fast_exp2(t[1])} + one;
                        const f32x2 r = {__builtin_amdgcn_rcpf(d[0]), __builtin_amdgcn_rcpf(d[1])};
                        const f32x2 yy = (ll + one) * (gg * r);
                        y[4 * n + i] = yy[0]; y[4 * n + i + 1] = yy[1]; } }
                u32x2 w; w.x = pk4_fp8(y[0], y[1], y[2], y[3]); w.y = pk4_fp8(y[4], y[5], y[6], y[7]);
                *(u32x2*)(ACT + (size_t)(row0 + ai * HALF + m * 16) * DE + jc0) = w; }
    }
};
struct EpiDown {
    unsigned char* Y; const LAS unsigned* rtab; const LAS int* tab;
    DI void operator()(const f32x4 (&acc)[2][2][4][2], const Unit& u, int wr, int wc, int fr, int fq) const {
        const int nrows = __builtin_amdgcn_readfirstlane(tab[33 + u.e]) - u.mt * 256;
        const LAS unsigned* rt = rtab + (u.idx & 1) * RSLOT;
        const LAS float* bias = (const LAS float*)(rt + 512);
        const int cl0 = wc * 64 + 16 * fq, col0 = u.pn * 256 + cl0;
        f32x4 bv[2][2];
#pragma unroll
        for (int bj = 0; bj < 2; ++bj)
#pragma unroll
            for (int n = 0; n < 2; ++n) bv[bj][n] = *(const LAS f32x4*)(bias + cl0 + 8 * bj + 4 * n);
#pragma unroll
        for (int ai = 0; ai < 2; ++ai)
#pragma unroll
            for (int m = 0; m < 4; ++m) { const int rloc = ai * HALF + wr * 64 + m * 16 + fr;
                if (rloc < nrows) { const unsigned pair = rt[rloc]; float g = __builtin_bit_cast(float, rt[256 + rloc]); asm volatile("" : "+v"(g)); g *= Y_SCALE; const float sg = g * (1.0f / WD_SCALE);
                    u32x4 w;
#pragma unroll
                    for (int bj = 0; bj < 2; ++bj) { const f32x4 v0 = acc[ai][bj][m][0] * sg + bv[bj][0] * g, v1 = acc[ai][bj][m][1] * sg + bv[bj][1] * g;
                        w[2 * bj] = pk4_fp8(v0[0], v0[1], v0[2], v0[3]); w[2 * bj + 1] = pk4_fp8(v1[0], v1[1], v1[2], v1[3]); }
                    *(u32x4*)(Y + (size_t)pair * DM + col0) = w; } }
    }
};
}

namespace att {
typedef short v4i16_t __attribute__((ext_vector_type(4)));
DI int crow(int r, int hi) { return (r & 3) + 8 * (r >> 2) + 4 * hi; }
DI s16x4 vtr(const LAS unsigned char* p) { return __builtin_bit_cast(s16x4, __builtin_amdgcn_ds_read_tr16_b64_v4i16((LAS v4i16_t*)p)); }
#ifndef ATT_K8
#define ATT_K8 1
#endif
constexpr float Q8_SCALE = 4.0f, K8_SCALE = 0.25f;
DI u32x2 bf8x8(const u32x4 w, const float sc) {
    u32x2 o;
    o.x = pk4_fp8(bflo(w.x) * sc, bfhi(w.x) * sc, bflo(w.y) * sc, bfhi(w.y) * sc);
    o.y = pk4_fp8(bflo(w.z) * sc, bfhi(w.z) * sc, bflo(w.w) * sc, bfhi(w.w) * sc);
    return o;
}
DI pg8::i32x8v q_to_fp8(const bf16x8 (&qf)[4]) {
    pg8::i32x8v q;
#pragma unroll
    for (int d0 = 0; d0 < 4; ++d0) { const u32x2 t = bf8x8(__builtin_bit_cast(u32x4, qf[d0]), Q8_SCALE); q[2 * d0] = (int)t.x; q[2 * d0 + 1] = (int)t.y; }
    return q;
}
DI pg8::i32x8v k8_read(const LAS unsigned char* p) { const u32x4 a = *(const LAS u32x4*)p, b = *(const LAS u32x4*)(p + 16); return (pg8::i32x8v){(int)a.x, (int)a.y, (int)a.z, (int)a.w, (int)b.x, (int)b.y, (int)b.z, (int)b.w}; }
#define MFMA_QK8(kf, qf8, c) __builtin_amdgcn_mfma_scale_f32_32x32x64_f8f6f4(kf, qf8, c, 0, 0, 0, 0, 0, 0)
#define ATT_BAR() asm volatile("s_waitcnt lgkmcnt(0)\n\ts_barrier" ::: "memory")

struct AttnP {
    const bf16* Q; int qp;
    const bf16* K; int kp;
    const bf16* K2; int k2p;
    const bf16* V; int vp;
    unsigned char* O; int op;
    int kt0, ntiles;
    int brow0, na_lo, na_nloc, qr0;
    const float* rpb;
    int rope_q, qpos0;
    int shadow;
};
constexpr int RPB_OFF = 60 * 1024;
constexpr int O1_OFF = 64 * 1024;

template <int DQK, int DV, int MODE>
DI void attn_core(LAS unsigned char* lds, const AttnP& p, const bf16x8 (&qf)[DQK / 16], f32x16 (&o)[DV / 32], float& m_run, float& l_run, const int tid, const int wid, const int lane) {
    constexpr bool K8 = ATT_K8 && (DQK == 64);
    constexpr int KROWB = K8 ? 80 : (DQK + 8) * 2, VROWB = (DV == 64) ? 192 : 320, TILEB = 64 * (KROWB + VROWB), CPR = DQK / 8, VPR = DV / 8;
    constexpr int NKC = (DQK == 64) ? 1 : 2, NVC = DV / 64;
    static_assert(2 * TILEB <= RPB_OFF, "attention LDS");
    const int r32 = lane & 31, hi = lane >> 5;
    int krow[NKC], kch[NKC], vrow[NVC], vch[NVC];
#pragma unroll
    for (int i = 0; i < NKC; ++i) { const int c = tid + 512 * i; krow[i] = c / CPR; kch[i] = c - krow[i] * CPR; }
#pragma unroll
    for (int i = 0; i < NVC; ++i) { const int c = tid + 512 * i; vrow[i] = c / VPR; vch[i] = c - vrow[i] * VPR; }
    u32x4 krA[NKC], vrA[NVC], krB[NKC], vrB[NVC];
    const int ntiles = p.ntiles;
#define ATT_TROW(j) ((MODE == 0) ? (p.kt0 + 64 * (j)) : (((j) < p.na_nloc) ? (p.brow0 + 256 + (p.na_lo + (j)) * 64) : (p.brow0 + ((j) - p.na_nloc) * 64)))
#define ATT_LOAD(j, kr, vr) do { const int trow_ = ATT_TROW(j); \
        _Pragma("unroll") for (int i = 0; i < NKC; ++i) { if (DQK == 64 || i == 0 || tid < 256) { \
            const bf16* src_ = (kch[i] < 8) ? (p.K + (size_t)(trow_ + krow[i]) * p.kp + kch[i] * 8) : (p.K2 + (size_t)(trow_ + krow[i]) * p.k2p + (kch[i] - 8) * 8); \
            kr[i] = *(const u32x4*)src_; } } \
        _Pragma("unroll") for (int i = 0; i < NVC; ++i) vr[i] = *(const u32x4*)(p.V + (size_t)(trow_ + vrow[i]) * p.vp + vch[i] * 8); } while (0)
#define ATT_WRITE(b, kr, vr) do { LAS unsigned char* kb_ = lds + (b) * TILEB; LAS unsigned char* vb_ = kb_ + 64 * KROWB; \
        if constexpr (K8) { *(LAS u32x2*)(kb_ + krow[0] * KROWB + 32 * (kch[0] & 1) + 8 * (kch[0] >> 1)) = bf8x8(kr[0], K8_SCALE); } else { \
        _Pragma("unroll") for (int i = 0; i < NKC; ++i) { if (DQK == 64 || i == 0 || tid < 256) *(LAS u32x4*)(kb_ + krow[i] * KROWB + kch[i] * 16) = kr[i]; } } \
        _Pragma("unroll") for (int i = 0; i < NVC; ++i) *(LAS u32x4*)(vb_ + vrow[i] * VROWB + vch[i] * 16) = vr[i]; } while (0)
    ATT_LOAD(0, krA, vrA); ATT_WRITE(0, krA, vrA);
    if (ntiles > 1) ATT_LOAD(1, krB, vrB);
    if (ntiles > 2) ATT_LOAD(2, krA, vrA);
    ATT_BAR();
    pg8::i32x8v q8 = {0, 0, 0, 0, 0, 0, 0, 0};
    if constexpr (K8) q8 = q_to_fp8(qf);
    const bool sh_noload = PROBE_SHADOW && (p.shadow == 2), sh_nocomp = PROBE_SHADOW && (p.shadow == 1);
    f32x16 negm;
#pragma unroll
    for (int r = 0; r < 16; ++r) negm[r] = -m_run;
    bool first = true;
    const int qr = p.qr0 + (wid >> 1), rs = min(max(qr - 4, 0), 24);
    const int qc = 32 * (wid & 1) + r32, cs = min(max(qc - 8, 0), 48);
    const int q4 = (lane & 15) >> 2, p4 = lane & 3, blk = (lane >> 4) & 1;
    unsigned boff0[(MODE == 1 && DV == 64) ? 16 : 1], boff1[(MODE == 1 && DV == 64) ? 16 : 1];
    if (MODE == 1 && DV == 64) {
#pragma unroll
        for (int r = 0; r < 16; ++r) { const int kc0 = crow(r, hi), kc1 = kc0 + 32;
            boff0[r] = ((kc0 >= cs) && (kc0 < cs + 16)) ? (unsigned)(kc0 - qc + 15) * 4u : 124u;
            boff1[r] = ((kc1 >= cs) && (kc1 < cs + 16)) ? (unsigned)(kc1 - qc + 15) * 4u : 124u; }
    }
    auto tile = [&](const int j) __attribute__((always_inline)) {
        bool active = true; int krg = 0;
        if (MODE == 1) { krg = p.na_lo + j; active = (j >= p.na_nloc) || (krg >= rs && krg < rs + 8); }
        if (sh_nocomp) active = false;
        if (active && DV == 64) {
            const LAS unsigned char* kb = lds + (j & 1) * TILEB; const LAS unsigned char* vb = kb + 64 * KROWB;
            f32x16 s0 = negm, s1 = negm;
            if constexpr (K8) {
                s0 = MFMA_QK8(k8_read(kb + r32 * KROWB + 32 * hi), q8, s0);
                s1 = MFMA_QK8(k8_read(kb + (32 + r32) * KROWB + 32 * hi), q8, s1);
            } else {
#pragma unroll
            for (int d0 = 0; d0 < DQK / 16; ++d0) {
                const bf16x8 k0 = *(const LAS bf16x8*)(kb + r32 * KROWB + (16 * d0 + 8 * hi) * 2);
                const bf16x8 k1 = *(const LAS bf16x8*)(kb + (32 + r32) * KROWB + (16 * d0 + 8 * hi) * 2);
                s0 = __builtin_amdgcn_mfma_f32_32x32x16_bf16(k0, qf[d0], s0, 0, 0, 0);
                s1 = __builtin_amdgcn_mfma_f32_32x32x16_bf16(k1, qf[d0], s1, 0, 0, 0);
            } }
            if (MODE == 1 && j < p.na_nloc) {
                const LAS unsigned char* brow = lds + RPB_OFF + (krg - qr + 7) * 128;
#pragma unroll
                for (int r = 0; r < 16; ++r) { s0[r] += *(const LAS float*)(brow + boff0[r]); s1[r] += *(const LAS float*)(brow + boff1[r]); }
            }
            if (first) {
                float mt = fmaxf(fmaxf(s0[0], s1[0]), fmaxf(s0[1], s1[1]));
#pragma unroll
                for (int r = 2; r < 16; r += 2) mt = fmaxf(fmaxf(mt, fmaxf(s0[r], s1[r])), fmaxf(s0[r + 1], s1[r + 1]));
                mt = fmaxf(mt, __shfl_xor(mt, 32));
                const float dl = (mt > -__builtin_inff()) ? mt : 0.f;
                m_run += dl;
#pragma unroll
                for (int r = 0; r < 16; ++r) { s0[r] -= dl; s1[r] -= dl; negm[r] = -m_run; }
                first = false;
            }
            float ps0 = 0.f, ps1 = 0.f, ps2 = 0.f, ps3 = 0.f;
#pragma unroll
            for (int r = 0; r < 16; r += 2) { s0[r] = fast_exp2(s0[r]); s0[r + 1] = fast_exp2(s0[r + 1]); s1[r] = fast_exp2(s1[r]); s1[r + 1] = fast_exp2(s1[r + 1]);
                ps0 += s0[r]; ps1 += s0[r + 1]; ps2 += s1[r]; ps3 += s1[r + 1]; }
            const float ps = (ps0 + ps1) + (ps2 + ps3);
            l_run += ps;
            const float pt = ps + __shfl_xor(ps, 32);
            const bool need = pt > 65536.0f;
            bf16x8 pa[2][2];
#pragma unroll
            for (int s = 0; s < 2; ++s) {
                u32x4 w0, w1;
                w0.x = pg8::cvt_pk_bf16(s0[8 * s + 0], s0[8 * s + 1]); w0.y = pg8::cvt_pk_bf16(s0[8 * s + 2], s0[8 * s + 3]); w0.z = pg8::cvt_pk_bf16(s0[8 * s + 4], s0[8 * s + 5]); w0.w = pg8::cvt_pk_bf16(s0[8 * s + 6], s0[8 * s + 7]);
                w1.x = pg8::cvt_pk_bf16(s1[8 * s + 0], s1[8 * s + 1]); w1.y = pg8::cvt_pk_bf16(s1[8 * s + 2], s1[8 * s + 3]); w1.z = pg8::cvt_pk_bf16(s1[8 * s + 4], s1[8 * s + 5]); w1.w = pg8::cvt_pk_bf16(s1[8 * s + 6], s1[8 * s + 7]);
                pa[0][s] = __builtin_bit_cast(bf16x8, w0); pa[1][s] = __builtin_bit_cast(bf16x8, w1);
            }
            const LAS unsigned char* vbase = vb + (4 * hi + q4) * VROWB + 32 * blk + 8 * p4;
#pragma unroll
            for (int u = 0; u < 2; ++u)
#pragma unroll
                for (int s = 0; s < 2; ++s)
#pragma unroll
                    for (int c = 0; c < 2; ++c) {
                        const LAS unsigned char* a0 = vbase + (32 * u + 16 * s) * VROWB + 64 * c;
                        const s16x4 lo = vtr(a0), hh = vtr(a0 + 8 * VROWB);
                        const bf16x8 vf = (bf16x8){lo[0], lo[1], lo[2], lo[3], hh[0], hh[1], hh[2], hh[3]};
                        o[c % (DV / 32)] = __builtin_amdgcn_mfma_f32_32x32x16_bf16(pa[u][s], vf, o[c % (DV / 32)], 0, 0, 0);
                    }
            if (__any(need)) {
                const int ex = (int)((__builtin_bit_cast(unsigned, pt) >> 23) & 255u) - 127;
                const float dl = need ? (float)ex : 0.f, f = fast_exp2(-dl);
                m_run += dl; l_run *= f;
#pragma unroll
                for (int r = 0; r < 16; ++r) negm[r] = -m_run;
                int hio = hi; asm volatile("" : "+v"(hio));
#pragma unroll
                for (int r = 0; r < 16; ++r) { const float fr_ = __shfl(f, crow(r, hio)); o[0][r] *= fr_; o[1 % (DV / 32)][r] *= fr_; }
            }
        }
        if (active && DV != 64) {
            const LAS unsigned char* kb = lds + (j & 1) * TILEB; const LAS unsigned char* vb = kb + 64 * KROWB;
#pragma unroll
            for (int u = 0; u < 2; ++u) {
                const LAS unsigned char* kbu = kb + u * 32 * KROWB;
                f32x16 s0 = negm;
                if constexpr (K8) { s0 = MFMA_QK8(k8_read(kbu + r32 * KROWB + 32 * hi), q8, s0); } else {
#pragma unroll
                for (int d0 = 0; d0 < DQK / 16; ++d0) {
                    const bf16x8 k0 = *(const LAS bf16x8*)(kbu + r32 * KROWB + (16 * d0 + 8 * hi) * 2);
                    s0 = __builtin_amdgcn_mfma_f32_32x32x16_bf16(k0, qf[d0], s0, 0, 0, 0);
                } }
                if (MODE == 1 && j < p.na_nloc) {
                    const LAS float* brow = (const LAS float*)(lds + RPB_OFF) + (krg - qr + 7) * 32;
                    int hio = hi; asm volatile("" : "+v"(hio));
#pragma unroll
                    for (int r = 0; r < 16; ++r) {
                        const int kc0 = crow(r, hio) + 32 * u;
                        const bool v0 = (kc0 >= cs) && (kc0 < cs + 16);
                        const int i0 = min(max(kc0 - qc + 15, 0), 30);
                        s0[r] = v0 ? s0[r] + brow[i0] : -__builtin_inff();
                    }
                }
                if (first) {
                    float mt = fmaxf(fmaxf(s0[0], s0[1]), s0[2]);
#pragma unroll
                    for (int r = 3; r < 15; r += 2) mt = fmaxf(fmaxf(mt, s0[r]), s0[r + 1]);
                    mt = fmaxf(mt, s0[15]);
                    mt = fmaxf(mt, __shfl_xor(mt, 32));
                    const float dl = (mt > -__builtin_inff()) ? mt : 0.f;
                    m_run += dl;
#pragma unroll
                    for (int r = 0; r < 16; ++r) { s0[r] -= dl; negm[r] = -m_run; }
                    first = false;
                }
                float ps0 = 0.f, ps1 = 0.f;
#pragma unroll
                for (int r = 0; r < 16; r += 2) { s0[r] = fast_exp2(s0[r]); s0[r + 1] = fast_exp2(s0[r + 1]); ps0 += s0[r]; ps1 += s0[r + 1]; }
                const float ps = ps0 + ps1;
                l_run += ps;
                const float pt = ps + __shfl_xor(ps, 32);
                const bool need = pt > 65536.0f;
                bf16x8 pa[2];
#pragma unroll
                for (int s = 0; s < 2; ++s) {
                    u32x4 w0;
                    w0.x = pg8::cvt_pk_bf16(s0[8 * s + 0], s0[8 * s + 1]); w0.y = pg8::cvt_pk_bf16(s0[8 * s + 2], s0[8 * s + 3]); w0.z = pg8::cvt_pk_bf16(s0[8 * s + 4], s0[8 * s + 5]); w0.w = pg8::cvt_pk_bf16(s0[8 * s + 6], s0[8 * s + 7]);
                    pa[s] = __builtin_bit_cast(bf16x8, w0);
                }
                const LAS unsigned char* vbase = vb + (32 * u + 4 * hi + q4) * VROWB + 32 * blk + 8 * p4;
#pragma unroll
                for (int c = 0; c < DV / 32; ++c)
#pragma unroll
                    for (int s = 0; s < 2; ++s) {
                        const LAS unsigned char* a0 = vbase + (16 * s) * VROWB + 64 * c;
                        const s16x4 lo = vtr(a0), hh = vtr(a0 + 8 * VROWB);
                        const bf16x8 vf = (bf16x8){lo[0], lo[1], lo[2], lo[3], hh[0], hh[1], hh[2], hh[3]};
                        o[c] = __builtin_amdgcn_mfma_f32_32x32x16_bf16(pa[s], vf, o[c], 0, 0, 0);
                    }
                if (__any(need)) {
                    const int ex = (int)((__builtin_bit_cast(unsigned, pt) >> 23) & 255u) - 127;
                    const float dl = need ? (float)ex : 0.f, f = fast_exp2(-dl);
                    m_run += dl; l_run *= f;
#pragma unroll
                    for (int r = 0; r < 16; ++r) negm[r] = -m_run;
                    int hio = hi; asm volatile("" : "+v"(hio));
#pragma unroll
                    for (int r = 0; r < 16; ++r) { const float fr_ = __shfl(f, crow(r, hio));
#pragma unroll
                        for (int c = 0; c < DV / 32; ++c) o[c][r] *= fr_; }
                }
            }
        }
    };
    for (int j = 0; j < ntiles; j += 2) {
        tile(j);
        if (j + 1 < ntiles) ATT_WRITE((j + 1) & 1, krB, vrB);
        if (j + 3 < ntiles) ATT_LOAD(j + 3, krB, vrB);
        ATT_BAR();
        if (j + 1 >= ntiles) break;
        tile(j + 1);
        if (j + 2 < ntiles) ATT_WRITE((j + 2) & 1, krA, vrA);
        if (j + 4 < ntiles) ATT_LOAD(j + 4, krA, vrA);
        ATT_BAR();
    }
#undef ATT_TROW
#undef ATT_LOAD
#undef ATT_WRITE
}

template <int DQK>
DI void attn_core_pipe(LAS unsigned char* lds, const AttnP& p, const bf16x8 (&qf)[DQK / 16], f32x16 (&o)[2], float& m_run, float& l_run, const int tid, const int wid, const int lane) {
    constexpr int KROWB = (DQK + 8) * 2, VROWB = 192, TILEB = 64 * (KROWB + VROWB), CPR = DQK / 8;
    constexpr int NKC = (DQK == 64) ? 1 : 2;
    static_assert(2 * TILEB <= RPB_OFF, "attention LDS");
    const int r32 = lane & 31, hi = lane >> 5;
    int krow[NKC], kch[NKC];
#pragma unroll
    for (int i = 0; i < NKC; ++i) { const int c = tid + 512 * i; krow[i] = c / CPR; kch[i] = c - krow[i] * CPR; }
    const int vrow = tid >> 3, vch = tid & 7;
    u32x4 kr[NKC], vr;
    const int nt = p.ntiles;
#define AP_LOADK(j) do { const int trow_ = p.kt0 + 64 * min((j), nt - 1); \
        _Pragma("unroll") for (int i = 0; i < NKC; ++i) { if (DQK == 64 || i == 0 || tid < 256) { \
            const bf16* src_ = (kch[i] < 8) ? (p.K + (size_t)(trow_ + krow[i]) * p.kp + kch[i] * 8) : (p.K2 + (size_t)(trow_ + krow[i]) * p.k2p + (kch[i] - 8) * 8); \
            kr[i] = *(const u32x4*)src_; } } } while (0)
#define AP_LOADV(j) do { const int trow_ = p.kt0 + 64 * min((j), nt - 1); vr = *(const u32x4*)(p.V + (size_t)(trow_ + vrow) * p.vp + vch * 8); } while (0)
#define AP_WRITEK(b) do { LAS unsigned char* kb_ = lds + (b) * TILEB; \
        _Pragma("unroll") for (int i = 0; i < NKC; ++i) { if (DQK == 64 || i == 0 || tid < 256) *(LAS u32x4*)(kb_ + krow[i] * KROWB + kch[i] * 16) = kr[i]; } } while (0)
#define AP_WRITEV(b) do { *(LAS u32x4*)(lds + (b) * TILEB + 64 * KROWB + vrow * VROWB + vch * 16) = vr; } while (0)
#define AP_QK(b, S0, S1) do { const LAS unsigned char* kb_ = lds + (b) * TILEB; \
        _Pragma("unroll") for (int d0 = 0; d0 < DQK / 16; ++d0) { \
            const bf16x8 k0_ = *(const LAS bf16x8*)(kb_ + r32 * KROWB + (16 * d0 + 8 * hi) * 2); \
            const bf16x8 k1_ = *(const LAS bf16x8*)(kb_ + (32 + r32) * KROWB + (16 * d0 + 8 * hi) * 2); \
            S0 = __builtin_amdgcn_mfma_f32_32x32x16_bf16(k0_, qf[d0], S0, 0, 0, 0); \
            S1 = __builtin_amdgcn_mfma_f32_32x32x16_bf16(k1_, qf[d0], S1, 0, 0, 0); } } while (0)
    AP_LOADK(0); AP_LOADV(0); AP_WRITEK(0); AP_WRITEV(0); AP_LOADK(1);
    ATT_BAR();
    f32x16 negm, s0, s1;
#pragma unroll
    for (int r = 0; r < 16; ++r) { s0[r] = 0.f; s1[r] = 0.f; }
    AP_QK(0, s0, s1);
    {
        float mt = fmaxf(fmaxf(s0[0], s1[0]), fmaxf(s0[1], s1[1]));
#pragma unroll
        for (int r = 2; r < 16; r += 2) mt = fmaxf(fmaxf(mt, fmaxf(s0[r], s1[r])), fmaxf(s0[r + 1], s1[r + 1]));
        mt = fmaxf(mt, __shfl_xor(mt, 32));
        m_run = mt;
#pragma unroll
        for (int r = 0; r < 16; ++r) { s0[r] -= mt; s1[r] -= mt; negm[r] = -mt; }
    }
    AP_WRITEK(1); AP_LOADK(2); AP_LOADV(1);
    ATT_BAR();
    const int q4 = (lane & 15) >> 2, p4 = lane & 3, blk = (lane >> 4) & 1;
    const LAS unsigned char* vlane = lds + 64 * KROWB + (4 * hi + q4) * VROWB + 32 * blk + 8 * p4;
#define AP_SOFTMAX_PV(J) \
        float ps0 = 0.f, ps1 = 0.f, ps2 = 0.f, ps3 = 0.f; \
        _Pragma("unroll") for (int r = 0; r < 16; r += 2) { s0[r] = fast_exp2(s0[r]); s0[r + 1] = fast_exp2(s0[r + 1]); s1[r] = fast_exp2(s1[r]); s1[r + 1] = fast_exp2(s1[r + 1]); \
            ps0 += s0[r]; ps1 += s0[r + 1]; ps2 += s1[r]; ps3 += s1[r + 1]; } \
        const float ps = (ps0 + ps1) + (ps2 + ps3); \
        l_run += ps; \
        bf16x8 pa[2][2]; \
        _Pragma("unroll") for (int s = 0; s < 2; ++s) { \
            u32x4 w0, w1; \
            w0.x = pg8::cvt_pk_bf16(s0[8 * s + 0], s0[8 * s + 1]); w0.y = pg8::cvt_pk_bf16(s0[8 * s + 2], s0[8 * s + 3]); w0.z = pg8::cvt_pk_bf16(s0[8 * s + 4], s0[8 * s + 5]); w0.w = pg8::cvt_pk_bf16(s0[8 * s + 6], s0[8 * s + 7]); \
            w1.x = pg8::cvt_pk_bf16(s1[8 * s + 0], s1[8 * s + 1]); w1.y = pg8::cvt_pk_bf16(s1[8 * s + 2], s1[8 * s + 3]); w1.z = pg8::cvt_pk_bf16(s1[8 * s + 4], s1[8 * s + 5]); w1.w = pg8::cvt_pk_bf16(s1[8 * s + 6], s1[8 * s + 7]); \
            pa[0][s] = __builtin_bit_cast(bf16x8, w0); pa[1][s] = __builtin_bit_cast(bf16x8, w1); } \
        const LAS unsigned char* vbase = vlane + ((J) & 1) * TILEB; \
        _Pragma("unroll") for (int u = 0; u < 2; ++u) _Pragma("unroll") for (int s = 0; s < 2; ++s) _Pragma("unroll") for (int c = 0; c < 2; ++c) { \
                    const LAS unsigned char* a0 = vbase + (32 * u + 16 * s) * VROWB + 64 * c; \
                    const s16x4 lo = vtr(a0), hh = vtr(a0 + 8 * VROWB); \
                    const bf16x8 vf = (bf16x8){lo[0], lo[1], lo[2], lo[3], hh[0], hh[1], hh[2], hh[3]}; \
                    o[c] = __builtin_amdgcn_mfma_f32_32x32x16_bf16(pa[u][s], vf, o[c], 0, 0, 0); }
    for (int j = 0; j < nt - 1; ++j) {
        AP_WRITEK(j & 1); AP_WRITEV((j + 1) & 1);
        AP_LOADK(j + 3); AP_LOADV(j + 2);
        f32x16 sn0 = negm, sn1 = negm;
        AP_QK((j + 1) & 1, sn0, sn1);
        AP_SOFTMAX_PV(j)
        const float pt = ps + __shfl_xor(ps, 32);
        const bool need = pt > 65536.0f;
        s0 = sn0; s1 = sn1;
        if (__any(need)) {
            const int ex = (int)((__builtin_bit_cast(unsigned, pt) >> 23) & 255u) - 127;
            const float dl = need ? (float)ex : 0.f, f = fast_exp2(-dl);
            m_run += dl; l_run *= f;
#pragma unroll
            for (int r = 0; r < 16; ++r) { negm[r] = -m_run; s0[r] -= dl; s1[r] -= dl; }
            int hio = hi; asm volatile("" : "+v"(hio));
#pragma unroll
            for (int r = 0; r < 16; ++r) { const float fr_ = __shfl(f, crow(r, hio)); o[0][r] *= fr_; o[1][r] *= fr_; }
        }
        ATT_BAR();
    }
    {
        AP_SOFTMAX_PV(nt - 1)
        ATT_BAR();
    }
#undef AP_SOFTMAX_PV
#undef AP_LOADK
#undef AP_LOADV
#undef AP_WRITEK
#undef AP_WRITEV
#undef AP_QK
}

DI void rope_frag(bf16x8& frag, const int position, const int hi, const float freq_step  ) {
    u32x4 mine = __builtin_bit_cast(u32x4, frag), oth;
#pragma unroll
    for (int w = 0; w < 4; ++w) oth[w] = (unsigned)__shfl_xor((int)mine[w], 32);
    float res[8];
#pragma unroll
    for (int i = 0; i < 8; ++i) {
        const float x = (i & 1) ? bfhi(mine[i >> 1]) : bflo(mine[i >> 1]);
        const float y = (i & 1) ? bfhi(oth[i >> 1]) : bflo(oth[i >> 1]);
        float rev = (float)position * fast_exp2(-(float)i * freq_step) * 0.15915494309189535f; rev = rev - floorf(rev);
        const float sn = __builtin_amdgcn_sinf(rev), cs = __builtin_amdgcn_cosf(rev);
        res[i] = hi ? (y * sn + x * cs) : (x * cs - y * sn);
    }
    u32x4 w; w.x = pk2(res[0], res[1]); w.y = pk2(res[2], res[3]); w.z = pk2(res[4], res[5]); w.w = pk2(res[6], res[7]);
    frag = __builtin_bit_cast(bf16x8, w);
}

template <int DQK, int MODE>
DI void attn_unit(LAS unsigned char* lds, const AttnP& p) {
    const int tid = opaque_tid(), lane = tid & 63, wid = __builtin_amdgcn_readfirstlane(tid >> 6), r32 = lane & 31, hi = lane >> 5;
    bf16x8 qf[DQK / 16];
    const bf16* qrow = p.Q + (size_t)(32 * wid + r32) * p.qp;
#pragma unroll
    for (int d0 = 0; d0 < DQK / 16; ++d0) qf[d0] = *(const bf16x8*)(qrow + 16 * d0 + 8 * hi);
    if (DQK == 96) { if (p.rope_q) { const int pos = p.qpos0 + 32 * wid + r32; rope_frag(qf[4], pos >> 6, hi, LOG2_THETA / 8.f); rope_frag(qf[5], pos & 63, hi, LOG2_THETA / 8.f); } }
    if (MODE == 1) { if (tid < 465) { const int dr = tid / 31, dc = tid - dr * 31; ((LAS float*)(lds + RPB_OFF))[dr * 32 + dc] = p.rpb[tid] * LOG2E; }
                     if (tid < 15) ((LAS float*)(lds + RPB_OFF))[tid * 32 + 31] = -__builtin_inff(); }
    f32x16 o[2];
#pragma unroll
    for (int r = 0; r < 16; ++r) { o[0][r] = 0.f; o[1][r] = 0.f; }
    float m_run = 0.f, l_run = 0.f;
    if constexpr (MODE == 0) attn_core_pipe<DQK>(lds, p, qf, o, m_run, l_run, tid, wid, lane); else attn_core<DQK, 64, MODE>(lds, p, qf, o, m_run, l_run, tid, wid, lane);
    const float l = l_run + __shfl_xor(l_run, 32), inv = 1.0f / l;
    unsigned char* orow = p.O + (size_t)(32 * wid) * p.op + r32;
#pragma unroll
    for (int r = 0; r < 16; ++r) { int hio = hi; asm volatile("" : "+v"(hio)); const int q = crow(r, hio); const float iv = __shfl(inv, q) * MIX_SCALE;
#pragma unroll
        for (int c = 0; c < 2; ++c) orow[(size_t)q * p.op + 32 * c] = (unsigned char)__builtin_amdgcn_cvt_pk_fp8_f32(o[c][r] * iv, 0.f, 0u, false);
        __builtin_amdgcn_sched_barrier(0); }
}

template <int DQK>
DI void attn_core_w64(LAS unsigned char* lds, const AttnP& p, const bf16x8 (&qa)[DQK / 16], const bf16x8 (&qb)[DQK / 16], f32x16 (&oa)[2], f32x16 (&ob)[2], float (&m_run)[2], float (&l_run)[2],
                      const int tid, const int wid, const int lane) {
    constexpr bool K8 = ATT_K8 && (DQK == 64), K8M = ATT_K8 && (DQK == 96);
    constexpr int KROWB = K8 ? 80 : K8M ? 112 : (DQK + 8) * 2, VROWB = 192, TILEB = 64 * (KROWB + VROWB), CPR = DQK / 8;
    constexpr int NKC = (DQK == 64) ? 1 : 2;
    constexpr bool USE_NEGM = (DQK == 64);
    static_assert(2 * TILEB <= RPB_OFF, "attention LDS");
    const int r32 = lane & 31, hi = lane >> 5;
    int krow[NKC], kch[NKC];
#pragma unroll
    for (int i = 0; i < NKC; ++i) { const int c = tid + 512 * i; krow[i] = c / CPR; kch[i] = c - krow[i] * CPR; }
    const int vrow = tid >> 3, vch = tid & 7;
    u32x4 krA[NKC], vrA, krB[NKC], vrB;
    const int nt = p.ntiles;
#define AW_LOAD(j, kr, vr) do { const int trow_ = p.kt0 + 64 * (j); \
        _Pragma("unroll") for (int i = 0; i < NKC; ++i) { if (DQK == 64 || i == 0 || tid < 256) { \
            const bf16* src_ = (kch[i] < 8) ? (p.K + (size_t)(trow_ + krow[i]) * p.kp + kch[i] * 8) : (p.K2 + (size_t)(trow_ + krow[i]) * p.k2p + (kch[i] - 8) * 8); \
            kr[i] = *(const u32x4*)src_; } } \
        vr = *(const u32x4*)(p.V + (size_t)(trow_ + vrow) * p.vp + vch * 8); } while (0)
#define AW_WRITE(b, kr, vr) do { LAS unsigned char* kb_ = lds + (b) * TILEB; \
        if constexpr (K8) { *(LAS u32x2*)(kb_ + krow[0] * KROWB + 32 * (kch[0] & 1) + 8 * (kch[0] >> 1)) = bf8x8(kr[0], K8_SCALE); } \
        else if constexpr (K8M) { _Pragma("unroll") for (int i = 0; i < NKC; ++i) { if (i == 0 || tid < 256) { const int kc_ = kch[i] - 8; \
            const int off_ = (kch[i] < 8) ? (32 * (kch[i] & 1) + 8 * (kch[i] >> 1)) : (64 + 16 * (kc_ & 1) + 8 * (kc_ >> 1)); \
            *(LAS u32x2*)(kb_ + krow[i] * KROWB + off_) = bf8x8(kr[i], K8_SCALE); } } } else { \
        _Pragma("unroll") for (int i = 0; i < NKC; ++i) { if (DQK == 64 || i == 0 || tid < 256) *(LAS u32x4*)(kb_ + krow[i] * KROWB + kch[i] * 16) = kr[i]; } } \
        *(LAS u32x4*)(kb_ + 64 * KROWB + vrow * VROWB + vch * 16) = vr; } while (0)
    AW_LOAD(0, krA, vrA); AW_WRITE(0, krA, vrA);
    if (nt > 1) AW_LOAD(1, krB, vrB);
    if (nt > 2) AW_LOAD(2, krA, vrA);
    ATT_BAR();
    pg8::i32x8v q8a = {0, 0, 0, 0, 0, 0, 0, 0}, q8b = {0, 0, 0, 0, 0, 0, 0, 0};
    pg8::i32x8v q8a1 = {0, 0, 0, 0, 0, 0, 0, 0}, q8b1 = {0, 0, 0, 0, 0, 0, 0, 0};
    if constexpr (K8) { q8a = q_to_fp8(qa); q8b = q_to_fp8(qb); }
    if constexpr (K8M) {
#pragma unroll
        for (int d0 = 0; d0 < 4; ++d0) { const u32x2 ta = bf8x8(__builtin_bit_cast(u32x4, qa[d0]), Q8_SCALE), tb = bf8x8(__builtin_bit_cast(u32x4, qb[d0]), Q8_SCALE); q8a[2 * d0] = (int)ta.x; q8a[2 * d0 + 1] = (int)ta.y; q8b[2 * d0] = (int)tb.x; q8b[2 * d0 + 1] = (int)tb.y; }
#pragma unroll
        for (int d0 = 4; d0 < 6; ++d0) { const u32x2 ta = bf8x8(__builtin_bit_cast(u32x4, qa[d0]), Q8_SCALE), tb = bf8x8(__builtin_bit_cast(u32x4, qb[d0]), Q8_SCALE); q8a1[2 * (d0 - 4)] = (int)ta.x; q8a1[2 * (d0 - 4) + 1] = (int)ta.y; q8b1[2 * (d0 - 4)] = (int)tb.x; q8b1[2 * (d0 - 4) + 1] = (int)tb.y; }
    }
    f32x16 nma, nmb;
#pragma unroll
    for (int r = 0; r < 16; ++r) { nma[r] = 0.f; nmb[r] = 0.f; }
    bool first = true;
    const int q4 = (lane & 15) >> 2, p4 = lane & 3, blk = (lane >> 4) & 1;
    auto half = [&](const int j, const int u) __attribute__((always_inline)) {
        const LAS unsigned char* kb = lds + (j & 1) * TILEB; const LAS unsigned char* vb = kb + 64 * KROWB;
        {
            const LAS unsigned char* kbu = kb + u * 32 * KROWB + r32 * KROWB + ((K8 || K8M) ? 32 : 16) * hi;
            f32x16 sa, sb;
            if (USE_NEGM) { sa = nma; sb = nmb; } else {
#pragma unroll
                for (int r = 0; r < 16; ++r) { sa[r] = 0.f; sb[r] = 0.f; } }
            if constexpr (K8) { const pg8::i32x8v k8 = k8_read(kbu); sa = MFMA_QK8(k8, q8a, sa); sb = MFMA_QK8(k8, q8b, sb); }
            else if constexpr (K8M) { const pg8::i32x8v k8 = k8_read(kbu); const u32x4 kt = *(const LAS u32x4*)(kbu + 64 - 16 * hi);
                const pg8::i32x8v k81 = {(int)kt.x, (int)kt.y, (int)kt.z, (int)kt.w, 0, 0, 0, 0};
                sa = MFMA_QK8(k8, q8a, sa); sb = MFMA_QK8(k8, q8b, sb); sa = MFMA_QK8(k81, q8a1, sa); sb = MFMA_QK8(k81, q8b1, sb); } else {
#pragma unroll
            for (int d0 = 0; d0 < DQK / 16; ++d0) {
                const bf16x8 k0 = *(const LAS bf16x8*)(kbu + 32 * d0);
                sa = __builtin_amdgcn_mfma_f32_32x32x16_bf16(k0, qa[d0], sa, 0, 0, 0);
                sb = __builtin_amdgcn_mfma_f32_32x32x16_bf16(k0, qb[d0], sb, 0, 0, 0);
            } }
            if (first) {
                float ma = fmaxf(fmaxf(sa[0], sa[1]), sa[2]), mb = fmaxf(fmaxf(sb[0], sb[1]), sb[2]);
#pragma unroll
                for (int r = 3; r < 15; r += 2) { ma = fmaxf(fmaxf(ma, sa[r]), sa[r + 1]); mb = fmaxf(fmaxf(mb, sb[r]), sb[r + 1]); }
                ma = fmaxf(ma, sa[15]); mb = fmaxf(mb, sb[15]);
                ma = fmaxf(ma, __shfl_xor(ma, 32)); mb = fmaxf(mb, __shfl_xor(mb, 32));
                m_run[0] = ma; m_run[1] = mb;
                if (USE_NEGM) {
#pragma unroll
                    for (int r = 0; r < 16; ++r) { sa[r] -= ma; sb[r] -= mb; nma[r] = -ma; nmb[r] = -mb; } }
                first = false;
            }
            float pa0 = 0.f, pa1 = 0.f, pb0 = 0.f, pb1 = 0.f;
            if (USE_NEGM) {
#pragma unroll
                for (int r = 0; r < 16; r += 2) { sa[r] = fast_exp2(sa[r]); sa[r + 1] = fast_exp2(sa[r + 1]); sb[r] = fast_exp2(sb[r]); sb[r + 1] = fast_exp2(sb[r + 1]);
                    pa0 += sa[r]; pa1 += sa[r + 1]; pb0 += sb[r]; pb1 += sb[r + 1]; }
            } else { const float ma = m_run[0], mb = m_run[1];
#pragma unroll
                for (int r = 0; r < 16; r += 2) { sa[r] = fast_exp2(sa[r] - ma); sa[r + 1] = fast_exp2(sa[r + 1] - ma); sb[r] = fast_exp2(sb[r] - mb); sb[r + 1] = fast_exp2(sb[r + 1] - mb);
                    pa0 += sa[r]; pa1 += sa[r + 1]; pb0 += sb[r]; pb1 += sb[r + 1]; }
            }
            const float psa = pa0 + pa1, psb = pb0 + pb1;
            l_run[0] += psa; l_run[1] += psb;
            const float pta = psa + __shfl_xor(psa, 32), ptb = psb + __shfl_xor(psb, 32);
            const bool needa = pta > 65536.0f, needb = ptb > 65536.0f;
            bf16x8 fa[2], fb[2];
#pragma unroll
            for (int s = 0; s < 2; ++s) {
                u32x4 w0, w1;
                w0.x = pg8::cvt_pk_bf16(sa[8 * s + 0], sa[8 * s + 1]); w0.y = pg8::cvt_pk_bf16(sa[8 * s + 2], sa[8 * s + 3]); w0.z = pg8::cvt_pk_bf16(sa[8 * s + 4], sa[8 * s + 5]); w0.w = pg8::cvt_pk_bf16(sa[8 * s + 6], sa[8 * s + 7]);
                w1.x = pg8::cvt_pk_bf16(sb[8 * s + 0], sb[8 * s + 1]); w1.y = pg8::cvt_pk_bf16(sb[8 * s + 2], sb[8 * s + 3]); w1.z = pg8::cvt_pk_bf16(sb[8 * s + 4], sb[8 * s + 5]); w1.w = pg8::cvt_pk_bf16(sb[8 * s + 6], sb[8 * s + 7]);
                fa[s] = __builtin_bit_cast(bf16x8, w0); fb[s] = __builtin_bit_cast(bf16x8, w1);
            }
            const LAS unsigned char* vbase = vb + (32 * u + 4 * hi + q4) * VROWB + 32 * blk + 8 * p4;
#pragma unroll
            for (int s = 0; s < 2; ++s)
#pragma unroll
                for (int c = 0; c < 2; ++c) {
                    const LAS unsigned char* a0 = vbase + (16 * s) * VROWB + 64 * c;
                    const s16x4 lo = vtr(a0), hh = vtr(a0 + 8 * VROWB);
                    const bf16x8 vf = (bf16x8){lo[0], lo[1], lo[2], lo[3], hh[0], hh[1], hh[2], hh[3]};
                    oa[c] = __builtin_amdgcn_mfma_f32_32x32x16_bf16(fa[s], vf, oa[c], 0, 0, 0);
                    ob[c] = __builtin_amdgcn_mfma_f32_32x32x16_bf16(fb[s], vf, ob[c], 0, 0, 0);
                }
            if (__any(needa || needb)) {
                const int exa = (int)((__builtin_bit_cast(unsigned, pta) >> 23) & 255u) - 127, exb = (int)((__builtin_bit_cast(unsigned, ptb) >> 23) & 255u) - 127;
                const float dla = needa ? (float)exa : 0.f, dlb = needb ? (float)exb : 0.f, fsa = fast_exp2(-dla), fsb = fast_exp2(-dlb);
                m_run[0] += dla; m_run[1] += dlb; l_run[0] *= fsa; l_run[1] *= fsb;
                if (USE_NEGM) {
#pragma unroll
                    for (int r = 0; r < 16; ++r) { nma[r] = -m_run[0]; nmb[r] = -m_run[1]; } }
                int hio = hi; asm volatile("" : "+v"(hio));
#pragma unroll
                for (int r = 0; r < 16; ++r) { const float fra = __shfl(fsa, crow(r, hio)), frb = __shfl(fsb, crow(r, hio)); oa[0][r] *= fra; oa[1][r] *= fra; ob[0][r] *= frb; ob[1][r] *= frb; }
            }
        }
    };
    for (int j = 0; j < nt; j += 2) {
        half(j, 0);
        if (j + 1 < nt) AW_WRITE((j + 1) & 1, krB, vrB);
        if (j + 3 < nt) AW_LOAD(j + 3, krB, vrB);
        half(j, 1);
        ATT_BAR();
        if (j + 1 >= nt) break;
        half(j + 1, 0);
        if (j + 2 < nt) AW_WRITE((j + 2) & 1, krA, vrA);
        if (j + 4 < nt) AW_LOAD(j + 4, krA, vrA);
        half(j + 1, 1);
        ATT_BAR();
    }
#undef AW_LOAD
#undef AW_WRITE
}

template <int DQK>
DI void attn_unit_w64(LAS unsigned char* lds, const AttnP& p) {
    const int tid = opaque_tid(), lane = tid & 63, wid = __builtin_amdgcn_readfirstlane(tid >> 6), r32 = lane & 31, hi = lane >> 5;
    bf16x8 qa[DQK / 16], qb[DQK / 16];
    const bf16* qrow = p.Q + (size_t)(64 * wid + r32) * p.qp;
#pragma unroll
    for (int d0 = 0; d0 < DQK / 16; ++d0) { qa[d0] = *(const bf16x8*)(qrow + 16 * d0 + 8 * hi); qb[d0] = *(const bf16x8*)(qrow + (size_t)32 * p.qp + 16 * d0 + 8 * hi); }
    if (DQK == 96) { if (p.rope_q) { const int pos = p.qpos0 + 64 * wid + r32;
        rope_frag(qa[4], pos >> 6, hi, LOG2_THETA / 8.f); rope_frag(qa[5], pos & 63, hi, LOG2_THETA / 8.f);
        rope_frag(qb[4], (pos + 32) >> 6, hi, LOG2_THETA / 8.f); rope_frag(qb[5], (pos + 32) & 63, hi, LOG2_THETA / 8.f); } }
    f32x16 oa[2], ob[2];
#pragma unroll
    for (int r = 0; r < 16; ++r) { oa[0][r] = 0.f; oa[1][r] = 0.f; ob[0][r] = 0.f; ob[1][r] = 0.f; }
    float m_run[2] = {0.f, 0.f}, l_run[2] = {0.f, 0.f};
    attn_core_w64<DQK>(lds, p, qa, qb, oa, ob, m_run, l_run, tid, wid, lane);
    const float inva = 1.0f / (l_run[0] + __shfl_xor(l_run[0], 32)), invb = 1.0f / (l_run[1] + __shfl_xor(l_run[1], 32));
    unsigned char* orow = p.O + (size_t)(64 * wid) * p.op + r32;
#pragma unroll
    for (int r = 0; r < 16; ++r) { int hio = hi; asm volatile("" : "+v"(hio)); const int q = crow(r, hio); const float iva = __shfl(inva, q) * MIX_SCALE, ivb = __shfl(invb, q) * MIX_SCALE;
#pragma unroll
        for (int c = 0; c < 2; ++c) { orow[(size_t)q * p.op + 32 * c] = (unsigned char)__builtin_amdgcn_cvt_pk_fp8_f32(oa[c][r] * iva, 0.f, 0u, false);
                                      orow[(size_t)(q + 32) * p.op + 32 * c] = (unsigned char)__builtin_amdgcn_cvt_pk_fp8_f32(ob[c][r] * ivb, 0.f, 0u, false); }
        __builtin_amdgcn_sched_barrier(0); }
}

DI void attn_unit_diff(LAS unsigned char* lds, const AttnP& p, const float lam, const float oml, const float* subln) {
    const int tid = opaque_tid(), lane = tid & 63, wid = __builtin_amdgcn_readfirstlane(tid >> 6), r32 = lane & 31, hi = lane >> 5;
    LAS unsigned* stash = (LAS unsigned*)(lds + O1_OFF) + tid;
    for (int jh = 0; jh < 2; ++jh) {
        AttnP pj = p; pj.K = p.K + 64 * jh;
        bf16x8 qf[4];
        const bf16* qrow = p.Q + (size_t)(32 * wid + r32) * p.qp + 64 * jh;
#pragma unroll
        for (int d0 = 0; d0 < 4; ++d0) qf[d0] = *(const bf16x8*)(qrow + 16 * d0 + 8 * hi);
        f32x16 o[4];
#pragma unroll
        for (int c = 0; c < 4; ++c)
#pragma unroll
            for (int r = 0; r < 16; ++r) o[c][r] = 0.f;
        float m_run = 0.f, l_run = 0.f;
        attn_core<64, 128, 0>(lds, pj, qf, o, m_run, l_run, tid, wid, lane);
        const float l = l_run + __shfl_xor(l_run, 32), inv = 1.0f / l;
        if (jh == 0) {
#pragma unroll
            for (int r = 0; r < 8; ++r) { int hio = hi; asm volatile("" : "+v"(hio)); const float iv0 = __shfl(inv, crow(2 * r, hio)), iv1 = __shfl(inv, crow(2 * r + 1, hio));
#pragma unroll
                for (int c = 0; c < 4; ++c) stash[512 * (c * 8 + r)] = pk2(o[c][2 * r] * iv0, o[c][2 * r + 1] * iv1);
                __builtin_amdgcn_sched_barrier(0); }
        } else {
            float sg[4];
#pragma unroll
            for (int c = 0; c < 4; ++c) sg[c] = subln[32 * c + r32] * (oml * MIX_SCALE);
            unsigned char* orow = p.O + (size_t)(32 * wid) * p.op + r32;
#pragma unroll
            for (int r = 0; r < 16; ++r) { int hio = hi; asm volatile("" : "+v"(hio)); const int q = crow(r, hio); const float iv = __shfl(inv, q);
                float v[4]; float ss = 0.f;
#pragma unroll
                for (int c = 0; c < 4; ++c) { const unsigned w1 = stash[512 * (c * 8 + (r >> 1))]; const float o1 = (r & 1) ? bfhi(w1) : bflo(w1); v[c] = o1 - lam * (o[c][r] * iv); ss += v[c] * v[c]; }
                ss += __shfl_xor(ss, 1); ss += __shfl_xor(ss, 2); ss += __shfl_xor(ss, 4); ss += __shfl_xor(ss, 8); ss += __shfl_xor(ss, 16);
                const float rinv = 1.0f / sqrtf(ss * (1.0f / 128.0f) + RMS_EPS);
#pragma unroll
                for (int c = 0; c < 4; ++c) orow[(size_t)q * p.op + 32 * c] = (unsigned char)__builtin_amdgcn_cvt_pk_fp8_f32(v[c] * rinv * sg[c], 0.f, 0u, false);
                __builtin_amdgcn_sched_barrier(0); }
        }
    }
}
}


DI void p0_mod_item(LAS unsigned char* lds, const float* c, const float* c_ctx, const float* mod_w, const float* mod_b, float* mod, const int item) {
    const int tid = opaque_tid(), lane = tid & 63, wid = __builtin_amdgcn_readfirstlane(tid >> 6), l = item / 48, col0 = (item - l * 48) * 128;
    constexpr int SP = 1026;
    LAS float* s = (LAS float*)lds;
    __syncthreads();
    for (int idx = tid; idx < 33 * 1024; idx += NTHR) { const int r = idx >> 10, kk = idx & 1023; const float cv = (r < 32) ? c[r * 1024 + kk] : c_ctx[kk]; s[r * SP + kk] = cv / (1.0f + __expf(-cv)); }
    __syncthreads();
    const int i32 = lane & 31, hi = lane >> 5;
    f32x16 acc[4];
#pragma unroll
    for (int cb = 0; cb < 4; ++cb)
#pragma unroll
        for (int r = 0; r < 16; ++r) acc[cb][r] = 0.f;
    float a32[4] = {0.f, 0.f, 0.f, 0.f};
    const float* w = mod_w + ((size_t)l * 1024 + wid * 128) * 6144 + col0 + i32;
    const LAS float* sa = s + i32 * SP + wid * 128 + 2 * hi;
    const LAS float* sc = s + 32 * SP + wid * 128 + 2 * hi;
#pragma unroll 4
    for (int q = 0; q < 32; ++q) {
        const float* wp = w + (size_t)(4 * q + 2 * hi) * 6144;
        float b0[4], b1[4];
#pragma unroll
        for (int cb = 0; cb < 4; ++cb) { b0[cb] = wp[32 * cb]; b1[cb] = wp[6144 + 32 * cb]; }
        const f32x2 av = *(const LAS f32x2*)(sa + 4 * q), cv = *(const LAS f32x2*)(sc + 4 * q);
#pragma unroll
        for (int cb = 0; cb < 4; ++cb) {
            acc[cb] = __builtin_amdgcn_mfma_f32_32x32x2f32(av[0], b0[cb], acc[cb], 0, 0, 0);
            acc[cb] = __builtin_amdgcn_mfma_f32_32x32x2f32(av[1], b1[cb], acc[cb], 0, 0, 0);
            a32[cb] += cv[0] * b0[cb] + cv[1] * b1[cb];
        }
    }
#pragma unroll
    for (int cb = 0; cb < 4; ++cb) a32[cb] += __shfl_xor(a32[cb], 32);
    __syncthreads();
    LAS float* red = s + (size_t)wid * 33 * 128;
#pragma unroll
    for (int cb = 0; cb < 4; ++cb) {
#pragma unroll
        for (int r = 0; r < 16; ++r) red[((r & 3) + 8 * (r >> 2) + 4 * hi) * 128 + 32 * cb + i32] = acc[cb][r];
        if (hi == 0) red[32 * 128 + 32 * cb + i32] = a32[cb];
    }
    __syncthreads();
    for (int idx = tid; idx < 33 * 128; idx += NTHR) { const int r = idx >> 7, cc = idx & 127; float v = 0.f;
#pragma unroll
        for (int wv = 0; wv < 8; ++wv) v += s[(wv * 33 + r) * 128 + cc];
        mod[((size_t)l * 33 + r) * 6144 + col0 + cc] = v + mod_b[l * 6144 + col0 + cc]; }
    __syncthreads();
}
struct TrDesc { const float* W; unsigned char* WT; int K, N, dK, mode, scale_n, fp8, item; float scale, scale2; };
constexpr int TI_GU = 128 * 1024, TI_D = 128 * 512, TI_WE = 2 * 1152, TI_WO_ = 2 * 976, TI_OUT = 4 * 512, TI_UQ = 2 * 96, TI_UKV = 2 * 64;
constexpr int TI_TOTAL = TI_GU + TI_D + TI_WE + TI_WO_ + TI_OUT + TI_UQ + TI_UKV;
DI TrDesc tr_decode(const float* const* in, unsigned char* ws, int r) {
    TrDesc d; d.scale_n = 0; d.scale = 1.f; d.scale2 = 1.f; d.mode = 0; d.fp8 = 0;
    if (r < TI_GU) { const int le = r >> 10; d.W = in[28] + (size_t)le * 1024 * 2048; d.K = 1024; d.N = 2048; d.WT = ws + WS_WGU + (size_t)le * 2048 * 1024; d.dK = 1024; d.mode = 1; d.scale_n = 1 << 30; d.scale = WGU_SCALE; d.fp8 = 1; d.item = r & 1023; return d; } r -= TI_GU;
    if (r < TI_D) { const int le = r >> 9; d.W = in[30] + (size_t)le * 1024 * 1024; d.K = 1024; d.N = 1024; d.WT = ws + WS_WD + (size_t)le * 1024 * 1024; d.dK = 1024; d.mode = 2; d.scale_n = 1 << 30; d.scale = WD_SCALE; d.fp8 = 1; d.item = r & 511; return d; } r -= TI_D;
    if (r < TI_WE) { const int j = r / 1152; d.W = in[10] + (size_t)j * 1024 * 2304; d.K = 1024; d.N = 2304; d.WT = ws + WS_WIN + (size_t)(2 * j) * 2304 * 1024 * 2; d.dK = 1024; d.scale_n = 512; d.scale = C2; d.item = r - j * 1152; if (INPROJ_FP8) { d.fp8 = 1; d.scale = C2 * WI_SCALE; d.scale2 = WI_SCALE; } return d; } r -= TI_WE;
    if (r < TI_WO_) { const int j = r / 976; d.W = in[15] + (size_t)j * 1024 * 1952; d.K = 1024; d.N = 1952; d.WT = ws + WS_WIN + (size_t)(2 * j + 1) * 2304 * 1024 * 2; d.dK = 1024; d.scale_n = 512; d.scale = C2; d.item = r - j * 976; if (INPROJ_FP8) { d.fp8 = 1; d.scale = C2 * WI_SCALE; d.scale2 = WI_SCALE; } return d; } r -= TI_WO_;
    if (r < TI_OUT) { const int q = r >> 9, j = q >> 1, odd = q & 1; d.W = in[odd ? 16 : 11] + (size_t)j * 1024 * 1024; d.K = 1024; d.N = 1024; d.WT = ws + WS_WOUT + (size_t)(2 * j + odd) * 1024 * 1024; d.dK = 1024; d.scale_n = 1 << 30; d.scale = WO_SCALE; d.fp8 = 1; d.item = r & 511; return d; } r -= TI_OUT;
    if (r < TI_UQ) { const int j = r / 96; d.W = in[23] + (size_t)j * 256 * 768; d.K = 256; d.N = 768; d.WT = ws + WS_WUQ + (size_t)j * 768 * 256 * 2; d.dK = 256; d.scale_n = 768; d.scale = C2M; d.item = r - j * 96; return d; } r -= TI_UQ;
    { const int j = r / 64; d.W = in[25] + (size_t)j * 128 * 1024; d.K = 128; d.N = 1024; d.WT = ws + WS_WUKV + (size_t)j * 1024 * 256 * 2; d.dK = 256; d.item = r - j * 64; return d; }
}
DI void tr_load(const TrDesc& d, f32x4 (&tv)[8], const int lane) {
    const int nblk = d.N / 32, kb = d.item / nblk, nb = d.item - kb * nblk, k0 = 64 * kb, n0 = 32 * nb;
    const float* p = d.W + (size_t)(k0 + (lane >> 3)) * d.N + n0 + 4 * (lane & 7);
#pragma unroll
    for (int i = 0; i < 8; ++i) tv[i] = *(const f32x4*)(p + (size_t)(8 * i) * d.N);
}
DI void tr_store(const TrDesc& d, LAS float* scr, const int lane) {
    const int nblk = d.N / 32, kb = d.item / nblk, nb = d.item - kb * nblk, k0 = 64 * kb, n0 = 32 * nb;
    if (d.fp8) {
        const int cch = lane & 3;
#pragma unroll
        for (int j = 0; j < 2; ++j) { const int nl = (lane >> 2) + 16 * j, n = n0 + nl; const LAS float* s = scr + (16 * cch) * 33 + nl; const float sc = (n < d.scale_n) ? d.scale : d.scale2;
            int row = n; if (d.mode == 1) { const int jj = n >> 1, sh = n & 1; row = 256 * (jj >> 7) + 128 * sh + (jj & 127); }
            if (d.mode == 2) { const int na = n & 255; row = (n & ~255) + 128 * ((na >> 3) & 1) + 32 * (na >> 6) + 8 * ((na >> 4) & 3) + (na & 7); }
            u32x4 o;
            o.x = pk4_fp8(s[0 * 33] * sc, s[1 * 33] * sc, s[2 * 33] * sc, s[3 * 33] * sc); o.y = pk4_fp8(s[4 * 33] * sc, s[5 * 33] * sc, s[6 * 33] * sc, s[7 * 33] * sc);
            o.z = pk4_fp8(s[8 * 33] * sc, s[9 * 33] * sc, s[10 * 33] * sc, s[11 * 33] * sc); o.w = pk4_fp8(s[12 * 33] * sc, s[13 * 33] * sc, s[14 * 33] * sc, s[15 * 33] * sc);
            *(u32x4*)(d.WT + (size_t)row * d.dK + k0 + 16 * cch) = o; }
    } else {
        const int cch = lane & 7;
#pragma unroll
        for (int j = 0; j < 4; ++j) { const int nl = (lane >> 3) + 8 * j, n = n0 + nl; const LAS float* s = scr + (8 * cch) * 33 + nl;
            const float sc = (n < d.scale_n) ? d.scale : 1.0f;
            u32x4 o; o.x = pk2(s[0 * 33] * sc, s[1 * 33] * sc); o.y = pk2(s[2 * 33] * sc, s[3 * 33] * sc); o.z = pk2(s[4 * 33] * sc, s[5 * 33] * sc); o.w = pk2(s[6 * 33] * sc, s[7 * 33] * sc);
            *(u32x4*)((bf16*)d.WT + (size_t)n * d.dK + k0 + 8 * cch) = o; }
    }
}
DI void p0_transposes(LAS unsigned char* lds, const float* const* in, unsigned char* ws, const int gw, const int ngw, const int wid, const int lane) {
    LAS float* scr = (LAS float*)(lds + wid * 16384);
    if (gw >= TI_TOTAL) return;
    f32x4 ta[8], tb[8];
    TrDesc da = tr_decode(in, ws, gw), db = da;
    tr_load(da, ta, lane);
    if (gw + ngw < TI_TOTAL) { db = tr_decode(in, ws, gw + ngw); tr_load(db, tb, lane); }
#define TR_STEP(D, TV, NEXT) do { \
        _Pragma("unroll") for (int i = 0; i < 8; ++i) { LAS float* sp = scr + ((lane >> 3) + 8 * i) * 33 + 4 * (lane & 7); sp[0] = TV[i][0]; sp[1] = TV[i][1]; sp[2] = TV[i][2]; sp[3] = TV[i][3]; } \
        TrDesc nx_ = D; \
        if ((NEXT) < TI_TOTAL) { nx_ = tr_decode(in, ws, (NEXT)); tr_load(nx_, TV, lane); } \
        asm volatile("s_waitcnt lgkmcnt(0)" ::: "memory"); \
        tr_store(D, scr, lane); \
        asm volatile("s_waitcnt lgkmcnt(0)" ::: "memory"); \
        D = nx_; } while (0)
    for (int it = gw; it < TI_TOTAL; it += 2 * ngw) {
        TR_STEP(da, ta, it + 2 * ngw);
        if (it + ngw >= TI_TOTAL) break;
        TR_STEP(db, tb, it + 3 * ngw);
    }
#undef TR_STEP
}
DI void p0_zero(unsigned char* ws, const int gtid, const int ngt) {
    if (INPROJ_FP8) { for (int i = gtid; i < 2 * 96 * 64; i += ngt) { const int j = i / (96 * 64), r = i - j * 96 * 64; *(u32x4*)(ws + WS_WIN + (size_t)(2 * j + 1) * 2304 * 1024 * 2 + (size_t)1952 * 1024 + (size_t)r * 16) = (u32x4){0u, 0u, 0u, 0u}; } }
    else for (int i = gtid; i < 2 * 96 * 128; i += ngt) { const int j = i / (96 * 128), r = i - j * 96 * 128; *(u32x4*)((bf16*)(ws + WS_WIN) + ((size_t)(2 * j + 1) * 2304 + 1952) * 1024 + (size_t)r * 8) = (u32x4){0u, 0u, 0u, 0u}; }
    for (int i = gtid; i < 2 * 1024 * 16; i += ngt) { const int row = i >> 4, ch = i & 15; *(u32x4*)((bf16*)(ws + WS_WUKV) + (size_t)row * 256 + 128 + ch * 8) = (u32x4){0u, 0u, 0u, 0u}; }
}
DI void p0b_rows(const float* x, const float* ctx, const float* mod0, bf16* X, bf16* H, const int gw, const int ngw, const int lane) {
    const int c0 = 16 * lane;
    f32x4 vn[4];
#define P0B_SRC(mm) (((mm) % TPB < CTXL) ? ctx + ((size_t)((mm) / TPB) * CTXL + (mm) % TPB) * DM : x + ((size_t)((mm) / TPB) * SEQ + ((mm) % TPB - CTXL)) * DM)
    if (gw < T) { const float* src = P0B_SRC(gw) + c0;
#pragma unroll
        for (int j = 0; j < 4; ++j) vn[j] = *(const f32x4*)(src + 4 * j); }
    for (int m = gw; m < T; m += ngw) {
        const int b = m / TPB, t = m - b * TPB;
        const float* md = mod0 + (size_t)((t < CTXL) ? 32 : b) * 6144 + c0;
        f32x4 vc[4];
#pragma unroll
        for (int j = 0; j < 4; ++j) vc[j] = vn[j];
        if (m + ngw < T) { const float* src = P0B_SRC(m + ngw) + c0;
#pragma unroll
            for (int j = 0; j < 4; ++j) vn[j] = *(const f32x4*)(src + 4 * j); }
        u32x4 xo[2], ho[2];
#pragma unroll
        for (int j = 0; j < 4; ++j) { const f32x4 v = vc[j];
            xo[j >> 1][2 * (j & 1)] = pk2(v[0], v[1]); xo[j >> 1][2 * (j & 1) + 1] = pk2(v[2], v[3]);
            const f32x4 sh = *(const f32x4*)(md + 4 * j), sc = *(const f32x4*)(md + 1024 + 4 * j); const f32x4 h = v * (sc + 1.0f) + sh;
            ho[j >> 1][2 * (j & 1)] = pk2(h[0], h[1]); ho[j >> 1][2 * (j & 1) + 1] = pk2(h[2], h[3]); }
        bf16* xr = X + (size_t)m * DM + c0; *(u32x4*)xr = xo[0]; *(u32x4*)(xr + 8) = xo[1];
        if (INPROJ_FP8) { u32x4 h8;
#pragma unroll
            for (int j = 0; j < 4; ++j) { const f32x4 sh = *(const f32x4*)(md + 4 * j), sc = *(const f32x4*)(md + 1024 + 4 * j); const f32x4 h = (vc[j] * (sc + 1.0f) + sh) * H_SCALE; h8[j] = pk4_fp8(h[0], h[1], h[2], h[3]); }
            *(u32x4*)((unsigned char*)H + (size_t)m * DM + c0) = h8; }
        else { bf16* hr = H + (size_t)m * DM + c0; *(u32x4*)hr = ho[0]; *(u32x4*)(hr + 8) = ho[1]; }
    }
#undef P0B_SRC
}
DI void unpack8(const u32x4 w, float (&v)[8]) { v[0] = bflo(w.x); v[1] = bfhi(w.x); v[2] = bflo(w.y); v[3] = bfhi(w.y); v[4] = bflo(w.z); v[5] = bfhi(w.z); v[6] = bflo(w.w); v[7] = bfhi(w.w); }
DI u32x4 pack8(const float (&v)[8]) { u32x4 w; w.x = pk2(v[0], v[1]); w.y = pk2(v[2], v[3]); w.z = pk2(v[4], v[5]); w.w = pk2(v[6], v[7]); return w; }
DI void rope_chunk(float (&y)[8], const float (&rf)[8], const float position, const bool second, const int pmask) {
#pragma unroll
    for (int e = 0; e < 8; ++e) { float rev = position * rf[e]; rev = rev - floorf(rev);
        const float sn = __builtin_amdgcn_sinf(rev), cs = __builtin_amdgcn_cosf(rev); const float partner = __shfl_xor(y[e], pmask);
        y[e] = second ? (partner * sn + y[e] * cs) : (y[e] * cs - partner * sn); }
}
DI void post_even_rows(const bf16* P, bf16* PQ, const float* qg, const float* kg, const int gw, const int ngw, const int lane) {
    const int ch = lane & 7;
    float gq[8], gk[8], rf[8];
#pragma unroll
    for (int e = 0; e < 8; ++e) { gq[e] = qg[8 * ch + e] * C2; gk[e] = kg[8 * ch + e]; rf[e] = fast_exp2(-(float)(8 * (ch & 1) + e) * (LOG2_THETA / 16.f)) * 0.15915494309189535f; }
    const bool second = (ch & 2) != 0, colpart = (ch & 4) != 0;
    u32x4 nq, nk;
    if (gw < T) { const bf16* r0 = P + (size_t)gw * NPP; nq = *(const u32x4*)(r0 + 1536 + 8 * lane); nk = *(const u32x4*)(r0 + 2048 + 8 * (lane & 15)); }
    for (int m = gw; m < T; m += ngw) {
        const int b = m / TPB, t = m - b * TPB; const bool lat = t >= CTXL; const int pos = t - CTXL;
        bf16* row = PQ + (size_t)m * NPP;
        u32x4* pq = (u32x4*)(row + 1536 + 8 * lane); u32x4* pk = (u32x4*)(row + 2048 + 8 * (lane & 15));
        const u32x4 wq = nq, wk = nk;
        if (m + ngw < T) { const bf16* r1 = P + (size_t)(m + ngw) * NPP; nq = *(const u32x4*)(r1 + 1536 + 8 * lane); nk = *(const u32x4*)(r1 + 2048 + 8 * (lane & 15)); }
        const float position = (float)(colpart ? (pos & 63) : (pos >> 6));
        float v[8];
        unpack8(wq, v);
        { float ss = 0.f;
#pragma unroll
          for (int e = 0; e < 8; ++e) ss += v[e] * v[e];
          ss += __shfl_xor(ss, 1); ss += __shfl_xor(ss, 2); ss += __shfl_xor(ss, 4);
          const float ri = 1.0f / sqrtf(ss * (1.0f / 64.0f) + RMS_EPS);
#pragma unroll
          for (int e = 0; e < 8; ++e) v[e] = v[e] * ri * gq[e];
          if (lat) rope_chunk(v, rf, position, second, 2);
          *pq = pack8(v); }
        unpack8(wk, v);
        { float ss = 0.f;
#pragma unroll
          for (int e = 0; e < 8; ++e) ss += v[e] * v[e];
          ss += __shfl_xor(ss, 1); ss += __shfl_xor(ss, 2); ss += __shfl_xor(ss, 4);
          const float ri = 1.0f / sqrtf(ss * (1.0f / 64.0f) + RMS_EPS);
#pragma unroll
          for (int e = 0; e < 8; ++e) v[e] = v[e] * ri * gk[e];
          if (lat) rope_chunk(v, rf, position, second, 2);
          if (lane < 16) *pk = pack8(v); }
    }
}
DI void post_odd_rows(const bf16* P, bf16* PQ, const float* mqg, const float* mkvg, const int gw, const int ngw, const int lane) {
    const int ch = lane & 7;
    float rf[8], rf32[8], g3[8];
#pragma unroll
    for (int e = 0; e < 8; ++e) { rf[e] = fast_exp2(-(float)(8 * (ch & 1) + e) * (LOG2_THETA / 16.f)) * 0.15915494309189535f; rf32[e] = fast_exp2(-(float)e * (LOG2_THETA / 8.f)) * 0.15915494309189535f;
        g3[e] = (lane < 32) ? mqg[8 * lane + e] : (lane < 48) ? mkvg[8 * (lane - 32) + e] : 1.0f; }
    const bool second = (ch & 2) != 0, colpart = (ch & 4) != 0;
    const int c3 = lane;
    const bool second32 = (lane & 1) != 0, colpart32 = (lane & 2) != 0;
    u32x4 a0, a1, a3, b0, b1, b3;
#define PODD_LOAD(mm, N0, N1, N3) do { const bf16* r_ = P + (size_t)(mm) * NPP; N3 = *(const u32x4*)(r_ + 1536 + 8 * c3); N0 = *(const u32x4*)(r_ + 8 * lane); N1 = *(const u32x4*)(r_ + 512 + 8 * lane); } while (0)
    if (gw < T) PODD_LOAD(gw, a0, a1, a3);
    if (gw + ngw < T) PODD_LOAD(gw + ngw, b0, b1, b3);
    auto do_row = [&](const int m, const u32x4 w0, const u32x4 w1, const u32x4 w3) __attribute__((always_inline)) {
        const int b = m / TPB, t = m - b * TPB; const bool lat = t >= CTXL; const int pos = t - CTXL;
        bf16* row = PQ + (size_t)m * NPP;
        u32x4* p0 = (u32x4*)(row + 8 * lane); u32x4* p1 = (u32x4*)(row + 512 + 8 * lane); u32x4* p3 = (u32x4*)(row + 1536 + 8 * c3);
        float v[8];
        if (lat) {
            const float position = (float)(colpart ? (pos & 63) : (pos >> 6));
            unpack8(w0, v); rope_chunk(v, rf, position, second, 2); *p0 = pack8(v);
            unpack8(w1, v); rope_chunk(v, rf, position, second, 2); *p1 = pack8(v);
        } else { *p0 = w0; *p1 = w1; }
        unpack8(w3, v);
        float ss = 0.f;
#pragma unroll
        for (int e = 0; e < 8; ++e) ss += v[e] * v[e];
        ss += __shfl_xor(ss, 1); ss += __shfl_xor(ss, 2); ss += __shfl_xor(ss, 4); ss += __shfl_xor(ss, 8);
        const float ss16 = ss + __shfl_xor(ss, 16);
        const float ri = (lane < 32) ? 1.0f / sqrtf(ss16 * (1.0f / 256.0f) + RMS_EPS) : 1.0f / sqrtf(ss * (1.0f / 128.0f) + RMS_EPS);
        float vn[8];
#pragma unroll
        for (int e = 0; e < 8; ++e) vn[e] = v[e] * ri * g3[e];
        if (lat) { const float position32 = (float)(colpart32 ? (pos & 63) : (pos >> 6)); rope_chunk(v, rf32, position32, second32, 1); }
        if (lane < 48) *p3 = pack8(vn); else if (lane < 52) { if (lat) *p3 = pack8(v); else *p3 = w3; } else *p3 = (u32x4){0u, 0u, 0u, 0u};
    };
    for (int m = gw; m < T; m += 2 * ngw) {
        { const u32x4 w0 = a0, w1 = a1, w3 = a3; if (m + 2 * ngw < T) PODD_LOAD(m + 2 * ngw, a0, a1, a3); do_row(m, w0, w1, w3); }
        if (m + ngw >= T) break;
        { const u32x4 w0 = b0, w1 = b1, w3 = b3; if (m + 3 * ngw < T) PODD_LOAD(m + 3 * ngw, b0, b1, b3); do_row(m + ngw, w0, w1, w3); }
    }
#undef PODD_LOAD
}
DI int ln_row(const int wg, const int i, const int last) { if (!last) return wg * 288 + i; const int idx = wg * 256 + i; return (idx >> 11) * TPB + CTXL + (idx & 2047); }

DI void ln1_router_table(LAS unsigned char* lds, const float* rw) {
    const int tid = opaque_tid();
    for (int i = 0; i < 32; ++i) { const int idx = tid + NTHR * i, e = idx & 31, k = (idx >> 5) * 2;
        *(LAS unsigned*)(lds + e * 2064 + k * 2) = pk2(rw[k * 32 + e], rw[(k + 1) * 32 + e]); }
}
DI void ln1_router_phase(LAS unsigned char* lds, bf16* X, unsigned char* H8, const float* mod_l, const float* lng, const float* lnb, const float* rw, const float* rb,
                         unsigned* cnt_l, unsigned* list, float* gsort, const int wg, const int last, const int have_table) {
    const int tid = opaque_tid(), lane = tid & 63, wid = __builtin_amdgcn_readfirstlane(tid >> 6);
    constexpr int TROW = 2064;
    LAS unsigned char* wrt = lds; LAS unsigned char* ht = lds + 66048; LAS float* logt = (LAS float*)(lds + 99072);
    LAS unsigned* ent = (LAS unsigned*)(lds + 101376); LAS float* entw = (LAS float*)(ent + 1152); LAS unsigned* lcnt = ent + 2304; LAS unsigned* lbase = lcnt + 32;
    if (!have_table) ln1_router_table(lds, rw);
    if (tid < 32) lcnt[tid] = 0u;
    const int nrows = last ? 256 : 288, nblk = nrows >> 4;
    const int c0 = 16 * lane;
    f32x4 gv[4], bv[4];
#pragma unroll
    for (int j = 0; j < 4; ++j) { gv[j] = *(const f32x4*)(lng + c0 + 4 * j); bv[j] = *(const f32x4*)(lnb + c0 + 4 * j); }
    u32x4 xnext[2][2];
#define LN1_LOAD(blk_) do { _Pragma("unroll") for (int r = 0; r < 2; ++r) { const bf16* xp_ = X + (size_t)ln_row(wg, (blk_) * 16 + 2 * wid + r, last) * DM + c0; \
        xnext[r][0] = *(const u32x4*)xp_; xnext[r][1] = *(const u32x4*)(xp_ + 8); } } while (0)
    LN1_LOAD(0);
    __syncthreads();
    for (int blk = 0; blk < nblk; ++blk) {
        u32x4 xcur[2][2];
#pragma unroll
        for (int r = 0; r < 2; ++r) { xcur[r][0] = xnext[r][0]; xcur[r][1] = xnext[r][1]; }
        if (blk + 1 < nblk) LN1_LOAD(blk + 1);
#pragma unroll
        for (int r = 0; r < 2; ++r) {
            const int m = ln_row(wg, blk * 16 + 2 * wid + r, last); const int b = m / TPB, t = m - b * TPB;
            const float* md = mod_l + (size_t)((t < CTXL) ? 32 : b) * 6144;
            f32x4 v[4]; float s = 0.f;
#pragma unroll
            for (int j = 0; j < 4; ++j) { const unsigned xa = xcur[r][j >> 1][2 * (j & 1)], xb = xcur[r][j >> 1][2 * (j & 1) + 1]; v[j] = (f32x4){bflo(xa), bfhi(xa), bflo(xb), bfhi(xb)}; s += (v[j][0] + v[j][1]) + (v[j][2] + v[j][3]); }
            const float mean = wave_sum(s) * (1.0f / DM); float s2 = 0.f;
#pragma unroll
            for (int j = 0; j < 4; ++j) { v[j] = v[j] - mean; s2 += (v[j][0] * v[j][0] + v[j][1] * v[j][1]) + (v[j][2] * v[j][2] + v[j][3] * v[j][3]); }
            const float rstd = 1.0f / sqrtf(wave_sum(s2) * (1.0f / DM) + LN_EPS);
            LAS unsigned char* hrow = ht + (2 * wid + r) * TROW + c0 * 2;
            u32x4 ho[2], h8;
#pragma unroll
            for (int j = 0; j < 4; ++j) { const f32x4 y = v[j] * rstd * gv[j] + bv[j];
                const f32x4 sh = *(const f32x4*)(md + 3072 + c0 + 4 * j), sc = *(const f32x4*)(md + 4096 + c0 + 4 * j); const f32x4 h = y * (sc + 1.0f) + sh;
                h8[j] = pk4_fp8(h[0], h[1], h[2], h[3]);
                ho[j >> 1][2 * (j & 1)] = pk2(h[0], h[1]); ho[j >> 1][2 * (j & 1) + 1] = pk2(h[2], h[3]); }
            *(u32x4*)(H8 + (size_t)m * DM + c0) = h8;
            *(LAS u32x4*)hrow = ho[0]; *(LAS u32x4*)(hrow + 16) = ho[1];
        }
        __syncthreads();
        if (wid < 2) {
            f32x4 d = {0.f, 0.f, 0.f, 0.f};
            const LAS unsigned char* ap = ht + (lane & 15) * TROW + (lane >> 4) * 16;
            const LAS unsigned char* bp = wrt + (16 * wid + (lane & 15)) * TROW + (lane >> 4) * 16;
#pragma unroll 8
            for (int s = 0; s < 32; ++s) d = __builtin_amdgcn_mfma_f32_16x16x32_bf16(*(const LAS bf16x8*)(ap + 64 * s), *(const LAS bf16x8*)(bp + 64 * s), d, 0, 0, 0);
            const float rbias = rb[16 * wid + (lane & 15)];
#pragma unroll
            for (int i = 0; i < 4; ++i) logt[(4 * (lane >> 4) + i) * 33 + 16 * wid + (lane & 15)] = d[i] + rbias;
        }
        __syncthreads();
        {
            const int half = lane >> 5, e = lane & 31, rr = 2 * wid + half;
            float v = logt[rr * 33 + e];
            float tv[4]; int te[4];
#define MX_DPP(x, ctrl, rmask) __builtin_bit_cast(float, __builtin_amdgcn_update_dpp(__builtin_bit_cast(int, x), __builtin_bit_cast(int, x), ctrl, rmask, 0xf, false))
#pragma unroll
            for (int k = 0; k < 4; ++k) {
                float m = v;
                m = fmaxf(m, MX_DPP(m, 0xB1, 0xf)); m = fmaxf(m, MX_DPP(m, 0x4E, 0xf)); m = fmaxf(m, MX_DPP(m, 0x141, 0xf)); m = fmaxf(m, MX_DPP(m, 0x140, 0xf));
                m = fmaxf(m, MX_DPP(m, 0x142, 0xa));
                const float m0 = __builtin_bit_cast(float, __builtin_amdgcn_readlane(__builtin_bit_cast(int, m), 31)), m1 = __builtin_bit_cast(float, __builtin_amdgcn_readlane(__builtin_bit_cast(int, m), 63));
                const float mh = half ? m1 : m0;
                const unsigned long long bal = __ballot(v == mh);
                const unsigned hm = half ? (unsigned)(bal >> 32) : (unsigned)bal;
                const int bi = __builtin_ctz(hm);
                tv[k] = mh; te[k] = bi;
                v = (e == bi) ? -3.0e38f : v;
            }
#undef MX_DPP
            const float e1 = __expf(tv[1] - tv[0]), e2 = __expf(tv[2] - tv[0]), e3 = __expf(tv[3] - tv[0]); const float rs = 1.0f / (1.0f + e1 + e2 + e3);
            if (e == 0) { const int irow = blk * 16 + rr;
                const float ww[4] = {rs, e1 * rs, e2 * rs, e3 * rs};
#pragma unroll
                for (int k = 0; k < 4; ++k) { const unsigned lr = __hip_atomic_fetch_add(lcnt + te[k], 1u, __ATOMIC_RELAXED, __HIP_MEMORY_SCOPE_WORKGROUP);
                    ent[irow * 4 + k] = (unsigned)te[k] | (lr << 8); entw[irow * 4 + k] = ww[k]; } }
        }
    }
#undef LN1_LOAD
    __syncthreads();
    if (tid < 32) lbase[tid] = __hip_atomic_fetch_add(cnt_l + tid * 64, lcnt[tid], __ATOMIC_RELAXED, __HIP_MEMORY_SCOPE_AGENT);
    __syncthreads();
    for (int sidx = tid; sidx < nrows * 4; sidx += NTHR) { const unsigned en = ent[sidx]; const int e = en & 255u; const unsigned lr = en >> 8;
        const int m = ln_row(wg, sidx >> 2, last); const size_t pos = (size_t)e * T + lbase[e] + lr; list[pos] = (unsigned)m * 4u + (unsigned)(sidx & 3); gsort[pos] = entw[sidx]; }
    __syncthreads();
}
DI void ln2_phase(bf16* X, const unsigned char* Y, bf16* H, float* out, const float* mod_l, const float* mod_n, const float* lng1, const float* lnb1, const float* lng, const float* lnb, const int wg, const int last, const int wid, const int lane) {
    const int nrows = last ? 256 : 288, c0 = 16 * lane;
    f32x4 gv[4], bv[4], gv1[4], bv1[4];
#pragma unroll
    for (int q = 0; q < 4; ++q) { gv[q] = *(const f32x4*)(lng + c0 + 4 * q); bv[q] = *(const f32x4*)(lnb + c0 + 4 * q); gv1[q] = *(const f32x4*)(lng1 + c0 + 4 * q); bv1[q] = *(const f32x4*)(lnb1 + c0 + 4 * q); }
    u32x4 xa[2], ya[4], xb[2], yb[4];
#define LN2_LOAD(mm, XN, YN) do { const bf16* xp_ = X + (size_t)(mm) * DM + c0; const unsigned char* yp_ = Y + (size_t)(mm) * 4 * DM + c0; \
        XN[0] = *(const u32x4*)xp_; XN[1] = *(const u32x4*)(xp_ + 8); \
        _Pragma("unroll") for (int k = 0; k < 4; ++k) YN[k] = *(const u32x4*)(yp_ + (size_t)k * DM); } while (0)
    if (wid < nrows) LN2_LOAD(ln_row(wg, wid, last), xa, ya);
    if (wid + NWAVES < nrows) LN2_LOAD(ln_row(wg, wid + NWAVES, last), xb, yb);
    auto row = [&](const int i, const u32x4 (&xcur)[2], const u32x4 (&ycur)[4]) __attribute__((always_inline)) {
        const int m = ln_row(wg, i, last); const int b = m / TPB, t = m - b * TPB; const int mrow = (t < CTXL) ? 32 : b;
        const float* md = mod_l + (size_t)mrow * 6144;
        bf16* xr = X + (size_t)m * DM + c0;
        f32x4 v[4]; float s = 0.f;
        { float s1 = 0.f;
#pragma unroll
          for (int q = 0; q < 4; ++q) { const unsigned xa = xcur[q >> 1][2 * (q & 1)], xb = xcur[q >> 1][2 * (q & 1) + 1]; v[q] = (f32x4){bflo(xa), bfhi(xa), bflo(xb), bfhi(xb)}; s1 += (v[q][0] + v[q][1]) + (v[q][2] + v[q][3]); }
          const float mean1 = wave_sum(s1) * (1.0f / DM); float q1 = 0.f;
#pragma unroll
          for (int q = 0; q < 4; ++q) { v[q] = v[q] - mean1; q1 += (v[q][0] * v[q][0] + v[q][1] * v[q][1]) + (v[q][2] * v[q][2] + v[q][3] * v[q][3]); }
          const float rstd1 = 1.0f / sqrtf(wave_sum(q1) * (1.0f / DM) + LN_EPS);
#pragma unroll
          for (int q = 0; q < 4; ++q) v[q] = v[q] * rstd1 * gv1[q] + bv1[q]; }
#pragma unroll
        for (int q = 0; q < 4; ++q) { f32x4 y = (f32x4){0.f, 0.f, 0.f, 0.f};
#pragma unroll
            for (int k = 0; k < 4; ++k) { const unsigned w = ycur[k][q]; const f32x2 lo = __builtin_amdgcn_cvt_pk_f32_fp8(w, false), hi2 = __builtin_amdgcn_cvt_pk_f32_fp8(w, true); y += (f32x4){lo[0], lo[1], hi2[0], hi2[1]}; }
            const f32x4 g2 = *(const f32x4*)(md + 5120 + c0 + 4 * q) * (1.0f / Y_SCALE);
            v[q] = v[q] * DN_ALPHA + g2 * y; s += (v[q][0] + v[q][1]) + (v[q][2] + v[q][3]); }
        const float mean = wave_sum(s) * (1.0f / DM); float s2 = 0.f;
#pragma unroll
        for (int q = 0; q < 4; ++q) { v[q] = v[q] - mean; s2 += (v[q][0] * v[q][0] + v[q][1] * v[q][1]) + (v[q][2] * v[q][2] + v[q][3] * v[q][3]); }
        const float rstd = 1.0f / sqrtf(wave_sum(s2) * (1.0f / DM) + LN_EPS);
        if (last) { float* orow = out + ((size_t)b * SEQ + (t - CTXL)) * DM + c0;
#pragma unroll
            for (int q = 0; q < 4; ++q) *(f32x4*)(orow + 4 * q) = v[q] * rstd * gv[q] + bv[q];
        } else { const float* mn = mod_n + (size_t)mrow * 6144 + c0;
            u32x4 xo[2], ho[2];
#pragma unroll
            for (int q = 0; q < 4; ++q) { const f32x4 y = v[q] * rstd * gv[q] + bv[q];
                xo[q >> 1][2 * (q & 1)] = pk2(y[0], y[1]); xo[q >> 1][2 * (q & 1) + 1] = pk2(y[2], y[3]);
                const f32x4 sh = *(const f32x4*)(mn + 4 * q), sc = *(const f32x4*)(mn + 1024 + 4 * q); const f32x4 h = y * (sc + 1.0f) + sh;
                ho[q >> 1][2 * (q & 1)] = pk2(h[0], h[1]); ho[q >> 1][2 * (q & 1) + 1] = pk2(h[2], h[3]); }
            *(u32x4*)xr = xo[0]; *(u32x4*)(xr + 8) = xo[1];
            if (INPROJ_FP8) { u32x4 h8;
#pragma unroll
                for (int q = 0; q < 4; ++q) { const f32x4 y = v[q] * rstd * gv[q] + bv[q]; const f32x4 sh = *(const f32x4*)(mn + 4 * q), sc = *(const f32x4*)(mn + 1024 + 4 * q); const f32x4 h = (y * (sc + 1.0f) + sh) * H_SCALE; h8[q] = pk4_fp8(h[0], h[1], h[2], h[3]); }
                *(u32x4*)((unsigned char*)H + (size_t)m * DM + c0) = h8; }
            else { bf16* hr = H + (size_t)m * DM + c0; *(u32x4*)hr = ho[0]; *(u32x4*)(hr + 8) = ho[1]; }
        }
    };
    for (int i = wid; i < nrows; i += 2 * NWAVES) {
        { u32x4 xc[2], yc[4]; xc[0] = xa[0]; xc[1] = xa[1];
#pragma unroll
          for (int k = 0; k < 4; ++k) yc[k] = ya[k];
          if (i + 2 * NWAVES < nrows) LN2_LOAD(ln_row(wg, i + 2 * NWAVES, last), xa, ya);
          row(i, xc, yc); }
        if (i + NWAVES >= nrows) break;
        { u32x4 xc[2], yc[4]; xc[0] = xb[0]; xc[1] = xb[1];
#pragma unroll
          for (int k = 0; k < 4; ++k) yc[k] = yb[k];
          if (i + 3 * NWAVES < nrows) LN2_LOAD(ln_row(wg, i + 3 * NWAVES, last), xb, yb);
          row(i + NWAVES, xc, yc); }
    }
#undef LN2_LOAD
}

DI void build_expert_table(LAS int* tab, const unsigned* cnt_l) {
    const int tid = opaque_tid();
    __syncthreads();
    if (tid < 32) tab[33 + tid] = (int)__hip_atomic_load(cnt_l + tid * 64, __ATOMIC_RELAXED, __HIP_MEMORY_SCOPE_AGENT);
    __syncthreads();
    if (tid == 0) { int acc = 0; for (int e = 0; e < 32; ++e) { tab[e] = acc; acc += (tab[33 + e] + 255) >> 8; } tab[32] = acc; }
    __syncthreads();
}


DI void attn_phase_even(LAS unsigned char* lds, const bf16* P, const bf16* PQ, unsigned char* MIX, const float* rpb_j, const int G, const int bx, const int shadow) {
    for (int i = 0;; ++i) {
        const int L = i * G + bx;
        att::AttnP p{}; bool na = false, big = false; p.shadow = shadow;
        p.qp = NPP; p.kp = NPP; p.vp = NPP; p.op = DM; p.K2 = P; p.k2p = NPP;
        if (L < 1024) { int b = L >> 5, h = (L >> 2) & 7, qb = L & 3;
            if (G == 256) { const int x = bx & 7, j = bx >> 3, g = x + 8 * (j >> 4), jq = j & 15; b = 8 * i + (g >> 1); h = 4 * (g & 1) + (jq >> 2); qb = jq & 3; }
            const int row0 = b * TPB + CTXL + qb * 512;
            p.Q = PQ + (size_t)row0 * NPP + 1536 + 64 * h; p.K = PQ + 2048 + 64 * (h >> 2); p.V = P + 2176 + 64 * (h >> 2); p.O = MIX + (size_t)row0 * DM + 512 + 64 * h; p.kt0 = b * TPB; p.ntiles = 36; big = true; }
        else if (L < 3072) { const int L2 = L - 1024; int b = L2 >> 6, h = (L2 >> 3) & 7, rg = (L2 + (L2 >> 8)) & 7  ;
            if (G == 256) { const int x = bx & 7, j = bx >> 3, g = x + 8 * (j >> 3); b = 4 * (i - 4) + (g >> 3); h = g & 7; rg = ((j & 7) + i) & 7; }
 const int qr0 = 4 * rg, row0 = b * TPB + CTXL + qr0 * 64;
            p.Q = P + (size_t)row0 * NPP + 64 * h; p.K = P + 512 + 64 * h; p.V = P + 1024 + 64 * h; p.O = MIX + (size_t)row0 * DM + 64 * h;
            p.brow0 = b * TPB; p.na_lo = min(max(qr0 - 4, 0), 24); p.na_nloc = min(max(qr0 - 1, 0), 24) + 7 - p.na_lo + 1; p.ntiles = p.na_nloc + 4; p.qr0 = qr0; p.rpb = rpb_j + h * 465; na = true; }
        else if (L < 3584) { const int L3 = L - 3072, b = L3 >> 4, hh = L3 & 15; const int row0 = b * TPB;
            if (hh < 8) { p.Q = P + (size_t)row0 * NPP + 64 * hh; p.K = P + 512 + 64 * hh; p.V = P + 1024 + 64 * hh; p.O = MIX + (size_t)row0 * DM + 64 * hh; }
            else { const int h = hh - 8; p.Q = PQ + (size_t)row0 * NPP + 1536 + 64 * h; p.K = PQ + 2048 + 64 * (h >> 2); p.V = P + 2176 + 64 * (h >> 2); p.O = MIX + (size_t)row0 * DM + 512 + 64 * h; }
            p.kt0 = row0; p.ntiles = 4; }
        else break;
#ifndef ATT_MASK
#define ATT_MASK 15
#endif
        if (na) { if (ATT_MASK & 1) att::attn_unit<64, 1>(lds, p); } else if (big) { if (ATT_MASK & 2) att::attn_unit_w64<64>(lds, p); } else { if (ATT_MASK & 2) att::attn_unit<64, 0>(lds, p); }
    }
}
DI void attn_phase_odd(LAS unsigned char* lds, const bf16* P, const bf16* PQ, const bf16* QM, const bf16* KVM, unsigned char* MIX, const float lam, const float oml, const float* subln, const int G, const int bx, const int last, const int shadow) {
    const int total = last ? 2048 : 2432;
    for (int i = 0;; ++i) {
        const int L = i * G + bx; if (L >= total) break;
        att::AttnP p{}; bool diff = false, big = false; p.shadow = shadow;
        p.op = DM; p.K2 = PQ + 1920; p.k2p = NPP;
        if (L < 1024 || (L >= 2048 && L < 2176)) { int b, h, row0;
            if (L < 1024) { b = L >> 5; h = (L >> 3) & 3; int qb = L & 7;
                if (G == 256) { const int x = bx & 7, j = bx >> 3, g = x + 8 * (j >> 3); b = 8 * i + (g >> 2); h = g & 3; qb = j & 7; }
                row0 = b * TPB + CTXL + qb * 256; p.ntiles = 36; } else { const int L3 = L - 2048; b = L3 >> 2; h = L3 & 3; row0 = b * TPB; p.ntiles = 4; }
            p.Q = PQ + (size_t)row0 * NPP + 128 * h; p.qp = NPP; p.K = PQ + 512 + 128 * h; p.kp = NPP; p.V = P + 1024 + 128 * h; p.vp = NPP; p.O = MIX + (size_t)row0 * DM + 128 * h; p.kt0 = b * TPB; diff = true; }
        else { int b, h, row0;
            if (L < 2048) { const int L2 = L - 1024; b = L2 >> 5; h = (L2 >> 2) & 7; int qb = L2 & 3;
                if (G == 256) { const int x = bx & 7, j = bx >> 3, g = x + 8 * (j >> 2); b = 8 * (i - 4) + (g >> 3); h = g & 7; qb = j & 3; }
                row0 = b * TPB + CTXL + qb * 512; p.ntiles = 36; p.rope_q = 1; p.qpos0 = qb * 512; big = true; }
            else { const int L4 = L - 2176; b = L4 >> 3; h = L4 & 7; row0 = b * TPB; p.ntiles = 4; p.rope_q = 0; p.qpos0 = 0; }
            p.Q = QM + (size_t)row0 * 768 + 96 * h; p.qp = 768; p.K = KVM + 128 * h; p.kp = DM; p.V = KVM + 128 * h + 64; p.vp = DM; p.O = MIX + (size_t)row0 * DM + 512 + 64 * h; p.kt0 = b * TPB; }
        if (diff) { if (ATT_MASK & 4) att::attn_unit_diff(lds, p, lam, oml, subln); } else if (big) { if (ATT_MASK & 8) att::attn_unit_w64<96>(lds, p); } else { if (ATT_MASK & 8) att::attn_unit<96, 0>(lds, p); }
    }
}

constexpr int NPHASE = 2 + 9 * NL;
struct Args { const float* in[32]; float* out; unsigned char* ws; int ph_lo, ph_hi, li, pad; };
__global__ void __launch_bounds__(NTHR, 2) fwd(Args a) {
    extern __shared__ __attribute__((aligned(16))) unsigned char lds_raw[];
    LAS unsigned char* lds = (LAS unsigned char*)lds_raw;
    volatile LAS unsigned* MISC = (volatile LAS unsigned*)(lds + MISC_OFF);
    LAS int* tab = (LAS int*)(lds + MISC_OFF + 256);
    LAS int* utab = (LAS int*)(lds + pg8::UTAB_OFF); LAS unsigned* rtab = (LAS unsigned*)(lds + pg8::RTAB_OFF);
    const int tid = opaque_tid(), lane = tid & 63, wid = __builtin_amdgcn_readfirstlane(tid >> 6);
    const int G = gridDim.x, bx = blockIdx.x, gw = bx * NWAVES + wid, ngw = G * NWAVES;
    for (int u = tid; u < (LDS_BYTES - MISC_OFF) / 4; u += NTHR) MISC[u] = 0u;
    __syncthreads();
    unsigned char* ws = a.ws;
    unsigned* ctl = (unsigned*)(ws + WS_CTL);
    const int lo = a.ph_lo, hi = a.ph_hi;
    XcdBarrier bar; bar.bar = ctl + CW_BAR + a.li * XCD_BAR_WORDS; bar.x = 0; bar.st = MISC;
    if (hi - lo > 1) bar = xcd_barrier_post(ctl + CW_BAR + a.li * XCD_BAR_WORDS, MISC);
#ifndef PH_MASK
#define PH_MASK 0x7ff
#endif
#define PHM(k) (((PH_MASK) >> ((k) < 2 ? (k) : 2 + ((k) - 2) % 9)) & 1)
#define IN(k) (PHM(k) && lo <= (k) && (k) < hi)
#ifndef PROBE_DUP
#define PROBE_DUP 0
#endif
#define NREP(kind) (1 + (((PROBE_DUP) >> (kind)) & 1))
#define SEAM(k) do { if (lo <= (k) && (k) + 1 < hi) xcd_barrier(bar); } while (0)
    float* mod = (float*)(ws + WS_MOD);
    bf16* X = (bf16*)(ws + WS_X); bf16* H = (bf16*)(ws + WS_H); bf16* P = (bf16*)(ws + WS_P); bf16* QM = (bf16*)(ws + WS_QM); bf16* KVM = (bf16*)(ws + WS_KVM);
    bf16* PQ = (bf16*)(ws + WS_PQ);
    unsigned char* MIX = ws + WS_MIX; unsigned char* ACT = ws + WS_ACT; unsigned char* H8 = ws + WS_H8; unsigned char* Y = ws + WS_Y;
    unsigned* list = (unsigned*)(ws + WS_LIST); float* gsort = (float*)(ws + WS_GSORT);

    if (IN(0)) for (int rep = 0; rep < NREP(0); ++rep) {
        for (int it = bx; it < 192; it += G) p0_mod_item(lds, a.in[1], a.in[3], a.in[4], a.in[5], mod, it);
        p0_transposes(lds, a.in, ws, gw, ngw, wid, lane);
        p0_zero(ws, bx * NTHR + tid, G * NTHR);
    }
    SEAM(0);
    if (IN(1)) p0b_rows(a.in[0], a.in[2], mod, X, H, gw, ngw, lane);
    SEAM(1);
    for (int l = 0; l < NL; ++l) {
        const int tid = opaque_tid(), lane = tid & 63, wid = __builtin_amdgcn_readfirstlane(tid >> 6), gw = bx * NWAVES + wid;
        const int pb = 2 + 9 * l, odd = l & 1, j = l >> 1, last = (l == NL - 1) ? 1 : 0;
        const float* mod_l = mod + (size_t)l * 33 * 6144;
        unsigned* cnt_l = ctl + CW_CNT + l * 32 * 64;
        if (IN(pb + 0)) for (int rep = 0; rep < NREP(2); ++rep) {
#if INPROJ_FP8
            pg8::DenseSched S; S.init(H, 512, (const bf16*)(ws + WS_WIN) + (size_t)l * 2304 * 1024, 512, NTILE_M, odd ? 8 : 9, G, bx, 0);
            pg8::EpiBf16 E{P, NPP, 1.0f / (WI_SCALE * H_SCALE)};
            pg8::gemm_phase<true>(lds, 1024, S, E);
#else
            pg8::DenseSched S; S.init(H, DM, (const bf16*)(ws + WS_WIN) + (size_t)l * 2304 * 1024, 1024, NTILE_M, odd ? 8 : 9, G, bx, 0);
            pg8::EpiBf16 E{P, NPP, 1.0f};
            pg8::gemm_phase<false>(lds, 2048, S, E);
#endif
        }
        SEAM(pb + 0);
        if (IN(pb + 1)) {
            if (odd) post_odd_rows(P, PQ, a.in[22] + j * 256, a.in[24] + j * 128, gw, ngw, lane);
            else post_even_rows(P, PQ, a.in[13] + j * 64, a.in[14] + j * 64, gw, ngw, lane);
        }
        SEAM(pb + 1);
        if (odd) {
            if (IN(pb + 2)) for (int rep = 0; rep < NREP(4); ++rep) {
                { pg8::DenseSched S; S.init(PQ + 1536, NPP, (const bf16*)(ws + WS_WUQ) + (size_t)j * 768 * 256, 256, NTILE_M, 3, G, bx, 0); pg8::EpiBf16 E{QM, 768, 1.0f}; pg8::gemm_phase<false>(lds, 512, S, E); }
                { pg8::DenseSched S; S.init(PQ + 1792, NPP, (const bf16*)(ws + WS_WUKV) + (size_t)j * 1024 * 256, 256, NTILE_M, 4, G, (bx + G - (NTILE_M * 3) % G) % G, 0); pg8::EpiBf16 E{KVM, DM, 1.0f}; pg8::gemm_phase<false>(lds, 512, S, E); }
            }
            SEAM(pb + 2);
        }
        if (IN(pb + 3)) for (int rep = 0; rep < NREP(5); ++rep) {
            if (odd) {
                const float s1 = wave_sum(a.in[17][j * 64 + lane] * a.in[18][j * 64 + lane]), s2 = wave_sum(a.in[19][j * 64 + lane] * a.in[20][j * 64 + lane]);
                const float lam_init = (l == 1) ? 0.35550906759310934f : 0.55605820415610350f;
                const float lam = __expf(s1) - __expf(s2) + lam_init;
#ifndef PROBE_SHADOW
#define PROBE_SHADOW 0
#endif
                attn_phase_odd(lds, P, PQ, QM, KVM, rep ? ACT : MIX, lam, 1.0f - lam_init, a.in[21] + j * 128, G, bx, last, rep ? PROBE_SHADOW : 0);
            } else attn_phase_even(lds, P, PQ, rep ? ACT : MIX, a.in[12] + (size_t)j * 8 * 465, G, bx, rep ? PROBE_SHADOW : 0);
        }
        SEAM(pb + 3 - ((odd || true) ? 0 : 0));
        if (IN(pb + 4)) {
            pg8::DenseSched S; S.init((const bf16*)MIX, 512, (const bf16*)(ws + WS_WOUT + (size_t)l * 1024 * 1024), 512, last ? 256 : NTILE_M, 4, G, bx, last);
            pg8::EpiResid E{X, mod_l};
            pg8::gemm_phase<true>(lds, 1024, S, E);
        }
        const int pre_rt = (IN(pb + 4) && IN(pb + 5) && G == 256) ? 1 : 0;
        if (pre_rt) { __syncthreads(); ln1_router_table(lds, a.in[26] + (size_t)l * 1024 * 32); }
        SEAM(pb + 4);
        if (IN(pb + 5)) {
            for (int wg = bx; wg < 256; wg += G)
                ln1_router_phase(lds, X, H8, mod_l, a.in[6] + l * 1024, a.in[7] + l * 1024, a.in[26] + (size_t)l * 1024 * 32, a.in[27] + l * 32, cnt_l, list, gsort, wg, last, pre_rt);
        }
        SEAM(pb + 5);
        if (IN(pb + 6)) for (int rep = 0; rep < NREP(8); ++rep) {
            build_expert_table(tab, cnt_l);
            const int nun = pg8::build_unit_table(tab, utab, 8, G, bx);
            pg8::GroupSched S{tab, utab, rtab, nun, 8, G, bx, 1024, (const char*)H8, list, gsort, 1, (const char*)(ws + WS_WGU + (size_t)l * 32 * 2048 * 1024), (size_t)2048 * 1024, a.in[29] + (size_t)l * 32 * 2048, 2048};
            S.fill_sync(0, tid); S.fill_sync(1, tid); __syncthreads();
            pg8::EpiSwiglu E{ACT, rtab};
            pg8::gemm_phase<true>(lds, 1024, S, E);
        }
        int nun_d = -1;
        if (IN(pb + 6) && IN(pb + 7) && NREP(9) == 1) {
            __syncthreads();
            build_expert_table(tab, cnt_l);
            nun_d = pg8::build_unit_table(tab, utab, 4, G, bx);
            pg8::GroupSched S{tab, utab, rtab, nun_d, 4, G, bx, 1024, (const char*)ACT, list, gsort, 0, (const char*)(ws + WS_WD + (size_t)l * 32 * 1024 * 1024), (size_t)1024 * 1024, a.in[31] + (size_t)l * 32 * 1024, 1024};
            S.fill_sync(0, tid);
        }
        SEAM(pb + 6);
        if (IN(pb + 7)) for (int rep = 0; rep < NREP(9); ++rep) {
            int nun = nun_d;
            if (nun_d < 0) { build_expert_table(tab, cnt_l); nun = pg8::build_unit_table(tab, utab, 4, G, bx); }
            pg8::GroupSched S{tab, utab, rtab, nun, 4, G, bx, 1024, (const char*)ACT, list, gsort, 0, (const char*)(ws + WS_WD + (size_t)l * 32 * 1024 * 1024), (size_t)1024 * 1024, a.in[31] + (size_t)l * 32 * 1024, 1024};
            if (nun_d < 0) S.fill_sync(0, tid);
            __syncthreads();
            pg8::EpiDown E{Y, rtab, tab};
            pg8::gemm_phase<true>(lds, 1024, S, E);
        }
        SEAM(pb + 7);
        if (IN(pb + 8)) {
            for (int wg = bx; wg < 256; wg += G)
                ln2_phase(X, Y, H, a.out, mod_l, mod + (size_t)(last ? l : l + 1) * 33 * 6144, a.in[6] + l * 1024, a.in[7] + l * 1024, a.in[8] + l * 1024, a.in[9] + l * 1024, wg, last, wid, lane);
        }
        SEAM(pb + 8);
    }
#undef IN
#undef SEAM
}

extern "C" void kernel_launch(void* const* d_in, const int* in_sizes, int n_in, void* d_out, int out_size, void* d_ws, size_t ws_size, hipStream_t stream) {
    static int grid = 0;
    if (grid == 0) {
        if (n_in != 32 || ws_size < WS_END || out_size != NBATCH * SEQ * DM) { fprintf(stderr, "kernel_launch: unexpected shapes (n_in %d, out %d, ws %zu)\n", n_in, out_size, ws_size); grid = -1; return; }
        int dev = 0, cus = 0, per_cu = 0;
        if (hipGetDevice(&dev) != hipSuccess || hipDeviceGetAttribute(&cus, hipDeviceAttributeMultiprocessorCount, dev) != hipSuccess) { grid = -1; return; }
        if (hipFuncSetAttribute((const void*)fwd, hipFuncAttributeMaxDynamicSharedMemorySize, LDS_BYTES) != hipSuccess) { fprintf(stderr, "kernel_launch: hipFuncSetAttribute failed\n"); grid = -1; return; }
        if (hipOccupancyMaxActiveBlocksPerMultiprocessor(&per_cu, (const void*)fwd, NTHR, LDS_BYTES) != hipSuccess || per_cu < 1) fprintf(stderr, "kernel_launch: occupancy query reports %d\n", per_cu);
        (void)hipGetLastError();
        grid = cus < 256 ? cus : 256;
    }
    if (grid < 0) return;
    (void)hipMemsetAsync((char*)d_ws + WS_CTL, 0, CTL_ZERO_BYTES, stream);
    Args a{};
    for (int i = 0; i < 32; ++i) a.in[i] = (const float*)d_in[i];
    a.out = (float*)d_out; a.ws = (unsigned char*)d_ws;
#if MK_ONE_LAUNCH
    a.ph_lo = 0; a.ph_hi = NPHASE; a.li = 0;
    hipLaunchKernelGGL(fwd, dim3(grid), dim3(NTHR), LDS_BYTES, stream, a);
#else
    int li = 0;
    for (int ph = 0; ph < NPHASE; ++ph) {
        if (ph >= 2 && ((ph - 2) % 9) == 2 && (((ph - 2) / 9) & 1) == 0) continue;
        a.ph_lo = ph; a.ph_hi = ph + 1; a.li = 0; ++li;
        hipLaunchKernelGGL(fwd, dim3(grid), dim3(NTHR), LDS_BYTES, stream, a);
    }
#endif
}
```
